# Optimizing an MI355X kernel written in HIP

```python
import math
import jax, jax.numpy as jnp
from jax import lax
import numpy as np

D_MODEL = 1024
BATCH = 8
SEQ = 2048
DEPTH = 4

N_MIXERS = 2
N_CONV_LAYERS = (DEPTH + N_MIXERS - 1) // N_MIXERS
N_ATTN_LAYERS = DEPTH // N_MIXERS
CONV_WIDTH = 3
N_HEADS = 16
KV_LATENT = 128
N_IDX_HEADS = 8
IDX_DIM = 64
TOPK_MAX = 256
Q_BLOCK = 128
ATTN_IN_WIDTH = N_HEADS * KV_LATENT + KV_LATENT + N_IDX_HEADS * IDX_DIM + IDX_DIM + N_IDX_HEADS
N_BUCKETS = 32
MAX_DISTANCE = 128
N_GROUPS = 8
EXPERTS_PER_GROUP = 8
N_EXPERTS = N_GROUPS * EXPERTS_PER_GROUP
TOPK_IN_GROUP = 2
D_EXPERT = 256
MOE_BLOCK = 128
LN_EPS = 1e-5
RMS_EPS = 1e-6
DEEPNORM_ALPHA = (2.0 * DEPTH) ** 0.25
DEEPNORM_BETA = (8.0 * DEPTH) ** -0.25

kernel_name = "hybrid_conv_dsa_hmoe_deepnorm"


def layer_norm(x, g, b):
    xf = x.astype(jnp.float32)
    mu = jnp.mean(xf, axis=-1, keepdims=True)
    var = jnp.mean(jnp.square(xf - mu), axis=-1, keepdims=True)
    y = (xf - mu) * lax.rsqrt(var + LN_EPS) * g.astype(jnp.float32) + b.astype(jnp.float32)
    return y.astype(x.dtype)


def rms_norm(x, g):
    xf = x.astype(jnp.float32)
    y = xf * lax.rsqrt(jnp.mean(jnp.square(xf), axis=-1, keepdims=True) + RMS_EPS) * g.astype(jnp.float32)
    return y.astype(x.dtype)


def t5_bucket(dist):
    max_exact = N_BUCKETS // 2
    d_f = jnp.maximum(dist, 1).astype(jnp.float32)
    large = max_exact + (jnp.log(d_f / max_exact) / math.log(MAX_DISTANCE / max_exact)
                         * (N_BUCKETS - max_exact)).astype(jnp.int32)
    large = jnp.minimum(large, N_BUCKETS - 1)
    return jnp.where(dist < max_exact, dist, large)


def short_conv_mixer(x, w_in, conv_k, w_out):
    S = x.shape[1]
    b_gate, c_gate, h = jnp.split(x @ w_in, 3, axis=-1)
    u = c_gate * h
    up = jnp.pad(u, ((0, 0), (CONV_WIDTH - 1, 0), (0, 0)))
    conv = up[:, 0:S] * conv_k[0]
    for j in range(1, CONV_WIDTH):
        conv = conv + up[:, j:j + S] * conv_k[j]
    return (b_gate * conv) @ w_out


def dsa_mixer(x, w_in, kv_norm_g, kidx_ln_g, kidx_ln_b, w_out, rel_bias):
    Bsz, S, _ = x.shape
    topk = min(TOPK_MAX, S // 4)
    hq = N_HEADS * KV_LATENT
    cuts = [hq, hq + KV_LATENT, hq + KV_LATENT + N_IDX_HEADS * IDX_DIM,
            hq + KV_LATENT + N_IDX_HEADS * IDX_DIM + IDX_DIM]
    q, c_kv, q_idx, k_idx, w_idx = jnp.split(x @ w_in, cuts, axis=-1)
    q = q.reshape(Bsz, S, N_HEADS, KV_LATENT)
    c_kv = rms_norm(c_kv, kv_norm_g)
    q_idx = q_idx.reshape(Bsz, S, N_IDX_HEADS, IDX_DIM)
    k_idx = layer_norm(k_idx, kidx_ln_g, kidx_ln_b)
    w_idx = w_idx * (N_IDX_HEADS ** -0.5)
    nb = S // Q_BLOCK
    key_pos = jnp.arange(S)

    def to_blocks(a):
        return jnp.moveaxis(a.reshape(Bsz, nb, Q_BLOCK, *a.shape[2:]), 1, 0)

    def block_fn(args):
        qb, qib, wb, blk = args
        t = blk * Q_BLOCK + jnp.arange(Q_BLOCK)
        s_idx = jnp.einsum('bthd,bsd->bths', qib, k_idx,
                           preferred_element_type=jnp.float32) * (IDX_DIM ** -0.5)
        score = jnp.einsum('bths,bth->bts', jax.nn.relu(s_idx), wb.astype(jnp.float32))
        causal = key_pos[None, :] <= t[:, None]
        score = jnp.where(causal[None], score, -jnp.inf)
        _, sel = lax.top_k(score, topk)
        valid = sel <= t[None, :, None]
        kv_sel = jax.vmap(lambda c, i: c[i])(c_kv, sel)
        logits = jnp.einsum('bthc,btjc->bthj', qb, kv_sel,
                            preferred_element_type=jnp.float32) * (KV_LATENT ** -0.5)
        bucket = t5_bucket(jnp.maximum(t[None, :, None] - sel, 0))
        bias = jnp.moveaxis(rel_bias[bucket], -1, 2)
        logits = logits + bias.astype(jnp.float32)
        logits = jnp.where(valid[:, :, None, :], logits, -jnp.inf)
        p = jax.nn.softmax(logits, axis=-1).astype(x.dtype)
        o = jnp.einsum('bthj,btjc->bthc', p, kv_sel)
        return o.reshape(Bsz, Q_BLOCK, hq)

    o = lax.map(block_fn, (to_blocks(q), to_blocks(q_idx), to_blocks(w_idx), jnp.arange(nb)))
    o = jnp.moveaxis(o, 0, 1).reshape(Bsz, S, hq)
    return o @ w_out


def hier_moe(x, wg, bg, we, be, w1, w3, w2):
    Bsz, S, D = x.shape
    xt = x.reshape(-1, D)
    T = xt.shape[0]
    g_logits = (xt @ wg + bg).astype(jnp.float32)
    g_prob = jax.nn.softmax(g_logits, axis=-1)
    g_top = jnp.argmax(g_logits, axis=-1)
    g_gate = jnp.take_along_axis(g_prob, g_top[:, None], axis=-1)
    e_logits = (xt @ we + be).astype(jnp.float32).reshape(T, N_GROUPS, EXPERTS_PER_GROUP)
    e_logits = jnp.take_along_axis(e_logits, g_top[:, None, None], axis=1)[:, 0]
    e_val, e_loc = lax.top_k(e_logits, TOPK_IN_GROUP)
    gate = jax.nn.softmax(e_val, axis=-1) * g_gate
    e_id = g_top[:, None] * EXPERTS_PER_GROUP + e_loc
    N = T * TOPK_IN_GROUP
    flat_e = e_id.reshape(-1).astype(jnp.int32)
    flat_tok = jnp.repeat(jnp.arange(T, dtype=jnp.int32), TOPK_IN_GROUP)
    flat_w = gate.reshape(-1)
    order = jnp.argsort(flat_e)
    e_s, tok_s, w_s = flat_e[order], flat_tok[order], flat_w[order]
    counts = jax.ops.segment_sum(jnp.ones_like(flat_e), flat_e, num_segments=N_EXPERTS)
    padded = (counts + MOE_BLOCK - 1) // MOE_BLOCK * MOE_BLOCK
    start = jnp.cumsum(counts) - counts
    pend = jnp.cumsum(padded)
    pstart = pend - padded
    dest = pstart[e_s] + jnp.arange(N, dtype=jnp.int32) - start[e_s]
    R = (-(-N // MOE_BLOCK) + N_EXPERTS) * MOE_BLOCK
    row_tok = jnp.zeros((R,), jnp.int32).at[dest].set(tok_s)
    row_w = jnp.zeros((R,), jnp.float32).at[dest].set(w_s)
    nblk = R // MOE_BLOCK
    blk_e = jnp.minimum(jnp.searchsorted(pend, jnp.arange(nblk, dtype=jnp.int32) * MOE_BLOCK,
                                         side='right'), N_EXPERTS - 1)
    xs = xt[row_tok].reshape(nblk, MOE_BLOCK, D)

    def expert_block(args):
        xb, e = args
        h = jax.nn.silu(xb @ w1[e]) * (xb @ w3[e])
        return h @ w2[e]

    ys = lax.map(expert_block, (xs, blk_e)).reshape(R, D)
    out = jnp.zeros_like(xt).at[row_tok].add(ys * row_w[:, None].astype(ys.dtype))
    return out.reshape(Bsz, S, D)


def setup_inputs(seed: int = 0) -> dict:
    key = jax.random.key(seed)
    ks = jax.random.split(key, 24)
    D = D_MODEL
    f32 = jnp.float32

    def nrm(k, shape, scale):
        return jax.random.normal(k, shape, f32) * scale

    return {
        "x": nrm(ks[0], (BATCH, SEQ, D), 1.0),
        "conv_w_in": nrm(ks[1], (N_CONV_LAYERS, D, 3 * D), D ** -0.5),
        "conv_k": nrm(ks[2], (N_CONV_LAYERS, CONV_WIDTH, D), CONV_WIDTH ** -0.5),
        "conv_w_out": nrm(ks[3], (N_CONV_LAYERS, D, D), DEEPNORM_BETA * D ** -0.5),
        "attn_w_in": nrm(ks[4], (N_ATTN_LAYERS, D, ATTN_IN_WIDTH), D ** -0.5),
        "kv_norm_g": 1.0 + nrm(ks[5], (N_ATTN_LAYERS, KV_LATENT), 0.02),
        "kidx_ln_g": 1.0 + nrm(ks[6], (N_ATTN_LAYERS, IDX_DIM), 0.02),
        "kidx_ln_b": nrm(ks[7], (N_ATTN_LAYERS, IDX_DIM), 0.02),
        "attn_w_out": nrm(ks[8], (N_ATTN_LAYERS, N_HEADS * KV_LATENT, D),
                          DEEPNORM_BETA * (N_HEADS * KV_LATENT) ** -0.5),
        "rel_bias": nrm(ks[9], (N_BUCKETS, N_HEADS), 0.5),
        "router_wg": nrm(ks[10], (DEPTH, D, N_GROUPS), D ** -0.5),
        "router_bg": nrm(ks[11], (DEPTH, N_GROUPS), 0.01),
        "router_we": nrm(ks[12], (DEPTH, D, N_EXPERTS), D ** -0.5),
        "router_be": nrm(ks[13], (DEPTH, N_EXPERTS), 0.01),
        "exp_w1": nrm(ks[14], (DEPTH, N_EXPERTS, D, D_EXPERT), D ** -0.5),
        "exp_w3": nrm(ks[15], (DEPTH, N_EXPERTS, D, D_EXPERT), D ** -0.5),
        "exp_w2": nrm(ks[16], (DEPTH, N_EXPERTS, D_EXPERT, D), DEEPNORM_BETA * D_EXPERT ** -0.5),
        "ln1_g": 1.0 + nrm(ks[17], (DEPTH, D), 0.02),
        "ln1_b": nrm(ks[18], (DEPTH, D), 0.02),
        "ln2_g": 1.0 + nrm(ks[19], (DEPTH, D), 0.02),
        "ln2_b": nrm(ks[20], (DEPTH, D), 0.02),
    }


def reference(x, conv_w_in, conv_k, conv_w_out, attn_w_in, kv_norm_g, kidx_ln_g, kidx_ln_b,
              attn_w_out, rel_bias, router_wg, router_bg, router_we, router_be,
              exp_w1, exp_w3, exp_w2, ln1_g, ln1_b, ln2_g, ln2_b):
    for i in range(DEPTH):
        j = i // N_MIXERS
        if i % N_MIXERS == 0:
            m = short_conv_mixer(x, conv_w_in[j], conv_k[j], conv_w_out[j])
        else:
            m = dsa_mixer(x, attn_w_in[j], kv_norm_g[j], kidx_ln_g[j], kidx_ln_b[j],
                          attn_w_out[j], rel_bias)
        x = layer_norm(DEEPNORM_ALPHA * x + m, ln1_g[i], ln1_b[i])
        f = hier_moe(x, router_wg[i], router_bg[i], router_we[i], router_be[i],
                     exp_w1[i], exp_w3[i], exp_w2[i])
        x = layer_norm(DEEPNORM_ALPHA * x + f, ln2_g[i], ln2_b[i])
    return x
```

```cpp
#include <hip/hip_runtime.h>
#include <cstdio>
#include <cstdint>

#define LAS __attribute__((address_space(3)))
#define GAS __attribute__((address_space(1)))
typedef unsigned short bf16_t;
typedef short bf16x8 __attribute__((ext_vector_type(8)));
typedef float f32x4 __attribute__((ext_vector_type(4)));
typedef float f32x2 __attribute__((ext_vector_type(2)));
typedef float f32x16 __attribute__((ext_vector_type(16)));
typedef unsigned u32x4 __attribute__((ext_vector_type(4)));
typedef unsigned u32x2 __attribute__((ext_vector_type(2)));

constexpr int T_TOK = 16384, DM = 1024, NBATCH = 8, SEQ = 2048, DEPTH = 4;
constexpr int NH = 16, KVL = 128, NIH = 8, IDXD = 64, TOPK = 256;
constexpr int AIW = 2760, AIWP = 2816;
constexpr int NGRP = 8, EPG = 8, NEXP = 64, DEXP = 256;
constexpr float LN_EPS = 1e-5f, RMS_EPS = 1e-6f;
constexpr float ALPHA = 1.6817928305074290f;
constexpr int NWAVES = 8, NTHREADS = 512;
constexpr int MAXBLK = 192;

constexpr size_t MiB = 1u << 20;
constexpr size_t alup(size_t x) { return (x + MiB - 1) & ~(MiB - 1); }
constexpr size_t WS_CTL = 0, CTL_BYTES = MiB;
constexpr size_t WS_VEC = WS_CTL + CTL_BYTES;
constexpr size_t WS_CSCI = WS_VEC + MiB;
constexpr size_t WS_BSCI = WS_CSCI + 2 * 3072 * 4;
constexpr size_t WS_CSAI = WS_BSCI + 2 * 3072 * 4;
constexpr size_t WS_BSAI = WS_CSAI + 2 * AIWP * 4;
constexpr size_t WS_CSR  = WS_BSAI + 2 * AIWP * 4;
constexpr size_t WS_BSR  = WS_CSR + 4 * 96 * 4;
constexpr size_t WS_CSUP = alup(WS_BSR + 4 * 96 * 4);
constexpr size_t WS_BSUP = WS_CSUP + (size_t)4 * 64 * 512 * 4;
constexpr size_t WS_WCI  = alup(WS_BSUP + (size_t)4 * 64 * 512 * 4);
constexpr size_t WS_WCO  = WS_WCI + (size_t)2 * 3072 * 1024 * 2;
constexpr size_t WS_WAI  = WS_WCO + (size_t)2 * 1024 * 1024 * 2;
constexpr size_t WS_WAO  = alup(WS_WAI + (size_t)2 * AIWP * 1024 * 2);
constexpr size_t WS_WR   = WS_WAO + (size_t)2 * 1024 * 2048 * 2;
constexpr size_t WS_WUP  = alup(WS_WR + (size_t)4 * 2 * 96 * 1024 * 2);
constexpr size_t WS_WDN  = WS_WUP + (size_t)4 * 64 * 512 * 1024 * 2;
constexpr size_t WS_ZA   = WS_WDN + (size_t)4 * 64 * 1024 * 256 * 2;
constexpr size_t WS_ZB   = WS_ZA + (size_t)T_TOK * DM * 2;
constexpr size_t WS_STA  = WS_ZB + (size_t)T_TOK * DM * 2;
constexpr size_t WS_STB  = WS_STA + (size_t)T_TOK * 8;
constexpr size_t WS_PART = alup(WS_STB + (size_t)T_TOK * 8);
constexpr size_t WS_U    = WS_PART + (size_t)T_TOK * 16 * 8;
constexpr size_t WS_BG   = WS_U + (size_t)T_TOK * DM * 2;
constexpr size_t WS_Y    = WS_BG + (size_t)T_TOK * DM * 2;
constexpr size_t WS_Q    = WS_Y + (size_t)T_TOK * DM * 2;
constexpr size_t WS_QI   = WS_Q + (size_t)T_TOK * 2048 * 2;
constexpr size_t WS_MISC = WS_QI + (size_t)T_TOK * 512 * 2;
constexpr size_t WS_CKV  = WS_MISC + (size_t)T_TOK * 256 * 4;
constexpr size_t WS_KI   = WS_CKV + (size_t)T_TOK * 128 * 2;
constexpr size_t WS_SEL  = WS_KI + (size_t)T_TOK * 64 * 2;
constexpr size_t WS_O    = WS_SEL + (size_t)T_TOK * 256 * 2;
constexpr size_t WS_LIST = WS_O + (size_t)T_TOK * 2048 * 2;
constexpr size_t WS_GATE = WS_LIST + (size_t)64 * 16384 * 4;
constexpr size_t WS_H    = alup(WS_GATE + (size_t)T_TOK * 8);
constexpr size_t WS_YM   = WS_H + (size_t)MAXBLK * 256 * 256 * 2;
constexpr size_t WS_CSP  = WS_YM + (size_t)T_TOK * 2 * DM * 2;
constexpr size_t WS_Z8   = WS_CSP + (size_t)2 * 32 * 4 * 64 * 512 * 4;
constexpr size_t WS_ZA8  = WS_Z8 + (size_t)T_TOK * DM;
constexpr size_t WS_END  = WS_ZA8 + (size_t)T_TOK * DM;

constexpr int CW_BAR = 4096;
constexpr int CW_CNT = 16384;
constexpr int CW_XCC = 8192;
constexpr int CW_QUEUE = 20480;
constexpr int CW_DONE = 24576;

constexpr int LDS_STAGE = 0, STAGE_BYTES_ALL = 131072;
constexpr int LDS_AUX = 131072;
constexpr int LDS_MISC = 131072 + 31744;
constexpr int LDS_BYTES = 163840;

__device__ __forceinline__ unsigned f2bf(float f) { unsigned u = __builtin_bit_cast(unsigned, f); return (u + 0x7fffu + ((u >> 16) & 1u)) >> 16; }
__device__ __forceinline__ float bf2f(unsigned b) { return __builtin_bit_cast(float, b << 16); }
__device__ __forceinline__ unsigned pk2(float lo, float hi) { return f2bf(lo) | (f2bf(hi) << 16); }
__device__ __forceinline__ float bflo(unsigned w) { return __builtin_bit_cast(float, w << 16); }
__device__ __forceinline__ float bfhi(unsigned w) { return __builtin_bit_cast(float, w & 0xffff0000u); }
__device__ __forceinline__ float shx(float v, int o, int lane) { return __builtin_bit_cast(float, __builtin_amdgcn_ds_bpermute((lane ^ o) << 2, __builtin_bit_cast(int, v))); }
__device__ __forceinline__ float wave_sum(float v, int lane) {
#pragma unroll
    for (int o = 1; o < 64; o <<= 1) v += shx(v, o, lane);
    return v;
}
__device__ __forceinline__ void st16wt(void* p, const u32x4 v) { asm volatile("global_store_dwordx4 %0, %1, off sc1\n\ts_nop 1" :: "v"(p), "v"(v) : "memory"); }
typedef int i32x8 __attribute__((ext_vector_type(8)));
__device__ __forceinline__ unsigned pk4_fp8(float a, float b, float c, float d) { int w = 0; w = __builtin_amdgcn_cvt_pk_fp8_f32(a, b, w, false); w = __builtin_amdgcn_cvt_pk_fp8_f32(c, d, w, true); return (unsigned)w; }
__device__ __forceinline__ float fp8_rt(float a) { const int w = __builtin_amdgcn_cvt_pk_fp8_f32(a, a, 0, false); return __builtin_amdgcn_cvt_f32_fp8(w, 0); }
__device__ __forceinline__ void st8wt(void* p, const u32x2 v) { __hip_atomic_store((unsigned long long*)p, ((unsigned long long)v.y << 32) | v.x, __ATOMIC_RELAXED, __HIP_MEMORY_SCOPE_AGENT); }
#define LDS_WAIT() asm volatile("s_waitcnt lgkmcnt(0)" ::: "memory")
#define VM_WAIT() asm volatile("s_waitcnt vmcnt(0)" ::: "memory")

#define XB_TMO      128
#define XB_XCNT(j)  (256  + 64 * (j))
#define XB_XSUB(j)  (1280 + 64 * (j))
#define XB_XGEN(j)  (2304 + 64 * (j))
#define XB_TOP      3328
#define XB_TOPGEN   3392
#define XCD_BAR_WORDS 3456
#define XB_SPIN_CAP (1u << 18)

__device__ __forceinline__ unsigned xb_ld(unsigned* p)              { return __hip_atomic_load(p, __ATOMIC_RELAXED, __HIP_MEMORY_SCOPE_AGENT); }
__device__ __forceinline__ unsigned xb_add(unsigned* p, unsigned v) { return __hip_atomic_fetch_add(p, v, __ATOMIC_RELAXED, __HIP_MEMORY_SCOPE_AGENT); }
__device__ __forceinline__ unsigned xb_xcc_id() { return (unsigned)__builtin_amdgcn_s_getreg((3 << 11) | 20) & 0xFu; }
#define XB_SPIN(cond, bar) do { unsigned _sp = 0; while (cond) { __builtin_amdgcn_s_sleep(1); \
    if ((++_sp & 255u) == 0u) { if (xb_ld(&(bar)[XB_TMO])) break; if (_sp > XB_SPIN_CAP) { atomicAdd(&(bar)[XB_TMO], 1u); break; } } } } while (0)

struct XcdBarrier {
    unsigned* bar; unsigned x;
    volatile LAS unsigned* st;
};

__device__ __forceinline__ XcdBarrier xcd_barrier_post(unsigned* bar, volatile LAS unsigned* st) {
    XcdBarrier b; b.bar = bar; b.x = xb_xcc_id(); b.st = st;
    if (threadIdx.x == 0) (void)xb_add(&bar[XB_XCNT(b.x)], 1u);
    return b;
}
__device__ __forceinline__ void xcd_barrier_complete(unsigned* bar, unsigned x, unsigned& nloc, unsigned& nx) {
    const unsigned G = gridDim.x * gridDim.y * gridDim.z;
    unsigned sum, cnt, mine, sp = 0u;
    for (;;) {
        sum = 0u; cnt = 0u; mine = 0u;
#pragma unroll
        for (unsigned j = 0; j < 16; ++j) { const unsigned c = xb_ld(&bar[XB_XCNT(j)]); sum += c; cnt += (c > 0u) ? 1u : 0u; mine = (j == x) ? c : mine; }
        if (sum == G) break;
        __builtin_amdgcn_s_sleep(1);
        if ((++sp & 255u) == 0u) { if (xb_ld(&bar[XB_TMO])) break; if (sp > XB_SPIN_CAP) { atomicAdd(&bar[XB_TMO], 1u); break; } }
    }
    nloc = mine > 0u ? mine : 1u; nx = cnt > 0u ? cnt : 1u;
}

template <bool LOCAL = false>
__device__ __forceinline__ void xcd_barrier(const XcdBarrier& b_in) {
    XcdBarrier b = b_in; asm volatile("" : "+s"(b.bar), "+s"(b.x));
    asm volatile("s_waitcnt vmcnt(0)" ::: "memory");
    __syncthreads();
    if (threadIdx.x == 0) {
        unsigned* bar = b.bar;
        __builtin_amdgcn_s_waitcnt(0);
        unsigned nloc = b.st[0], nx = b.st[1];
        if (nloc == 0u) { xcd_barrier_complete(bar, b.x, nloc, nx); b.st[0] = nloc; b.st[1] = nx; }
        const unsigned old = xb_add(&bar[XB_XSUB(b.x)], 1u);
        const unsigned gen = old / nloc;
        if (old + 1u == (gen + 1u) * nloc) {
          if (!(LOCAL && b.st[2] != 0u)) {
            __builtin_amdgcn_fence(__ATOMIC_RELEASE, "agent");
            asm volatile("s_waitcnt vmcnt(0)" ::: "memory");
            const unsigned og = xb_add(&bar[XB_TOP], 1u);
            const unsigned tg = og / nx;
            if (og + 1u == (tg + 1u) * nx) xb_add(&bar[XB_TOPGEN], 1u);
            else XB_SPIN(xb_ld(&bar[XB_TOPGEN]) == tg, bar);
          }
            __builtin_amdgcn_fence(__ATOMIC_ACQUIRE, "agent");
            xb_add(&bar[XB_XGEN(b.x)], 1u);
            asm volatile("s_waitcnt vmcnt(0)" ::: "memory");
        } else {
            XB_SPIN(xb_ld(&bar[XB_XGEN(b.x)]) == gen, bar);
            __builtin_amdgcn_fence(__ATOMIC_ACQUIRE, "agent");
            asm volatile("s_waitcnt vmcnt(0)" ::: "memory");
        }
    }
    __syncthreads();
}

struct Params { const float* in[21]; float* out; unsigned char* ws; int ph_lo, ph_hi; };
enum { I_X = 0, I_CWIN, I_CK, I_CWOUT, I_AWIN, I_KVG, I_KIG, I_KIB, I_AWOUT, I_RELB, I_RWG, I_RBG, I_RWE, I_RBE, I_W1, I_W3, I_W2, I_L1G, I_L1B, I_L2G, I_L2B };

struct Frame {
    LAS unsigned char* lds;
    int G, bx;
    int batch, jb;
    unsigned char* ws;
};

__device__ __forceinline__ unsigned bf4_to_fp8(const u32x2 w) {
    return pk4_fp8(__builtin_bit_cast(float, w.x << 16), __builtin_bit_cast(float, w.x & 0xffff0000u), __builtin_bit_cast(float, w.y << 16), __builtin_bit_cast(float, w.y & 0xffff0000u));
}
template <bool F8 = false>
__device__ __forceinline__ void prol_item64(const float* W, int K, int ldw, int src0, int nvalid, const float* gk, const float* bk, float colscale,
                                            void* Btv, int ldbt, int n0, float* cs, float* bs, LAS unsigned char* scr, int lane) {
    const int kk = lane >> 4, c4 = lane & 15;
    float csum[4] = {0.f, 0.f, 0.f, 0.f}, bsum[4] = {0.f, 0.f, 0.f, 0.f};
    const bool cv = 4 * c4 < nvalid;
    const unsigned sbase = (unsigned)(size_t)scr;
    const unsigned q4 = (unsigned)(lane & 15) >> 2, p4 = (unsigned)lane & 3u;
    for (int k0 = 0; k0 < K; k0 += 64) {
        f32x4 v[16]; float gv[16], bv[16];
#pragma unroll
        for (int ld = 0; ld < 16; ++ld) { gv[ld] = gk ? gk[k0 + 4 * ld + kk] : 1.f; bv[ld] = bk ? bk[k0 + 4 * ld + kk] : 0.f; }
#pragma unroll
        for (int ld = 0; ld < 16; ++ld) v[ld] = cv ? *(const f32x4*)(W + (size_t)(k0 + 4 * ld + kk) * ldw + src0 + 4 * c4) : (f32x4){0.f, 0.f, 0.f, 0.f};
#pragma unroll
        for (int ld = 0; ld < 16; ++ld) {
            const float g = gv[ld] * colscale, bb = bv[ld] * colscale;
            unsigned h[4];
#pragma unroll
            for (int e = 0; e < 4; ++e) { if constexpr (F8) { const float r = fp8_rt(v[ld][e] * g); h[e] = __builtin_bit_cast(unsigned, r) >> 16; csum[e] += r; } else { h[e] = f2bf(v[ld][e] * g); csum[e] += bf2f(h[e]); } bsum[e] += v[ld][e] * bb; }
            *(LAS u32x2*)(scr + (4 * ld + kk) * 144 + c4 * 8) = (u32x2){h[0] | (h[1] << 16), h[2] | (h[3] << 16)};
        }
        LDS_WAIT(); asm volatile("" ::: "memory");
        u32x2 tr[4][2][2];
#pragma unroll
        for (int nt = 0; nt < 4; ++nt)
#pragma unroll
            for (int ch = 0; ch < 2; ++ch) {
                const unsigned a0 = sbase + (8u * (unsigned)(kk + 4 * ch) + q4) * 144u + (16u * nt + 4u * p4) * 2u, a1 = a0 + 4u * 144u;
                asm volatile("ds_read_b64_tr_b16 %0, %2\n\tds_read_b64_tr_b16 %1, %3" : "=&v"(tr[nt][ch][0]), "=&v"(tr[nt][ch][1]) : "v"(a0), "v"(a1) : "memory");
            }
        asm volatile("s_waitcnt lgkmcnt(0)" : "+v"(tr[0][0][0]), "+v"(tr[0][0][1]), "+v"(tr[0][1][0]), "+v"(tr[0][1][1]), "+v"(tr[1][0][0]), "+v"(tr[1][0][1]), "+v"(tr[1][1][0]), "+v"(tr[1][1][1]),
                     "+v"(tr[2][0][0]), "+v"(tr[2][0][1]), "+v"(tr[2][1][0]), "+v"(tr[2][1][1]), "+v"(tr[3][0][0]), "+v"(tr[3][0][1]), "+v"(tr[3][1][0]), "+v"(tr[3][1][1]) :: "memory");
#pragma unroll
        for (int nt = 0; nt < 4; ++nt)
#pragma unroll
            for (int ch = 0; ch < 2; ++ch) {
                if constexpr (F8) *(u32x2*)((unsigned char*)Btv + (size_t)(n0 + 16 * nt + (lane & 15)) * ldbt + k0 + 8 * (kk + 4 * ch)) = (u32x2){bf4_to_fp8(tr[nt][ch][0]), bf4_to_fp8(tr[nt][ch][1])};
                else { u32x4 o; o.x = tr[nt][ch][0].x; o.y = tr[nt][ch][0].y; o.z = tr[nt][ch][1].x; o.w = tr[nt][ch][1].y;
                    *(u32x4*)((bf16_t*)Btv + (size_t)(n0 + 16 * nt + (lane & 15)) * ldbt + k0 + 8 * (kk + 4 * ch)) = o; }
            }
    }
    if (cs) {
#pragma unroll
        for (int e = 0; e < 4; ++e) { csum[e] += shx(csum[e], 16, lane); csum[e] += shx(csum[e], 32, lane); bsum[e] += shx(bsum[e], 16, lane); bsum[e] += shx(bsum[e], 32, lane); }
        if (kk == 0) { *(f32x4*)(cs + n0 + 4 * c4) = (f32x4){csum[0], csum[1], csum[2], csum[3]}; *(f32x4*)(bs + n0 + 4 * c4) = (f32x4){bsum[0], bsum[1], bsum[2], bsum[3]}; }
    }
}

constexpr int PT_TILES = 3 * 4096, PT_GRAN = 2, PT_BUF = 50176;
struct PTile { const float* src; int ldw; unsigned char* bt; int ldbt; int kbase; int rowadd; int up; const float* gk; const float* bk; float* csp; };
__device__ __forceinline__ PTile pt_decode(const Params& P, unsigned char* ws, int T) {
    PTile t;
    if (T < 8192) { const int which = T >> 12, r = T & 4095, le = r >> 4, kt = r & 15, l = le >> 6;
        t.src = (which ? P.in[I_W3] : P.in[I_W1]) + (size_t)le * DM * DEXP + (size_t)kt * 64 * DEXP; t.ldw = DEXP; t.bt = ws + WS_WUP + (size_t)le * 512 * DM; t.ldbt = DM; t.kbase = 64 * kt;
        t.rowadd = 128 * which; t.up = 1; t.gk = P.in[I_L1G] + l * DM + 64 * kt; t.bk = P.in[I_L1B] + l * DM + 64 * kt; t.csp = (float*)(ws + WS_CSP) + ((size_t)kt * 256 + le) * 512;
    } else { const int r = T - 8192, le = r >> 4, kt = (r >> 2) & 3, nq = r & 3;
        t.src = P.in[I_W2] + (size_t)le * DEXP * DM + (size_t)kt * 64 * DM + 256 * nq; t.ldw = DM; t.bt = ws + WS_WDN + (size_t)le * DM * DEXP; t.ldbt = DEXP; t.kbase = 64 * kt;
        t.rowadd = 256 * nq; t.up = 0; t.gk = nullptr; t.bk = nullptr; t.csp = nullptr; }
    return t;
}
__device__ __forceinline__ void p0_expert_tiles(const Frame& F, const Params& P, int tid, int lane, int wave) {
    unsigned char* ws = F.ws;
    volatile LAS int* slot = (volatile LAS int*)(F.lds + LDS_MISC + 64);
    unsigned* qctr = (unsigned*)(ws + WS_CTL) + CW_QUEUE;
    if (tid == 0) { slot[0] = (int)atomicAdd(qctr, (unsigned)PT_GRAN); slot[1] = (int)atomicAdd(qctr, (unsigned)PT_GRAN); }
    __syncthreads();
    int g0 = slot[0], g1 = slot[1], par = 0;
    const unsigned g16 = (unsigned)lane >> 4, q4 = (unsigned)(lane & 15) >> 2, p4 = (unsigned)lane & 3u;
    f32x4 cur[PT_GRAN][8], nxt[PT_GRAN][8];
#define PT_LOAD(T, vv) do { const PTile _t = pt_decode(P, ws, (T)); _Pragma("unroll") for (int i = 0; i < 8; ++i) vv[i] = *(const f32x4*)(_t.src + (size_t)(8 * wave + i) * _t.ldw + 4 * lane); } while (0)
    if (g0 < PT_TILES) {
#pragma unroll
        for (int j = 0; j < PT_GRAN; ++j) PT_LOAD(g0 + j, cur[j]); }
    while (g0 < PT_TILES) {
        if (tid == 0) slot[2 + par] = (int)atomicAdd(qctr, (unsigned)PT_GRAN);
        if (g1 < PT_TILES) {
#pragma unroll
            for (int j = 0; j < PT_GRAN; ++j) PT_LOAD(g1 + j, nxt[j]); }
#pragma unroll
        for (int j = 0; j < PT_GRAN; ++j) {
            const PTile t = pt_decode(P, ws, g0 + j);
            LAS unsigned char* tile = F.lds + (j & 1) * PT_BUF;
            LAS float* part = (LAS float*)(F.lds + (j & 1) * PT_BUF + 33792);
            f32x4 pc = (f32x4){0.f, 0.f, 0.f, 0.f}, pb = (f32x4){0.f, 0.f, 0.f, 0.f};
#pragma unroll
            for (int i = 0; i < 8; ++i) {
                const float gvi = t.up ? t.gk[8 * wave + i] : 1.f, bvi = t.up ? t.bk[8 * wave + i] : 0.f;
                const int w8 = (int)pk4_fp8(cur[j][i][0] * gvi, cur[j][i][1] * gvi, cur[j][i][2] * gvi, cur[j][i][3] * gvi);
                const float r0 = __builtin_amdgcn_cvt_f32_fp8(w8, 0), r1 = __builtin_amdgcn_cvt_f32_fp8(w8, 1), r2 = __builtin_amdgcn_cvt_f32_fp8(w8, 2), r3 = __builtin_amdgcn_cvt_f32_fp8(w8, 3);
                pc[0] += r0; pc[1] += r1; pc[2] += r2; pc[3] += r3;
#pragma unroll
                for (int e = 0; e < 4; ++e) pb[e] += cur[j][i][e] * bvi;
                *(LAS u32x2*)(tile + (8 * wave + i) * 528 + lane * 8) = (u32x2){(__builtin_bit_cast(unsigned, r0) >> 16) | (__builtin_bit_cast(unsigned, r1) & 0xffff0000u),
                                                                                (__builtin_bit_cast(unsigned, r2) >> 16) | (__builtin_bit_cast(unsigned, r3) & 0xffff0000u)};
            }
            if (t.up) { *(LAS f32x4*)(part + wave * 256 + 4 * lane) = pc; *(LAS f32x4*)(part + 2048 + wave * 256 + 4 * lane) = pb; }
            __syncthreads();
            {
                u32x2 tr[2][4];
                const unsigned sbase = (unsigned)(size_t)tile;
#pragma unroll
                for (int jj = 0; jj < 2; ++jj)
#pragma unroll
                    for (int c = 0; c < 4; ++c) {
                        const unsigned a0 = sbase + (16u * g16 + 4u * c + q4) * 528u + (16u * (2 * wave + jj) + 4u * p4) * 2u;
                        asm volatile("ds_read_b64_tr_b16 %0, %1" : "=&v"(tr[jj][c]) : "v"(a0) : "memory");
                    }
                asm volatile("s_waitcnt lgkmcnt(0)" : "+v"(tr[0][0]), "+v"(tr[0][1]), "+v"(tr[0][2]), "+v"(tr[0][3]), "+v"(tr[1][0]), "+v"(tr[1][1]), "+v"(tr[1][2]), "+v"(tr[1][3]) :: "memory");
#pragma unroll
                for (int jj = 0; jj < 2; ++jj) {
                    const int n = 16 * (2 * wave + jj) + (lane & 15);
                    const int brow = t.up ? (n & 127) + 256 * (n >> 7) + t.rowadd : 128 * ((n >> 3) & 1) + 32 * (n >> 6) + 8 * ((n >> 4) & 3) + (n & 7) + t.rowadd;
                    u32x4 o; o.x = bf4_to_fp8(tr[jj][0]); o.y = bf4_to_fp8(tr[jj][1]); o.z = bf4_to_fp8(tr[jj][2]); o.w = bf4_to_fp8(tr[jj][3]);
                    *(u32x4*)(t.bt + (size_t)brow * t.ldbt + t.kbase + 16 * g16) = o;
                }
            }
            if (t.up && tid < 256) {
                float cs = part[tid], bs = part[2048 + tid];
#pragma unroll
                for (int w2 = 1; w2 < 8; ++w2) { cs += part[w2 * 256 + tid]; bs += part[2048 + w2 * 256 + tid]; }
                const int brow = (tid & 127) + 256 * (tid >> 7) + t.rowadd;
                t.csp[brow] = cs; t.csp[(size_t)32 * 4 * 64 * 512 + brow] = bs;
            }
        }
        g0 = g1; g1 = slot[2 + par]; par ^= 1;
#pragma unroll
        for (int j = 0; j < PT_GRAN; ++j)
#pragma unroll
            for (int i = 0; i < 8; ++i) cur[j][i] = nxt[j][i];
    }
    __syncthreads();
#undef PT_LOAD
}

__device__ __forceinline__ void p0_heavy_item(const Params& P, unsigned char* ws, int r, LAS unsigned char* scr, int lane) {
    constexpr int N_AO = 2 * 16 * 2, N_CI = 2 * 48, N_AI = 2 * 44;
    if (r < N_AO) {
        const int jl = r / 32, g = (r % 32) >> 1, kh = r & 1;
        prol_item64<true>(P.in[I_AWOUT] + (size_t)jl * 2048 * DM + (size_t)kh * 1024 * DM, 1024, DM, 64 * g, 64, nullptr, nullptr, 64.f,
                    ws + WS_WAO + (size_t)jl * DM * 2048 + kh * 1024, 2048, 64 * g, nullptr, nullptr, scr, lane);
        return; }
    r -= N_AO;
    if (r < N_CI) {
        const int jl = r / 48, g = r % 48, n0 = 64 * g;
        int src;
        if (n0 < 2048) { const int p = n0 >> 8, half = (n0 >> 7) & 1; src = (half ? 2048 : 1024) + 128 * p + (n0 & 127); } else src = n0 - 2048;
        const float* gk = jl ? P.in[I_L2G] + (2 * jl - 1) * DM : nullptr; const float* bk = jl ? P.in[I_L2B] + (2 * jl - 1) * DM : nullptr;
        prol_item64(P.in[I_CWIN] + (size_t)jl * DM * 3072, DM, 3072, src, 64, gk, bk, 1.f, (bf16_t*)(ws + WS_WCI) + (size_t)jl * 3072 * DM, DM, n0,
                    (float*)(ws + WS_CSCI) + jl * 3072, (float*)(ws + WS_BSCI) + jl * 3072, scr, lane);
        return; }
    r -= N_CI;
    if (r < N_AI) {
        const int jl = r / 44, g = r % 44, n0 = 64 * g;
        int src, nvalid = 64; float sc = 1.f;
        if (n0 < 2048) { src = n0; sc = 0.08838834764831845f; }
        else if (n0 < 2176) src = n0;
        else if (n0 < 2240) src = 2688;
        else if (n0 < 2304) { src = 2752; nvalid = 8; sc = 0.35355339059327373f; }
        else { src = 2176 + (n0 - 2304); sc = 0.125f; }
        if (n0 < 2048)
            prol_item64<true>(P.in[I_AWIN] + (size_t)jl * DM * AIW, DM, AIW, src, nvalid, P.in[I_L2G] + (2 * jl) * DM, P.in[I_L2B] + (2 * jl) * DM, 1.f,
                    ws + WS_WAI + (size_t)jl * AIWP * DM * 2, DM, n0, (float*)(ws + WS_CSAI) + jl * AIWP, (float*)(ws + WS_BSAI) + jl * AIWP, scr, lane);
        else
            prol_item64(P.in[I_AWIN] + (size_t)jl * DM * AIW, DM, AIW, src, nvalid, P.in[I_L2G] + (2 * jl) * DM, P.in[I_L2B] + (2 * jl) * DM, sc,
                    (bf16_t*)(ws + WS_WAI) + (size_t)jl * AIWP * DM, DM, n0, (float*)(ws + WS_CSAI) + jl * AIWP, (float*)(ws + WS_BSAI) + jl * AIWP, scr, lane);
        return; }
    r -= N_AI;
    {
        const int jl = r / 16, g = r % 16;
        prol_item64(P.in[I_CWOUT] + (size_t)jl * DM * DM, DM, DM, 64 * g, 64, nullptr, nullptr, 1.f, (bf16_t*)(ws + WS_WCO) + (size_t)jl * DM * DM, DM, 64 * g, nullptr, nullptr, scr, lane);
    }
}

__device__ __forceinline__ void p0_prologue(const Frame& F, const Params& P) {
    int tid = threadIdx.x; asm volatile("" : "+v"(tid)); const int lane = tid & 63, wave = __builtin_amdgcn_readfirstlane(tid >> 6);
    LAS unsigned char* scr = F.lds + LDS_STAGE + wave * 16896;
    const int gw = F.bx * NWAVES + wave, NGW = F.G * NWAVES;
    unsigned char* ws = F.ws;
    constexpr int N_DENSE = 2 * 16 * 2 + 2 * 48 + 2 * 44 + 2 * 16;
    if (gw < N_DENSE) p0_heavy_item(P, ws, gw, scr, lane);
    __syncthreads();
    p0_expert_tiles(F, P, tid, lane, wave);
    if (gw < 4 * 96) {
        const int l = gw / 96, n = gw % 96;
        const int ks = lane >> 1, fq0 = 2 * (lane & 1), nt = n >> 4;
        bf16_t* hi = (bf16_t*)(ws + WS_WR) + ((((size_t)(l * 32 + ks) * 2 + 0) * 6 + nt) * 64 + (n & 15) + 16 * fq0) * 8; bf16_t* lo = hi + (size_t)6 * 64 * 8;
        float csum = 0.f, bsum = 0.f; unsigned hw[8], lw[8];
        if (n < 72) {
            const float* Wc = n < 8 ? P.in[I_RWG] + (size_t)l * DM * 8 + n : P.in[I_RWE] + (size_t)l * DM * 64 + (n - 8); const int ldw = n < 8 ? 8 : 64;
            float w[16], g[16], b[16];
#pragma unroll
            for (int i = 0; i < 16; ++i) w[i] = Wc[(size_t)(16 * lane + i) * ldw];
#pragma unroll
            for (int i = 0; i < 4; ++i) { const f32x4 g4 = *(const f32x4*)(P.in[I_L1G] + l * DM + 16 * lane + 4 * i), b4 = *(const f32x4*)(P.in[I_L1B] + l * DM + 16 * lane + 4 * i);
#pragma unroll
                for (int e = 0; e < 4; ++e) { g[4 * i + e] = g4[e]; b[4 * i + e] = b4[e]; } }
            unsigned hb[16], lb[16];
#pragma unroll
            for (int i = 0; i < 16; ++i) { const float wf = w[i] * g[i]; hb[i] = f2bf(wf); const float h = bf2f(hb[i]); lb[i] = f2bf(wf - h); csum += h + bf2f(lb[i]); bsum += w[i] * b[i]; }
#pragma unroll
            for (int i = 0; i < 8; ++i) { hw[i] = hb[2 * i] | (hb[2 * i + 1] << 16); lw[i] = lb[2 * i] | (lb[2 * i + 1] << 16); }
        } else {
#pragma unroll
            for (int i = 0; i < 8; ++i) { hw[i] = 0u; lw[i] = 0u; }
        }
        *(u32x4*)hi = (u32x4){hw[0], hw[1], hw[2], hw[3]}; *(u32x4*)(hi + 16 * 8) = (u32x4){hw[4], hw[5], hw[6], hw[7]};
        *(u32x4*)lo = (u32x4){lw[0], lw[1], lw[2], lw[3]}; *(u32x4*)(lo + 16 * 8) = (u32x4){lw[4], lw[5], lw[6], lw[7]};
        csum = wave_sum(csum, lane); bsum = wave_sum(bsum, lane);
        if (lane == 0) { ((float*)(ws + WS_CSR))[l * 96 + n] = csum; ((float*)(ws + WS_BSR))[l * 96 + n] = bsum; }
    }
    for (int m0 = gw; m0 < T_TOK; m0 += 4 * NGW) {
        f32x4 xv[4][4];
#pragma unroll
        for (int r = 0; r < 4; ++r) { const GAS f32x4* xr = (const GAS f32x4*)(P.in[I_X] + (size_t)(m0 + r * NGW) * DM) + lane;
#pragma unroll
            for (int q = 0; q < 4; ++q) xv[r][q] = xr[64 * q]; }
#pragma unroll
        for (int r = 0; r < 4; ++r) { const int m = m0 + r * NGW;
            GAS u32x2* o = (GAS u32x2*)((bf16_t*)(ws + WS_ZA) + (size_t)m * DM) + lane;
#pragma unroll
            for (int q = 0; q < 4; ++q) { const f32x4 v = xv[r][q]; u32x2 w; w.x = pk2(v.x, v.y); w.y = pk2(v.z, v.w); o[64 * q] = w; }
            if (lane == 0) { float* st = (float*)(ws + WS_STA) + 2 * m; st[0] = 0.f; st[1] = 1.f; } }
    }
    if (F.bx == 0) { float* v = (float*)(ws + WS_VEC); for (int i = tid; i < 2048; i += NTHREADS) v[i] = i < 1024 ? 1.f : 0.f; }
}

__device__ __forceinline__ f32x2 stats_from_part(const float* part, int row);
template <bool FINAL>
__device__ __forceinline__ void combine_phase(const Frame& F, const bf16_t* zin, const float* stin, const float* partin, const float* g, const float* b, const unsigned char* y,
                                              bf16_t* zout, float* stout, const float* gout, const float* bout, float* out, unsigned char* z8out) {
    int tid = threadIdx.x; asm volatile("" : "+v"(tid)); const int lane = tid & 63, wave = __builtin_amdgcn_readfirstlane(tid >> 6); (void)lane; (void)wave;
    const int row0 = 2048 * F.batch + 64 * F.jb + 8 * wave;
    const int c0 = 8 * lane;
    float gv[2][8], bv[2][8];
#pragma unroll
    for (int j2 = 0; j2 < 2; ++j2) {
        const f32x4 g0 = *(const f32x4*)(g + c0 + 512 * j2), g1 = *(const f32x4*)(g + c0 + 512 * j2 + 4), b0 = *(const f32x4*)(b + c0 + 512 * j2), b1 = *(const f32x4*)(b + c0 + 512 * j2 + 4);
#pragma unroll
        for (int e = 0; e < 4; ++e) { gv[j2][e] = g0[e]; gv[j2][4 + e] = g1[e]; bv[j2][e] = b0[e]; bv[j2][4 + e] = b1[e]; }
    }
    for (int r2 = 0; r2 < 8; r2 += 8) {
      u32x4 zws[8][2]; u32x2 yws[8][2][2]; f32x2 sts[8];
#pragma unroll
      for (int rr = 0; rr < 8; ++rr) { const int row = row0 + r2 + rr;
          sts[rr] = partin ? stats_from_part(partin, row) : *(const f32x2*)(stin + 2 * row);
#pragma unroll
          for (int j2 = 0; j2 < 2; ++j2) { zws[rr][j2] = *(const u32x4*)(zin + (size_t)row * DM + c0 + 512 * j2);
              if (y) {
#pragma unroll
                  for (int sl = 0; sl < 2; ++sl) yws[rr][j2][sl] = *(const u32x2*)(y + ((size_t)row * 2 + sl) * DM + c0 + 512 * j2); } } }
#pragma unroll
      for (int rr = 0; rr < 8; ++rr) {
        const int row = row0 + r2 + rr;
        const f32x2 st = sts[rr];
        float v[2][8]; float s = 0.f;
#pragma unroll
        for (int j2 = 0; j2 < 2; ++j2) {
            const u32x4 zw = zws[rr][j2];
            float z[8] = {bflo(zw.x), bfhi(zw.x), bflo(zw.y), bfhi(zw.y), bflo(zw.z), bfhi(zw.z), bflo(zw.w), bfhi(zw.w)};
            float acc[8];
#pragma unroll
            for (int e = 0; e < 8; ++e) acc[e] = ALPHA * ((z[e] - st.x) * st.y * gv[j2][e] + bv[j2][e]);
            if (y) {
#pragma unroll
                for (int sl = 0; sl < 2; ++sl) {
                    const u32x2 yw = yws[rr][j2][sl];
                    acc[0] += 0.0625f * __builtin_amdgcn_cvt_f32_fp8((int)yw.x, 0); acc[1] += 0.0625f * __builtin_amdgcn_cvt_f32_fp8((int)yw.x, 1); acc[2] += 0.0625f * __builtin_amdgcn_cvt_f32_fp8((int)yw.x, 2); acc[3] += 0.0625f * __builtin_amdgcn_cvt_f32_fp8((int)yw.x, 3);
                    acc[4] += 0.0625f * __builtin_amdgcn_cvt_f32_fp8((int)yw.y, 0); acc[5] += 0.0625f * __builtin_amdgcn_cvt_f32_fp8((int)yw.y, 1); acc[6] += 0.0625f * __builtin_amdgcn_cvt_f32_fp8((int)yw.y, 2); acc[7] += 0.0625f * __builtin_amdgcn_cvt_f32_fp8((int)yw.y, 3);
                }
            }
            if (!FINAL) {
#pragma unroll
                for (int e = 0; e < 8; ++e) acc[e] = bf2f(f2bf(acc[e]));
            }
#pragma unroll
            for (int e = 0; e < 8; ++e) { v[j2][e] = acc[e]; s += acc[e]; }
        }
        const float mean = wave_sum(s, lane) * (1.f / DM);
        float s2 = 0.f;
#pragma unroll
        for (int j2 = 0; j2 < 2; ++j2)
#pragma unroll
            for (int e = 0; e < 8; ++e) { const float d = v[j2][e] - mean; s2 += d * d; }
        const float rstd = 1.f / sqrtf(wave_sum(s2, lane) * (1.f / DM) + LN_EPS);
        if (!FINAL) {
#pragma unroll
            for (int j2 = 0; j2 < 2; ++j2) {
                u32x4 o; o.x = pk2(v[j2][0], v[j2][1]); o.y = pk2(v[j2][2], v[j2][3]); o.z = pk2(v[j2][4], v[j2][5]); o.w = pk2(v[j2][6], v[j2][7]);
                *(u32x4*)(zout + (size_t)row * DM + c0 + 512 * j2) = o;
                if (z8out) *(u32x2*)(z8out + (size_t)row * DM + c0 + 512 * j2) = (u32x2){pk4_fp8(v[j2][0], v[j2][1], v[j2][2], v[j2][3]), pk4_fp8(v[j2][4], v[j2][5], v[j2][6], v[j2][7])};
            }
            if (lane == 0) { *(f32x2*)(stout + 2 * row) = (f32x2){mean, rstd}; }
        } else {
#pragma unroll
            for (int j2 = 0; j2 < 2; ++j2) {
                const f32x4 g0 = *(const f32x4*)(gout + c0 + 512 * j2), g1 = *(const f32x4*)(gout + c0 + 512 * j2 + 4), b0 = *(const f32x4*)(bout + c0 + 512 * j2), b1 = *(const f32x4*)(bout + c0 + 512 * j2 + 4);
                f32x4 o0, o1;
#pragma unroll
                for (int e = 0; e < 4; ++e) { o0[e] = (v[j2][e] - mean) * rstd * g0[e] + b0[e]; o1[e] = (v[j2][4 + e] - mean) * rstd * g1[e] + b1[e]; }
                *(f32x4*)(out + (size_t)row * DM + c0 + 512 * j2) = o0; *(f32x4*)(out + (size_t)row * DM + c0 + 512 * j2 + 4) = o1;
            }
        }
      }
    }
}

namespace pg8 {
constexpr int BM = 256, BK = 64, HALF = 128, HTB = HALF * BK * 2, STAGE_BYTES = 8 * HTB, NXCD = 8, WGM = 8;
__host__ __device__ __forceinline__ int lds_byte(int r, int c) { const int st = (r >> 4) * 2 + (c >> 5), rr = r & 15, cc = c & 31, ob = rr * 64 + cc * 2; return st * 1024 + (ob ^ (((ob >> 9) & 1) << 5)); }
__host__ __device__ __forceinline__ void stage_rc(int b, int& R, int& C) { const int st = b / 1024, sb = b % 1024, swz = sb ^ (((sb >> 9) & 1) << 5); R = (st >> 1) * 16 + swz / 64; C = (st & 1) * 32 + (swz % 64) / 2; }
__host__ __device__ __forceinline__ int perm32(int rho) { const int n = rho >> 4, i = rho & 15; return 8 * (i >> 2) + 4 * n + (i & 3); }

struct Unit { const char* A; const char* B; int pm, pn, x0, x1; };

struct StaticOrder {
    int nM, nN, nwg, G, c; const char* A; const char* B; size_t astep, bstep;
    __device__ void init(int M, int N, int G_, int c_, const void* A_, size_t lda_bytes, const void* B_, size_t ldb_bytes) { nM = M / BM; nN = N / BM; nwg = nM * nN; G = G_; c = c_; A = (const char*)A_; B = (const char*)B_; astep = lda_bytes * BM; bstep = ldb_bytes * BM; }
    __device__ bool next(int i, Unit& u) const {
        const long L = (long)i * G + c; if (L >= nwg) return false;
        int wgid = (int)L; { const int q = nwg / NXCD, r = nwg % NXCD, xcd = wgid % NXCD, off = wgid / NXCD; wgid = (xcd < r ? xcd * (q + 1) : r * (q + 1) + (xcd - r) * q) + off; }
        const int nig = WGM * nN, gid = wgid / nig, fm = gid * WGM, gsz = (nM - fm) < WGM ? (nM - fm) : WGM;
        u.pm = fm + ((wgid % nig) % gsz); u.pn = (wgid % nig) / gsz; u.A = A + (size_t)u.pm * astep; u.B = B + (size_t)u.pn * bstep; u.x0 = 0; u.x1 = 0; return true;
    }
    __device__ __forceinline__ const LAS unsigned* rowoff(int) const { return nullptr; }
    __device__ __forceinline__ void a_ready(const Unit&) const {}
};

__device__ __forceinline__ unsigned cvt_pk_bf16(float lo, float hi) { unsigned r; asm volatile("v_cvt_pk_bf16_f32 %0, %1, %2" : "=v"(r) : "v"(lo), "v"(hi)); return r; }

template <class Epi, class Sched, bool GATHER, bool FP8 = false>
__device__ __forceinline__ void gemm_phase(LAS unsigned char* lds, const int K, const unsigned lda_bytes, const unsigned ldb_bytes, const Sched& S, const Epi& E, const int b_e8m0 = 127) {
    int tid = threadIdx.x; asm volatile("" : "+v"(tid));
    const int wid = __builtin_amdgcn_readfirstlane(tid >> 6), lane = tid & 63, wr = wid >> 2, wc = wid & 3, fr = lane & 15, fq = lane >> 4;
    int nt = K / BK; asm volatile("" : "+s"(nt));
    unsigned voffA[2], voffB[2];
#pragma unroll
    for (int i = 0; i < 2; ++i) { int R, C; stage_rc(tid * 16 + i * 8192, R, C); const int Rb = (R & ~31) + perm32(R & 31);
        voffA[i] = (unsigned)R * lda_bytes + (unsigned)C * 2u; voffB[i] = (unsigned)Rb * ldb_bytes + (unsigned)C * 2u; }
#define PG8_GOFF(dst, ro) do { int _t = threadIdx.x; asm volatile("" : "+v"(_t)); _Pragma("unroll") for (int _i = 0; _i < 2; ++_i) { int _R, _C; stage_rc(_t * 16 + _i * 8192, _R, _C); \
        _Pragma("unroll") for (int _h = 0; _h < 2; ++_h) dst[_h][_i] = (ro)[_h * HALF + _R] + (unsigned)_C * 2u; } } while (0)
    const size_t kstep = (size_t)(BK * 2);
    const size_t hstepA = (size_t)HALF * lda_bytes, hstepB = (size_t)HALF * ldb_bytes;
    const unsigned ldsw = (unsigned)wid * 1024u;
    const int aoff = lds_byte(wr * 64 + fr, fq * 8), boff = lds_byte(wc * 32 + fr, fq * 8);
#define PG8_SA(b, h) (((b) * 2 + (h)) * HTB)
#define PG8_SB(b, h) ((4 + (b) * 2 + (h)) * HTB)
#define PG8_GLDS(src, bufoff, i) __builtin_amdgcn_global_load_lds((const unsigned*)(src), (LAS unsigned*)(lds + (bufoff) + ldsw + (i) * 8192), 16, 0, 0)
#define PG8_STAGE_B(bufoff, gbase) do { _Pragma("unroll") for (int _i = 0; _i < 2; ++_i) PG8_GLDS((const char*)(gbase) + voffB[_i], bufoff, _i); } while (0)
#define PG8_STAGE_A(bufoff, gbase, h, GO) do { _Pragma("unroll") for (int _i = 0; _i < 2; ++_i) { \
        if constexpr (GATHER) PG8_GLDS((const char*)(gbase) + (GO)[h][_i], bufoff, _i); else PG8_GLDS((const char*)(gbase) + (h) * hstepA + voffA[_i], bufoff, _i); } } while (0)
#define PG8_LDA(dst, b, h) do { _Pragma("unroll") for (int m = 0; m < 4; ++m) _Pragma("unroll") for (int k = 0; k < 2; ++k) dst[m][k] = *(const LAS bf16x8*)(lds + PG8_SA(b, h) + aoff + m * 2048 + k * 1024); } while (0)
#define PG8_LDB(dst, b, h) do { _Pragma("unroll") for (int n = 0; n < 2; ++n) _Pragma("unroll") for (int k = 0; k < 2; ++k) dst[n][k] = *(const LAS bf16x8*)(lds + PG8_SB(b, h) + boff + n * 2048 + k * 1024); } while (0)
#define PG8_MMA(ai, bj, At, Bt) do { __builtin_amdgcn_s_setprio(1); _Pragma("unroll") for (int m = 0; m < 4; ++m) _Pragma("unroll") for (int n = 0; n < 2; ++n) { \
        if constexpr (FP8) { const u32x4 b0 = __builtin_bit_cast(u32x4, Bt[n][0]), b1 = __builtin_bit_cast(u32x4, Bt[n][1]), a0 = __builtin_bit_cast(u32x4, At[m][0]), a1 = __builtin_bit_cast(u32x4, At[m][1]); \
            const i32x8 vb = {(int)b0.x, (int)b0.y, (int)b0.z, (int)b0.w, (int)b1.x, (int)b1.y, (int)b1.z, (int)b1.w}, va = {(int)a0.x, (int)a0.y, (int)a0.z, (int)a0.w, (int)a1.x, (int)a1.y, (int)a1.z, (int)a1.w}; \
            asm volatile("v_mfma_scale_f32_16x16x128_f8f6f4 %0, %1, %2, %0, %3, %4 op_sel_hi:[0,0,0]" : "+v"(acc[ai][bj][m][n]) : "v"(vb), "v"(va), "v"(fp8_bscale), "v"(fp8_scale)); } \
        else { _Pragma("unroll") for (int k = 0; k < 2; ++k) acc[ai][bj][m][n] = __builtin_amdgcn_mfma_f32_16x16x32_bf16(Bt[n][k], At[m][k], acc[ai][bj][m][n], 0, 0, 0); } } \
        __builtin_amdgcn_s_setprio(0); } while (0)
#define PG8_WAIT_V(n) asm volatile("s_waitcnt vmcnt(" #n ")" ::: "memory")
#define PG8_WAIT_L(n) asm volatile("s_waitcnt lgkmcnt(" #n ")" ::: "memory")
#define PG8_BAR __builtin_amdgcn_s_barrier()
#define PG8_SCHED __builtin_amdgcn_sched_barrier(0)
    Unit cur, nxt; int ui = 0;
    if (!S.next(0, cur)) return;
    int fp8_scale = 0x7F7F7F7F; asm volatile("" : "+v"(fp8_scale));
    int fp8_bscale = b_e8m0 * 0x01010101; asm volatile("" : "+v"(fp8_bscale));
    (void)fp8_scale; (void)fp8_bscale;
    f32x4 acc[2][2][4][2];
#pragma unroll
    for (int a = 0; a < 2; ++a)
#pragma unroll
        for (int b = 0; b < 2; ++b)
#pragma unroll
            for (int m = 0; m < 4; ++m)
#pragma unroll
                for (int n = 0; n < 2; ++n) acc[a][b][m][n] = (f32x4){0.f, 0.f, 0.f, 0.f};
    bf16x8 At[4][2], B0[2][2], B1[2][2];
    unsigned cG[2][2] = {{0u, 0u}, {0u, 0u}};
    if constexpr (GATHER) { const LAS unsigned* ro = S.rowoff(0); PG8_GOFF(cG, ro); }
    const char* cA = cur.A; const char* cB = cur.B;
    int eslot = 0;
    E.prefetch(cur, 0, wid, lane);
    S.a_ready(cur);
    PG8_STAGE_B(PG8_SB(0, 0), cB); PG8_STAGE_B(PG8_SB(0, 1), cB + hstepB); PG8_STAGE_A(PG8_SA(0, 0), cA, 0, cG); PG8_STAGE_A(PG8_SA(0, 1), cA, 1, cG);
    if (wr == 1) PG8_BAR;
    PG8_WAIT_V(2); PG8_BAR;
    PG8_STAGE_B(PG8_SB(1, 0), cB + kstep); PG8_STAGE_A(PG8_SA(1, 0), cA + kstep, 0, cG); PG8_STAGE_B(PG8_SB(1, 1), cB + hstepB + kstep);
    PG8_WAIT_V(6); PG8_BAR;
    for (;;) {
        const bool has_next = S.next(ui + 1, nxt);
        const int nslot = eslot == 2 ? 0 : eslot + 1;
        if (has_next) E.prefetch(nxt, nslot, wid, lane);
        const char* nA = has_next ? nxt.A : cA; const char* nB = has_next ? nxt.B : cB;
        for (int t = 0; t < nt; t += 2) {
            const bool last = (t == nt - 2);
            if (last && has_next) S.a_ready(nxt);
            const char* a1 = cA + (size_t)(t + 1) * kstep;
            const char* a2 = last ? nA : cA + (size_t)(t + 2) * kstep; const char* b2 = last ? nB : cB + (size_t)(t + 2) * kstep;
            const char* a3 = a2 + kstep; const char* b3 = b2 + kstep;
            unsigned g2[2][2] = {{0u, 0u}, {0u, 0u}};
            if constexpr (GATHER) { const LAS unsigned* ro = S.rowoff((last && has_next) ? ui + 1 : ui); PG8_GOFF(g2, ro); }
            PG8_LDB(B0, 0, 0); PG8_LDB(B1, 0, 1); PG8_SCHED; PG8_LDA(At, 0, 0); PG8_STAGE_A(PG8_SA(1, 1), a1, 1, cG);
            PG8_WAIT_V(8); PG8_WAIT_L(0); PG8_BAR; PG8_MMA(0, 0, At, B0); PG8_MMA(0, 1, At, B1); PG8_BAR; PG8_SCHED;
            PG8_LDA(At, 0, 1); PG8_STAGE_B(PG8_SB(0, 0), b2); PG8_STAGE_B(PG8_SB(0, 1), b2 + hstepB); PG8_STAGE_A(PG8_SA(0, 0), a2, 0, g2);
            PG8_WAIT_V(8); PG8_WAIT_L(0); PG8_BAR; PG8_MMA(1, 0, At, B0); PG8_MMA(1, 1, At, B1); PG8_BAR; PG8_SCHED;
            PG8_LDB(B0, 1, 0); PG8_LDB(B1, 1, 1); PG8_SCHED; PG8_LDA(At, 1, 0); PG8_STAGE_A(PG8_SA(0, 1), a2, 1, g2);
            PG8_WAIT_V(8); PG8_WAIT_L(0); PG8_BAR; PG8_MMA(0, 0, At, B0); PG8_MMA(0, 1, At, B1); PG8_BAR; PG8_SCHED;
            PG8_LDA(At, 1, 1); PG8_STAGE_B(PG8_SB(1, 0), b3); PG8_STAGE_B(PG8_SB(1, 1), b3 + hstepB); PG8_STAGE_A(PG8_SA(1, 0), a3, 0, g2);
            PG8_WAIT_V(8); PG8_WAIT_L(0); PG8_BAR; PG8_MMA(1, 0, At, B0); PG8_MMA(1, 1, At, B1); PG8_BAR; PG8_SCHED;
        }
        if constexpr (FP8) asm volatile("s_nop 15\n\ts_nop 15\n\ts_nop 7" ::: "memory");
        if (wr == 0) PG8_BAR;
        E(acc, cur, ui, wr, wc, fr, fq, eslot);
        if (!has_next) break;
#pragma unroll
        for (int a = 0; a < 2; ++a)
#pragma unroll
            for (int b = 0; b < 2; ++b)
#pragma unroll
                for (int m = 0; m < 4; ++m)
#pragma unroll
                    for (int n = 0; n < 2; ++n) acc[a][b][m][n] = (f32x4){0.f, 0.f, 0.f, 0.f};
        cur = nxt; cA = nA; cB = nB; ++ui; eslot = nslot;
        if constexpr (GATHER) { const LAS unsigned* ro = S.rowoff(ui); PG8_GOFF(cG, ro); }
        if (wr == 1) PG8_BAR;
    }
    PG8_WAIT_V(0);
    PG8_BAR;
#undef PG8_SA
#undef PG8_SB
#undef PG8_GLDS
#undef PG8_GOFF
#undef PG8_STAGE_A
#undef PG8_STAGE_B
#undef PG8_LDA
#undef PG8_LDB
#undef PG8_MMA
#undef PG8_WAIT_V
#undef PG8_WAIT_L
#undef PG8_BAR
#undef PG8_SCHED
}
}

__device__ __forceinline__ void ld8(const float* p, float (&v)[8]) { const f32x4 a = *(const f32x4*)p, b = *(const f32x4*)(p + 4); v[0] = a.x; v[1] = a.y; v[2] = a.z; v[3] = a.w; v[4] = b.x; v[5] = b.y; v[6] = b.z; v[7] = b.w; }
__device__ __forceinline__ void unpack8(const u32x4 w, float (&v)[8]) { v[0] = bflo(w.x); v[1] = bfhi(w.x); v[2] = bflo(w.y); v[3] = bfhi(w.y); v[4] = bflo(w.z); v[5] = bfhi(w.z); v[6] = bflo(w.w); v[7] = bfhi(w.w); }
__device__ __forceinline__ u32x4 pack8(const float (&v)[8]) { u32x4 o; o.x = pg8::cvt_pk_bf16(v[0], v[1]); o.y = pg8::cvt_pk_bf16(v[2], v[3]); o.z = pg8::cvt_pk_bf16(v[4], v[5]); o.w = pg8::cvt_pk_bf16(v[6], v[7]); return o; }

__device__ __forceinline__ void ld8l(const LAS float* p, float (&v)[8]) { const f32x4 a = *(const LAS f32x4*)p, b = *(const LAS f32x4*)(p + 4); v[0] = a.x; v[1] = a.y; v[2] = a.z; v[3] = a.w; v[4] = b.x; v[5] = b.y; v[6] = b.z; v[7] = b.w; }
__device__ __forceinline__ void epi_prefetch(LAS unsigned char* dst, const float* st256, const float* cs256, const float* bs256, int wid, int lane) {
    if (wid < 4) { const char* src = wid < 2 ? (const char*)st256 + wid * 1024 : (wid == 2 ? (const char*)cs256 : (const char*)bs256); int t = threadIdx.x; asm volatile("" : "+v"(t)); (void)lane;
        __builtin_amdgcn_global_load_lds((const unsigned*)(src + (t & 63) * 16), (LAS unsigned*)(dst + wid * 1024), 16, 0, 0); }
}
struct EpiConvIn {
    const float* st; const float* cs; const float* bs; bf16_t* u; bf16_t* bg; LAS unsigned char* aux;
    __device__ __forceinline__ void prefetch(const pg8::Unit& un, int slot, int wid, int lane) const { epi_prefetch(aux + slot * 4096, st + 2 * 256 * un.pm, cs + 256 * un.pn, bs + 256 * un.pn, wid, lane); }
    __device__ __forceinline__ void operator()(const f32x4 (&acc)[2][2][4][2], const pg8::Unit& un, int, int wr, int wc, int fr, int fq, int slot) const {
        const int colL = 32 * wc + 8 * fq;
        const LAS unsigned char* ep = aux + slot * 4096;
        float csv[2][8], bsv[2][8];
        ld8l((const LAS float*)(ep + 2048) + colL, csv[0]); ld8l((const LAS float*)(ep + 2048) + colL + 128, csv[1]); ld8l((const LAS float*)(ep + 3072) + colL, bsv[0]); ld8l((const LAS float*)(ep + 3072) + colL + 128, bsv[1]);
        f32x2 sv[2][4];
#pragma unroll
        for (int ai = 0; ai < 2; ++ai)
#pragma unroll
            for (int m = 0; m < 4; ++m) sv[ai][m] = ((const LAS f32x2*)ep)[128 * ai + 64 * wr + 16 * m + fr];
#pragma unroll
        for (int ai = 0; ai < 2; ++ai)
#pragma unroll
            for (int m = 0; m < 4; ++m) {
                const int row = 256 * un.pm + 128 * ai + 64 * wr + 16 * m + fr;
                const f32x2 s = sv[ai][m];
                float f[2][8];
#pragma unroll
                for (int bj = 0; bj < 2; ++bj)
#pragma unroll
                    for (int e = 0; e < 8; ++e) f[bj][e] = s.y * (acc[ai][bj][m][e >> 2][e & 3] - s.x * csv[bj][e]) + bsv[bj][e];
                if (un.pn < 8) {
                    float p[8];
#pragma unroll
                    for (int e = 0; e < 8; ++e) p[e] = f[0][e] * f[1][e];
                    *(u32x4*)(u + (size_t)row * DM + 128 * un.pn + colL) = pack8(p);
                } else {
                    *(u32x4*)(bg + (size_t)row * DM + 256 * (un.pn - 8) + colL) = pack8(f[0]);
                    *(u32x4*)(bg + (size_t)row * DM + 256 * (un.pn - 8) + 128 + colL) = pack8(f[1]);
                }
            }
    }
};

struct EpiRes {
    const bf16_t* zprev; const float* stprev; const float* gprev; const float* bprev; bf16_t* zout; float* part; unsigned char* z8;
    __device__ __forceinline__ void prefetch(const pg8::Unit&, int, int, int) const {}
    __device__ __forceinline__ void operator()(const f32x4 (&acc)[2][2][4][2], const pg8::Unit& un, int, int wr, int wc, int fr, int fq, int) const {
        const int cb = 256 * un.pn + 32 * wc + 8 * fq;
        float gv[2][8], bv[2][8];
        ld8(gprev + cb, gv[0]); ld8(gprev + cb + 128, gv[1]); ld8(bprev + cb, bv[0]); ld8(bprev + cb + 128, bv[1]);
#pragma unroll
        for (int ai = 0; ai < 2; ++ai) {
            f32x2 sv[4]; u32x4 zw[4][2];
#pragma unroll
            for (int m = 0; m < 4; ++m) { const int row = 256 * un.pm + 128 * ai + 64 * wr + 16 * m + fr; sv[m] = *(const f32x2*)(stprev + 2 * row);
#pragma unroll
                for (int bj = 0; bj < 2; ++bj) zw[m][bj] = *(const u32x4*)(zprev + (size_t)row * DM + cb + 128 * bj); }
#pragma unroll
            for (int m = 0; m < 4; ++m) {
                const int row = 256 * un.pm + 128 * ai + 64 * wr + 16 * m + fr;
                const f32x2 s = sv[m];
                float sum = 0.f, sq = 0.f;
#pragma unroll
                for (int bj = 0; bj < 2; ++bj) {
                    float z[8], v[8]; unpack8(zw[m][bj], z);
#pragma unroll
                    for (int e = 0; e < 8; ++e) v[e] = ALPHA * ((z[e] - s.x) * s.y * gv[bj][e] + bv[bj][e]) + acc[ai][bj][m][e >> 2][e & 3];
                    const u32x4 o = pack8(v);
                    *(u32x4*)(zout + (size_t)row * DM + cb + 128 * bj) = o;
                    *(u32x2*)(z8 + (size_t)row * DM + cb + 128 * bj) = (u32x2){pk4_fp8(v[0], v[1], v[2], v[3]), pk4_fp8(v[4], v[5], v[6], v[7])};
                    float r[8]; unpack8(o, r);
#pragma unroll
                    for (int e = 0; e < 8; ++e) { sum += r[e]; sq += r[e] * r[e]; }
                }
                { const int ln = fr + 16 * fq; sum += shx(sum, 16, ln); sq += shx(sq, 16, ln); sum += shx(sum, 32, ln); sq += shx(sq, 32, ln); }
                if (fq == 0) *(f32x2*)(part + ((size_t)row * 16 + un.pn * 4 + wc) * 2) = (f32x2){sum, sq};
            }
        }
    }
};

__device__ __forceinline__ void conv_phase(const Frame& F, const bf16_t* u, const bf16_t* bg, const float* ck, bf16_t* y) {
    int tid = threadIdx.x; asm volatile("" : "+v"(tid)); const int lane = tid & 63, wave = __builtin_amdgcn_readfirstlane(tid >> 6); (void)lane; (void)wave;
    const int cg = tid & 127, rs = tid >> 7, t0 = 64 * F.jb + 16 * rs, c0 = 8 * cg;
    const size_t rowb = (size_t)2048 * F.batch;
    float k0[8], k1[8], k2[8], um2[8], um1[8];
    ld8(ck + c0, k0); ld8(ck + DM + c0, k1); ld8(ck + 2 * DM + c0, k2);
    if (t0 >= 2) { unpack8(*(const u32x4*)(u + (rowb + t0 - 2) * DM + c0), um2); unpack8(*(const u32x4*)(u + (rowb + t0 - 1) * DM + c0), um1); }
    else {
#pragma unroll
        for (int e = 0; e < 8; ++e) { um2[e] = 0.f; um1[e] = 0.f; } }
    for (int r4 = 0; r4 < 16; r4 += 16) {
        u32x4 uw[16], bw[16];
#pragma unroll
        for (int i = 0; i < 16; ++i) { const size_t row = rowb + t0 + r4 + i; uw[i] = *(const u32x4*)(u + row * DM + c0); bw[i] = *(const u32x4*)(bg + row * DM + c0); }
#pragma unroll
        for (int i = 0; i < 16; ++i) {
            const size_t row = rowb + t0 + r4 + i;
            float uc[8], b[8], o[8];
            unpack8(uw[i], uc); unpack8(bw[i], b);
#pragma unroll
            for (int e = 0; e < 8; ++e) { o[e] = b[e] * (k0[e] * um2[e] + k1[e] * um1[e] + k2[e] * uc[e]); um2[e] = um1[e]; um1[e] = uc[e]; }
            *(u32x4*)(y + row * DM + c0) = pack8(o);
        }
    }
}

__device__ __forceinline__ f32x2 stats_from_part(const float* part, int row) {
    float s = 0.f, q = 0.f;
#pragma unroll
    for (int i = 0; i < 8; ++i) { const f32x4 p = *(const f32x4*)(part + (size_t)row * 32 + 4 * i); s += p.x + p.z; q += p.y + p.w; }
    const float mu = s * (1.f / DM); float var = q * (1.f / DM) - mu * mu; var = var > 0.f ? var : 0.f;
    return (f32x2){mu, 1.f / sqrtf(var + LN_EPS)};
}


constexpr int RT_LG = 0, RT_ST = 64 * 97 * 4, RT_HIST = RT_ST + 512, RT_BASE = RT_HIST + 256, RT_SEL = RT_BASE + 256, RT_GATE = RT_SEL + 1024;
__device__ __forceinline__ void router_phase(const Frame& F, const bf16_t* z, const float* part, float* stout, const bf16_t* wr_hi, const float* csr, const float* bsr,
                                             const float* rbg, const float* rbe, unsigned* cnt, unsigned* list, float* gate) {
    int tid = threadIdx.x; asm volatile("" : "+v"(tid)); const int lane = tid & 63, wave = __builtin_amdgcn_readfirstlane(tid >> 6);
    LAS unsigned char* aux = F.lds + LDS_AUX;
    LAS float* lg = (LAS float*)(aux + RT_LG); LAS float* stl = (LAS float*)(aux + RT_ST); LAS unsigned* hist = (LAS unsigned*)(aux + RT_HIST); LAS unsigned* base = (LAS unsigned*)(aux + RT_BASE);
    LAS unsigned* sel = (LAS unsigned*)(aux + RT_SEL); LAS float* gl = (LAS float*)(aux + RT_GATE);
    const int row0 = 2048 * F.batch + 64 * F.jb;
    if (tid < 64) { f32x2 s; if (part) { s = stats_from_part(part, row0 + tid); *(f32x2*)(stout + 2 * (row0 + tid)) = s; } else s = *(const f32x2*)(stout + 2 * (row0 + tid));
        stl[2 * tid] = s.x; stl[2 * tid + 1] = s.y; hist[tid] = 0u; }
    const int fr = lane & 15, fq = lane >> 4;
    f32x4 acc[4][6];
#pragma unroll
    for (int m = 0; m < 4; ++m)
#pragma unroll
        for (int j = 0; j < 6; ++j) acc[m][j] = (f32x4){0.f, 0.f, 0.f, 0.f};
    const bf16_t* ap = z + (size_t)(row0 + fr) * DM + 8 * fq;
    const bf16_t* wf = wr_hi + (size_t)lane * 8;
#pragma unroll 1
    for (int k4 = 0; k4 < 4; ++k4) {
        const int ks = 4 * wave + k4;
        bf16x8 a[4], bh[6], bl[6];
#pragma unroll
        for (int m = 0; m < 4; ++m) a[m] = *(const bf16x8*)(ap + (size_t)(16 * m) * DM + 32 * ks);
#pragma unroll
        for (int j = 0; j < 6; ++j) { bh[j] = *(const bf16x8*)(wf + ((size_t)(ks * 2 + 0) * 6 + j) * 512); bl[j] = *(const bf16x8*)(wf + ((size_t)(ks * 2 + 1) * 6 + j) * 512); }
#pragma unroll
        for (int m = 0; m < 4; ++m)
#pragma unroll
            for (int j = 0; j < 6; ++j) { acc[m][j] = __builtin_amdgcn_mfma_f32_16x16x32_bf16(a[m], bh[j], acc[m][j], 0, 0, 0); acc[m][j] = __builtin_amdgcn_mfma_f32_16x16x32_bf16(a[m], bl[j], acc[m][j], 0, 0, 0); }
    }
    {
        LAS f32x4* slots = (LAS f32x4*)(F.lds + LDS_STAGE);
#pragma unroll
        for (int half = 4; half >= 1; half >>= 1) {
            __syncthreads();
            if (wave >= half && wave < 2 * half) {
#pragma unroll
                for (int m = 0; m < 4; ++m)
#pragma unroll
                    for (int j = 0; j < 6; ++j) slots[((wave - half) * 24 + m * 6 + j) * 64 + lane] = acc[m][j];
            }
            __syncthreads();
            if (wave < half) {
#pragma unroll
                for (int m = 0; m < 4; ++m)
#pragma unroll
                    for (int j = 0; j < 6; ++j) acc[m][j] += slots[(wave * 24 + m * 6 + j) * 64 + lane];
            }
        }
    }
    if (wave == 0) {
#pragma unroll
        for (int j = 0; j < 6; ++j) {
            const int n = 16 * j + fr;
            const float c = csr[n], b = bsr[n] + (n < 8 ? rbg[n] : (n < 72 ? rbe[n - 8] : 0.f));
#pragma unroll
            for (int m = 0; m < 4; ++m)
#pragma unroll
                for (int r = 0; r < 4; ++r) { const int tk = 16 * m + 4 * fq + r; lg[tk * 97 + n] = stl[2 * tk + 1] * (acc[m][j][r] - stl[2 * tk] * c) + b; }
        }
    }
    __syncthreads();
    if (tid < 64) {
        const LAS float* l = lg + tid * 97;
        int g = 0; float gm = l[0];
#pragma unroll
        for (int i = 1; i < 8; ++i) { const float v = l[i]; if (v > gm) { gm = v; g = i; } }
        float gs = 0.f;
#pragma unroll
        for (int i = 0; i < 8; ++i) gs += __expf(l[i] - gm);
        const float ggate = 1.f / gs;
        const LAS float* el = l + 8 + 8 * g;
        int i0 = 0; float v0 = el[0];
#pragma unroll
        for (int i = 1; i < 8; ++i) { const float v = el[i]; if (v > v0) { v0 = v; i0 = i; } }
        int i1 = -1; float v1 = 0.f;
#pragma unroll
        for (int i = 0; i < 8; ++i) { const float v = el[i]; if (i != i0 && (i1 < 0 || v > v1)) { v1 = v; i1 = i; } }
        const float ex = __expf(v1 - v0), p0 = 1.f / (1.f + ex), p1 = ex * p0;
        const unsigned e0 = 8 * g + i0, e1 = 8 * g + i1;
        const unsigned r0 = atomicAdd((unsigned*)(hist + e0), 1u), r1 = atomicAdd((unsigned*)(hist + e1), 1u);
        sel[4 * tid] = e0; sel[4 * tid + 1] = e1; sel[4 * tid + 2] = r0; sel[4 * tid + 3] = r1;
        gl[2 * tid] = p0 * ggate; gl[2 * tid + 1] = p1 * ggate;
    }
    __syncthreads();
    if (tid < 64) { const unsigned h = hist[tid]; base[tid] = h ? __hip_atomic_fetch_add(cnt + tid, h, __ATOMIC_RELAXED, __HIP_MEMORY_SCOPE_AGENT) : 0u; }
    __syncthreads();
    if (tid < 64) {
        const unsigned e0 = sel[4 * tid], e1 = sel[4 * tid + 1], tok = (unsigned)(row0 + tid);
        list[(size_t)e0 * 16384 + base[e0] + sel[4 * tid + 2]] = 2u * tok;
        list[(size_t)e1 * 16384 + base[e1] + sel[4 * tid + 3]] = 2u * tok + 1u;
        *(f32x2*)(gate + 2 * tok) = (f32x2){gl[2 * tid], gl[2 * tid + 1]};
    }
}

constexpr int MS_PRE = 0, MS_N = 272, MS_DESC = 288, MS_DDN = 320, MS_ROFF = 512, MS_RINFO = MS_ROFF + 2 * 1024, MS_RDN = MS_RINFO + 2 * 1024, MS_CL = MS_RDN + 6 * 1024, MS_GDN = MS_CL + 256, MS_STUP = MS_GDN + 6 * 1024, MS_EPI = MS_STUP + 2 * 2048  , MS_END = MS_EPI + 3 * 2048;
static_assert(MS_END <= 31744, "MoE tables exceed the AUX region");
constexpr int MOE_MAXDN = 6;
__device__ __forceinline__ void moe_build(const Frame& F, const unsigned* cnt, const unsigned* list, const float* st, const float* gate) {
    int tid = threadIdx.x; asm volatile("" : "+v"(tid));
    LAS unsigned char* aux = F.lds + LDS_AUX;
    LAS unsigned* pre = (LAS unsigned*)(aux + MS_PRE); LAS unsigned* nd = (LAS unsigned*)(aux + MS_N); LAS unsigned* desc = (LAS unsigned*)(aux + MS_DESC); LAS unsigned* ddn = (LAS unsigned*)(aux + MS_DDN);
    LAS unsigned* roff = (LAS unsigned*)(aux + MS_ROFF); LAS unsigned* rinfo = (LAS unsigned*)(aux + MS_RINFO); LAS unsigned* rdn = (LAS unsigned*)(aux + MS_RDN);
    LAS unsigned* cl = (LAS unsigned*)(aux + MS_CL);
    __syncthreads();
    if (tid < 64) {
        const int lane = tid;
        const unsigned c = cnt[lane], nb = (c + 255u) >> 8;
        unsigned incl = nb;
#pragma unroll
        for (int o = 1; o < 64; o <<= 1) { const unsigned t = (unsigned)__builtin_amdgcn_ds_bpermute(((lane - o) & 63) << 2, (int)incl); incl += lane >= o ? t : 0u; }
        const unsigned excl = incl - nb;
        cl[lane] = c; pre[lane] = excl; if (lane == 63) pre[64] = incl;
        const unsigned NB = (unsigned)__builtin_amdgcn_readlane((int)incl, 63), G = (unsigned)F.G, v = (unsigned)((F.bx & 7) * (F.G >> 3) + (F.bx >> 3));
        const unsigned tup = 2u * NB, tdn = 4u * NB, nup2 = tup > G ? tup - G : 0u, nlight = G - nup2;
        unsigned n = 0;
#pragma unroll
        for (int k = 0; k < 2; ++k) {
            const unsigned u = v + (unsigned)k * G;
            if (u < tup) { const unsigned gb = u >> 1, nt = u & 1u;
                const unsigned e = (unsigned)__builtin_popcountll(__builtin_amdgcn_ballot_w64(excl <= gb)) - 1u;
                if (lane == 0) { desc[4 * k] = e; desc[4 * k + 1] = gb; desc[4 * k + 2] = nt; desc[4 * k + 3] = 0u; }
                n = (unsigned)k + 1u; }
        }
        const unsigned pos0 = v >= nup2 ? v - nup2 : nlight + v;
        unsigned m = 0;
#pragma unroll
        for (int k = 0; k < MOE_MAXDN; ++k) {
            const unsigned d = pos0 < nlight ? pos0 + (unsigned)k * nlight : 0xffffffffu;
            if (d < tdn && k < 4) { const unsigned gb = d >> 2, nt = d & 3u;
                const unsigned e = (unsigned)__builtin_popcountll(__builtin_amdgcn_ballot_w64(excl <= gb)) - 1u;
                if (lane == 0) { ddn[4 * m] = e; ddn[4 * m + 1] = gb; ddn[4 * m + 2] = nt; ddn[4 * m + 3] = 0u; }
                m = m + 1u; }
        }
        {
            const unsigned done4 = 4u * nlight;
#pragma unroll
            for (int k = 0; k < 2; ++k) {
                const unsigned d = done4 + v + (unsigned)k * G;
                if (d < tdn) { const unsigned gb = d >> 2, nt = d & 3u;
                    const unsigned e = (unsigned)__builtin_popcountll(__builtin_amdgcn_ballot_w64(excl <= gb)) - 1u;
                    if (lane == 0) { ddn[4 * m] = e; ddn[4 * m + 1] = gb; ddn[4 * m + 2] = nt; ddn[4 * m + 3] = 0u; }
                    m = m + 1u; }
            }
        }
        if (lane == 0) { nd[0] = n; nd[1] = m; }
    }
    __syncthreads();
    const unsigned n = nd[0], m = nd[1];
    for (unsigned i = 0; i < n; ++i) {
        if (tid < 256) { const unsigned e = desc[4 * i], gb = desc[4 * i + 1], idx = (gb - pre[e]) * 256u + (unsigned)tid, c = cl[e];
            LAS f32x2* stup = (LAS f32x2*)(aux + MS_STUP);
            if (idx < c) { const unsigned ts = list[(size_t)e * 16384 + idx]; roff[i * 256 + tid] = (ts >> 1) * (unsigned)DM; rinfo[i * 256 + tid] = ts; stup[i * 256 + tid] = *(const f32x2*)(st + 2 * (ts >> 1)); }
            else { roff[i * 256 + tid] = 0u; rinfo[i * 256 + tid] = 0xffffffffu; stup[i * 256 + tid] = (f32x2){0.f, 1.f}; } }
    }
    for (unsigned i = 0; i < m; ++i) {
        if (tid >= 256) { const unsigned r = (unsigned)tid - 256u, e = ddn[4 * i], gb = ddn[4 * i + 1], idx = (gb - pre[e]) * 256u + r, c = cl[e];
            LAS float* gdn = (LAS float*)(aux + MS_GDN);
            if (idx < c) { const unsigned ts = list[(size_t)e * 16384 + idx]; rdn[i * 256 + r] = ts; gdn[i * 256 + r] = 16.f * gate[ts]; }
            else { rdn[i * 256 + r] = 0xffffffffu; gdn[i * 256 + r] = 0.f; } }
    }
    __syncthreads();
}
template <bool UP>
struct MoeSched {
    LAS unsigned char* aux; const char* Abase; const char* Wbase; unsigned* done;
    __device__ __forceinline__ bool next(int i, pg8::Unit& u) const {
        const unsigned n = ((const LAS unsigned*)(aux + MS_N))[UP ? 0 : 1]; if ((unsigned)i >= n) return false;
        const LAS unsigned* d = (const LAS unsigned*)(aux + (UP ? MS_DESC : MS_DDN)) + 4 * i; const unsigned e = d[0], gb = d[1], nt = d[2];
        if (UP) { u.A = Abase; u.B = Wbase + ((size_t)e * 512 + nt * 256) * DM; }
        else { u.A = Abase + (size_t)gb * 256 * DEXP; u.B = Wbase + ((size_t)e * DM + nt * 256) * DEXP; }
        u.pm = (int)gb; u.pn = (int)nt; u.x0 = (int)e; u.x1 = i; return true;
    }
    __device__ __forceinline__ const LAS unsigned* rowoff(int i) const { return (const LAS unsigned*)(aux + MS_ROFF) + 256 * i; }
    __device__ __forceinline__ void a_ready(const pg8::Unit& u) const {
        if (!UP) {
            int t = threadIdx.x; asm volatile("" : "+v"(t));
            if (__builtin_amdgcn_readfirstlane(t >> 6) == 0) {
                unsigned sp = 0;
                while ((unsigned)__builtin_amdgcn_readfirstlane((int)__hip_atomic_load(done + u.pm, __ATOMIC_RELAXED, __HIP_MEMORY_SCOPE_AGENT)) < 2u) { __builtin_amdgcn_s_sleep(2); if (++sp > (1u << 22)) break; }
                __builtin_amdgcn_fence(__ATOMIC_ACQUIRE, "agent");
                asm volatile("s_waitcnt vmcnt(0)" ::: "memory");
            }
            asm volatile("" ::: "memory"); __builtin_amdgcn_s_barrier(); asm volatile("" ::: "memory");
        }
    }
};
struct EpiUp {
    LAS unsigned char* aux; const float* st; const float* cs; const float* bs; unsigned char* h; unsigned* done;
    __device__ __forceinline__ void prefetch(const pg8::Unit& un, int slot, int wid, int lane) const {
        if (wid == 2 || wid == 3) { const char* s = (const char*)((wid == 2 ? cs : bs) + un.x0 * 512 + 256 * un.pn); int t = threadIdx.x; asm volatile("" : "+v"(t)); (void)lane;
            __builtin_amdgcn_global_load_lds((const unsigned*)(s + (t & 63) * 16), (LAS unsigned*)(aux + MS_EPI + slot * 2048 + (wid - 2) * 1024), 16, 0, 0); } }
    __device__ __forceinline__ void operator()(const f32x4 (&acc)[2][2][4][2], const pg8::Unit& un, int ui, int wr, int wc, int fr, int fq, int slot) const {
        asm volatile("" : "+v"(fr), "+v"(fq));
        const int colL = 32 * wc + 8 * fq;
        const LAS float* ep = (const LAS float*)(aux + MS_EPI + slot * 2048);
        float csv[2][8], bsv[2][8];
        ld8l(ep + colL, csv[0]); ld8l(ep + colL + 128, csv[1]); ld8l(ep + 256 + colL, bsv[0]); ld8l(ep + 256 + colL + 128, bsv[1]);
        const LAS unsigned* rinfo = (const LAS unsigned*)(aux + MS_RINFO) + 256 * ui;
        const LAS f32x2* stup = (const LAS f32x2*)(aux + MS_STUP) + 256 * ui; (void)rinfo;
        f32x2 sv[2][4];
#pragma unroll
        for (int ai = 0; ai < 2; ++ai)
#pragma unroll
            for (int m = 0; m < 4; ++m) sv[ai][m] = stup[128 * ai + 64 * wr + 16 * m + fr];
#pragma unroll
        for (int ai = 0; ai < 2; ++ai)
#pragma unroll
            for (int m = 0; m < 4; ++m) {
                const int r = 128 * ai + 64 * wr + 16 * m + fr;
                const f32x2 s = sv[ai][m];
                float p[8];
#pragma unroll
                for (int e = 0; e < 8; ++e) {
                    const float a1 = s.y * (acc[ai][0][m][e >> 2][e & 3] - s.x * csv[0][e]) + bsv[0][e];
                    const float a3 = s.y * (acc[ai][1][m][e >> 2][e & 3] - s.x * csv[1][e]) + bsv[1][e];
                    p[e] = a1 / (1.f + __expf(-a1)) * a3;
                }
                st8wt(h + ((size_t)un.pm * 256 + r) * DEXP + 128 * un.pn + colL, (u32x2){pk4_fp8(p[0], p[1], p[2], p[3]), pk4_fp8(p[4], p[5], p[6], p[7])});
            }
        asm volatile("s_waitcnt vmcnt(0)" ::: "memory");
        __builtin_amdgcn_s_barrier();
        if (wr == 0 && wc == 0 && fr == 0 && fq == 0) __hip_atomic_fetch_add(done + un.pm, 1u, __ATOMIC_RELAXED, __HIP_MEMORY_SCOPE_AGENT);
    }
};
struct EpiDown {
    LAS unsigned char* aux; const float* gate; unsigned char* y;
    __device__ __forceinline__ void prefetch(const pg8::Unit&, int, int, int) const {}
    __device__ __forceinline__ void operator()(const f32x4 (&acc)[2][2][4][2], const pg8::Unit& un, int ui, int wr, int wc, int fr, int fq, int) const {
        const int cb = 256 * un.pn + 64 * wc + 16 * fq;
        const LAS unsigned* rinfo = (const LAS unsigned*)(aux + MS_RDN) + 256 * ui;
        const LAS float* gdn = (const LAS float*)(aux + MS_GDN) + 256 * ui;
        unsigned tsv[2][4]; float gvv[2][4];
#pragma unroll
        for (int ai = 0; ai < 2; ++ai)
#pragma unroll
            for (int m = 0; m < 4; ++m) { const int r = 128 * ai + 64 * wr + 16 * m + fr; tsv[ai][m] = rinfo[r]; gvv[ai][m] = gdn[r]; }
#pragma unroll
        for (int ai = 0; ai < 2; ++ai)
#pragma unroll
            for (int m = 0; m < 4; ++m) {
                const unsigned ts = tsv[ai][m];
                if (ts != 0xffffffffu) {
                    const float g = gvv[ai][m];
                    u32x4 o;
#pragma unroll
                    for (int bj = 0; bj < 2; ++bj) {
                        float p[8];
#pragma unroll
                        for (int e = 0; e < 8; ++e) p[e] = g * acc[ai][bj][m][e >> 2][e & 3];
                        o[2 * bj] = pk4_fp8(p[0], p[1], p[2], p[3]); o[2 * bj + 1] = pk4_fp8(p[4], p[5], p[6], p[7]);
                    }
                    *(u32x4*)(y + (size_t)ts * DM + cb) = o;
                }
            }
    }
};


struct EpiAttnIn {
    const float* st; const float* cs; const float* bs; unsigned char* q; bf16_t* qi; float* misc; int pn0; LAS unsigned char* aux;
    __device__ __forceinline__ void prefetch(const pg8::Unit& un, int slot, int wid, int lane) const { epi_prefetch(aux + slot * 4096, st + 2 * 256 * un.pm, cs + 256 * (un.pn + pn0), bs + 256 * (un.pn + pn0), wid, lane); }
    __device__ __forceinline__ void operator()(const f32x4 (&acc)[2][2][4][2], const pg8::Unit& un, int, int wr, int wc, int fr, int fq, int slot) const {
        const int pn = un.pn + pn0;
        const int colL = 32 * wc + 8 * fq;
        const LAS unsigned char* ep = aux + slot * 4096;
        float csv[2][8], bsv[2][8];
        ld8l((const LAS float*)(ep + 2048) + colL, csv[0]); ld8l((const LAS float*)(ep + 2048) + colL + 128, csv[1]); ld8l((const LAS float*)(ep + 3072) + colL, bsv[0]); ld8l((const LAS float*)(ep + 3072) + colL + 128, bsv[1]);
        f32x2 sv[2][4];
#pragma unroll
        for (int ai = 0; ai < 2; ++ai)
#pragma unroll
            for (int m = 0; m < 4; ++m) sv[ai][m] = ((const LAS f32x2*)ep)[128 * ai + 64 * wr + 16 * m + fr];
#pragma unroll
        for (int ai = 0; ai < 2; ++ai)
#pragma unroll
            for (int m = 0; m < 4; ++m) {
                const int row = 256 * un.pm + 128 * ai + 64 * wr + 16 * m + fr;
                const f32x2 s = sv[ai][m];
#pragma unroll
                for (int bj = 0; bj < 2; ++bj) {
                    float f[8];
#pragma unroll
                    for (int e = 0; e < 8; ++e) f[e] = s.y * (acc[ai][bj][m][e >> 2][e & 3] - s.x * csv[bj][e]) + bsv[bj][e];
                    if (pn < 8) *(u32x2*)(q + (size_t)row * 2048 + 256 * pn + 128 * bj + colL) = (u32x2){pk4_fp8(f[0], f[1], f[2], f[3]), pk4_fp8(f[4], f[5], f[6], f[7])};
                    else if (pn == 8) { float* d = misc + (size_t)row * 256 + 128 * bj + colL; *(f32x4*)d = (f32x4){f[0], f[1], f[2], f[3]}; *(f32x4*)(d + 4) = (f32x4){f[4], f[5], f[6], f[7]}; }
                    else *(u32x4*)(qi + (size_t)row * 512 + 256 * (pn - 9) + 128 * bj + colL) = pack8(f);
                }
            }
    }
};

__device__ __forceinline__ void attn_norm_phase(const Frame& F, const float* misc, const float* kvg, const float* kig, const float* kib, unsigned char* ckv8, bf16_t* ki) {
    int tid = threadIdx.x; asm volatile("" : "+v"(tid)); const int lane = tid & 63, wave = __builtin_amdgcn_readfirstlane(tid >> 6);
    const int row0 = 2048 * F.batch + 64 * F.jb + 8 * wave;
    const float g0 = kvg[2 * lane], g1 = kvg[2 * lane + 1], kg = kig[lane], kb = kib[lane];
    f32x2 cv[8]; float kv[8];
#pragma unroll
    for (int r = 0; r < 8; ++r) { cv[r] = *(const f32x2*)(misc + (size_t)(row0 + r) * 256 + 2 * lane); kv[r] = misc[(size_t)(row0 + r) * 256 + 128 + lane]; }
#pragma unroll
    for (int r = 0; r < 8; ++r) {
        const int row = row0 + r;
        const f32x2 c = cv[r];
        const float k = kv[r];
        const float ss = wave_sum(c.x * c.x + c.y * c.y, lane);
        const float rinv = 1.f / sqrtf(ss * (1.f / 128.f) + RMS_EPS);
        ((unsigned short*)(ckv8 + (size_t)row * 128))[lane] = (unsigned short)__builtin_amdgcn_cvt_pk_fp8_f32(c.x * rinv * g0, c.y * rinv * g1, 0, false);
        const float mu = wave_sum(k, lane) * (1.f / 64.f); const float d = k - mu;
        const float var = wave_sum(d * d, lane) * (1.f / 64.f);
        ki[(size_t)row * 64 + lane] = (bf16_t)f2bf(d * (1.f / sqrtf(var + LN_EPS)) * kg + kb);
    }
}

__device__ __forceinline__ unsigned sortable(float f) { const unsigned u = __builtin_bit_cast(unsigned, f); return (u & 0x80000000u) ? ~u : (u | 0x80000000u); }
__device__ __forceinline__ unsigned radix_select256(const unsigned (&k)[32], int nvalid, LAS unsigned* hist, int lane) {
    unsigned prefix = 0u, pmask = 0u, krem = 256u;
#pragma unroll 1
    for (int shift = 24; shift >= 0; shift -= 8) {
#pragma unroll
        for (int j = 0; j < 4; ++j) hist[lane + 64 * j] = 0u;
        asm volatile("s_waitcnt lgkmcnt(0)" ::: "memory");
#pragma unroll
        for (int g8 = 0; g8 < 4; ++g8) if (512 * g8 < nvalid) {
#pragma unroll
            for (int i = 8 * g8; i < 8 * g8 + 8; ++i) { const unsigned key = k[i]; if (key != 0u && (key & pmask) == prefix) __hip_atomic_fetch_add(hist + ((key >> shift) & 255u), 1u, __ATOMIC_RELAXED, __HIP_MEMORY_SCOPE_WAVEFRONT); } }
        asm volatile("s_waitcnt lgkmcnt(0)" ::: "memory");
        unsigned h[4];
#pragma unroll
        for (int j = 0; j < 4; ++j) h[j] = hist[255 - 4 * lane - j];
        const unsigned local = (h[0] + h[1]) + (h[2] + h[3]);
        unsigned incl = local;
#pragma unroll
        for (int o = 1; o < 64; o <<= 1) { const unsigned t = (unsigned)__builtin_amdgcn_ds_bpermute(((lane - o) & 63) << 2, (int)incl); incl += lane >= o ? t : 0u; }
        const unsigned long long m = __builtin_amdgcn_ballot_w64(incl >= krem);
        const int L = __builtin_ctzll(m);
        unsigned cum = (unsigned)__builtin_amdgcn_readlane((int)(incl - local), L);
        const unsigned c0 = (unsigned)__builtin_amdgcn_readlane((int)h[0], L), c1 = (unsigned)__builtin_amdgcn_readlane((int)h[1], L), c2 = (unsigned)__builtin_amdgcn_readlane((int)h[2], L), c3 = (unsigned)__builtin_amdgcn_readlane((int)h[3], L);
        unsigned bin, cb;
        if (cum + c0 >= krem) { bin = 255u - 4u * L; cb = c0; }
        else { cum += c0; if (cum + c1 >= krem) { bin = 254u - 4u * L; cb = c1; } else { cum += c1; if (cum + c2 >= krem) { bin = 253u - 4u * L; cb = c2; } else { cum += c2; bin = 252u - 4u * L; cb = c3; } } }
        krem -= cum; prefix |= bin << shift; pmask |= 255u << shift;
        if (cb == krem) break;
    }
    return prefix;
}

__device__ __forceinline__ void index_unit(const Frame& F, const bf16_t* qi, const float* misc, const bf16_t* ki, unsigned short* sel, int b, int t0, int lane, int wave) {
    const int hh = lane >> 5, l31 = lane & 31;
    const size_t rb = (size_t)b * 2048;
    LAS unsigned* sc = (LAS unsigned*)(F.lds + LDS_STAGE);
    const LAS unsigned* bkt = (const LAS unsigned*)(F.lds + LDS_AUX);
#define IDX_PACK(key, t) ({ const int _k = (key), _d = (t) - _k; (unsigned short)(_k | (int)(bkt[_d < 0 ? 0 : (_d > 127 ? 127 : _d)] << 11)); })
    if (t0 < 256) {
#pragma unroll
        for (int qq = 0; qq < 2; ++qq) { const int t = t0 + 2 * wave + qq;
#pragma unroll
            for (int j = 0; j < 4; ++j) { const int idx = lane + 64 * j; sel[(rb + t) * 256 + idx] = idx <= t ? IDX_PACK(idx, t) : (unsigned short)0; } }
        return;
    }
    const int nkt = (t0 + 16 + 31) >> 5;
    {
        LAS unsigned char* aq_l = F.lds + LDS_AUX + 10240; LAS float* w_l = (LAS float*)(F.lds + LDS_AUX + 26624);
        { const char* src = (const char*)(qi + (rb + t0) * 512);
#pragma unroll
          for (int j = 0; j < 2; ++j) __builtin_amdgcn_global_load_lds((const unsigned*)(src + (2 * wave + j) * 1024 + lane * 16), (LAS unsigned*)(aq_l + (2 * wave + j) * 1024), 16, 0, 0);
          if (wave < 2) { const int i = 64 * wave + lane; w_l[i] = misc[(rb + t0 + (i >> 3)) * 256 + 192 + (i & 7)]; } }
        asm volatile("s_waitcnt vmcnt(0)" ::: "memory");
        __syncthreads();
        bf16x8 aq[4][4];
        { const int r = l31, head = (r & 3) + 4 * ((r >> 3) & 1), query = (r >> 4) + 2 * ((r >> 2) & 1);
#pragma unroll
          for (int mt = 0; mt < 4; ++mt) { const LAS unsigned char* ap = aq_l + ((4 * mt + query) * 8 + head) * 128 + 16 * hh;
#pragma unroll
              for (int ks = 0; ks < 4; ++ks) aq[mt][ks] = *(const LAS bf16x8*)(ap + 32 * ks); } }
        const bf16_t* kp = ki + (rb + l31) * 64 + 8 * hh;
        bf16x8 bk[4], bn[4];
        if (wave < nkt) {
#pragma unroll
            for (int ks = 0; ks < 4; ++ks) bk[ks] = *(const bf16x8*)(kp + (size_t)wave * 2048 + 16 * ks); }
        for (int kt = wave; kt < nkt; kt += 8) {
            const int ktn = kt + 8 < nkt ? kt + 8 : kt;
#pragma unroll
            for (int ks = 0; ks < 4; ++ks) bn[ks] = *(const bf16x8*)(kp + (size_t)ktn * 2048 + 16 * ks);
            const int key = 32 * kt + l31;
#pragma unroll
            for (int mt = 0; mt < 4; ++mt) {
                f32x16 acc;
#pragma unroll
                for (int e = 0; e < 16; ++e) acc[e] = 0.f;
#pragma unroll
                for (int ks = 0; ks < 4; ++ks) acc = __builtin_amdgcn_mfma_f32_32x32x16_bf16(aq[mt][ks], bk[ks], acc, 0, 0, 0);
                float s0 = 0.f, s1 = 0.f;
                {
                    const LAS f32x4* wp = (const LAS f32x4*)(w_l + (4 * mt + 2 * hh) * 8); const f32x4 wa = wp[0], wb = wp[1], wc = wp[2], wd = wp[3];
                    const float w0[8] = {wa.x, wa.y, wa.z, wa.w, wb.x, wb.y, wb.z, wb.w}, w1[8] = {wc.x, wc.y, wc.z, wc.w, wd.x, wd.y, wd.z, wd.w};
#pragma unroll
                    for (int e = 0; e < 8; ++e) { s0 += fmaxf(acc[e], 0.f) * w0[e]; s1 += fmaxf(acc[8 + e], 0.f) * w1[e]; }
                }
                const int tq = t0 + 4 * mt + 2 * hh;
                sc[(4 * mt + 2 * hh) * 2048 + key] = key <= tq ? sortable(s0) : 0u;
                sc[(4 * mt + 2 * hh + 1) * 2048 + key] = key <= tq + 1 ? sortable(s1) : 0u;
            }
#pragma unroll
            for (int ks = 0; ks < 4; ++ks) bk[ks] = bn[ks];
        }
    }
    __syncthreads();
    {
    unsigned ka[32], kb[32];
    const int nvalid = 32 * nkt;
#pragma unroll
    for (int i = 0; i < 32; ++i) { const int key = 64 * i + lane; const bool v = key < nvalid; ka[i] = v ? sc[(2 * wave) * 2048 + key] : 0u; kb[i] = v ? sc[(2 * wave + 1) * 2048 + key] : 0u; }
    LAS unsigned* hist = (LAS unsigned*)(F.lds + LDS_AUX + 1024 + wave * 1024);
    const unsigned Ta = radix_select256(ka, nvalid, hist, lane), Tb = radix_select256(kb, nvalid, hist, lane);
#pragma unroll
    for (int qq = 0; qq < 2; ++qq) {
        const unsigned T = qq ? Tb : Ta;
        unsigned nge = 0u;
#pragma unroll
        for (int g8 = 0; g8 < 4; ++g8) if (512 * g8 < nvalid) {
#pragma unroll
            for (int i = 8 * g8; i < 8 * g8 + 8; ++i) nge += (unsigned)__builtin_popcountll(__builtin_amdgcn_ballot_w64((qq ? kb[i] : ka[i]) >= T)); }
        LAS unsigned short* out = (LAS unsigned short*)hist + 256 * qq;
        unsigned base = 0u;
        if (nge == 256u) {
            unsigned pkd[32];
#pragma unroll
            for (int i = 0; i < 32; ++i) pkd[i] = IDX_PACK(64 * i + lane, t0 + 2 * wave + qq);
#pragma unroll
            for (int i = 0; i < 32; ++i) if (64 * i < nvalid) {
                const unsigned k = qq ? kb[i] : ka[i];
                const bool take = k >= T;
                const unsigned long long mtk = __builtin_amdgcn_ballot_w64(take);
                const unsigned tkbelow = __builtin_amdgcn_mbcnt_hi((unsigned)(mtk >> 32), __builtin_amdgcn_mbcnt_lo((unsigned)mtk, 0u));
                if (take) out[base + tkbelow] = (unsigned short)pkd[i];
                base += (unsigned)__builtin_popcountll(mtk);
            }
        } else {
            unsigned ngt = 0u;
#pragma unroll
            for (int i = 0; i < 32; ++i) ngt += (unsigned)__builtin_popcountll(__builtin_amdgcn_ballot_w64((qq ? kb[i] : ka[i]) > T));
            const unsigned need = 256u - ngt;
            unsigned tbase = 0u;
#pragma unroll 4
            for (int i = 0; i < 32; ++i) if (64 * i < nvalid) {
                const unsigned k = qq ? kb[i] : ka[i];
                const bool eq = (k == T), gt = (k > T);
                const unsigned long long meq = __builtin_amdgcn_ballot_w64(eq);
                const unsigned eqbelow = __builtin_amdgcn_mbcnt_hi((unsigned)(meq >> 32), __builtin_amdgcn_mbcnt_lo((unsigned)meq, 0u));
                const bool take = gt || (eq && (tbase + eqbelow) < need);
                tbase += (unsigned)__builtin_popcountll(meq);
                const unsigned long long mtk = __builtin_amdgcn_ballot_w64(take);
                const unsigned tkbelow = __builtin_amdgcn_mbcnt_hi((unsigned)(mtk >> 32), __builtin_amdgcn_mbcnt_lo((unsigned)mtk, 0u));
                if (take) out[base + tkbelow] = IDX_PACK(64 * i + lane, t0 + 2 * wave + qq);
                base += (unsigned)__builtin_popcountll(mtk);
            }
        }
    }
    asm volatile("s_waitcnt lgkmcnt(0)" ::: "memory");
    *(u32x4*)(sel + (rb + t0 + 2 * wave + (lane >> 5)) * 256 + 8 * (lane & 31)) = *(const LAS u32x4*)((const LAS unsigned char*)hist + 16 * lane);
    }
    __syncthreads();
#undef IDX_PACK
}
__device__ __forceinline__ void index_phase(const Frame& F, const bf16_t* qi, const float* misc, const bf16_t* ki, unsigned short* sel) {
    int tid = threadIdx.x; asm volatile("" : "+v"(tid)); const int lane = tid & 63, wave = __builtin_amdgcn_readfirstlane(tid >> 6);
    if (tid < 128) { unsigned bk = (unsigned)tid; if (tid >= 16) { int v = 16 + (int)(__logf((float)tid / 16.f) / 2.0794415416798357f * 16.f); bk = (unsigned)(v < 31 ? v : 31); } ((LAS unsigned*)(F.lds + LDS_AUX))[tid] = bk; }
    __syncthreads();
    const int us[4] = {127 - F.jb, 64 + F.jb, 63 - F.jb, F.jb};
    for (int k = 0; k < 4; ++k) index_unit(F, qi, misc, ki, sel, F.batch, 16 * us[k], lane, wave);
}

constexpr int AT_P = 0, AT_BIAS = 16896, AT_Q = 18944  , AT_SEL = 27136  ;
static_assert(AT_SEL + 3 * 1024 <= 31744, "attention tables exceed the AUX region");
__device__ __forceinline__ unsigned at_f(unsigned row) { return ((row >> 2) & 1u) | (((row >> 1) & 1u) << 1) | (((row >> 3) & 1u) << 2); }
__device__ __forceinline__ void attn_phase(const Frame& F, const unsigned char* q8, const unsigned char* ckv8, const unsigned short* sel, const float* relb, unsigned char* o) {
    int tid = threadIdx.x; asm volatile("" : "+v"(tid)); const int lane = tid & 63, wave = __builtin_amdgcn_readfirstlane(tid >> 6);
    const int fr = lane & 15, fq = lane >> 4;
    LAS unsigned char* aux = F.lds + LDS_AUX;
    LAS float* biast = (LAS float*)(aux + AT_BIAS);
    for (int i = tid; i < 512; i += NTHREADS) biast[i] = relb[i];
    const size_t rb = (size_t)F.batch * 2048;
    const int us0 = 127 - F.jb, us1 = 64 + F.jb, us2 = 63 - F.jb, us3 = F.jb;
#define AT_T(it) (16 * ((it) < 8 ? us0 : ((it) < 16 ? us1 : ((it) < 24 ? us2 : us3))) + 2 * ((it) & 7))
    const unsigned char* ckvb = ckv8 + rb * 128;
    const unsigned dl8 = (unsigned)lane >> 3, dp = (unsigned)lane & 7u;
#define AT_DMA_SEL(t, slot) do { if (wave == 0) \
        __builtin_amdgcn_global_load_lds((const unsigned*)((const unsigned char*)(sel + (rb + (t)) * 256) + 16 * lane), (LAS unsigned*)(aux + AT_SEL + (slot) * 1024), 16, 0, 16); } while (0)
#define AT_DMA_Q(t, buf) do { if (wave == 1) { _Pragma("unroll") for (int j = 0; j < 4; ++j) { const unsigned R = 8u * j + dl8; \
        __builtin_amdgcn_global_load_lds((const unsigned*)(q8 + (rb + (t)) * 2048 + R * 128u + ((dp ^ at_f(R)) << 4)), (LAS unsigned*)(aux + AT_Q + (buf) * 4096 + j * 1024), 16, 0, 0); } } } while (0)
#define AT_GATHER(buf, slot) do { const LAS unsigned short* sp = (const LAS unsigned short*)(aux + AT_SEL + (slot) * 1024) + 32 * wave + dl8; unsigned svv[8]; \
        _Pragma("unroll") for (int j = 0; j < 8; ++j) svv[j] = sp[256 * (j >> 2) + 8 * (j & 3)]; \
        asm volatile("s_waitcnt lgkmcnt(0)" : "+v"(svv[0]), "+v"(svv[1]), "+v"(svv[2]), "+v"(svv[3]), "+v"(svv[4]), "+v"(svv[5]), "+v"(svv[6]), "+v"(svv[7]) :: "memory");     \
        _Pragma("unroll") for (int j = 0; j < 8; ++j) { const unsigned row = 32u * wave + 8u * (j & 3) + dl8; \
        __builtin_amdgcn_global_load_lds((const unsigned*)(ckvb + (size_t)(svv[j] & 2047u) * 128 + ((dp ^ at_f(row)) << 4)), (LAS unsigned*)(F.lds + ((buf) * 2 + (j >> 2)) * 32768 + (32 * wave + 8 * (j & 3)) * 128), 16, 0, 0); } } while (0)
    AT_DMA_SEL(AT_T(0), 0); AT_DMA_SEL(AT_T(1), 1); AT_DMA_Q(AT_T(0), 0);
    asm volatile("s_waitcnt vmcnt(0)" ::: "memory");
    __syncthreads();
    AT_GATHER(0, 0);
    const bf16x8 ones = {0x3F80, 0x3F80, 0x3F80, 0x3F80, 0x3F80, 0x3F80, 0x3F80, 0x3F80};
    const unsigned fsw = at_f((unsigned)fr);
    int s_cur = 0;
    for (int it = 0; it < 32; ++it) {
        const int t0 = AT_T(it), cur = it & 1;
        const int s_nxt = s_cur == 2 ? 0 : s_cur + 1, s_nn = s_nxt == 2 ? 0 : s_nxt + 1;
        asm volatile("s_waitcnt vmcnt(0) lgkmcnt(0)" ::: "memory");
        __builtin_amdgcn_s_barrier();
        if (it < 31) { AT_GATHER(cur ^ 1, s_nxt); AT_DMA_Q(AT_T(it + 1), cur ^ 1); if (it < 30) AT_DMA_SEL(AT_T(it + 2), s_nn); }
        {
            i32x8 qv[2], kv[2][2]; u32x2 pcw[2][2];
#pragma unroll
            for (int qq = 0; qq < 2; ++qq) {
                const LAS unsigned char* qrow = aux + AT_Q + cur * 4096 + (16 * qq + fr) * 128;
                const u32x4 qb0 = *(const LAS u32x4*)(qrow + (((2u * fq) ^ fsw) << 4)), qb1 = *(const LAS u32x4*)(qrow + (((2u * fq + 1u) ^ fsw) << 4));
                qv[qq] = (i32x8){(int)qb0.x, (int)qb0.y, (int)qb0.z, (int)qb0.w, (int)qb1.x, (int)qb1.y, (int)qb1.z, (int)qb1.w};
                const LAS unsigned char* srow = aux + AT_SEL + s_cur * 1024 + qq * 512 + (32 * wave + 4 * fq) * 2;
#pragma unroll
                for (int mt = 0; mt < 2; ++mt) {
                    const LAS unsigned char* krow = F.lds + (cur * 2 + qq) * 32768 + (32 * wave + 16 * mt + fr) * 128;
                    const u32x4 k0 = *(const LAS u32x4*)(krow + (((2u * fq) ^ fsw) << 4)), k1 = *(const LAS u32x4*)(krow + (((2u * fq + 1u) ^ fsw) << 4));
                    kv[qq][mt] = (i32x8){(int)k0.x, (int)k0.y, (int)k0.z, (int)k0.w, (int)k1.x, (int)k1.y, (int)k1.z, (int)k1.w};
                    pcw[qq][mt] = *(const LAS u32x2*)(srow + 32 * mt);
                }
            }
            float bv[2][2][4];
#pragma unroll
            for (int qq = 0; qq < 2; ++qq)
#pragma unroll
                for (int mt = 0; mt < 2; ++mt) {
                    const unsigned pw[2] = {pcw[qq][mt].x, pcw[qq][mt].y};
#pragma unroll
                    for (int r = 0; r < 4; ++r) { const unsigned bucket = ((pw[r >> 1] >> (16 * (r & 1))) & 0xffffu) >> 11; bv[qq][mt][r] = biast[bucket * 16 + fr]; }
                }
            f32x4 sacc[2][2];
#pragma unroll
            for (int qq = 0; qq < 2; ++qq)
#pragma unroll
                for (int mt = 0; mt < 2; ++mt)
                    sacc[qq][mt] = __builtin_amdgcn_mfma_scale_f32_16x16x128_f8f6f4(kv[qq][mt], qv[qq], (f32x4){0.f, 0.f, 0.f, 0.f}, 0, 0, 0, 0x7F7F7F7F, 0, 0x7F7F7F7F);
#pragma unroll
            for (int qq = 0; qq < 2; ++qq) {
                const int nsel = t0 + qq + 1 < TOPK ? t0 + qq + 1 : TOPK;
                LAS unsigned char* prow = aux + AT_P + qq * 8448 + fr * 528 + (32 * wave + 4 * fq) * 2;
#pragma unroll
                for (int mt = 0; mt < 2; ++mt) {
                    float p[4];
#pragma unroll
                    for (int r = 0; r < 4; ++r) {
                        const int slot = 32 * wave + 16 * mt + 4 * fq + r;
                        const float v = fminf(sacc[qq][mt][r] * 0.08838834764831845f + bv[qq][mt][r], 80.f);
                        p[r] = slot < nsel ? __expf(v) : 0.f;
                    }
                    u32x2 pk; pk.x = pk2(p[0], p[1]); pk.y = pk2(p[2], p[3]);
                    *(LAS u32x2*)(prow + 32 * mt) = pk;
                }
            }
        }
        asm volatile("s_waitcnt lgkmcnt(0)" ::: "memory"); __builtin_amdgcn_s_barrier(); asm volatile("" ::: "memory");
        {
            const int qq = wave >> 2; const unsigned db = (unsigned)wave & 3u;
            const unsigned img = (unsigned)(size_t)(F.lds + (cur * 2 + qq) * 32768);
            const LAS unsigned char* pbase = aux + AT_P + qq * 8448 + fr * 528;
            f32x4 oe = (f32x4){0.f, 0.f, 0.f, 0.f}, oo = (f32x4){0.f, 0.f, 0.f, 0.f}, tacc = (f32x4){0.f, 0.f, 0.f, 0.f};
            const unsigned r4 = (unsigned)(lane & 15) >> 2, c4 = (unsigned)lane & 3u;
            u32x2 ta[8][2]; bf16x8 pb[8];
#pragma unroll
            for (int ks = 0; ks < 8; ++ks)
#pragma unroll
                for (int h2 = 0; h2 < 2; ++h2) {
                    const unsigned row = 32u * ks + 8u * fq + 4u * h2 + r4;
                    const unsigned a0 = img + row * 128u + (((2u * db + (c4 >> 1)) ^ at_f(row)) << 4) + 8u * (c4 & 1u);
                    asm volatile("ds_read_b64_tr_b16 %0, %1" : "=&v"(ta[ks][h2]) : "v"(a0) : "memory");
                }
#pragma unroll
            for (int ks = 0; ks < 8; ++ks) pb[ks] = *(const LAS bf16x8*)(pbase + (32 * ks + 8 * fq) * 2);
            asm volatile("s_waitcnt lgkmcnt(0)" : "+v"(ta[0][0]), "+v"(ta[0][1]), "+v"(ta[1][0]), "+v"(ta[1][1]), "+v"(ta[2][0]), "+v"(ta[2][1]), "+v"(ta[3][0]), "+v"(ta[3][1]),
                         "+v"(ta[4][0]), "+v"(ta[4][1]), "+v"(ta[5][0]), "+v"(ta[5][1]), "+v"(ta[6][0]), "+v"(ta[6][1]), "+v"(ta[7][0]), "+v"(ta[7][1]) :: "memory");
#pragma unroll
            for (int ks = 0; ks < 8; ++ks) {
                const unsigned w[4] = {ta[ks][0].x, ta[ks][0].y, ta[ks][1].x, ta[ks][1].y};
                u32x4 ev, od;
#pragma unroll
                for (int j = 0; j < 4; ++j) {
                    const f32x2 a = __builtin_amdgcn_cvt_pk_f32_fp8((int)w[j], false), b = __builtin_amdgcn_cvt_pk_f32_fp8((int)w[j], true);
                    ev[j] = pg8::cvt_pk_bf16(a.x, b.x); od[j] = pg8::cvt_pk_bf16(a.y, b.y);
                }
                oe = __builtin_amdgcn_mfma_f32_16x16x32_bf16(__builtin_bit_cast(bf16x8, ev), pb[ks], oe, 0, 0, 0);
                oo = __builtin_amdgcn_mfma_f32_16x16x32_bf16(__builtin_bit_cast(bf16x8, od), pb[ks], oo, 0, 0, 0);
                tacc = __builtin_amdgcn_mfma_f32_16x16x32_bf16(ones, pb[ks], tacc, 0, 0, 0);
            }
            const float inv = __builtin_amdgcn_rcpf(tacc[0]);
            *(u32x2*)(o + ((rb + t0 + qq) * 16 + fr) * 128 + 32 * db + 8 * fq) = (u32x2){pk4_fp8(oe[0] * inv, oo[0] * inv, oe[1] * inv, oo[1] * inv), pk4_fp8(oe[2] * inv, oo[2] * inv, oe[3] * inv, oo[3] * inv)};
        }
        s_cur = s_nxt;
    }
    asm volatile("s_waitcnt vmcnt(0)" ::: "memory");
    __syncthreads();
#undef AT_DMA_SEL
#undef AT_DMA_Q
#undef AT_GATHER
#undef AT_T
}

__global__ void __launch_bounds__(NTHREADS, 2) fwd_kernel(Params P) {
    extern __shared__ __attribute__((aligned(16))) unsigned char lds_raw[];
    Frame F;
    F.lds = (LAS unsigned char*)lds_raw;
    F.G = gridDim.x; F.bx = blockIdx.x; F.batch = F.bx & 7; F.jb = F.bx >> 3; F.ws = P.ws;
    unsigned char* ws = P.ws;
    for (int u = threadIdx.x; u < 256; u += NTHREADS) ((LAS unsigned*)(F.lds + LDS_MISC))[u] = 0u;
    __syncthreads();
    XcdBarrier bar = xcd_barrier_post((unsigned*)(ws + WS_CTL) + CW_BAR, (volatile LAS unsigned*)(F.lds + LDS_MISC));
#define GRID_BAR() xcd_barrier<false>(bar)
#define GRID_BAR_L() xcd_barrier<true>(bar)
    if (threadIdx.x == 0) (void)xb_add((unsigned*)(ws + WS_CTL) + CW_XCC + F.bx, bar.x + 1u);

    bf16_t* zA; bf16_t* zB; float* stA; float* stB;
    const float* ones; const float* zeros;

    p0_prologue(F, P);
    GRID_BAR();
    {
        volatile LAS unsigned* okw = (volatile LAS unsigned*)(F.lds + LDS_MISC) + 3;
        if (threadIdx.x == 0) okw[0] = (F.G == 256) ? 1u : 0u;
        __syncthreads();
        if (threadIdx.x < 256 && (int)threadIdx.x < F.G) { unsigned* tab = (unsigned*)(ws + WS_CTL) + CW_XCC; const unsigned v = xb_ld(tab + threadIdx.x), r = xb_ld(tab + (threadIdx.x & 7)); if (v == 0u || v != r) okw[0] = 0u; }
        __syncthreads();
        if (threadIdx.x == 0) ((volatile LAS unsigned*)(F.lds + LDS_MISC))[2] = okw[0];
        __syncthreads();
    }
    {
        const float* csp = (const float*)(ws + WS_CSP); float* cs = (float*)(ws + WS_CSUP); float* bs = (float*)(ws + WS_BSUP);
        constexpr int NV = 4 * 64 * 512;
        for (int i = F.bx * NTHREADS + (int)threadIdx.x; i < NV; i += F.G * NTHREADS) {
            float a = 0.f, b = 0.f;
#pragma unroll 8
            for (int kt = 0; kt < 16; ++kt) { a += csp[(size_t)kt * NV + i]; b += csp[(size_t)(32 + kt) * NV + i]; }
            cs[i] = a; bs[i] = b;
        }
    }

    for (int layer = 0; layer < DEPTH; ++layer) {
        asm volatile("" : "+s"(ws));
        zA = (bf16_t*)(ws + WS_ZA); zB = (bf16_t*)(ws + WS_ZB); stA = (float*)(ws + WS_STA); stB = (float*)(ws + WS_STB); ones = (const float*)(ws + WS_VEC); zeros = ones + 1024;
        const float* gprev = layer ? P.in[I_L2G] + (layer - 1) * DM : ones;
        const float* bprev = layer ? P.in[I_L2B] + (layer - 1) * DM : zeros;
        const int jl = layer >> 1;
        bool have_part = false;
        if ((layer & 1) == 0) {
            {
                pg8::StaticOrder S; S.init(T_TOK, 3072, F.G, F.bx, zA, DM * 2, (const bf16_t*)(ws + WS_WCI) + (size_t)jl * 3072 * DM, DM * 2);
                EpiConvIn E{stA, (const float*)(ws + WS_CSCI) + jl * 3072, (const float*)(ws + WS_BSCI) + jl * 3072, (bf16_t*)(ws + WS_U), (bf16_t*)(ws + WS_BG), F.lds + LDS_AUX};
                pg8::gemm_phase<EpiConvIn, pg8::StaticOrder, false>(F.lds + LDS_STAGE, DM, DM * 2, DM * 2, S, E);
            }
            GRID_BAR_L();
            conv_phase(F, (const bf16_t*)(ws + WS_U), (const bf16_t*)(ws + WS_BG), P.in[I_CK] + (size_t)jl * 3 * DM, (bf16_t*)(ws + WS_Y));
            GRID_BAR_L();
            {
                pg8::StaticOrder S; S.init(T_TOK, DM, F.G, F.bx, (const bf16_t*)(ws + WS_Y), DM * 2, (const bf16_t*)(ws + WS_WCO) + (size_t)jl * DM * DM, DM * 2);
                EpiRes E{zA, stA, gprev, bprev, zB, (float*)(ws + WS_PART), ws + WS_Z8};
                pg8::gemm_phase<EpiRes, pg8::StaticOrder, false>(F.lds + LDS_STAGE, DM, DM * 2, DM * 2, S, E);
            }
            have_part = true;
            GRID_BAR_L();
        } else {
            {
                pg8::StaticOrder S; S.init(T_TOK, 2048, F.G, F.bx, ws + WS_ZA8, DM, ws + WS_WAI + (size_t)jl * AIWP * DM * 2, DM);
                EpiAttnIn E{stA, (const float*)(ws + WS_CSAI) + jl * AIWP, (const float*)(ws + WS_BSAI) + jl * AIWP, ws + WS_Q, (bf16_t*)(ws + WS_QI), (float*)(ws + WS_MISC), 0, F.lds + LDS_AUX};
                pg8::gemm_phase<EpiAttnIn, pg8::StaticOrder, false, true>(F.lds + LDS_STAGE, DM / 2, DM, DM, S, E);
            }
            {
                pg8::StaticOrder S; S.init(T_TOK, AIWP - 2048, F.G, F.bx, zA, DM * 2, (const bf16_t*)(ws + WS_WAI) + (size_t)jl * AIWP * DM + (size_t)2048 * DM, DM * 2);
                EpiAttnIn E{stA, (const float*)(ws + WS_CSAI) + jl * AIWP, (const float*)(ws + WS_BSAI) + jl * AIWP, ws + WS_Q, (bf16_t*)(ws + WS_QI), (float*)(ws + WS_MISC), 8, F.lds + LDS_AUX + 12288};
                pg8::gemm_phase<EpiAttnIn, pg8::StaticOrder, false>(F.lds + LDS_STAGE, DM, DM * 2, DM * 2, S, E);
            }
            GRID_BAR_L();
            attn_norm_phase(F, (const float*)(ws + WS_MISC), P.in[I_KVG] + jl * KVL, P.in[I_KIG] + jl * IDXD, P.in[I_KIB] + jl * IDXD, ws + WS_CKV, (bf16_t*)(ws + WS_KI));
            GRID_BAR_L();
            index_phase(F, (const bf16_t*)(ws + WS_QI), (const float*)(ws + WS_MISC), (const bf16_t*)(ws + WS_KI), (unsigned short*)(ws + WS_SEL));
            asm volatile("s_waitcnt vmcnt(0)" ::: "memory"); __syncthreads();
            attn_phase(F, ws + WS_Q, ws + WS_CKV, (const unsigned short*)(ws + WS_SEL), P.in[I_RELB], ws + WS_O);
            GRID_BAR_L();
            {
                pg8::StaticOrder S; S.init(T_TOK, DM, F.G, F.bx, ws + WS_O, 2048, ws + WS_WAO + (size_t)jl * DM * 2048, 2048);
                EpiRes E{zA, stA, gprev, bprev, zB, (float*)(ws + WS_PART), ws + WS_Z8};
                pg8::gemm_phase<EpiRes, pg8::StaticOrder, false, true>(F.lds + LDS_STAGE, 2048 / 2, 2048, 2048, S, E, 127 - 6);
            }
            have_part = true;
            GRID_BAR_L();
        }
        const float* partin = have_part ? (const float*)(ws + WS_PART) : nullptr;
        const unsigned char* ym = nullptr;
        {
            unsigned* cnt = (unsigned*)(ws + WS_CTL) + CW_CNT + 64 * layer; unsigned* list = (unsigned*)(ws + WS_LIST); float* gate = (float*)(ws + WS_GATE);
            const bf16_t* wrh = (const bf16_t*)(ws + WS_WR) + (size_t)layer * 32 * 2 * 6 * 512;
            router_phase(F, zB, partin, stB, wrh, (const float*)(ws + WS_CSR) + layer * 96, (const float*)(ws + WS_BSR) + layer * 96, P.in[I_RBG] + layer * 8, P.in[I_RBE] + layer * 64, cnt, list, gate);
            partin = nullptr;
            GRID_BAR();
            {
                unsigned* done = (unsigned*)(ws + WS_CTL) + CW_DONE + 256 * layer;
                moe_build(F, cnt, list, stB, gate);
                {
                    MoeSched<true> S{F.lds + LDS_AUX, (const char*)(ws + WS_Z8), (const char*)(ws + WS_WUP) + (size_t)layer * 64 * 512 * DM, done};
                    EpiUp E{F.lds + LDS_AUX, stB, (const float*)(ws + WS_CSUP) + (size_t)layer * 64 * 512, (const float*)(ws + WS_BSUP) + (size_t)layer * 64 * 512, ws + WS_H, done};
                    pg8::gemm_phase<EpiUp, MoeSched<true>, true, true>(F.lds + LDS_STAGE, DM / 2, DM, DM, S, E);
                }
                {
                    MoeSched<false> S{F.lds + LDS_AUX, (const char*)(ws + WS_H), (const char*)(ws + WS_WDN) + (size_t)layer * 64 * DM * DEXP, done};
                    EpiDown E{F.lds + LDS_AUX, gate, ws + WS_YM};
                    pg8::gemm_phase<EpiDown, MoeSched<false>, false, true>(F.lds + LDS_STAGE, DEXP / 2, DEXP, DEXP, S, E);
                }
            }
            GRID_BAR();
            ym = ws + WS_YM;
        }
        if (layer < DEPTH - 1) combine_phase<false>(F, zB, stB, partin, P.in[I_L1G] + layer * DM, P.in[I_L1B] + layer * DM, ym, zA, stA, nullptr, nullptr, nullptr, (layer & 1) ? nullptr : ws + WS_ZA8);
        else combine_phase<true>(F, zB, stB, partin, P.in[I_L1G] + layer * DM, P.in[I_L1B] + layer * DM, ym, nullptr, nullptr, P.in[I_L2G] + layer * DM, P.in[I_L2B] + layer * DM, P.out, nullptr);
        if (layer < DEPTH - 1) GRID_BAR_L();
    }
}

extern "C" void kernel_launch(void* const* d_in, const int* in_sizes, int n_in, void* d_out, int out_size, void* d_ws, size_t ws_size, hipStream_t stream) {
    static int grid = 0;
    if (!grid) {
        if (n_in != 21 || out_size != T_TOK * DM || ws_size < WS_END) { fprintf(stderr, "kernel_launch: unexpected shapes (n_in %d out %d ws %zu need %zu)\n", n_in, out_size, ws_size, (size_t)WS_END); grid = -1; return; }
        int dev = 0, cus = 0, per_cu = 0;
        hipGetDevice(&dev); hipDeviceGetAttribute(&cus, hipDeviceAttributeMultiprocessorCount, dev);
        if (hipFuncSetAttribute((const void*)fwd_kernel, hipFuncAttributeMaxDynamicSharedMemorySize, LDS_BYTES) != hipSuccess) { fprintf(stderr, "kernel_launch: hipFuncSetAttribute failed\n"); grid = -1; return; }
        hipOccupancyMaxActiveBlocksPerMultiprocessor(&per_cu, (const void*)fwd_kernel, NTHREADS, LDS_BYTES);
        if (per_cu < 1) fprintf(stderr, "kernel_launch: occupancy query reports %d\n", per_cu);
        grid = 256;
        if (cus != 256) fprintf(stderr, "kernel_launch: %d CUs (built for 256)\n", cus);
    }
    if (grid <= 0) return;
    hipMemsetAsync((char*)d_ws + WS_CTL, 0, CTL_BYTES, stream);
    Params p{};
    for (int i = 0; i < 21; ++i) p.in[i] = (const float*)d_in[i];
    p.out = (float*)d_out; p.ws = (unsigned char*)d_ws; p.ph_lo = 0; p.ph_hi = 1000;
    hipLaunchKernelGGL(fwd_kernel, dim3(grid), dim3(NTHREADS), LDS_BYTES, stream, p);
}
```

```cpp
#include <hip/hip_runtime.h>
#include <cstdio>
#include <cstdint>

#define LAS __attribute__((address_space(3)))
#define GAS __attribute__((address_space(1)))
typedef unsigned short bf16_t;
typedef short bf16x8 __attribute__((ext_vector_type(8)));
typedef float f32x4 __attribute__((ext_vector_type(4)));
typedef float f32x2 __attribute__((ext_vector_type(2)));
typedef float f32x16 __attribute__((ext_vector_type(16)));
typedef unsigned u32x4 __attribute__((ext_vector_type(4)));
typedef unsigned u32x2 __attribute__((ext_vector_type(2)));

constexpr int T_TOK = 16384, DM = 1024, NBATCH = 8, SEQ = 2048, DEPTH = 4;
constexpr int NH = 16, KVL = 128, NIH = 8, IDXD = 64, TOPK = 256;
constexpr int AIW = 2760, AIWP = 2816;
constexpr int NGRP = 8, EPG = 8, NEXP = 64, DEXP = 256;
constexpr float LN_EPS = 1e-5f, RMS_EPS = 1e-6f;
constexpr float ALPHA = 1.6817928305074290f;
constexpr int NWAVES = 8, NTHREADS = 512;
constexpr int MAXBLK = 192;

constexpr size_t MiB = 1u << 20;
constexpr size_t alup(size_t x) { return (x + MiB - 1) & ~(MiB - 1); }
constexpr size_t WS_CTL = 0, CTL_BYTES = MiB;
constexpr size_t WS_VEC = WS_CTL + CTL_BYTES;
constexpr size_t WS_CSCI = WS_VEC + MiB;
constexpr size_t WS_BSCI = WS_CSCI + 2 * 3072 * 4;
constexpr size_t WS_CSAI = WS_BSCI + 2 * 3072 * 4;
constexpr size_t WS_BSAI = WS_CSAI + 2 * AIWP * 4;
constexpr size_t WS_CSR  = WS_BSAI + 2 * AIWP * 4;
constexpr size_t WS_BSR  = WS_CSR + 4 * 96 * 4;
constexpr size_t WS_CSUP = alup(WS_BSR + 4 * 96 * 4);
constexpr size_t WS_BSUP = WS_CSUP + (size_t)4 * 64 * 512 * 4;
constexpr size_t WS_WCI  = alup(WS_BSUP + (size_t)4 * 64 * 512 * 4);
constexpr size_t WS_WCO  = WS_WCI + (size_t)2 * 3072 * 1024 * 2;
constexpr size_t WS_WAI  = WS_WCO + (size_t)2 * 1024 * 1024 * 2;
constexpr size_t WS_WAO  = alup(WS_WAI + (size_t)2 * AIWP * 1024 * 2);
constexpr size_t WS_WR   = WS_WAO + (size_t)2 * 1024 * 2048 * 2;
constexpr size_t WS_WUP  = alup(WS_WR + (size_t)4 * 2 * 96 * 1024 * 2);
constexpr size_t WS_WDN  = WS_WUP + (size_t)4 * 64 * 512 * 1024 * 2;
constexpr size_t WS_ZA   = WS_WDN + (size_t)4 * 64 * 1024 * 256 * 2;
constexpr size_t WS_ZB   = WS_ZA + (size_t)T_TOK * DM * 2;
constexpr size_t WS_STA  = WS_ZB + (size_t)T_TOK * DM * 2;
constexpr size_t WS_STB  = WS_STA + (size_t)T_TOK * 8;
constexpr size_t WS_PART = alup(WS_STB + (size_t)T_TOK * 8);
constexpr size_t WS_U    = WS_PART + (size_t)T_TOK * 16 * 8;
constexpr size_t WS_BG   = WS_U + (size_t)T_TOK * DM * 2;
constexpr size_t WS_Y    = WS_BG + (size_t)T_TOK * DM * 2;
constexpr size_t WS_Q    = WS_Y + (size_t)T_TOK * DM * 2;
constexpr size_t WS_QI   = WS_Q + (size_t)T_TOK * 2048 * 2;
constexpr size_t WS_MISC = WS_QI + (size_t)T_TOK * 512 * 2;
constexpr size_t WS_CKV  = WS_MISC + (size_t)T_TOK * 256 * 4;
constexpr size_t WS_KI   = WS_CKV + (size_t)T_TOK * 128 * 2;
constexpr size_t WS_SEL  = WS_KI + (size_t)T_TOK * 64 * 2;
constexpr size_t WS_O    = WS_SEL + (size_t)T_TOK * 256 * 2;
constexpr size_t WS_LIST = WS_O + (size_t)T_TOK * 2048 * 2;
constexpr size_t WS_GATE = WS_LIST + (size_t)64 * 16384 * 4;
constexpr size_t WS_H    = alup(WS_GATE + (size_t)T_TOK * 8);
constexpr size_t WS_YM   = WS_H + (size_t)MAXBLK * 256 * 256 * 2;
constexpr size_t WS_CSP  = WS_YM + (size_t)T_TOK * 2 * DM * 2;
constexpr size_t WS_Z8   = WS_CSP + (size_t)2 * 32 * 4 * 64 * 512 * 4;
constexpr size_t WS_ZA8  = WS_Z8 + (size_t)T_TOK * DM;
constexpr size_t WS_END  = WS_ZA8 + (size_t)T_TOK * DM;

constexpr int CW_BAR = 4096;
constexpr int CW_CNT = 16384;
constexpr int CW_XCC = 8192;
constexpr int CW_QUEUE = 20480;
constexpr int CW_DONE = 24576;

constexpr int LDS_STAGE = 0, STAGE_BYTES_ALL = 131072;
constexpr int LDS_AUX = 131072;
constexpr int LDS_MISC = 131072 + 31744;
constexpr int LDS_BYTES = 163840;

__device__ __forceinline__ unsigned f2bf(float f) { unsigned u = __builtin_bit_cast(unsigned, f); return (u + 0x7fffu + ((u >> 16) & 1u)) >> 16; }
__device__ __forceinline__ float bf2f(unsigned b) { return __builtin_bit_cast(float, b << 16); }
__device__ __forceinline__ unsigned pk2(float lo, float hi) { return f2bf(lo) | (f2bf(hi) << 16); }
__device__ __forceinline__ float bflo(unsigned w) { return __builtin_bit_cast(float, w << 16); }
__device__ __forceinline__ float bfhi(unsigned w) { return __builtin_bit_cast(float, w & 0xffff0000u); }
__device__ __forceinline__ float shx(float v, int o, int lane) { return __builtin_bit_cast(float, __builtin_amdgcn_ds_bpermute((lane ^ o) << 2, __builtin_bit_cast(int, v))); }
__device__ __forceinline__ float wave_sum(float v, int lane) {
#pragma unroll
    for (int o = 1; o < 64; o <<= 1) v += shx(v, o, lane);
    return v;
}
__device__ __forceinline__ void st16wt(void* p, const u32x4 v) { asm volatile("global_store_dwordx4 %0, %1, off sc1\n\ts_nop 1" :: "v"(p), "v"(v) : "memory"); }
typedef int i32x8 __attribute__((ext_vector_type(8)));
__device__ __forceinline__ unsigned pk4_fp8(float a, float b, float c, float d) { int w = 0; w = __builtin_amdgcn_cvt_pk_fp8_f32(a, b, w, false); w = __builtin_amdgcn_cvt_pk_fp8_f32(c, d, w, true); return (unsigned)w; }
__device__ __forceinline__ float fp8_rt(float a) { const int w = __builtin_amdgcn_cvt_pk_fp8_f32(a, a, 0, false); return __builtin_amdgcn_cvt_f32_fp8(w, 0); }
__device__ __forceinline__ void st8wt(void* p, const u32x2 v) { __hip_atomic_store((unsigned long long*)p, ((unsigned long long)v.y << 32) | v.x, __ATOMIC_RELAXED, __HIP_MEMORY_SCOPE_AGENT); }
#define LDS_WAIT() asm volatile("s_waitcnt lgkmcnt(0)" ::: "memory")
#define VM_WAIT() asm volatile("s_waitcnt vmcnt(0)" ::: "memory")

#define XB_TMO      128
#define XB_XCNT(j)  (256  + 64 * (j))
#define XB_XSUB(j)  (1280 + 64 * (j))
#define XB_XGEN(j)  (2304 + 64 * (j))
#define XB_TOP      3328
#define XB_TOPGEN   3392
#define XCD_BAR_WORDS 3456
#define XB_SPIN_CAP (1u << 18)

__device__ __forceinline__ unsigned xb_ld(unsigned* p)              { return __hip_atomic_load(p, __ATOMIC_RELAXED, __HIP_MEMORY_SCOPE_AGENT); }
__device__ __forceinline__ unsigned xb_add(unsigned* p, unsigned v) { return __hip_atomic_fetch_add(p, v, __ATOMIC_RELAXED, __HIP_MEMORY_SCOPE_AGENT); }
__device__ __forceinline__ unsigned xb_xcc_id() { return (unsigned)__builtin_amdgcn_s_getreg((3 << 11) | 20) & 0xFu; }
#define XB_SPIN(cond, bar) do { unsigned _sp = 0; while (cond) { __builtin_amdgcn_s_sleep(1); \
    if ((++_sp & 255u) == 0u) { if (xb_ld(&(bar)[XB_TMO])) break; if (_sp > XB_SPIN_CAP) { atomicAdd(&(bar)[XB_TMO], 1u); break; } } } } while (0)

struct XcdBarrier {
    unsigned* bar; unsigned x;
    volatile LAS unsigned* st;
};

__device__ __forceinline__ XcdBarrier xcd_barrier_post(unsigned* bar, volatile LAS unsigned* st) {
    XcdBarrier b; b.bar = bar; b.x = xb_xcc_id(); b.st = st;
    if (threadIdx.x == 0) (void)xb_add(&bar[XB_XCNT(b.x)], 1u);
    return b;
}
__device__ __forceinline__ void xcd_barrier_complete(unsigned* bar, unsigned x, unsigned& nloc, unsigned& nx) {
    const unsigned G = gridDim.x * gridDim.y * gridDim.z;
    unsigned sum, cnt, mine, sp = 0u;
    for (;;) {
        sum = 0u; cnt = 0u; mine = 0u;
#pragma unroll
        for (unsigned j = 0; j < 16; ++j) { const unsigned c = xb_ld(&bar[XB_XCNT(j)]); sum += c; cnt += (c > 0u) ? 1u : 0u; mine = (j == x) ? c : mine; }
        if (sum == G) break;
        __builtin_amdgcn_s_sleep(1);
        if ((++sp & 255u) == 0u) { if (xb_ld(&bar[XB_TMO])) break; if (sp > XB_SPIN_CAP) { atomicAdd(&bar[XB_TMO], 1u); break; } }
    }
    nloc = mine > 0u ? mine : 1u; nx = cnt > 0u ? cnt : 1u;
}

template <bool LOCAL = false>
__device__ __forceinline__ void xcd_barrier(const XcdBarrier& b_in) {
    XcdBarrier b = b_in; asm volatile("" : "+s"(b.bar), "+s"(b.x));
    asm volatile("s_waitcnt vmcnt(0)" ::: "memory");
    __syncthreads();
    if (threadIdx.x == 0) {
        unsigned* bar = b.bar;
        __builtin_amdgcn_s_waitcnt(0);
        unsigned nloc = b.st[0], nx = b.st[1];
        if (nloc == 0u) { xcd_barrier_complete(bar, b.x, nloc, nx); b.st[0] = nloc; b.st[1] = nx; }
        const unsigned old = xb_add(&bar[XB_XSUB(b.x)], 1u);
        const unsigned gen = old / nloc;
        if (old + 1u == (gen + 1u) * nloc) {
          if (!(LOCAL && b.st[2] != 0u)) {
            __builtin_amdgcn_fence(__ATOMIC_RELEASE, "agent");
            asm volatile("s_waitcnt vmcnt(0)" ::: "memory");
            const unsigned og = xb_add(&bar[XB_TOP], 1u);
            const unsigned tg = og / nx;
            if (og + 1u == (tg + 1u) * nx) xb_add(&bar[XB_TOPGEN], 1u);
            else XB_SPIN(xb_ld(&bar[XB_TOPGEN]) == tg, bar);
          }
            __builtin_amdgcn_fence(__ATOMIC_ACQUIRE, "agent");
            xb_add(&bar[XB_XGEN(b.x)], 1u);
            asm volatile("s_waitcnt vmcnt(0)" ::: "memory");
        } else {
            XB_SPIN(xb_ld(&bar[XB_XGEN(b.x)]) == gen, bar);
            __builtin_amdgcn_fence(__ATOMIC_ACQUIRE, "agent");
            asm volatile("s_waitcnt vmcnt(0)" ::: "memory");
        }
    }
    __syncthreads();
}

struct Params { const float* in[21]; float* out; unsigned char* ws; int ph_lo, ph_hi; };
enum { I_X = 0, I_CWIN, I_CK, I_CWOUT, I_AWIN, I_KVG, I_KIG, I_KIB, I_AWOUT, I_RELB, I_RWG, I_RBG, I_RWE, I_RBE, I_W1, I_W3, I_W2, I_L1G, I_L1B, I_L2G, I_L2B };

struct Frame {
    LAS unsigned char* lds;
    int G, bx;
    int batch, jb;
    unsigned char* ws;
};

__device__ __forceinline__ unsigned bf4_to_fp8(const u32x2 w) {
    return pk4_fp8(__builtin_bit_cast(float, w.x << 16), __builtin_bit_cast(float, w.x & 0xffff0000u), __builtin_bit_cast(float, w.y << 16), __builtin_bit_cast(float, w.y & 0xffff0000u));
}
template <bool F8 = false>
__device__ __forceinline__ void prol_item64(const float* W, int K, int ldw, int src0, int nvalid, const float* gk, const float* bk, float colscale,
                                            void* Btv, int ldbt, int n0, float* cs, float* bs, LAS unsigned char* scr, int lane) {
    const int kk = lane >> 4, c4 = lane & 15;
    float csum[4] = {0.f, 0.f, 0.f, 0.f}, bsum[4] = {0.f, 0.f, 0.f, 0.f};
    const bool cv = 4 * c4 < nvalid;
    const unsigned sbase = (unsigned)(size_t)scr;
    const unsigned q4 = (unsigned)(lane & 15) >> 2, p4 = (unsigned)lane & 3u;
    for (int k0 = 0; k0 < K; k0 += 64) {
        f32x4 v[16]; float gv[16], bv[16];
#pragma unroll
        for (int ld = 0; ld < 16; ++ld) { gv[ld] = gk ? gk[k0 + 4 * ld + kk] : 1.f; bv[ld] = bk ? bk[k0 + 4 * ld + kk] : 0.f; }
#pragma unroll
        for (int ld = 0; ld < 16; ++ld) v[ld] = cv ? *(const f32x4*)(W + (size_t)(k0 + 4 * ld + kk) * ldw + src0 + 4 * c4) : (f32x4){0.f, 0.f, 0.f, 0.f};
#pragma unroll
        for (int ld = 0; ld < 16; ++ld) {
            const float g = gv[ld] * colscale, bb = bv[ld] * colscale;
            unsigned h[4];
#pragma unroll
            for (int e = 0; e < 4; ++e) { if constexpr (F8) { const float r = fp8_rt(v[ld][e] * g); h[e] = __builtin_bit_cast(unsigned, r) >> 16; csum[e] += r; } else { h[e] = f2bf(v[ld][e] * g); csum[e] += bf2f(h[e]); } bsum[e] += v[ld][e] * bb; }
            *(LAS u32x2*)(scr + (4 * ld + kk) * 144 + c4 * 8) = (u32x2){h[0] | (h[1] << 16), h[2] | (h[3] << 16)};
        }
        LDS_WAIT(); asm volatile("" ::: "memory");
        u32x2 tr[4][2][2];
#pragma unroll
        for (int nt = 0; nt < 4; ++nt)
#pragma unroll
            for (int ch = 0; ch < 2; ++ch) {
                const unsigned a0 = sbase + (8u * (unsigned)(kk + 4 * ch) + q4) * 144u + (16u * nt + 4u * p4) * 2u, a1 = a0 + 4u * 144u;
                asm volatile("ds_read_b64_tr_b16 %0, %2\n\tds_read_b64_tr_b16 %1, %3" : "=&v"(tr[nt][ch][0]), "=&v"(tr[nt][ch][1]) : "v"(a0), "v"(a1) : "memory");
            }
        asm volatile("s_waitcnt lgkmcnt(0)" : "+v"(tr[0][0][0]), "+v"(tr[0][0][1]), "+v"(tr[0][1][0]), "+v"(tr[0][1][1]), "+v"(tr[1][0][0]), "+v"(tr[1][0][1]), "+v"(tr[1][1][0]), "+v"(tr[1][1][1]),
                     "+v"(tr[2][0][0]), "+v"(tr[2][0][1]), "+v"(tr[2][1][0]), "+v"(tr[2][1][1]), "+v"(tr[3][0][0]), "+v"(tr[3][0][1]), "+v"(tr[3][1][0]), "+v"(tr[3][1][1]) :: "memory");
#pragma unroll
        for (int nt = 0; nt < 4; ++nt)
#pragma unroll
            for (int ch = 0; ch < 2; ++ch) {
                if constexpr (F8) *(u32x2*)((unsigned char*)Btv + (size_t)(n0 + 16 * nt + (lane & 15)) * ldbt + k0 + 8 * (kk + 4 * ch)) = (u32x2){bf4_to_fp8(tr[nt][ch][0]), bf4_to_fp8(tr[nt][ch][1])};
                else { u32x4 o; o.x = tr[nt][ch][0].x; o.y = tr[nt][ch][0].y; o.z = tr[nt][ch][1].x; o.w = tr[nt][ch][1].y;
                    *(u32x4*)((bf16_t*)Btv + (size_t)(n0 + 16 * nt + (lane & 15)) * ldbt + k0 + 8 * (kk + 4 * ch)) = o; }
            }
    }
    if (cs) {
#pragma unroll
        for (int e = 0; e < 4; ++e) { csum[e] += shx(csum[e], 16, lane); csum[e] += shx(csum[e], 32, lane); bsum[e] += shx(bsum[e], 16, lane); bsum[e] += shx(bsum[e], 32, lane); }
        if (kk == 0) { *(f32x4*)(cs + n0 + 4 * c4) = (f32x4){csum[0], csum[1], csum[2], csum[3]}; *(f32x4*)(bs + n0 + 4 * c4) = (f32x4){bsum[0], bsum[1], bsum[2], bsum[3]}; }
    }
}

constexpr int PT_TILES = 3 * 4096, PT_GRAN = 2, PT_BUF = 50176;
struct PTile { const float* src; int ldw; unsigned char* bt; int ldbt; int kbase; int rowadd; int up; const float* gk; const float* bk; float* csp; };
__device__ __forceinline__ PTile pt_decode(const Params& P, unsigned char* ws, int T) {
    PTile t;
    if (T < 8192) { const int which = T >> 12, r = T & 4095, le = r >> 4, kt = r & 15, l = le >> 6;
        t.src = (which ? P.in[I_W3] : P.in[I_W1]) + (size_t)le * DM * DEXP + (size_t)kt * 64 * DEXP; t.ldw = DEXP; t.bt = ws + WS_WUP + (size_t)le * 512 * DM; t.ldbt = DM; t.kbase = 64 * kt;
        t.rowadd = 128 * which; t.up = 1; t.gk = P.in[I_L1G] + l * DM + 64 * kt; t.bk = P.in[I_L1B] + l * DM + 64 * kt; t.csp = (float*)(ws + WS_CSP) + ((size_t)kt * 256 + le) * 512;
    } else { const int r = T - 8192, le = r >> 4, kt = (r >> 2) & 3, nq = r & 3;
        t.src = P.in[I_W2] + (size_t)le * DEXP * DM + (size_t)kt * 64 * DM + 256 * nq; t.ldw = DM; t.bt = ws + WS_WDN + (size_t)le * DM * DEXP; t.ldbt = DEXP; t.kbase = 64 * kt;
        t.rowadd = 256 * nq; t.up = 0; t.gk = nullptr; t.bk = nullptr; t.csp = nullptr; }
    return t;
}
__device__ __forceinline__ void p0_expert_tiles(const Frame& F, const Params& P, int tid, int lane, int wave) {
    unsigned char* ws = F.ws;
    volatile LAS int* slot = (volatile LAS int*)(F.lds + LDS_MISC + 64);
    unsigned* qctr = (unsigned*)(ws + WS_CTL) + CW_QUEUE;
    if (tid == 0) { slot[0] = (int)atomicAdd(qctr, (unsigned)PT_GRAN); slot[1] = (int)atomicAdd(qctr, (unsigned)PT_GRAN); }
    __syncthreads();
    int g0 = slot[0], g1 = slot[1], par = 0;
    const unsigned g16 = (unsigned)lane >> 4, q4 = (unsigned)(lane & 15) >> 2, p4 = (unsigned)lane & 3u;
    f32x4 cur[PT_GRAN][8], nxt[PT_GRAN][8];
#define PT_LOAD(T, vv) do { const PTile _t = pt_decode(P, ws, (T)); _Pragma("unroll") for (int i = 0; i < 8; ++i) vv[i] = *(const f32x4*)(_t.src + (size_t)(8 * wave + i) * _t.ldw + 4 * lane); } while (0)
    if (g0 < PT_TILES) {
#pragma unroll
        for (int j = 0; j < PT_GRAN; ++j) PT_LOAD(g0 + j, cur[j]); }
    while (g0 < PT_TILES) {
        if (tid == 0) slot[2 + par] = (int)atomicAdd(qctr, (unsigned)PT_GRAN);
        if (g1 < PT_TILES) {
#pragma unroll
            for (int j = 0; j < PT_GRAN; ++j) PT_LOAD(g1 + j, nxt[j]); }
#pragma unroll
        for (int j = 0; j < PT_GRAN; ++j) {
            const PTile t = pt_decode(P, ws, g0 + j);
            LAS unsigned char* tile = F.lds + (j & 1) * PT_BUF;
            LAS float* part = (LAS float*)(F.lds + (j & 1) * PT_BUF + 33792);
            f32x4 pc = (f32x4){0.f, 0.f, 0.f, 0.f}, pb = (f32x4){0.f, 0.f, 0.f, 0.f};
#pragma unroll
            for (int i = 0; i < 8; ++i) {
                const float gvi = t.up ? t.gk[8 * wave + i] : 1.f, bvi = t.up ? t.bk[8 * wave + i] : 0.f;
                const int w8 = (int)pk4_fp8(cur[j][i][0] * gvi, cur[j][i][1] * gvi, cur[j][i][2] * gvi, cur[j][i][3] * gvi);
                const float r0 = __builtin_amdgcn_cvt_f32_fp8(w8, 0), r1 = __builtin_amdgcn_cvt_f32_fp8(w8, 1), r2 = __builtin_amdgcn_cvt_f32_fp8(w8, 2), r3 = __builtin_amdgcn_cvt_f32_fp8(w8, 3);
                pc[0] += r0; pc[1] += r1; pc[2] += r2; pc[3] += r3;
#pragma unroll
                for (int e = 0; e < 4; ++e) pb[e] += cur[j][i][e] * bvi;
                *(LAS u32x2*)(tile + (8 * wave + i) * 528 + lane * 8) = (u32x2){(__builtin_bit_cast(unsigned, r0) >> 16) | (__builtin_bit_cast(unsigned, r1) & 0xffff0000u),
                                                                                (__builtin_bit_cast(unsigned, r2) >> 16) | (__builtin_bit_cast(unsigned, r3) & 0xffff0000u)};
            }
            if (t.up) { *(LAS f32x4*)(part + wave * 256 + 4 * lane) = pc; *(LAS f32x4*)(part + 2048 + wave * 256 + 4 * lane) = pb; }
            __syncthreads();
            {
                u32x2 tr[2][4];
                const unsigned sbase = (unsigned)(size_t)tile;
#pragma unroll
                for (int jj = 0; jj < 2; ++jj)
#pragma unroll
                    for (int c = 0; c < 4; ++c) {
                        const unsigned a0 = sbase + (16u * g16 + 4u * c + q4) * 528u + (16u * (2 * wave + jj) + 4u * p4) * 2u;
                        asm volatile("ds_read_b64_tr_b16 %0, %1" : "=&v"(tr[jj][c]) : "v"(a0) : "memory");
                    }
                asm volatile("s_waitcnt lgkmcnt(0)" : "+v"(tr[0][0]), "+v"(tr[0][1]), "+v"(tr[0][2]), "+v"(tr[0][3]), "+v"(tr[1][0]), "+v"(tr[1][1]), "+v"(tr[1][2]), "+v"(tr[1][3]) :: "memory");
#pragma unroll
                for (int jj = 0; jj < 2; ++jj) {
                    const int n = 16 * (2 * wave + jj) + (lane & 15);
                    const int brow = t.up ? (n & 127) + 256 * (n >> 7) + t.rowadd : 128 * ((n >> 3) & 1) + 32 * (n >> 6) + 8 * ((n >> 4) & 3) + (n & 7) + t.rowadd;
                    u32x4 o; o.x = bf4_to_fp8(tr[jj][0]); o.y = bf4_to_fp8(tr[jj][1]); o.z = bf4_to_fp8(tr[jj][2]); o.w = bf4_to_fp8(tr[jj][3]);
                    *(u32x4*)(t.bt + (size_t)brow * t.ldbt + t.kbase + 16 * g16) = o;
                }
            }
            if (t.up && tid < 256) {
                float cs = part[tid], bs = part[2048 + tid];
#pragma unroll
                for (int w2 = 1; w2 < 8; ++w2) { cs += part[w2 * 256 + tid]; bs += part[2048 + w2 * 256 + tid]; }
                const int brow = (tid & 127) + 256 * (tid >> 7) + t.rowadd;
                t.csp[brow] = cs; t.csp[(size_t)32 * 4 * 64 * 512 + brow] = bs;
            }
        }
        g0 = g1; g1 = slot[2 + par]; par ^= 1;
#pragma unroll
        for (int j = 0; j < PT_GRAN; ++j)
#pragma unroll
            for (int i = 0; i < 8; ++i) cur[j][i] = nxt[j][i];
    }
    __syncthreads();
#undef PT_LOAD
}

__device__ __forceinline__ void p0_heavy_item(const Params& P, unsigned char* ws, int r, LAS unsigned char* scr, int lane) {
    constexpr int N_AO = 2 * 16 * 2, N_CI = 2 * 48, N_AI = 2 * 44;
    if (r < N_AO) {
        const int jl = r / 32, g = (r % 32) >> 1, kh = r & 1;
        prol_item64<true>(P.in[I_AWOUT] + (size_t)jl * 2048 * DM + (size_t)kh * 1024 * DM, 1024, DM, 64 * g, 64, nullptr, nullptr, 64.f,
                    ws + WS_WAO + (size_t)jl * DM * 2048 + kh * 1024, 2048, 64 * g, nullptr, nullptr, scr, lane);
        return; }
    r -= N_AO;
    if (r < N_CI) {
        const int jl = r / 48, g = r % 48, n0 = 64 * g;
        int src;
        if (n0 < 2048) { const int p = n0 >> 8, half = (n0 >> 7) & 1; src = (half ? 2048 : 1024) + 128 * p + (n0 & 127); } else src = n0 - 2048;
        const float* gk = jl ? P.in[I_L2G] + (2 * jl - 1) * DM : nullptr; const float* bk = jl ? P.in[I_L2B] + (2 * jl - 1) * DM : nullptr;
        prol_item64(P.in[I_CWIN] + (size_t)jl * DM * 3072, DM, 3072, src, 64, gk, bk, 1.f, (bf16_t*)(ws + WS_WCI) + (size_t)jl * 3072 * DM, DM, n0,
                    (float*)(ws + WS_CSCI) + jl * 3072, (float*)(ws + WS_BSCI) + jl * 3072, scr, lane);
        return; }
    r -= N_CI;
    if (r < N_AI) {
        const int jl = r / 44, g = r % 44, n0 = 64 * g;
        int src, nvalid = 64; float sc = 1.f;
        if (n0 < 2048) { src = n0; sc = 0.08838834764831845f; }
        else if (n0 < 2176) src = n0;
        else if (n0 < 2240) src = 2688;
        else if (n0 < 2304) { src = 2752; nvalid = 8; sc = 0.35355339059327373f; }
        else { src = 2176 + (n0 - 2304); sc = 0.125f; }
        if (n0 < 2048)
            prol_item64<true>(P.in[I_AWIN] + (size_t)jl * DM * AIW, DM, AIW, src, nvalid, P.in[I_L2G] + (2 * jl) * DM, P.in[I_L2B] + (2 * jl) * DM, 1.f,
                    ws + WS_WAI + (size_t)jl * AIWP * DM * 2, DM, n0, (float*)(ws + WS_CSAI) + jl * AIWP, (float*)(ws + WS_BSAI) + jl * AIWP, scr, lane);
        else
            prol_item64(P.in[I_AWIN] + (size_t)jl * DM * AIW, DM, AIW, src, nvalid, P.in[I_L2G] + (2 * jl) * DM, P.in[I_L2B] + (2 * jl) * DM, sc,
                    (bf16_t*)(ws + WS_WAI) + (size_t)jl * AIWP * DM, DM, n0, (float*)(ws + WS_CSAI) + jl * AIWP, (float*)(ws + WS_BSAI) + jl * AIWP, scr, lane);
        return; }
    r -= N_AI;
    {
        const int jl = r / 16, g = r % 16;
        prol_item64(P.in[I_CWOUT] + (size_t)jl * DM * DM, DM, DM, 64 * g, 64, nullptr, nullptr, 1.f, (bf16_t*)(ws + WS_WCO) + (size_t)jl * DM * DM, DM, 64 * g, nullptr, nullptr, scr, lane);
    }
}

__device__ __forceinline__ void p0_prologue(const Frame& F, const Params& P) {
    int tid = threadIdx.x; asm volatile("" : "+v"(tid)); const int lane = tid & 63, wave = __builtin_amdgcn_readfirstlane(tid >> 6);
    LAS unsigned char* scr = F.lds + LDS_STAGE + wave * 16896;
    const int gw = F.bx * NWAVES + wave, NGW = F.G * NWAVES;
    unsigned char* ws = F.ws;
    constexpr int N_DENSE = 2 * 16 * 2 + 2 * 48 + 2 * 44 + 2 * 16;
    if (gw < N_DENSE) p0_heavy_item(P, ws, gw, scr, lane);
    __syncthreads();
    p0_expert_tiles(F, P, tid, lane, wave);
    if (gw < 4 * 96) {
        const int l = gw / 96, n = gw % 96;
        const int ks = lane >> 1, fq0 = 2 * (lane & 1), nt = n >> 4;
        bf16_t* hi = (bf16_t*)(ws + WS_WR) + ((((size_t)(l * 32 + ks) * 2 + 0) * 6 + nt) * 64 + (n & 15) + 16 * fq0) * 8; bf16_t* lo = hi + (size_t)6 * 64 * 8;
        float csum = 0.f, bsum = 0.f; unsigned hw[8], lw[8];
        if (n < 72) {
            const float* Wc = n < 8 ? P.in[I_RWG] + (size_t)l * DM * 8 + n : P.in[I_RWE] + (size_t)l * DM * 64 + (n - 8); const int ldw = n < 8 ? 8 : 64;
            float w[16], g[16], b[16];
#pragma unroll
            for (int i = 0; i < 16; ++i) w[i] = Wc[(size_t)(16 * lane + i) * ldw];
#pragma unroll
            for (int i = 0; i < 4; ++i) { const f32x4 g4 = *(const f32x4*)(P.in[I_L1G] + l * DM + 16 * lane + 4 * i), b4 = *(const f32x4*)(P.in[I_L1B] + l * DM + 16 * lane + 4 * i);
#pragma unroll
                for (int e = 0; e < 4; ++e) { g[4 * i + e] = g4[e]; b[4 * i + e] = b4[e]; } }
            unsigned hb[16], lb[16];
#pragma unroll
            for (int i = 0; i < 16; ++i) { const float wf = w[i] * g[i]; hb[i] = f2bf(wf); const float h = bf2f(hb[i]); lb[i] = f2bf(wf - h); csum += h + bf2f(lb[i]); bsum += w[i] * b[i]; }
#pragma unroll
            for (int i = 0; i < 8; ++i) { hw[i] = hb[2 * i] | (hb[2 * i + 1] << 16); lw[i] = lb[2 * i] | (lb[2 * i + 1] << 16); }
        } else {
#pragma unroll
            for (int i = 0; i < 8; ++i) { hw[i] = 0u; lw[i] = 0u; }
        }
        *(u32x4*)hi = (u32x4){hw[0], hw[1], hw[2], hw[3]}; *(u32x4*)(hi + 16 * 8) = (u32x4){hw[4], hw[5], hw[6], hw[7]};
        *(u32x4*)lo = (u32x4){lw[0], lw[1], lw[2], lw[3]}; *(u32x4*)(lo + 16 * 8) = (u32x4){lw[4], lw[5], lw[6], lw[7]};
        csum = wave_sum(csum, lane); bsum = wave_sum(bsum, lane);
        if (lane == 0) { ((float*)(ws + WS_CSR))[l * 96 + n] = csum; ((float*)(ws + WS_BSR))[l * 96 + n] = bsum; }
    }
    for (int m0 = gw; m0 < T_TOK; m0 += 4 * NGW) {
        f32x4 xv[4][4];
#pragma unroll
        for (int r = 0; r < 4; ++r) { const GAS f32x4* xr = (const GAS f32x4*)(P.in[I_X] + (size_t)(m0 + r * NGW) * DM) + lane;
#pragma unroll
            for (int q = 0; q < 4; ++q) xv[r][q] = xr[64 * q]; }
#pragma unroll
        for (int r = 0; r < 4; ++r) { const int m = m0 + r * NGW;
            GAS u32x2* o = (GAS u32x2*)((bf16_t*)(ws + WS_ZA) + (size_t)m * DM) + lane;
#pragma unroll
            for (int q = 0; q < 4; ++q) { const f32x4 v = xv[r][q]; u32x2 w; w.x = pk2(v.x, v.y); w.y = pk2(v.z, v.w); o[64 * q] = w; }
            if (lane == 0) { float* st = (float*)(ws + WS_STA) + 2 * m; st[0] = 0.f; st[1] = 1.f; } }
    }
    if (F.bx == 0) { float* v = (float*)(ws + WS_VEC); for (int i = tid; i < 2048; i += NTHREADS) v[i] = i < 1024 ? 1.f : 0.f; }
}

__device__ __forceinline__ f32x2 stats_from_part(const float* part, int row);
template <bool FINAL>
__device__ __forceinline__ void combine_phase(const Frame& F, const bf16_t* zin, const float* stin, const float* partin, const float* g, const float* b, const unsigned char* y,
                                              bf16_t* zout, float* stout, const float* gout, const float* bout, float* out, unsigned char* z8out) {
    int tid = threadIdx.x; asm volatile("" : "+v"(tid)); const int lane = tid & 63, wave = __builtin_amdgcn_readfirstlane(tid >> 6); (void)lane; (void)wave;
    const int row0 = 2048 * F.batch + 64 * F.jb + 8 * wave;
    const int c0 = 8 * lane;
    float gv[2][8], bv[2][8];
#pragma unroll
    for (int j2 = 0; j2 < 2; ++j2) {
        const f32x4 g0 = *(const f32x4*)(g + c0 + 512 * j2), g1 = *(const f32x4*)(g + c0 + 512 * j2 + 4), b0 = *(const f32x4*)(b + c0 + 512 * j2), b1 = *(const f32x4*)(b + c0 + 512 * j2 + 4);
#pragma unroll
        for (int e = 0; e < 4; ++e) { gv[j2][e] = g0[e]; gv[j2][4 + e] = g1[e]; bv[j2][e] = b0[e]; bv[j2][4 + e] = b1[e]; }
    }
    for (int r2 = 0; r2 < 8; r2 += 8) {
      u32x4 zws[8][2]; u32x2 yws[8][2][2]; f32x2 sts[8];
#pragma unroll
      for (int rr = 0; rr < 8; ++rr) { const int row = row0 + r2 + rr;
          sts[rr] = partin ? stats_from_part(partin, row) : *(const f32x2*)(stin + 2 * row);
#pragma unroll
          for (int j2 = 0; j2 < 2; ++j2) { zws[rr][j2] = *(const u32x4*)(zin + (size_t)row * DM + c0 + 512 * j2);
              if (y) {
#pragma unroll
                  for (int sl = 0; sl < 2; ++sl) yws[rr][j2][sl] = *(const u32x2*)(y + ((size_t)row * 2 + sl) * DM + c0 + 512 * j2); } } }
#pragma unroll
      for (int rr = 0; rr < 8; ++rr) {
        const int row = row0 + r2 + rr;
        const f32x2 st = sts[rr];
        float v[2][8]; float s = 0.f;
#pragma unroll
        for (int j2 = 0; j2 < 2; ++j2) {
            const u32x4 zw = zws[rr][j2];
            float z[8] = {bflo(zw.x), bfhi(zw.x), bflo(zw.y), bfhi(zw.y), bflo(zw.z), bfhi(zw.z), bflo(zw.w), bfhi(zw.w)};
            float acc[8];
#pragma unroll
            for (int e = 0; e < 8; ++e) acc[e] = ALPHA * ((z[e] - st.x) * st.y * gv[j2][e] + bv[j2][e]);
            if (y) {
#pragma unroll
                for (int sl = 0; sl < 2; ++sl) {
                    const u32x2 yw = yws[rr][j2][sl];
                    acc[0] += 0.0625f * __builtin_amdgcn_cvt_f32_fp8((int)yw.x, 0); acc[1] += 0.0625f * __builtin_amdgcn_cvt_f32_fp8((int)yw.x, 1); acc[2] += 0.0625f * __builtin_amdgcn_cvt_f32_fp8((int)yw.x, 2); acc[3] += 0.0625f * __builtin_amdgcn_cvt_f32_fp8((int)yw.x, 3);
                    acc[4] += 0.0625f * __builtin_amdgcn_cvt_f32_fp8((int)yw.y, 0); acc[5] += 0.0625f * __builtin_amdgcn_cvt_f32_fp8((int)yw.y, 1); acc[6] += 0.0625f * __builtin_amdgcn_cvt_f32_fp8((int)yw.y, 2); acc[7] += 0.0625f * __builtin_amdgcn_cvt_f32_fp8((int)yw.y, 3);
                }
            }
            if (!FINAL) {
#pragma unroll
                for (int e = 0; e < 8; ++e) acc[e] = bf2f(f2bf(acc[e]));
            }
#pragma unroll
            for (int e = 0; e < 8; ++e) { v[j2][e] = acc[e]; s += acc[e]; }
        }
        const float mean = wave_sum(s, lane) * (1.f / DM);
        float s2 = 0.f;
#pragma unroll
        for (int j2 = 0; j2 < 2; ++j2)
#pragma unroll
            for (int e = 0; e < 8; ++e) { const float d = v[j2][e] - mean; s2 += d * d; }
        const float rstd = 1.f / sqrtf(wave_sum(s2, lane) * (1.f / DM) + LN_EPS);
        if (!FINAL) {
#pragma unroll
            for (int j2 = 0; j2 < 2; ++j2) {
                u32x4 o; o.x = pk2(v[j2][0], v[j2][1]); o.y = pk2(v[j2][2], v[j2][3]); o.z = pk2(v[j2][4], v[j2][5]); o.w = pk2(v[j2][6], v[j2][7]);
                *(u32x4*)(zout + (size_t)row * DM + c0 + 512 * j2) = o;
                if (z8out) *(u32x2*)(z8out + (size_t)row * DM + c0 + 512 * j2) = (u32x2){pk4_fp8(v[j2][0], v[j2][1], v[j2][2], v[j2][3]), pk4_fp8(v[j2][4], v[j2][5], v[j2][6], v[j2][7])};
            }
            if (lane == 0) { *(f32x2*)(stout + 2 * row) = (f32x2){mean, rstd}; }
        } else {
#pragma unroll
            for (int j2 = 0; j2 < 2; ++j2) {
                const f32x4 g0 = *(const f32x4*)(gout + c0 + 512 * j2), g1 = *(const f32x4*)(gout + c0 + 512 * j2 + 4), b0 = *(const f32x4*)(bout + c0 + 512 * j2), b1 = *(const f32x4*)(bout + c0 + 512 * j2 + 4);
                f32x4 o0, o1;
#pragma unroll
                for (int e = 0; e < 4; ++e) { o0[e] = (v[j2][e] - mean) * rstd * g0[e] + b0[e]; o1[e] = (v[j2][4 + e] - mean) * rstd * g1[e] + b1[e]; }
                *(f32x4*)(out + (size_t)row * DM + c0 + 512 * j2) = o0; *(f32x4*)(out + (size_t)row * DM + c0 + 512 * j2 + 4) = o1;
            }
        }
      }
    }
}

namespace pg8 {
constexpr int BM = 256, BK = 64, HALF = 128, HTB = HALF * BK * 2, STAGE_BYTES = 8 * HTB, NXCD = 8, WGM = 8;
__host__ __device__ __forceinline__ int lds_byte(int r, int c) { const int st = (r >> 4) * 2 + (c >> 5), rr = r & 15, cc = c & 31, ob = rr * 64 + cc * 2; return st * 1024 + (ob ^ (((ob >> 9) & 1) << 5)); }
__host__ __device__ __forceinline__ void stage_rc(int b, int& R, int& C) { const int st = b / 1024, sb = b % 1024, swz = sb ^ (((sb >> 9) & 1) << 5); R = (st >> 1) * 16 + swz / 64; C = (st & 1) * 32 + (swz % 64) / 2; }
__host__ __device__ __forceinline__ int perm32(int rho) { const int n = rho >> 4, i = rho & 15; return 8 * (i >> 2) + 4 * n + (i & 3); }

struct Unit { const char* A; const char* B; int pm, pn, x0, x1; };

struct StaticOrder {
    int nM, nN, nwg, G, c; const char* A; const char* B; size_t astep, bstep;
    __device__ void init(int M, int N, int G_, int c_, const void* A_, size_t lda_bytes, const void* B_, size_t ldb_bytes) { nM = M / BM; nN = N / BM; nwg = nM * nN; G = G_; c = c_; A = (const char*)A_; B = (const char*)B_; astep = lda_bytes * BM; bstep = ldb_bytes * BM; }
    __device__ bool next(int i, Unit& u) const {
        const long L = (long)i * G + c; if (L >= nwg) return false;
        int wgid = (int)L; { const int q = nwg / NXCD, r = nwg % NXCD, xcd = wgid % NXCD, off = wgid / NXCD; wgid = (xcd < r ? xcd * (q + 1) : r * (q + 1) + (xcd - r) * q) + off; }
        const int nig = WGM * nN, gid = wgid / nig, fm = gid * WGM, gsz = (nM - fm) < WGM ? (nM - fm) : WGM;
        u.pm = fm + ((wgid % nig) % gsz); u.pn = (wgid % nig) / gsz; u.A = A + (size_t)u.pm * astep; u.B = B + (size_t)u.pn * bstep; u.x0 = 0; u.x1 = 0; return true;
    }
    __device__ __forceinline__ const LAS unsigned* rowoff(int) const { return nullptr; }
    __device__ __forceinline__ void a_ready(const Unit&) const {}
};

__device__ __forceinline__ unsigned cvt_pk_bf16(float lo, float hi) { unsigned r; asm volatile("v_cvt_pk_bf16_f32 %0, %1, %2" : "=v"(r) : "v"(lo), "v"(hi)); return r; }

template <class Epi, class Sched, bool GATHER, bool FP8 = false>
__device__ __forceinline__ void gemm_phase(LAS unsigned char* lds, const int K, const unsigned lda_bytes, const unsigned ldb_bytes, const Sched& S, const Epi& E, const int b_e8m0 = 127) {
    int tid = threadIdx.x; asm volatile("" : "+v"(tid));
    const int wid = __builtin_amdgcn_readfirstlane(tid >> 6), lane = tid & 63, wr = wid >> 2, wc = wid & 3, fr = lane & 15, fq = lane >> 4;
    int nt = K / BK; asm volatile("" : "+s"(nt));
    unsigned voffA[2], voffB[2];
#pragma unroll
    for (int i = 0; i < 2; ++i) { int R, C; stage_rc(tid * 16 + i * 8192, R, C); const int Rb = (R & ~31) + perm32(R & 31);
        voffA[i] = (unsigned)R * lda_bytes + (unsigned)C * 2u; voffB[i] = (unsigned)Rb * ldb_bytes + (unsigned)C * 2u; }
#define PG8_GOFF(dst, ro) do { int _t = threadIdx.x; asm volatile("" : "+v"(_t)); _Pragma("unroll") for (int _i = 0; _i < 2; ++_i) { int _R, _C; stage_rc(_t * 16 + _i * 8192, _R, _C); \
        _Pragma("unroll") for (int _h = 0; _h < 2; ++_h) dst[_h][_i] = (ro)[_h * HALF + _R] + (unsigned)_C * 2u; } } while (0)
    const size_t kstep = (size_t)(BK * 2);
    const size_t hstepA = (size_t)HALF * lda_bytes, hstepB = (size_t)HALF * ldb_bytes;
    const unsigned ldsw = (unsigned)wid * 1024u;
    const int aoff = lds_byte(wr * 64 + fr, fq * 8), boff = lds_byte(wc * 32 + fr, fq * 8);
#define PG8_SA(b, h) (((b) * 2 + (h)) * HTB)
#define PG8_SB(b, h) ((4 + (b) * 2 + (h)) * HTB)
#define PG8_GLDS(src, bufoff, i) __builtin_amdgcn_global_load_lds((const unsigned*)(src), (LAS unsigned*)(lds + (bufoff) + ldsw + (i) * 8192), 16, 0, 0)
#define PG8_STAGE_B(bufoff, gbase) do { _Pragma("unroll") for (int _i = 0; _i < 2; ++_i) PG8_GLDS((const char*)(gbase) + voffB[_i], bufoff, _i); } while (0)
#define PG8_STAGE_A(bufoff, gbase, h, GO) do { _Pragma("unroll") for (int _i = 0; _i < 2; ++_i) { \
        if constexpr (GATHER) PG8_GLDS((const char*)(gbase) + (GO)[h][_i], bufoff, _i); else PG8_GLDS((const char*)(gbase) + (h) * hstepA + voffA[_i], bufoff, _i); } } while (0)
#define PG8_LDA(dst, b, h) do { _Pragma("unroll") for (int m = 0; m < 4; ++m) _Pragma("unroll") for (int k = 0; k < 2; ++k) dst[m][k] = *(const LAS bf16x8*)(lds + PG8_SA(b, h) + aoff + m * 2048 + k * 1024); } while (0)
#define PG8_LDB(dst, b, h) do { _Pragma("unroll") for (int n = 0; n < 2; ++n) _Pragma("unroll") for (int k = 0; k < 2; ++k) dst[n][k] = *(const LAS bf16x8*)(lds + PG8_SB(b, h) + boff + n * 2048 + k * 1024); } while (0)
#define PG8_MMA(ai, bj, At, Bt) do { __builtin_amdgcn_s_setprio(1); _Pragma("unroll") for (int m = 0; m < 4; ++m) _Pragma("unroll") for (int n = 0; n < 2; ++n) { \
        if constexpr (FP8) { const u32x4 b0 = __builtin_bit_cast(u32x4, Bt[n][0]), b1 = __builtin_bit_cast(u32x4, Bt[n][1]), a0 = __builtin_bit_cast(u32x4, At[m][0]), a1 = __builtin_bit_cast(u32x4, At[m][1]); \
            const i32x8 vb = {(int)b0.x, (int)b0.y, (int)b0.z, (int)b0.w, (int)b1.x, (int)b1.y, (int)b1.z, (int)b1.w}, va = {(int)a0.x, (int)a0.y, (int)a0.z, (int)a0.w, (int)a1.x, (int)a1.y, (int)a1.z, (int)a1.w}; \
            asm volatile("v_mfma_scale_f32_16x16x128_f8f6f4 %0, %1, %2, %0, %3, %4 op_sel_hi:[0,0,0]" : "+v"(acc[ai][bj][m][n]) : "v"(vb), "v"(va), "v"(fp8_bscale), "v"(fp8_scale)); } \
        else { _Pragma("unroll") for (int k = 0; k < 2; ++k) acc[ai][bj][m][n] = __builtin_amdgcn_mfma_f32_16x16x32_bf16(Bt[n][k], At[m][k], acc[ai][bj][m][n], 0, 0, 0); } } \
        __builtin_amdgcn_s_setprio(0); } while (0)
#define PG8_WAIT_V(n) asm volatile("s_waitcnt vmcnt(" #n ")" ::: "memory")
#define PG8_WAIT_L(n) asm volatile("s_waitcnt lgkmcnt(" #n ")" ::: "memory")
#define PG8_BAR __builtin_amdgcn_s_barrier()
#define PG8_SCHED __builtin_amdgcn_sched_barrier(0)
    Unit cur, nxt; int ui = 0;
    if (!S.next(0, cur)) return;
    int fp8_scale = 0x7F7F7F7F; asm volatile("" : "+v"(fp8_scale));
    int fp8_bscale = b_e8m0 * 0x01010101; asm volatile("" : "+v"(fp8_bscale));
    (void)fp8_scale; (void)fp8_bscale;
    f32x4 acc[2][2][4][2];
#pragma unroll
    for (int a = 0; a < 2; ++a)
#pragma unroll
        for (int b = 0; b < 2; ++b)
#pragma unroll
            for (int m = 0; m < 4; ++m)
#pragma unroll
                for (int n = 0; n < 2; ++n) acc[a][b][m][n] = (f32x4){0.f, 0.f, 0.f, 0.f};
    bf16x8 At[4][2], B0[2][2], B1[2][2];
    unsigned cG[2][2] = {{0u, 0u}, {0u, 0u}};
    if constexpr (GATHER) { const LAS unsigned* ro = S.rowoff(0); PG8_GOFF(cG, ro); }
    const char* cA = cur.A; const char* cB = cur.B;
    int eslot = 0;
    E.prefetch(cur, 0, wid, lane);
    S.a_ready(cur);
    PG8_STAGE_B(PG8_SB(0, 0), cB); PG8_STAGE_B(PG8_SB(0, 1), cB + hstepB); PG8_STAGE_A(PG8_SA(0, 0), cA, 0, cG); PG8_STAGE_A(PG8_SA(0, 1), cA, 1, cG);
    if (wr == 1) PG8_BAR;
    PG8_WAIT_V(2); PG8_BAR;
    PG8_STAGE_B(PG8_SB(1, 0), cB + kstep); PG8_STAGE_A(PG8_SA(1, 0), cA + kstep, 0, cG); PG8_STAGE_B(PG8_SB(1, 1), cB + hstepB + kstep);
    PG8_WAIT_V(6); PG8_BAR;
    for (;;) {
        const bool has_next = S.next(ui + 1, nxt);
        const int nslot = eslot == 2 ? 0 : eslot + 1;
        if (has_next) E.prefetch(nxt, nslot, wid, lane);
        const char* nA = has_next ? nxt.A : cA; const char* nB = has_next ? nxt.B : cB;
        for (int t = 0; t < nt; t += 2) {
            const bool last = (t == nt - 2);
            if (last && has_next) S.a_ready(nxt);
            const char* a1 = cA + (size_t)(t + 1) * kstep;
            const char* a2 = last ? nA : cA + (size_t)(t + 2) * kstep; const char* b2 = last ? nB : cB + (size_t)(t + 2) * kstep;
            const char* a3 = a2 + kstep; const char* b3 = b2 + kstep;
            unsigned g2[2][2] = {{0u, 0u}, {0u, 0u}};
            if constexpr (GATHER) { const LAS unsigned* ro = S.rowoff((last && has_next) ? ui + 1 : ui); PG8_GOFF(g2, ro); }
            PG8_LDB(B0, 0, 0); PG8_LDB(B1, 0, 1); PG8_SCHED; PG8_LDA(At, 0, 0); PG8_STAGE_A(PG8_SA(1, 1), a1, 1, cG);
            PG8_WAIT_V(8); PG8_WAIT_L(0); PG8_BAR; PG8_MMA(0, 0, At, B0); PG8_MMA(0, 1, At, B1); PG8_BAR; PG8_SCHED;
            PG8_LDA(At, 0, 1); PG8_STAGE_B(PG8_SB(0, 0), b2); PG8_STAGE_B(PG8_SB(0, 1), b2 + hstepB); PG8_STAGE_A(PG8_SA(0, 0), a2, 0, g2);
            PG8_WAIT_V(8); PG8_WAIT_L(0); PG8_BAR; PG8_MMA(1, 0, At, B0); PG8_MMA(1, 1, At, B1); PG8_BAR; PG8_SCHED;
            PG8_LDB(B0, 1, 0); PG8_LDB(B1, 1, 1); PG8_SCHED; PG8_LDA(At, 1, 0); PG8_STAGE_A(PG8_SA(0, 1), a2, 1, g2);
            PG8_WAIT_V(8); PG8_WAIT_L(0); PG8_BAR; PG8_MMA(0, 0, At, B0); PG8_MMA(0, 1, At, B1); PG8_BAR; PG8_SCHED;
            PG8_LDA(At, 1, 1); PG8_STAGE_B(PG8_SB(1, 0), b3); PG8_STAGE_B(PG8_SB(1, 1), b3 + hstepB); PG8_STAGE_A(PG8_SA(1, 0), a3, 0, g2);
            PG8_WAIT_V(8); PG8_WAIT_L(0); PG8_BAR; PG8_MMA(1, 0, At, B0); PG8_MMA(1, 1, At, B1); PG8_BAR; PG8_SCHED;
        }
        if constexpr (FP8) asm volatile("s_nop 15\n\ts_nop 15\n\ts_nop 7" ::: "memory");
        if (wr == 0) PG8_BAR;
        E(acc, cur, ui, wr, wc, fr, fq, eslot);
        if (!has_next) break;
#pragma unroll
        for (int a = 0; a < 2; ++a)
#pragma unroll
            for (int b = 0; b < 2; ++b)
#pragma unroll
                for (int m = 0; m < 4; ++m)
#pragma unroll
                    for (int n = 0; n < 2; ++n) acc[a][b][m][n] = (f32x4){0.f, 0.f, 0.f, 0.f};
        cur = nxt; cA = nA; cB = nB; ++ui; eslot = nslot;
        if constexpr (GATHER) { const LAS unsigned* ro = S.rowoff(ui); PG8_GOFF(cG, ro); }
        if (wr == 1) PG8_BAR;
    }
    PG8_WAIT_V(0);
    PG8_BAR;
#undef PG8_SA
#undef PG8_SB
#undef PG8_GLDS
#undef PG8_GOFF
#undef PG8_STAGE_A
#undef PG8_STAGE_B
#undef PG8_LDA
#undef PG8_LDB
#undef PG8_MMA
#undef PG8_WAIT_V
#undef PG8_WAIT_L
#undef PG8_BAR
#undef PG8_SCHED
}
}

__device__ __forceinline__ void ld8(const float* p, float (&v)[8]) { const f32x4 a = *(const f32x4*)p, b = *(const f32x4*)(p + 4); v[0] = a.x; v[1] = a.y; v[2] = a.z; v[3] = a.w; v[4] = b.x; v[5] = b.y; v[6] = b.z; v[7] = b.w; }
__device__ __forceinline__ void unpack8(const u32x4 w, float (&v)[8]) { v[0] = bflo(w.x); v[1] = bfhi(w.x); v[2] = bflo(w.y); v[3] = bfhi(w.y); v[4] = bflo(w.z); v[5] = bfhi(w.z); v[6] = bflo(w.w); v[7] = bfhi(w.w); }
__device__ __forceinline__ u32x4 pack8(const float (&v)[8]) { u32x4 o; o.x = pg8::cvt_pk_bf16(v[0], v[1]); o.y = pg8::cvt_pk_bf16(v[2], v[3]); o.z = pg8::cvt_pk_bf16(v[4], v[5]); o.w = pg8::cvt_pk_bf16(v[6], v[7]); return o; }

__device__ __forceinline__ void ld8l(const LAS float* p, float (&v)[8]) { const f32x4 a = *(const LAS f32x4*)p, b = *(const LAS f32x4*)(p + 4); v[0] = a.x; v[1] = a.y; v[2] = a.z; v[3] = a.w; v[4] = b.x; v[5] = b.y; v[6] = b.z; v[7] = b.w; }
__device__ __forceinline__ void epi_prefetch(LAS unsigned char* dst, const float* st256, const float* cs256, const float* bs256, int wid, int lane) {
    if (wid < 4) { const char* src = wid < 2 ? (const char*)st256 + wid * 1024 : (wid == 2 ? (const char*)cs256 : (const char*)bs256); int t = threadIdx.x; asm volatile("" : "+v"(t)); (void)lane;
        __builtin_amdgcn_global_load_lds((const unsigned*)(src + (t & 63) * 16), (LAS unsigned*)(dst + wid * 1024), 16, 0, 0); }
}
struct EpiConvIn {
    const float* st; const float* cs; const float* bs; bf16_t* u; bf16_t* bg; LAS unsigned char* aux;
    __device__ __forceinline__ void prefetch(const pg8::Unit& un, int slot, int wid, int lane) const { epi_prefetch(aux + slot * 4096, st + 2 * 256 * un.pm, cs + 256 * un.pn, bs + 256 * un.pn, wid, lane); }
    __device__ __forceinline__ void operator()(const f32x4 (&acc)[2][2][4][2], const pg8::Unit& un, int, int wr, int wc, int fr, int fq, int slot) const {
        const int colL = 32 * wc + 8 * fq;
        const LAS unsigned char* ep = aux + slot * 4096;
        float csv[2][8], bsv[2][8];
        ld8l((const LAS float*)(ep + 2048) + colL, csv[0]); ld8l((const LAS float*)(ep + 2048) + colL + 128, csv[1]); ld8l((const LAS float*)(ep + 3072) + colL, bsv[0]); ld8l((const LAS float*)(ep + 3072) + colL + 128, bsv[1]);
        f32x2 sv[2][4];
#pragma unroll
        for (int ai = 0; ai < 2; ++ai)
#pragma unroll
            for (int m = 0; m < 4; ++m) sv[ai][m] = ((const LAS f32x2*)ep)[128 * ai + 64 * wr + 16 * m + fr];
#pragma unroll
        for (int ai = 0; ai < 2; ++ai)
#pragma unroll
            for (int m = 0; m < 4; ++m) {
                const int row = 256 * un.pm + 128 * ai + 64 * wr + 16 * m + fr;
                const f32x2 s = sv[ai][m];
                float f[2][8];
#pragma unroll
                for (int bj = 0; bj < 2; ++bj)
#pragma unroll
                    for (int e = 0; e < 8; ++e) f[bj][e] = s.y * (acc[ai][bj][m][e >> 2][e & 3] - s.x * csv[bj][e]) + bsv[bj][e];
                if (un.pn < 8) {
                    float p[8];
#pragma unroll
                    for (int e = 0; e < 8; ++e) p[e] = f[0][e] * f[1][e];
                    *(u32x4*)(u + (size_t)row * DM + 128 * un.pn + colL) = pack8(p);
                } else {
                    *(u32x4*)(bg + (size_t)row * DM + 256 * (un.pn - 8) + colL) = pack8(f[0]);
                    *(u32x4*)(bg + (size_t)row * DM + 256 * (un.pn - 8) + 128 + colL) = pack8(f[1]);
                }
            }
    }
};

struct EpiRes {
    const bf16_t* zprev; const float* stprev; const float* gprev; const float* bprev; bf16_t* zout; float* part; unsigned char* z8;
    __device__ __forceinline__ void prefetch(const pg8::Unit&, int, int, int) const {}
    __device__ __forceinline__ void operator()(const f32x4 (&acc)[2][2][4][2], const pg8::Unit& un, int, int wr, int wc, int fr, int fq, int) const {
        const int cb = 256 * un.pn + 32 * wc + 8 * fq;
        float gv[2][8], bv[2][8];
        ld8(gprev + cb, gv[0]); ld8(gprev + cb + 128, gv[1]); ld8(bprev + cb, bv[0]); ld8(bprev + cb + 128, bv[1]);
#pragma unroll
        for (int ai = 0; ai < 2; ++ai) {
            f32x2 sv[4]; u32x4 zw[4][2];
#pragma unroll
            for (int m = 0; m < 4; ++m) { const int row = 256 * un.pm + 128 * ai + 64 * wr + 16 * m + fr; sv[m] = *(const f32x2*)(stprev + 2 * row);
#pragma unroll
                for (int bj = 0; bj < 2; ++bj) zw[m][bj] = *(const u32x4*)(zprev + (size_t)row * DM + cb + 128 * bj); }
#pragma unroll
            for (int m = 0; m < 4; ++m) {
                const int row = 256 * un.pm + 128 * ai + 64 * wr + 16 * m + fr;
                const f32x2 s = sv[m];
                float sum = 0.f, sq = 0.f;
#pragma unroll
                for (int bj = 0; bj < 2; ++bj) {
                    float z[8], v[8]; unpack8(zw[m][bj], z);
#pragma unroll
                    for (int e = 0; e < 8; ++e) v[e] = ALPHA * ((z[e] - s.x) * s.y * gv[bj][e] + bv[bj][e]) + acc[ai][bj][m][e >> 2][e & 3];
                    const u32x4 o = pack8(v);
                    *(u32x4*)(zout + (size_t)row * DM + cb + 128 * bj) = o;
                    *(u32x2*)(z8 + (size_t)row * DM + cb + 128 * bj) = (u32x2){pk4_fp8(v[0], v[1], v[2], v[3]), pk4_fp8(v[4], v[5], v[6], v[7])};
                    float r[8]; unpack8(o, r);
#pragma unroll
                    for (int e = 0; e < 8; ++e) { sum += r[e]; sq += r[e] * r[e]; }
                }
                { const int ln = fr + 16 * fq; sum += shx(sum, 16, ln); sq += shx(sq, 16, ln); sum += shx(sum, 32, ln); sq += shx(sq, 32, ln); }
                if (fq == 0) *(f32x2*)(part + ((size_t)row * 16 + un.pn * 4 + wc) * 2) = (f32x2){sum, sq};
            }
        }
    }
};

__device__ __forceinline__ void conv_phase(const Frame& F, const bf16_t* u, const bf16_t* bg, const float* ck, bf16_t* y) {
    int tid = threadIdx.x; asm volatile("" : "+v"(tid)); const int lane = tid & 63, wave = __builtin_amdgcn_readfirstlane(tid >> 6); (void)lane; (void)wave;
    const int cg = tid & 127, rs = tid >> 7, t0 = 64 * F.jb + 16 * rs, c0 = 8 * cg;
    const size_t rowb = (size_t)2048 * F.batch;
    float k0[8], k1[8], k2[8], um2[8], um1[8];
    ld8(ck + c0, k0); ld8(ck + DM + c0, k1); ld8(ck + 2 * DM + c0, k2);
    if (t0 >= 2) { unpack8(*(const u32x4*)(u + (rowb + t0 - 2) * DM + c0), um2); unpack8(*(const u32x4*)(u + (rowb + t0 - 1) * DM + c0), um1); }
    else {
#pragma unroll
        for (int e = 0; e < 8; ++e) { um2[e] = 0.f; um1[e] = 0.f; } }
    for (int r4 = 0; r4 < 16; r4 += 16) {
        u32x4 uw[16], bw[16];
#pragma unroll
        for (int i = 0; i < 16; ++i) { const size_t row = rowb + t0 + r4 + i; uw[i] = *(const u32x4*)(u + row * DM + c0); bw[i] = *(const u32x4*)(bg + row * DM + c0); }
#pragma unroll
        for (int i = 0; i < 16; ++i) {
            const size_t row = rowb + t0 + r4 + i;
            float uc[8], b[8], o[8];
            unpack8(uw[i], uc); unpack8(bw[i], b);
#pragma unroll
            for (int e = 0; e < 8; ++e) { o[e] = b[e] * (k0[e] * um2[e] + k1[e] * um1[e] + k2[e] * uc[e]); um2[e] = um1[e]; um1[e] = uc[e]; }
            *(u32x4*)(y + row * DM + c0) = pack8(o);
        }
    }
}

__device__ __forceinline__ f32x2 stats_from_part(const float* part, int row) {
    float s = 0.f, q = 0.f;
#pragma unroll
    for (int i = 0; i < 8; ++i) { const f32x4 p = *(const f32x4*)(part + (size_t)row * 32 + 4 * i); s += p.x + p.z; q += p.y + p.w; }
    const float mu = s * (1.f / DM); float var = q * (1.f / DM) - mu * mu; var = var > 0.f ? var : 0.f;
    return (f32x2){mu, 1.f / sqrtf(var + LN_EPS)};
}


constexpr int RT_LG = 0, RT_ST = 64 * 97 * 4, RT_HIST = RT_ST + 512, RT_BASE = RT_HIST + 256, RT_SEL = RT_BASE + 256, RT_GATE = RT_SEL + 1024;
__device__ __forceinline__ void router_phase(const Frame& F, const bf16_t* z, const float* part, float* stout, const bf16_t* wr_hi, const float* csr, const float* bsr,
                                             const float* rbg, const float* rbe, unsigned* cnt, unsigned* list, float* gate) {
    int tid = threadIdx.x; asm volatile("" : "+v"(tid)); const int lane = tid & 63, wave = __builtin_amdgcn_readfirstlane(tid >> 6);
    LAS unsigned char* aux = F.lds + LDS_AUX;
    LAS float* lg = (LAS float*)(aux + RT_LG); LAS float* stl = (LAS float*)(aux + RT_ST); LAS unsigned* hist = (LAS unsigned*)(aux + RT_HIST); LAS unsigned* base = (LAS unsigned*)(aux + RT_BASE);
    LAS unsigned* sel = (LAS unsigned*)(aux + RT_SEL); LAS float* gl = (LAS float*)(aux + RT_GATE);
    const int row0 = 2048 * F.batch + 64 * F.jb;
    if (tid < 64) { f32x2 s; if (part) { s = stats_from_part(part, row0 + tid); *(f32x2*)(stout + 2 * (row0 + tid)) = s; } else s = *(const f32x2*)(stout + 2 * (row0 + tid));
        stl[2 * tid] = s.x; stl[2 * tid + 1] = s.y; hist[tid] = 0u; }
    const int fr = lane & 15, fq = lane >> 4;
    f32x4 acc[4][6];
#pragma unroll
    for (int m = 0; m < 4; ++m)
#pragma unroll
        for (int j = 0; j < 6; ++j) acc[m][j] = (f32x4){0.f, 0.f, 0.f, 0.f};
    const bf16_t* ap = z + (size_t)(row0 + fr) * DM + 8 * fq;
    const bf16_t* wf = wr_hi + (size_t)lane * 8;
#pragma unroll 1
    for (int k4 = 0; k4 < 4; ++k4) {
        const int ks = 4 * wave + k4;
        bf16x8 a[4], bh[6], bl[6];
#pragma unroll
        for (int m = 0; m < 4; ++m) a[m] = *(const bf16x8*)(ap + (size_t)(16 * m) * DM + 32 * ks);
#pragma unroll
        for (int j = 0; j < 6; ++j) { bh[j] = *(const bf16x8*)(wf + ((size_t)(ks * 2 + 0) * 6 + j) * 512); bl[j] = *(const bf16x8*)(wf + ((size_t)(ks * 2 + 1) * 6 + j) * 512); }
#pragma unroll
        for (int m = 0; m < 4; ++m)
#pragma unroll
            for (int j = 0; j < 6; ++j) { acc[m][j] = __builtin_amdgcn_mfma_f32_16x16x32_bf16(a[m], bh[j], acc[m][j], 0, 0, 0); acc[m][j] = __builtin_amdgcn_mfma_f32_16x16x32_bf16(a[m], bl[j], acc[m][j], 0, 0, 0); }
    }
    {
        LAS f32x4* slots = (LAS f32x4*)(F.lds + LDS_STAGE);
#pragma unroll
        for (int half = 4; half >= 1; half >>= 1) {
            __syncthreads();
            if (wave >= half && wave < 2 * half) {
#pragma unroll
                for (int m = 0; m < 4; ++m)
#pragma unroll
                    for (int j = 0; j < 6; ++j) slots[((wave - half) * 24 + m * 6 + j) * 64 + lane] = acc[m][j];
            }
            __syncthreads();
            if (wave < half) {
#pragma unroll
                for (int m = 0; m < 4; ++m)
#pragma unroll
                    for (int j = 0; j < 6; ++j) acc[m][j] += slots[(wave * 24 + m * 6 + j) * 64 + lane];
            }
        }
    }
    if (wave == 0) {
#pragma unroll
        for (int j = 0; j < 6; ++j) {
            const int n = 16 * j + fr;
            const float c = csr[n], b = bsr[n] + (n < 8 ? rbg[n] : (n < 72 ? rbe[n - 8] : 0.f));
#pragma unroll
            for (int m = 0; m < 4; ++m)
#pragma unroll
                for (int r = 0; r < 4; ++r) { const int tk = 16 * m + 4 * fq + r; lg[tk * 97 + n] = stl[2 * tk + 1] * (acc[m][j][r] - stl[2 * tk] * c) + b; }
        }
    }
    __syncthreads();
    if (tid < 64) {
        const LAS float* l = lg + tid * 97;
        int g = 0; float gm = l[0];
#pragma unroll
        for (int i = 1; i < 8; ++i) { const float v = l[i]; if (v > gm) { gm = v; g = i; } }
        float gs = 0.f;
#pragma unroll
        for (int i = 0; i < 8; ++i) gs += __expf(l[i] - gm);
        const float ggate = 1.f / gs;
        const LAS float* el = l + 8 + 8 * g;
        int i0 = 0; float v0 = el[0];
#pragma unroll
        for (int i = 1; i < 8; ++i) { const float v = el[i]; if (v > v0) { v0 = v; i0 = i; } }
        int i1 = -1; float v1 = 0.f;
#pragma unroll
        for (int i = 0; i < 8; ++i) { const float v = el[i]; if (i != i0 && (i1 < 0 || v > v1)) { v1 = v; i1 = i; } }
        const float ex = __expf(v1 - v0), p0 = 1.f / (1.f + ex), p1 = ex * p0;
        const unsigned e0 = 8 * g + i0, e1 = 8 * g + i1;
        const unsigned r0 = atomicAdd((unsigned*)(hist + e0), 1u), r1 = atomicAdd((unsigned*)(hist + e1), 1u);
        sel[4 * tid] = e0; sel[4 * tid + 1] = e1; sel[4 * tid + 2] = r0; sel[4 * tid + 3] = r1;
        gl[2 * tid] = p0 * ggate; gl[2 * tid + 1] = p1 * ggate;
    }
    __syncthreads();
    if (tid < 64) { const unsigned h = hist[tid]; base[tid] = h ? __hip_atomic_fetch_add(cnt + tid, h, __ATOMIC_RELAXED, __HIP_MEMORY_SCOPE_AGENT) : 0u; }
    __syncthreads();
    if (tid < 64) {
        const unsigned e0 = sel[4 * tid], e1 = sel[4 * tid + 1], tok = (unsigned)(row0 + tid);
        list[(size_t)e0 * 16384 + base[e0] + sel[4 * tid + 2]] = 2u * tok;
        list[(size_t)e1 * 16384 + base[e1] + sel[4 * tid + 3]] = 2u * tok + 1u;
        *(f32x2*)(gate + 2 * tok) = (f32x2){gl[2 * tid], gl[2 * tid + 1]};
    }
}

constexpr int MS_PRE = 0, MS_N = 272, MS_DESC = 288, MS_DDN = 320, MS_ROFF = 512, MS_RINFO = MS_ROFF + 2 * 1024, MS_RDN = MS_RINFO + 2 * 1024, MS_CL = MS_RDN + 6 * 1024, MS_GDN = MS_CL + 256, MS_STUP = MS_GDN + 6 * 1024, MS_EPI = MS_STUP + 2 * 2048  , MS_END = MS_EPI + 3 * 2048;
static_assert(MS_END <= 31744, "MoE tables exceed the AUX region");
constexpr int MOE_MAXDN = 6;
__device__ __forceinline__ void moe_build(const Frame& F, const unsigned* cnt, const unsigned* list, const float* st, const float* gate) {
    int tid = threadIdx.x; asm volatile("" : "+v"(tid));
    LAS unsigned char* aux = F.lds + LDS_AUX;
    LAS unsigned* pre = (LAS unsigned*)(aux + MS_PRE); LAS unsigned* nd = (LAS unsigned*)(aux + MS_N); LAS unsigned* desc = (LAS unsigned*)(aux + MS_DESC); LAS unsigned* ddn = (LAS unsigned*)(aux + MS_DDN);
    LAS unsigned* roff = (LAS unsigned*)(aux + MS_ROFF); LAS unsigned* rinfo = (LAS unsigned*)(aux + MS_RINFO); LAS unsigned* rdn = (LAS unsigned*)(aux + MS_RDN);
    LAS unsigned* cl = (LAS unsigned*)(aux + MS_CL);
    __syncthreads();
    if (tid < 64) {
        const int lane = tid;
        const unsigned c = cnt[lane], nb = (c + 255u) >> 8;
        unsigned incl = nb;
#pragma unroll
        for (int o = 1; o < 64; o <<= 1) { const unsigned t = (unsigned)__builtin_amdgcn_ds_bpermute(((lane - o) & 63) << 2, (int)incl); incl += lane >= o ? t : 0u; }
        const unsigned excl = incl - nb;
        cl[lane] = c; pre[lane] = excl; if (lane == 63) pre[64] = incl;
        const unsigned NB = (unsigned)__builtin_amdgcn_readlane((int)incl, 63), G = (unsigned)F.G, v = (unsigned)((F.bx & 7) * (F.G >> 3) + (F.bx >> 3));
        const unsigned tup = 2u * NB, tdn = 4u * NB, nup2 = tup > G ? tup - G : 0u, nlight = G - nup2;
        unsigned n = 0;
#pragma unroll
        for (int k = 0; k < 2; ++k) {
            const unsigned u = v + (unsigned)k * G;
            if (u < tup) { const unsigned gb = u >> 1, nt = u & 1u;
                const unsigned e = (unsigned)__builtin_popcountll(__builtin_amdgcn_ballot_w64(excl <= gb)) - 1u;
                if (lane == 0) { desc[4 * k] = e; desc[4 * k + 1] = gb; desc[4 * k + 2] = nt; desc[4 * k + 3] = 0u; }
                n = (unsigned)k + 1u; }
        }
        const unsigned pos0 = v >= nup2 ? v - nup2 : nlight + v;
        unsigned m = 0;
#pragma unroll
        for (int k = 0; k < MOE_MAXDN; ++k) {
            const unsigned d = pos0 < nlight ? pos0 + (unsigned)k * nlight : 0xffffffffu;
            if (d < tdn && k < 4) { const unsigned gb = d >> 2, nt = d & 3u;
                const unsigned e = (unsigned)__builtin_popcountll(__builtin_amdgcn_ballot_w64(excl <= gb)) - 1u;
                if (lane == 0) { ddn[4 * m] = e; ddn[4 * m + 1] = gb; ddn[4 * m + 2] = nt; ddn[4 * m + 3] = 0u; }
                m = m + 1u; }
        }
        {
            const unsigned done4 = 4u * nlight;
#pragma unroll
            for (int k = 0; k < 2; ++k) {
                const unsigned d = done4 + v + (unsigned)k * G;
                if (d < tdn) { const unsigned gb = d >> 2, nt = d & 3u;
                    const unsigned e = (unsigned)__builtin_popcountll(__builtin_amdgcn_ballot_w64(excl <= gb)) - 1u;
                    if (lane == 0) { ddn[4 * m] = e; ddn[4 * m + 1] = gb; ddn[4 * m + 2] = nt; ddn[4 * m + 3] = 0u; }
                    m = m + 1u; }
            }
        }
        if (lane == 0) { nd[0] = n; nd[1] = m; }
    }
    __syncthreads();
    const unsigned n = nd[0], m = nd[1];
    for (unsigned i = 0; i < n; ++i) {
        if (tid < 256) { const unsigned e = desc[4 * i], gb = desc[4 * i + 1], idx = (gb - pre[e]) * 256u + (unsigned)tid, c = cl[e];
            LAS f32x2* stup = (LAS f32x2*)(aux + MS_STUP);
            if (idx < c) { const unsigned ts = list[(size_t)e * 16384 + idx]; roff[i * 256 + tid] = (ts >> 1) * (unsigned)DM; rinfo[i * 256 + tid] = ts; stup[i * 256 + tid] = *(const f32x2*)(st + 2 * (ts >> 1)); }
            else { roff[i * 256 + tid] = 0u; rinfo[i * 256 + tid] = 0xffffffffu; stup[i * 256 + tid] = (f32x2){0.f, 1.f}; } }
    }
    for (unsigned i = 0; i < m; ++i) {
        if (tid >= 256) { const unsigned r = (unsigned)tid - 256u, e = ddn[4 * i], gb = ddn[4 * i + 1], idx = (gb - pre[e]) * 256u + r, c = cl[e];
            LAS float* gdn = (LAS float*)(aux + MS_GDN);
            if (idx < c) { const unsigned ts = list[(size_t)e * 16384 + idx]; rdn[i * 256 + r] = ts; gdn[i * 256 + r] = 16.f * gate[ts]; }
            else { rdn[i * 256 + r] = 0xffffffffu; gdn[i * 256 + r] = 0.f; } }
    }
    __syncthreads();
}
template <bool UP>
struct MoeSched {
    LAS unsigned char* aux; const char* Abase; const char* Wbase; unsigned* done;
    __device__ __forceinline__ bool next(int i, pg8::Unit& u) const {
        const unsigned n = ((const LAS unsigned*)(aux + MS_N))[UP ? 0 : 1]; if ((unsigned)i >= n) return false;
        const LAS unsigned* d = (const LAS unsigned*)(aux + (UP ? MS_DESC : MS_DDN)) + 4 * i; const unsigned e = d[0], gb = d[1], nt = d[2];
        if (UP) { u.A = Abase; u.B = Wbase + ((size_t)e * 512 + nt * 256) * DM; }
        else { u.A = Abase + (size_t)gb * 256 * DEXP; u.B = Wbase + ((size_t)e * DM + nt * 256) * DEXP; }
        u.pm = (int)gb; u.pn = (int)nt; u.x0 = (int)e; u.x1 = i; return true;
    }
    __device__ __forceinline__ const LAS unsigned* rowoff(int i) const { return (const LAS unsigned*)(aux + MS_ROFF) + 256 * i; }
    __device__ __forceinline__ void a_ready(const pg8::Unit& u) const {
        if (!UP) {
            int t = threadIdx.x; asm volatile("" : "+v"(t));
            if (__builtin_amdgcn_readfirstlane(t >> 6) == 0) {
                unsigned sp = 0;
                while ((unsigned)__builtin_amdgcn_readfirstlane((int)__hip_atomic_load(done + u.pm, __ATOMIC_RELAXED, __HIP_MEMORY_SCOPE_AGENT)) < 2u) { __builtin_amdgcn_s_sleep(2); if (++sp > (1u << 22)) break; }
                __builtin_amdgcn_fence(__ATOMIC_ACQUIRE, "agent");
                asm volatile("s_waitcnt vmcnt(0)" ::: "memory");
            }
            asm volatile("" ::: "memory"); __builtin_amdgcn_s_barrier(); asm volatile("" ::: "memory");
        }
    }
};
struct EpiUp {
    LAS unsigned char* aux; const float* st; const float* cs; const float* bs; unsigned char* h; unsigned* done;
    __device__ __forceinline__ void prefetch(const pg8::Unit& un, int slot, int wid, int lane) const {
        if (wid == 2 || wid == 3) { const char* s = (const char*)((wid == 2 ? cs : bs) + un.x0 * 512 + 256 * un.pn); int t = threadIdx.x; asm volatile("" : "+v"(t)); (void)lane;
            __builtin_amdgcn_global_load_lds((const unsigned*)(s + (t & 63) * 16), (LAS unsigned*)(aux + MS_EPI + slot * 2048 + (wid - 2) * 1024), 16, 0, 0); } }
    __device__ __forceinline__ void operator()(const f32x4 (&acc)[2][2][4][2], const pg8::Unit& un, int ui, int wr, int wc, int fr, int fq, int slot) const {
        asm volatile("" : "+v"(fr), "+v"(fq));
        const int colL = 32 * wc + 8 * fq;
        const LAS float* ep = (const LAS float*)(aux + MS_EPI + slot * 2048);
        float csv[2][8], bsv[2][8];
        ld8l(ep + colL, csv[0]); ld8l(ep + colL + 128, csv[1]); ld8l(ep + 256 + colL, bsv[0]); ld8l(ep + 256 + colL + 128, bsv[1]);
        const LAS unsigned* rinfo = (const LAS unsigned*)(aux + MS_RINFO) + 256 * ui;
        const LAS f32x2* stup = (const LAS f32x2*)(aux + MS_STUP) + 256 * ui; (void)rinfo;
        f32x2 sv[2][4];
#pragma unroll
        for (int ai = 0; ai < 2; ++ai)
#pragma unroll
            for (int m = 0; m < 4; ++m) sv[ai][m] = stup[128 * ai + 64 * wr + 16 * m + fr];
#pragma unroll
        for (int ai = 0; ai < 2; ++ai)
#pragma unroll
            for (int m = 0; m < 4; ++m) {
                const int r = 128 * ai + 64 * wr + 16 * m + fr;
                const f32x2 s = sv[ai][m];
                float p[8];
#pragma unroll
                for (int e = 0; e < 8; ++e) {
                    const float a1 = s.y * (acc[ai][0][m][e >> 2][e & 3] - s.x * csv[0][e]) + bsv[0][e];
                    const float a3 = s.y * (acc[ai][1][m][e >> 2][e & 3] - s.x * csv[1][e]) + bsv[1][e];
                    p[e] = a1 / (1.f + __expf(-a1)) * a3;
                }
                st8wt(h + ((size_t)un.pm * 256 + r) * DEXP + 128 * un.pn + colL, (u32x2){pk4_fp8(p[0], p[1], p[2], p[3]), pk4_fp8(p[4], p[5], p[6], p[7])});
            }
        asm volatile("s_waitcnt vmcnt(0)" ::: "memory");
        __builtin_amdgcn_s_barrier();
        if (wr == 0 && wc == 0 && fr == 0 && fq == 0) __hip_atomic_fetch_add(done + un.pm, 1u, __ATOMIC_RELAXED, __HIP_MEMORY_SCOPE_AGENT);
    }
};
struct EpiDown {
    LAS unsigned char* aux; const float* gate; unsigned char* y;
    __device__ __forceinline__ void prefetch(const pg8::Unit&, int, int, int) const {}
    __device__ __forceinline__ void operator()(const f32x4 (&acc)[2][2][4][2], const pg8::Unit& un, int ui, int wr, int wc, int fr, int fq, int) const {
        const int cb = 256 * un.pn + 64 * wc + 16 * fq;
        const LAS unsigned* rinfo = (const LAS unsigned*)(aux + MS_RDN) + 256 * ui;
        const LAS float* gdn = (const LAS float*)(aux + MS_GDN) + 256 * ui;
        unsigned tsv[2][4]; float gvv[2][4];
#pragma unroll
        for (int ai = 0; ai < 2; ++ai)
#pragma unroll
            for (int m = 0; m < 4; ++m) { const int r = 128 * ai + 64 * wr + 16 * m + fr; tsv[ai][m] = rinfo[r]; gvv[ai][m] = gdn[r]; }
#pragma unroll
        for (int ai = 0; ai < 2; ++ai)
#pragma unroll
            for (int m = 0; m < 4; ++m) {
                const unsigned ts = tsv[ai][m];
                if (ts != 0xffffffffu) {
                    const float g = gvv[ai][m];
                    u32x4 o;
#pragma unroll
                    for (int bj = 0; bj < 2; ++bj) {
                        float p[8];
#pragma unroll
                        for (int e = 0; e < 8; ++e) p[e] = g * acc[ai][bj][m][e >> 2][e & 3];
                        o[2 * bj] = pk4_fp8(p[0], p[1], p[2], p[3]); o[2 * bj + 1] = pk4_fp8(p[4], p[5], p[6], p[7]);
                    }
                    *(u32x4*)(y + (size_t)ts * DM + cb) = o;
                }
            }
    }
};


struct EpiAttnIn {
    const float* st; const float* cs; const float* bs; unsigned char* q; bf16_t* qi; float* misc; int pn0; LAS unsigned char* aux;
    __device__ __forceinline__ void prefetch(const pg8::Unit& un, int slot, int wid, int lane) const { epi_prefetch(aux + slot * 4096, st + 2 * 256 * un.pm, cs + 256 * (un.pn + pn0), bs + 256 * (un.pn + pn0), wid, lane); }
    __device__ __forceinline__ void operator()(const f32x4 (&acc)[2][2][4][2], const pg8::Unit& un, int, int wr, int wc, int fr, int fq, int slot) const {
        const int pn = un.pn + pn0;
        const int colL = 32 * wc + 8 * fq;
        const LAS unsigned char* ep = aux + slot * 4096;
        float csv[2][8], bsv[2][8];
        ld8l((const LAS float*)(ep + 2048) + colL, csv[0]); ld8l((const LAS float*)(ep + 2048) + colL + 128, csv[1]); ld8l((const LAS float*)(ep + 3072) + colL, bsv[0]); ld8l((const LAS float*)(ep + 3072) + colL + 128, bsv[1]);
        f32x2 sv[2][4];
#pragma unroll
        for (int ai = 0; ai < 2; ++ai)
#pragma unroll
            for (int m = 0; m < 4; ++m) sv[ai][m] = ((const LAS f32x2*)ep)[128 * ai + 64 * wr + 16 * m + fr];
#pragma unroll
        for (int ai = 0; ai < 2; ++ai)
#pragma unroll
            for (int m = 0; m < 4; ++m) {
                const int row = 256 * un.pm + 128 * ai + 64 * wr + 16 * m + fr;
                const f32x2 s = sv[ai][m];
#pragma unroll
                for (int bj = 0; bj < 2; ++bj) {
                    float f[8];
#pragma unroll
                    for (int e = 0; e < 8; ++e) f[e] = s.y * (acc[ai][bj][m][e >> 2][e & 3] - s.x * csv[bj][e]) + bsv[bj][e];
                    if (pn < 8) *(u32x2*)(q + (size_t)row * 2048 + 256 * pn + 128 * bj + colL) = (u32x2){pk4_fp8(f[0], f[1], f[2], f[3]), pk4_fp8(f[4], f[5], f[6], f[7])};
                    else if (pn == 8) { float* d = misc + (size_t)row * 256 + 128 * bj + colL; *(f32x4*)d = (f32x4){f[0], f[1], f[2], f[3]}; *(f32x4*)(d + 4) = (f32x4){f[4], f[5], f[6], f[7]}; }
                    else *(u32x4*)(qi + (size_t)row * 512 + 256 * (pn - 9) + 128 * bj + colL) = pack8(f);
                }
            }
    }
};

__device__ __forceinline__ void attn_norm_phase(const Frame& F, const float* misc, const float* kvg, const float* kig, const float* kib, unsigned char* ckv8, bf16_t* ki) {
    int tid = threadIdx.x; asm volatile("" : "+v"(tid)); const int lane = tid & 63, wave = __builtin_amdgcn_readfirstlane(tid >> 6);
    const int row0 = 2048 * F.batch + 64 * F.jb + 8 * wave;
    const float g0 = kvg[2 * lane], g1 = kvg[2 * lane + 1], kg = kig[lane], kb = kib[lane];
    f32x2 cv[8]; float kv[8];
#pragma unroll
    for (int r = 0; r < 8; ++r) { cv[r] = *(const f32x2*)(misc + (size_t)(row0 + r) * 256 + 2 * lane); kv[r] = misc[(size_t)(row0 + r) * 256 + 128 + lane]; }
#pragma unroll
    for (int r = 0; r < 8; ++r) {
        const int row = row0 + r;
        const f32x2 c = cv[r];
        const float k = kv[r];
        const float ss = wave_sum(c.x * c.x + c.y * c.y, lane);
        const float rinv = 1.f / sqrtf(ss * (1.f / 128.f) + RMS_EPS);
        ((unsigned short*)(ckv8 + (size_t)row * 128))[lane] = (unsigned short)__builtin_amdgcn_cvt_pk_fp8_f32(c.x * rinv * g0, c.y * rinv * g1, 0, false);
        const float mu = wave_sum(k, lane) * (1.f / 64.f); const float d = k - mu;
        const float var = wave_sum(d * d, lane) * (1.f / 64.f);
        ki[(size_t)row * 64 + lane] = (bf16_t)f2bf(d * (1.f / sqrtf(var + LN_EPS)) * kg + kb);
    }
}

__device__ __forceinline__ unsigned sortable(float f) { const unsigned u = __builtin_bit_cast(unsigned, f); return (u & 0x80000000u) ? ~u : (u | 0x80000000u); }
__device__ __forceinline__ unsigned radix_select256(const unsigned (&k)[32], int nvalid, LAS unsigned* hist, int lane) {
    unsigned prefix = 0u, pmask = 0u, krem = 256u;
#pragma unroll 1
    for (int shift = 24; shift >= 0; shift -= 8) {
#pragma unroll
        for (int j = 0; j < 4; ++j) hist[lane + 64 * j] = 0u;
        asm volatile("s_waitcnt lgkmcnt(0)" ::: "memory");
#pragma unroll
        for (int g8 = 0; g8 < 4; ++g8) if (512 * g8 < nvalid) {
#pragma unroll
            for (int i = 8 * g8; i < 8 * g8 + 8; ++i) { const unsigned key = k[i]; if (key != 0u && (key & pmask) == prefix) __hip_atomic_fetch_add(hist + ((key >> shift) & 255u), 1u, __ATOMIC_RELAXED, __HIP_MEMORY_SCOPE_WAVEFRONT); } }
        asm volatile("s_waitcnt lgkmcnt(0)" ::: "memory");
        unsigned h[4];
#pragma unroll
        for (int j = 0; j < 4; ++j) h[j] = hist[255 - 4 * lane - j];
        const unsigned local = (h[0] + h[1]) + (h[2] + h[3]);
        unsigned incl = local;
#pragma unroll
        for (int o = 1; o < 64; o <<= 1) { const unsigned t = (unsigned)__builtin_amdgcn_ds_bpermute(((lane - o) & 63) << 2, (int)incl); incl += lane >= o ? t : 0u; }
        const unsigned long long m = __builtin_amdgcn_ballot_w64(incl >= krem);
        const int L = __builtin_ctzll(m);
        unsigned cum = (unsigned)__builtin_amdgcn_readlane((int)(incl - local), L);
        const unsigned c0 = (unsigned)__builtin_amdgcn_readlane((int)h[0], L), c1 = (unsigned)__builtin_amdgcn_readlane((int)h[1], L), c2 = (unsigned)__builtin_amdgcn_readlane((int)h[2], L), c3 = (unsigned)__builtin_amdgcn_readlane((int)h[3], L);
        unsigned bin, cb;
        if (cum + c0 >= krem) { bin = 255u - 4u * L; cb = c0; }
        else { cum += c0; if (cum + c1 >= krem) { bin = 254u - 4u * L; cb = c1; } else { cum += c1; if (cum + c2 >= krem) { bin = 253u - 4u * L; cb = c2; } else { cum += c2; bin = 252u - 4u * L; cb = c3; } } }
        krem -= cum; prefix |= bin << shift; pmask |= 255u << shift;
        if (cb == krem) break;
    }
    return prefix;
}

__device__ __forceinline__ void index_unit(const Frame& F, const bf16_t* qi, const float* misc, const bf16_t* ki, unsigned short* sel, int b, int t0, int lane, int wave) {
    const int hh = lane >> 5, l31 = lane & 31;
    const size_t rb = (size_t)b * 2048;
    LAS unsigned* sc = (LAS unsigned*)(F.lds + LDS_STAGE);
    const LAS unsigned* bkt = (const LAS unsigned*)(F.lds + LDS_AUX);
#define IDX_PACK(key, t) ({ const int _k = (key), _d = (t) - _k; (unsigned short)(_k | (int)(bkt[_d < 0 ? 0 : (_d > 127 ? 127 : _d)] << 11)); })
    if (t0 < 256) {
#pragma unroll
        for (int qq = 0; qq < 2; ++qq) { const int t = t0 + 2 * wave + qq;
#pragma unroll
            for (int j = 0; j < 4; ++j) { const int idx = lane + 64 * j; sel[(rb + t) * 256 + idx] = idx <= t ? IDX_PACK(idx, t) : (unsigned short)0; } }
        return;
    }
    const int nkt = (t0 + 16 + 31) >> 5;
    {
        LAS unsigned char* aq_l = F.lds + LDS_AUX + 10240; LAS float* w_l = (LAS float*)(F.lds + LDS_AUX + 26624);
        { const char* src = (const char*)(qi + (rb + t0) * 512);
#pragma unroll
          for (int j = 0; j < 2; ++j) __builtin_amdgcn_global_load_lds((const unsigned*)(src + (2 * wave + j) * 1024 + lane * 16), (LAS unsigned*)(aq_l + (2 * wave + j) * 1024), 16, 0, 0);
          if (wave < 2) { const int i = 64 * wave + lane; w_l[i] = misc[(rb + t0 + (i >> 3)) * 256 + 192 + (i & 7)]; } }
        asm volatile("s_waitcnt vmcnt(0)" ::: "memory");
        __syncthreads();
        bf16x8 aq[4][4];
        { const int r = l31, head = (r & 3) + 4 * ((r >> 3) & 1), query = (r >> 4) + 2 * ((r >> 2) & 1);
#pragma unroll
          for (int mt = 0; mt < 4; ++mt) { const LAS unsigned char* ap = aq_l + ((4 * mt + query) * 8 + head) * 128 + 16 * hh;
#pragma unroll
              for (int ks = 0; ks < 4; ++ks) aq[mt][ks] = *(const LAS bf16x8*)(ap + 32 * ks); } }
        const bf16_t* kp = ki + (rb + l31) * 64 + 8 * hh;
        bf16x8 bk[4], bn[4];
        if (wave < nkt) {
#pragma unroll
            for (int ks = 0; ks < 4; ++ks) bk[ks] = *(const bf16x8*)(kp + (size_t)wave * 2048 + 16 * ks); }
        for (int kt = wave; kt < nkt; kt += 8) {
            const int ktn = kt + 8 < nkt ? kt + 8 : kt;
#pragma unroll
            for (int ks = 0; ks < 4; ++ks) bn[ks] = *(const bf16x8*)(kp + (size_t)ktn * 2048 + 16 * ks);
            const int key = 32 * kt + l31;
#pragma unroll
            for (int mt = 0; mt < 4; ++mt) {
                f32x16 acc;
#pragma unroll
                for (int e = 0; e < 16; ++e) acc[e] = 0.f;
#pragma unroll
                for (int ks = 0; ks < 4; ++ks) acc = __builtin_amdgcn_mfma_f32_32x32x16_bf16(aq[mt][ks], bk[ks], acc, 0, 0, 0);
                float s0 = 0.f, s1 = 0.f;
                {
                    const LAS f32x4* wp = (const LAS f32x4*)(w_l + (4 * mt + 2 * hh) * 8); const f32x4 wa = wp[0], wb = wp[1], wc = wp[2], wd = wp[3];
                    const float w0[8] = {wa.x, wa.y, wa.z, wa.w, wb.x, wb.y, wb.z, wb.w}, w1[8] = {wc.x, wc.y, wc.z, wc.w, wd.x, wd.y, wd.z, wd.w};
#pragma unroll
                    for (int e = 0; e < 8; ++e) { s0 += fmaxf(acc[e], 0.f) * w0[e]; s1 += fmaxf(acc[8 + e], 0.f) * w1[e]; }
                }
                const int tq = t0 + 4 * mt + 2 * hh;
                sc[(4 * mt + 2 * hh) * 2048 + key] = key <= tq ? sortable(s0) : 0u;
                sc[(4 * mt + 2 * hh + 1) * 2048 + key] = key <= tq + 1 ? sortable(s1) : 0u;
            }
#pragma unroll
            for (int ks = 0; ks < 4; ++ks) bk[ks] = bn[ks];
        }
    }
    __syncthreads();
    {
    unsigned ka[32], kb[32];
    const int nvalid = 32 * nkt;
#pragma unroll
    for (int i = 0; i < 32; ++i) { const int key = 64 * i + lane; const bool v = key < nvalid; ka[i] = v ? sc[(2 * wave) * 2048 + key] : 0u; kb[i] = v ? sc[(2 * wave + 1) * 2048 + key] : 0u; }
    LAS unsigned* hist = (LAS unsigned*)(F.lds + LDS_AUX + 1024 + wave * 1024);
    const unsigned Ta = radix_select256(ka, nvalid, hist, lane), Tb = radix_select256(kb, nvalid, hist, lane);
#pragma unroll
    for (int qq = 0; qq < 2; ++qq) {
        const unsigned T = qq ? Tb : Ta;
        unsigned nge = 0u;
#pragma unroll
        for (int g8 = 0; g8 < 4; ++g8) if (512 * g8 < nvalid) {
#pragma unroll
            for (int i = 8 * g8; i < 8 * g8 + 8; ++i) nge += (unsigned)__builtin_popcountll(__builtin_amdgcn_ballot_w64((qq ? kb[i] : ka[i]) >= T)); }
        LAS unsigned short* out = (LAS unsigned short*)hist + 256 * qq;
        unsigned base = 0u;
        if (nge == 256u) {
#pragma unroll
            for (int i = 0; i < 32; ++i) if (64 * i < nvalid) {
                const unsigned k = qq ? kb[i] : ka[i];
                const bool take = k >= T;
                const unsigned long long mtk = __builtin_amdgcn_ballot_w64(take);
                const unsigned tkbelow = __builtin_amdgcn_mbcnt_hi((unsigned)(mtk >> 32), __builtin_amdgcn_mbcnt_lo((unsigned)mtk, 0u));
                if (take) out[base + tkbelow] = IDX_PACK(64 * i + lane, t0 + 2 * wave + qq);
                base += (unsigned)__builtin_popcountll(mtk);
            }
        } else {
            unsigned ngt = 0u;
#pragma unroll
            for (int i = 0; i < 32; ++i) ngt += (unsigned)__builtin_popcountll(__builtin_amdgcn_ballot_w64((qq ? kb[i] : ka[i]) > T));
            const unsigned need = 256u - ngt;
            unsigned tbase = 0u;
#pragma unroll 4
            for (int i = 0; i < 32; ++i) if (64 * i < nvalid) {
                const unsigned k = qq ? kb[i] : ka[i];
                const bool eq = (k == T), gt = (k > T);
                const unsigned long long meq = __builtin_amdgcn_ballot_w64(eq);
                const unsigned eqbelow = __builtin_amdgcn_mbcnt_hi((unsigned)(meq >> 32), __builtin_amdgcn_mbcnt_lo((unsigned)meq, 0u));
                const bool take = gt || (eq && (tbase + eqbelow) < need);
                tbase += (unsigned)__builtin_popcountll(meq);
                const unsigned long long mtk = __builtin_amdgcn_ballot_w64(take);
                const unsigned tkbelow = __builtin_amdgcn_mbcnt_hi((unsigned)(mtk >> 32), __builtin_amdgcn_mbcnt_lo((unsigned)mtk, 0u));
                if (take) out[base + tkbelow] = IDX_PACK(64 * i + lane, t0 + 2 * wave + qq);
                base += (unsigned)__builtin_popcountll(mtk);
            }
        }
    }
    asm volatile("s_waitcnt lgkmcnt(0)" ::: "memory");
    *(u32x4*)(sel + (rb + t0 + 2 * wave + (lane >> 5)) * 256 + 8 * (lane & 31)) = *(const LAS u32x4*)((const LAS unsigned char*)hist + 16 * lane);
    }
    __syncthreads();
#undef IDX_PACK
}
__device__ __forceinline__ void index_phase(const Frame& F, const bf16_t* qi, const float* misc, const bf16_t* ki, unsigned short* sel) {
    int tid = threadIdx.x; asm volatile("" : "+v"(tid)); const int lane = tid & 63, wave = __builtin_amdgcn_readfirstlane(tid >> 6);
    if (tid < 128) { unsigned bk = (unsigned)tid; if (tid >= 16) { int v = 16 + (int)(__logf((float)tid / 16.f) / 2.0794415416798357f * 16.f); bk = (unsigned)(v < 31 ? v : 31); } ((LAS unsigned*)(F.lds + LDS_AUX))[tid] = bk; }
    __syncthreads();
    const int us[4] = {127 - F.jb, 64 + F.jb, 63 - F.jb, F.jb};
    for (int k = 0; k < 4; ++k) index_unit(F, qi, misc, ki, sel, F.batch, 16 * us[k], lane, wave);
}

constexpr int AT_P = 0  , AT_SCT = 8704  , AT_BIAS = 16896, AT_Q = 18944  , AT_SEL = 27136  ;
static_assert(AT_SEL + 3 * 1024 <= 31744, "attention tables exceed the AUX region");
__device__ __forceinline__ unsigned at_f(unsigned row) { return ((row >> 2) & 1u) | (((row >> 1) & 1u) << 1) | (((row >> 3) & 1u) << 2); }
__device__ __forceinline__ void attn_phase(const Frame& F, const unsigned char* q8, const unsigned char* ckv8, const unsigned short* sel, const float* relb, unsigned char* o) {
    int tid = threadIdx.x; asm volatile("" : "+v"(tid)); const int lane = tid & 63, wave = __builtin_amdgcn_readfirstlane(tid >> 6);
    const int fr = lane & 15, fq = lane >> 4;
    LAS unsigned char* aux = F.lds + LDS_AUX;
    LAS float* biast = (LAS float*)(aux + AT_BIAS);
    for (int i = tid; i < 512; i += NTHREADS) biast[i] = relb[i];
    const size_t rb = (size_t)F.batch * 2048;
    const int us0 = 127 - F.jb, us1 = 64 + F.jb, us2 = 63 - F.jb, us3 = F.jb;
#define AT_T(it) (16 * ((it) < 8 ? us0 : ((it) < 16 ? us1 : ((it) < 24 ? us2 : us3))) + 2 * ((it) & 7))
    const unsigned char* ckvb = ckv8 + rb * 128;
    const unsigned dl8 = (unsigned)lane >> 3, dp = (unsigned)lane & 7u;
#define AT_DMA_SEL(t, slot) do { if (wave == 0) \
        __builtin_amdgcn_global_load_lds((const unsigned*)((const unsigned char*)(sel + (rb + (t)) * 256) + 16 * lane), (LAS unsigned*)(aux + AT_SEL + (slot) * 1024), 16, 0, 16); } while (0)
#define AT_DMA_Q(t, buf) do { if (wave == 1) { _Pragma("unroll") for (int j = 0; j < 4; ++j) { const unsigned R = 8u * j + dl8; \
        __builtin_amdgcn_global_load_lds((const unsigned*)(q8 + (rb + (t)) * 2048 + R * 128u + ((dp ^ at_f(R)) << 4)), (LAS unsigned*)(aux + AT_Q + (buf) * 4096 + j * 1024), 16, 0, 0); } } } while (0)
#define AT_GATHER(buf, slot) do { const LAS unsigned short* sp = (const LAS unsigned short*)(aux + AT_SEL + (slot) * 1024) + 32 * wave + dl8; unsigned svv[8]; \
        _Pragma("unroll") for (int j = 0; j < 8; ++j) svv[j] = sp[256 * (j >> 2) + 8 * (j & 3)]; \
        asm volatile("s_waitcnt lgkmcnt(0)" : "+v"(svv[0]), "+v"(svv[1]), "+v"(svv[2]), "+v"(svv[3]), "+v"(svv[4]), "+v"(svv[5]), "+v"(svv[6]), "+v"(svv[7]) :: "memory");     \
        _Pragma("unroll") for (int j = 0; j < 8; ++j) { const unsigned row = 32u * wave + 8u * (j & 3) + dl8; \
        __builtin_amdgcn_global_load_lds((const unsigned*)(ckvb + (size_t)(svv[j] & 2047u) * 128 + ((dp ^ at_f(row)) << 4)), (LAS unsigned*)(F.lds + ((buf) * 2 + (j >> 2)) * 32768 + (32 * wave + 8 * (j & 3)) * 128), 16, 0, 0); } } while (0)
    AT_DMA_SEL(AT_T(0), 0); AT_DMA_SEL(AT_T(1), 1); AT_DMA_Q(AT_T(0), 0);
    asm volatile("s_waitcnt vmcnt(0)" ::: "memory");
    __syncthreads();
    AT_GATHER(0, 0);
    const bf16x8 ones = {0x3F80, 0x3F80, 0x3F80, 0x3F80, 0x3F80, 0x3F80, 0x3F80, 0x3F80};
    const unsigned fsw = at_f((unsigned)fr);
    int s_cur = 0;
    for (int it = 0; it < 32; ++it) {
        const int t0 = AT_T(it), cur = it & 1;
        const int s_nxt = s_cur == 2 ? 0 : s_cur + 1, s_nn = s_nxt == 2 ? 0 : s_nxt + 1;
        asm volatile("s_waitcnt vmcnt(0) lgkmcnt(0)" ::: "memory");
        __builtin_amdgcn_s_barrier();
        if (it < 31) { AT_GATHER(cur ^ 1, s_nxt); AT_DMA_Q(AT_T(it + 1), cur ^ 1); if (it < 30) AT_DMA_SEL(AT_T(it + 2), s_nn); }
        {
            i32x8 qv[2], kv[2][2]; u32x2 pcw[2][2];
#pragma unroll
            for (int qq = 0; qq < 2; ++qq) {
                const LAS unsigned char* qrow = aux + AT_Q + cur * 4096 + (16 * qq + fr) * 128;
                const u32x4 qb0 = *(const LAS u32x4*)(qrow + (((2u * fq) ^ fsw) << 4)), qb1 = *(const LAS u32x4*)(qrow + (((2u * fq + 1u) ^ fsw) << 4));
                qv[qq] = (i32x8){(int)qb0.x, (int)qb0.y, (int)qb0.z, (int)qb0.w, (int)qb1.x, (int)qb1.y, (int)qb1.z, (int)qb1.w};
                const LAS unsigned char* srow = aux + AT_SEL + s_cur * 1024 + qq * 512 + (32 * wave + 4 * fq) * 2;
#pragma unroll
                for (int mt = 0; mt < 2; ++mt) {
                    const LAS unsigned char* krow = F.lds + (cur * 2 + qq) * 32768 + (32 * wave + 16 * mt + fr) * 128;
                    const u32x4 k0 = *(const LAS u32x4*)(krow + (((2u * fq) ^ fsw) << 4)), k1 = *(const LAS u32x4*)(krow + (((2u * fq + 1u) ^ fsw) << 4));
                    kv[qq][mt] = (i32x8){(int)k0.x, (int)k0.y, (int)k0.z, (int)k0.w, (int)k1.x, (int)k1.y, (int)k1.z, (int)k1.w};
                    pcw[qq][mt] = *(const LAS u32x2*)(srow + 32 * mt);
                }
            }
            float bv[2][2][4];
#pragma unroll
            for (int qq = 0; qq < 2; ++qq)
#pragma unroll
                for (int mt = 0; mt < 2; ++mt) {
                    const unsigned pw[2] = {pcw[qq][mt].x, pcw[qq][mt].y};
#pragma unroll
                    for (int r = 0; r < 4; ++r) { const unsigned bucket = ((pw[r >> 1] >> (16 * (r & 1))) & 0xffffu) >> 11; bv[qq][mt][r] = biast[bucket * 16 + fr]; }
                }
            f32x4 sacc[2][2];
#pragma unroll
            for (int qq = 0; qq < 2; ++qq)
#pragma unroll
                for (int mt = 0; mt < 2; ++mt)
                    sacc[qq][mt] = __builtin_amdgcn_mfma_scale_f32_16x16x128_f8f6f4(kv[qq][mt], qv[qq], (f32x4){0.f, 0.f, 0.f, 0.f}, 0, 0, 0, 0x7F7F7F7F, 0, 0x7F7F7F7F);
#pragma unroll
            for (int qq = 0; qq < 2; ++qq) {
                const int nsel = t0 + qq + 1 < TOPK ? t0 + qq + 1 : TOPK;
                float v2[2][4]; float mx = -115.f;
#pragma unroll
                for (int mt = 0; mt < 2; ++mt)
#pragma unroll
                    for (int r = 0; r < 4; ++r) {
                        const int slot = 32 * wave + 16 * mt + 4 * fq + r;
                        const float v = fminf(sacc[qq][mt][r] * 0.08838834764831845f + bv[qq][mt][r], 80.f) * 1.4426950408889634f;
                        v2[mt][r] = slot < nsel ? v : -1e30f; mx = fmaxf(mx, v2[mt][r]);
                    }
                {
                    const unsigned mb = __builtin_bit_cast(unsigned, mx);
                    const auto s16 = __builtin_amdgcn_permlane16_swap(mb, mb, false, false);
                    const float m1 = fmaxf(__builtin_bit_cast(float, (unsigned)s16[0]), __builtin_bit_cast(float, (unsigned)s16[1]));
                    const unsigned m1b = __builtin_bit_cast(unsigned, m1);
                    const auto s32 = __builtin_amdgcn_permlane32_swap(m1b, m1b, false, false);
                    mx = fmaxf(__builtin_bit_cast(float, (unsigned)s32[0]), __builtin_bit_cast(float, (unsigned)s32[1]));
                }
                const float ef = floorf(mx) + 1.f;
                LAS unsigned char* prow = aux + AT_P + qq * 4352 + fr * 272 + 32 * wave + 4 * fq;
#pragma unroll
                for (int mt = 0; mt < 2; ++mt)
                    *(LAS unsigned*)(prow + 16 * mt) = pk4_fp8(__builtin_amdgcn_exp2f(v2[mt][0] - ef), __builtin_amdgcn_exp2f(v2[mt][1] - ef), __builtin_amdgcn_exp2f(v2[mt][2] - ef), __builtin_amdgcn_exp2f(v2[mt][3] - ef));
                if (fq == 0) *(LAS unsigned char*)(aux + AT_SCT + qq * 128 + fr * 8 + wave) = (unsigned char)(127 + (int)ef);
            }
        }
        asm volatile("s_waitcnt lgkmcnt(0)" ::: "memory"); __builtin_amdgcn_s_barrier(); asm volatile("" ::: "memory");
        {
            const int qq = wave >> 2; const unsigned db = (unsigned)wave & 3u;
            const unsigned img = (unsigned)(size_t)(F.lds + (cur * 2 + qq) * 32768);
            const LAS unsigned char* pbase = aux + AT_P + qq * 4352 + fr * 272 + 16 * fq;
            const LAS unsigned char* sbase = aux + AT_SCT + qq * 128 + fr * 8 + fq;
            f32x4 oe = (f32x4){0.f, 0.f, 0.f, 0.f}, oo = (f32x4){0.f, 0.f, 0.f, 0.f}, tacc = (f32x4){0.f, 0.f, 0.f, 0.f};
            const unsigned r4 = (unsigned)(lane & 15) >> 2, c4 = (unsigned)lane & 3u;
            u32x2 ta[2][8]; u32x4 pf[2][2]; unsigned sb[2];
#pragma unroll
            for (int kb = 0; kb < 2; ++kb)
#pragma unroll
                for (int j = 0; j < 8; ++j) {
                    const unsigned row = 128u * kb + 64u * (j >> 2) + 16u * fq + 4u * (j & 3) + r4;
                    const unsigned a0 = img + row * 128u + (((2u * db + (c4 >> 1)) ^ at_f(row)) << 4) + 8u * (c4 & 1u);
                    asm volatile("ds_read_b64_tr_b16 %0, %1" : "=&v"(ta[kb][j]) : "v"(a0) : "memory");
                }
#pragma unroll
            for (int kb = 0; kb < 2; ++kb) { pf[kb][0] = *(const LAS u32x4*)(pbase + 128 * kb); pf[kb][1] = *(const LAS u32x4*)(pbase + 128 * kb + 64); sb[kb] = *(sbase + 4 * kb); }
            asm volatile("s_waitcnt lgkmcnt(0)" : "+v"(ta[0][0]), "+v"(ta[0][1]), "+v"(ta[0][2]), "+v"(ta[0][3]), "+v"(ta[0][4]), "+v"(ta[0][5]), "+v"(ta[0][6]), "+v"(ta[0][7]),
                         "+v"(ta[1][0]), "+v"(ta[1][1]), "+v"(ta[1][2]), "+v"(ta[1][3]), "+v"(ta[1][4]), "+v"(ta[1][5]), "+v"(ta[1][6]), "+v"(ta[1][7]) :: "memory");
            const i32x8 onesv = {0x38383838, 0x38383838, 0x38383838, 0x38383838, 0x38383838, 0x38383838, 0x38383838, 0x38383838};
#pragma unroll
            for (int kb = 0; kb < 2; ++kb) {
                i32x8 ev, od;
#pragma unroll
                for (int j = 0; j < 8; ++j) { ev[j] = (int)__builtin_amdgcn_perm(ta[kb][j].y, ta[kb][j].x, 0x06040200u); od[j] = (int)__builtin_amdgcn_perm(ta[kb][j].y, ta[kb][j].x, 0x07050301u); }
                const i32x8 pv8 = {(int)pf[kb][0].x, (int)pf[kb][0].y, (int)pf[kb][0].z, (int)pf[kb][0].w, (int)pf[kb][1].x, (int)pf[kb][1].y, (int)pf[kb][1].z, (int)pf[kb][1].w};
                oe = __builtin_amdgcn_mfma_scale_f32_16x16x128_f8f6f4(ev, pv8, oe, 0, 0, 0, 0x7F7F7F7F, 0, (int)sb[kb]);
                oo = __builtin_amdgcn_mfma_scale_f32_16x16x128_f8f6f4(od, pv8, oo, 0, 0, 0, 0x7F7F7F7F, 0, (int)sb[kb]);
                tacc = __builtin_amdgcn_mfma_scale_f32_16x16x128_f8f6f4(onesv, pv8, tacc, 0, 0, 0, 0x7F7F7F7F, 0, (int)sb[kb]);
            }
            const float inv = __builtin_amdgcn_rcpf(tacc[0]);
            *(u32x2*)(o + ((rb + t0 + qq) * 16 + fr) * 128 + 32 * db + 8 * fq) = (u32x2){pk4_fp8(oe[0] * inv, oo[0] * inv, oe[1] * inv, oo[1] * inv), pk4_fp8(oe[2] * inv, oo[2] * inv, oe[3] * inv, oo[3] * inv)};
        }
        s_cur = s_nxt;
    }
    asm volatile("s_waitcnt vmcnt(0)" ::: "memory");
    __syncthreads();
#undef AT_DMA_SEL
#undef AT_DMA_Q
#undef AT_GATHER
#undef AT_T
}

__global__ void __launch_bounds__(NTHREADS, 2) fwd_kernel(Params P) {
    extern __shared__ __attribute__((aligned(16))) unsigned char lds_raw[];
    Frame F;
    F.lds = (LAS unsigned char*)lds_raw;
    F.G = gridDim.x; F.bx = blockIdx.x; F.batch = F.bx & 7; F.jb = F.bx >> 3; F.ws = P.ws;
    unsigned char* ws = P.ws;
    for (int u = threadIdx.x; u < 256; u += NTHREADS) ((LAS unsigned*)(F.lds + LDS_MISC))[u] = 0u;
    __syncthreads();
    XcdBarrier bar = xcd_barrier_post((unsigned*)(ws + WS_CTL) + CW_BAR, (volatile LAS unsigned*)(F.lds + LDS_MISC));
#define GRID_BAR() xcd_barrier<false>(bar)
#define GRID_BAR_L() xcd_barrier<true>(bar)
    if (threadIdx.x == 0) (void)xb_add((unsigned*)(ws + WS_CTL) + CW_XCC + F.bx, bar.x + 1u);

    bf16_t* zA; bf16_t* zB; float* stA; float* stB;
    const float* ones; const float* zeros;

    p0_prologue(F, P);
    GRID_BAR();
    {
        volatile LAS unsigned* okw = (volatile LAS unsigned*)(F.lds + LDS_MISC) + 3;
        if (threadIdx.x == 0) okw[0] = (F.G == 256) ? 1u : 0u;
        __syncthreads();
        if (threadIdx.x < 256 && (int)threadIdx.x < F.G) { unsigned* tab = (unsigned*)(ws + WS_CTL) + CW_XCC; const unsigned v = xb_ld(tab + threadIdx.x), r = xb_ld(tab + (threadIdx.x & 7)); if (v == 0u || v != r) okw[0] = 0u; }
        __syncthreads();
        if (threadIdx.x == 0) ((volatile LAS unsigned*)(F.lds + LDS_MISC))[2] = okw[0];
        __syncthreads();
    }
    {
        const float* csp = (const float*)(ws + WS_CSP); float* cs = (float*)(ws + WS_CSUP); float* bs = (float*)(ws + WS_BSUP);
        constexpr int NV = 4 * 64 * 512;
        for (int i = F.bx * NTHREADS + (int)threadIdx.x; i < NV; i += F.G * NTHREADS) {
            float a = 0.f, b = 0.f;
#pragma unroll 8
            for (int kt = 0; kt < 16; ++kt) { a += csp[(size_t)kt * NV + i]; b += csp[(size_t)(32 + kt) * NV + i]; }
            cs[i] = a; bs[i] = b;
        }
    }

    for (int layer = 0; layer < DEPTH; ++layer) {
        asm volatile("" : "+s"(ws));
        zA = (bf16_t*)(ws + WS_ZA); zB = (bf16_t*)(ws + WS_ZB); stA = (float*)(ws + WS_STA); stB = (float*)(ws + WS_STB); ones = (const float*)(ws + WS_VEC); zeros = ones + 1024;
        const float* gprev = layer ? P.in[I_L2G] + (layer - 1) * DM : ones;
        const float* bprev = layer ? P.in[I_L2B] + (layer - 1) * DM : zeros;
        const int jl = layer >> 1;
        bool have_part = false;
        if ((layer & 1) == 0) {
            {
                pg8::StaticOrder S; S.init(T_TOK, 3072, F.G, F.bx, zA, DM * 2, (const bf16_t*)(ws + WS_WCI) + (size_t)jl * 3072 * DM, DM * 2);
                EpiConvIn E{stA, (const float*)(ws + WS_CSCI) + jl * 3072, (const float*)(ws + WS_BSCI) + jl * 3072, (bf16_t*)(ws + WS_U), (bf16_t*)(ws + WS_BG), F.lds + LDS_AUX};
                pg8::gemm_phase<EpiConvIn, pg8::StaticOrder, false>(F.lds + LDS_STAGE, DM, DM * 2, DM * 2, S, E);
            }
            GRID_BAR_L();
            conv_phase(F, (const bf16_t*)(ws + WS_U), (const bf16_t*)(ws + WS_BG), P.in[I_CK] + (size_t)jl * 3 * DM, (bf16_t*)(ws + WS_Y));
            GRID_BAR_L();
            {
                pg8::StaticOrder S; S.init(T_TOK, DM, F.G, F.bx, (const bf16_t*)(ws + WS_Y), DM * 2, (const bf16_t*)(ws + WS_WCO) + (size_t)jl * DM * DM, DM * 2);
                EpiRes E{zA, stA, gprev, bprev, zB, (float*)(ws + WS_PART), ws + WS_Z8};
                pg8::gemm_phase<EpiRes, pg8::StaticOrder, false>(F.lds + LDS_STAGE, DM, DM * 2, DM * 2, S, E);
            }
            have_part = true;
            GRID_BAR_L();
        } else {
            {
                pg8::StaticOrder S; S.init(T_TOK, 2048, F.G, F.bx, ws + WS_ZA8, DM, ws + WS_WAI + (size_t)jl * AIWP * DM * 2, DM);
                EpiAttnIn E{stA, (const float*)(ws + WS_CSAI) + jl * AIWP, (const float*)(ws + WS_BSAI) + jl * AIWP, ws + WS_Q, (bf16_t*)(ws + WS_QI), (float*)(ws + WS_MISC), 0, F.lds + LDS_AUX};
                pg8::gemm_phase<EpiAttnIn, pg8::StaticOrder, false, true>(F.lds + LDS_STAGE, DM / 2, DM, DM, S, E);
            }
            {
                pg8::StaticOrder S; S.init(T_TOK, AIWP - 2048, F.G, F.bx, zA, DM * 2, (const bf16_t*)(ws + WS_WAI) + (size_t)jl * AIWP * DM + (size_t)2048 * DM, DM * 2);
                EpiAttnIn E{stA, (const float*)(ws + WS_CSAI) + jl * AIWP, (const float*)(ws + WS_BSAI) + jl * AIWP, ws + WS_Q, (bf16_t*)(ws + WS_QI), (float*)(ws + WS_MISC), 8, F.lds + LDS_AUX + 12288};
                pg8::gemm_phase<EpiAttnIn, pg8::StaticOrder, false>(F.lds + LDS_STAGE, DM, DM * 2, DM * 2, S, E);
            }
            GRID_BAR_L();
            attn_norm_phase(F, (const float*)(ws + WS_MISC), P.in[I_KVG] + jl * KVL, P.in[I_KIG] + jl * IDXD, P.in[I_KIB] + jl * IDXD, ws + WS_CKV, (bf16_t*)(ws + WS_KI));
            GRID_BAR_L();
            index_phase(F, (const bf16_t*)(ws + WS_QI), (const float*)(ws + WS_MISC), (const bf16_t*)(ws + WS_KI), (unsigned short*)(ws + WS_SEL));
            asm volatile("s_waitcnt vmcnt(0)" ::: "memory"); __syncthreads();
            attn_phase(F, ws + WS_Q, ws + WS_CKV, (const unsigned short*)(ws + WS_SEL), P.in[I_RELB], ws + WS_O);
            GRID_BAR_L();
            {
                pg8::StaticOrder S; S.init(T_TOK, DM, F.G, F.bx, ws + WS_O, 2048, ws + WS_WAO + (size_t)jl * DM * 2048, 2048);
                EpiRes E{zA, stA, gprev, bprev, zB, (float*)(ws + WS_PART), ws + WS_Z8};
                pg8::gemm_phase<EpiRes, pg8::StaticOrder, false, true>(F.lds + LDS_STAGE, 2048 / 2, 2048, 2048, S, E, 127 - 6);
            }
            have_part = true;
            GRID_BAR_L();
        }
        const float* partin = have_part ? (const float*)(ws + WS_PART) : nullptr;
        const unsigned char* ym = nullptr;
        {
            unsigned* cnt = (unsigned*)(ws + WS_CTL) + CW_CNT + 64 * layer; unsigned* list = (unsigned*)(ws + WS_LIST); float* gate = (float*)(ws + WS_GATE);
            const bf16_t* wrh = (const bf16_t*)(ws + WS_WR) + (size_t)layer * 32 * 2 * 6 * 512;
            router_phase(F, zB, partin, stB, wrh, (const float*)(ws + WS_CSR) + layer * 96, (const float*)(ws + WS_BSR) + layer * 96, P.in[I_RBG] + layer * 8, P.in[I_RBE] + layer * 64, cnt, list, gate);
            partin = nullptr;
            GRID_BAR();
            {
                unsigned* done = (unsigned*)(ws + WS_CTL) + CW_DONE + 256 * layer;
                moe_build(F, cnt, list, stB, gate);
                {
                    MoeSched<true> S{F.lds + LDS_AUX, (const char*)(ws + WS_Z8), (const char*)(ws + WS_WUP) + (size_t)layer * 64 * 512 * DM, done};
                    EpiUp E{F.lds + LDS_AUX, stB, (const float*)(ws + WS_CSUP) + (size_t)layer * 64 * 512, (const float*)(ws + WS_BSUP) + (size_t)layer * 64 * 512, ws + WS_H, done};
                    pg8::gemm_phase<EpiUp, MoeSched<true>, true, true>(F.lds + LDS_STAGE, DM / 2, DM, DM, S, E);
                }
                {
                    MoeSched<false> S{F.lds + LDS_AUX, (const char*)(ws + WS_H), (const char*)(ws + WS_WDN) + (size_t)layer * 64 * DM * DEXP, done};
                    EpiDown E{F.lds + LDS_AUX, gate, ws + WS_YM};
                    pg8::gemm_phase<EpiDown, MoeSched<false>, false, true>(F.lds + LDS_STAGE, DEXP / 2, DEXP, DEXP, S, E);
                }
            }
            GRID_BAR();
            ym = ws + WS_YM;
        }
        if (layer < DEPTH - 1) combine_phase<false>(F, zB, stB, partin, P.in[I_L1G] + layer * DM, P.in[I_L1B] + layer * DM, ym, zA, stA, nullptr, nullptr, nullptr, (layer & 1) ? nullptr : ws + WS_ZA8);
        else combine_phase<true>(F, zB, stB, partin, P.in[I_L1G] + layer * DM, P.in[I_L1B] + layer * DM, ym, nullptr, nullptr, P.in[I_L2G] + layer * DM, P.in[I_L2B] + layer * DM, P.out, nullptr);
        if (layer < DEPTH - 1) GRID_BAR_L();
    }
}

extern "C" void kernel_launch(void* const* d_in, const int* in_sizes, int n_in, void* d_out, int out_size, void* d_ws, size_t ws_size, hipStream_t stream) {
    static int grid = 0;
    if (!grid) {
        if (n_in != 21 || out_size != T_TOK * DM || ws_size < WS_END) { fprintf(stderr, "kernel_launch: unexpected shapes (n_in %d out %d ws %zu need %zu)\n", n_in, out_size, ws_size, (size_t)WS_END); grid = -1; return; }
        int dev = 0, cus = 0, per_cu = 0;
        hipGetDevice(&dev); hipDeviceGetAttribute(&cus, hipDeviceAttributeMultiprocessorCount, dev);
        if (hipFuncSetAttribute((const void*)fwd_kernel, hipFuncAttributeMaxDynamicSharedMemorySize, LDS_BYTES) != hipSuccess) { fprintf(stderr, "kernel_launch: hipFuncSetAttribute failed\n"); grid = -1; return; }
        hipOccupancyMaxActiveBlocksPerMultiprocessor(&per_cu, (const void*)fwd_kernel, NTHREADS, LDS_BYTES);
        if (per_cu < 1) fprintf(stderr, "kernel_launch: occupancy query reports %d\n", per_cu);
        grid = 256;
        if (cus != 256) fprintf(stderr, "kernel_launch: %d CUs (built for 256)\n", cus);
    }
    if (grid <= 0) return;
    hipMemsetAsync((char*)d_ws + WS_CTL, 0, CTL_BYTES, stream);
    Params p{};
    for (int i = 0; i < 21; ++i) p.in[i] = (const float*)d_in[i];
    p.out = (float*)d_out; p.ws = (unsigned char*)d_ws; p.ph_lo = 0; p.ph_hi = 1000;
    hipLaunchKernelGGL(fwd_kernel, dim3(grid), dim3(NTHREADS), LDS_BYTES, stream, p);
}
```

```cpp
#include <hip/hip_runtime.h>
#include <cstdio>
#include <cstdint>

#define LAS __attribute__((address_space(3)))
#define GAS __attribute__((address_space(1)))
typedef unsigned short bf16_t;
typedef short bf16x8 __attribute__((ext_vector_type(8)));
typedef float f32x4 __attribute__((ext_vector_type(4)));
typedef float f32x2 __attribute__((ext_vector_type(2)));
typedef float f32x16 __attribute__((ext_vector_type(16)));
typedef unsigned u32x4 __attribute__((ext_vector_type(4)));
typedef unsigned u32x2 __attribute__((ext_vector_type(2)));

constexpr int T_TOK = 16384, DM = 1024, NBATCH = 8, SEQ = 2048, DEPTH = 4;
constexpr int NH = 16, KVL = 128, NIH = 8, IDXD = 64, TOPK = 256;
constexpr int AIW = 2760, AIWP = 2816;
constexpr int NGRP = 8, EPG = 8, NEXP = 64, DEXP = 256;
constexpr float LN_EPS = 1e-5f, RMS_EPS = 1e-6f;
constexpr float ALPHA = 1.6817928305074290f;
constexpr int NWAVES = 8, NTHREADS = 512;
constexpr int MAXBLK = 192;

constexpr size_t MiB = 1u << 20;
constexpr size_t alup(size_t x) { return (x + MiB - 1) & ~(MiB - 1); }
constexpr size_t WS_CTL = 0, CTL_BYTES = MiB;
constexpr size_t WS_VEC = WS_CTL + CTL_BYTES;
constexpr size_t WS_CSCI = WS_VEC + MiB;
constexpr size_t WS_BSCI = WS_CSCI + 2 * 3072 * 4;
constexpr size_t WS_CSAI = WS_BSCI + 2 * 3072 * 4;
constexpr size_t WS_BSAI = WS_CSAI + 2 * AIWP * 4;
constexpr size_t WS_CSR  = WS_BSAI + 2 * AIWP * 4;
constexpr size_t WS_BSR  = WS_CSR + 4 * 96 * 4;
constexpr size_t WS_CSUP = alup(WS_BSR + 4 * 96 * 4);
constexpr size_t WS_BSUP = WS_CSUP + (size_t)4 * 64 * 512 * 4;
constexpr size_t WS_WCI  = alup(WS_BSUP + (size_t)4 * 64 * 512 * 4);
constexpr size_t WS_WCO  = WS_WCI + (size_t)2 * 3072 * 1024 * 2;
constexpr size_t WS_WAI  = WS_WCO + (size_t)2 * 1024 * 1024 * 2;
constexpr size_t WS_WAO  = alup(WS_WAI + (size_t)2 * AIWP * 1024 * 2);
constexpr size_t WS_WR   = WS_WAO + (size_t)2 * 1024 * 2048 * 2;
constexpr size_t WS_WUP  = alup(WS_WR + (size_t)4 * 2 * 96 * 1024 * 2);
constexpr size_t WS_WDN  = WS_WUP + (size_t)4 * 64 * 512 * 1024 * 2;
constexpr size_t WS_ZA   = WS_WDN + (size_t)4 * 64 * 1024 * 256 * 2;
constexpr size_t WS_ZB   = WS_ZA + (size_t)T_TOK * DM * 2;
constexpr size_t WS_STA  = WS_ZB + (size_t)T_TOK * DM * 2;
constexpr size_t WS_STB  = WS_STA + (size_t)T_TOK * 8;
constexpr size_t WS_PART = alup(WS_STB + (size_t)T_TOK * 8);
constexpr size_t WS_U    = WS_PART + (size_t)T_TOK * 16 * 8;
constexpr size_t WS_BG   = WS_U + (size_t)T_TOK * DM * 2;
constexpr size_t WS_Y    = WS_BG + (size_t)T_TOK * DM * 2;
constexpr size_t WS_Q    = WS_Y + (size_t)T_TOK * DM * 2;
constexpr size_t WS_QI   = WS_Q + (size_t)T_TOK * 2048 * 2;
constexpr size_t WS_MISC = WS_QI + (size_t)T_TOK * 512 * 2;
constexpr size_t WS_CKV  = WS_MISC + (size_t)T_TOK * 256 * 4;
constexpr size_t WS_KI   = WS_CKV + (size_t)T_TOK * 128 * 2;
constexpr size_t WS_SEL  = WS_KI + (size_t)T_TOK * 64 * 2;
constexpr size_t WS_O    = WS_SEL + (size_t)T_TOK * 256 * 2;
constexpr size_t WS_LIST = WS_O + (size_t)T_TOK * 2048 * 2;
constexpr size_t WS_GATE = WS_LIST + (size_t)64 * 16384 * 4;
constexpr size_t WS_H    = alup(WS_GATE + (size_t)T_TOK * 8);
constexpr size_t WS_YM   = WS_H + (size_t)MAXBLK * 256 * 256 * 2;
constexpr size_t WS_CSP  = WS_YM + (size_t)T_TOK * 2 * DM * 2;
constexpr size_t WS_Z8   = WS_CSP + (size_t)2 * 32 * 4 * 64 * 512 * 4;
constexpr size_t WS_ZA8  = WS_Z8 + (size_t)T_TOK * DM;
constexpr size_t WS_END  = WS_ZA8 + (size_t)T_TOK * DM;

constexpr int CW_BAR = 4096;
constexpr int CW_CNT = 16384;
constexpr int CW_XCC = 8192;
constexpr int CW_QUEUE = 20480;
constexpr int CW_DONE = 24576;

constexpr int LDS_STAGE = 0, STAGE_BYTES_ALL = 131072;
constexpr int LDS_AUX = 131072;
constexpr int LDS_MISC = 131072 + 31744;
constexpr int LDS_BYTES = 163840;

__device__ __forceinline__ unsigned f2bf(float f) { unsigned u = __builtin_bit_cast(unsigned, f); return (u + 0x7fffu + ((u >> 16) & 1u)) >> 16; }
__device__ __forceinline__ float bf2f(unsigned b) { return __builtin_bit_cast(float, b << 16); }
__device__ __forceinline__ unsigned pk2(float lo, float hi) { return f2bf(lo) | (f2bf(hi) << 16); }
__device__ __forceinline__ float bflo(unsigned w) { return __builtin_bit_cast(float, w << 16); }
__device__ __forceinline__ float bfhi(unsigned w) { return __builtin_bit_cast(float, w & 0xffff0000u); }
__device__ __forceinline__ float shx(float v, int o, int lane) { return __builtin_bit_cast(float, __builtin_amdgcn_ds_bpermute((lane ^ o) << 2, __builtin_bit_cast(int, v))); }
__device__ __forceinline__ float dpp_f(float v, const int ctrl_sel) {
    const int x = __builtin_bit_cast(int, v);
    return __builtin_bit_cast(float, ctrl_sel == 0 ? __builtin_amdgcn_update_dpp(x, x, 0xB1, 0xF, 0xF, false)
                                   : ctrl_sel == 1 ? __builtin_amdgcn_update_dpp(x, x, 0x4E, 0xF, 0xF, false)
                                   : ctrl_sel == 2 ? __builtin_amdgcn_update_dpp(x, x, 0x141, 0xF, 0xF, false)
                                                   : __builtin_amdgcn_update_dpp(x, x, 0x140, 0xF, 0xF, false));
}
__device__ __forceinline__ float rows_sum(float v) {
    const unsigned a = __builtin_bit_cast(unsigned, v);
    const auto s16 = __builtin_amdgcn_permlane16_swap(a, a, false, false);
    const float m1 = __builtin_bit_cast(float, (unsigned)s16[0]) + __builtin_bit_cast(float, (unsigned)s16[1]);
    const unsigned b = __builtin_bit_cast(unsigned, m1);
    const auto s32 = __builtin_amdgcn_permlane32_swap(b, b, false, false);
    return __builtin_bit_cast(float, (unsigned)s32[0]) + __builtin_bit_cast(float, (unsigned)s32[1]);
}
__device__ __forceinline__ float wave_sum(float v, int lane) {
    (void)lane;
    v += dpp_f(v, 0); v += dpp_f(v, 1); v += dpp_f(v, 2); v += dpp_f(v, 3);
    return rows_sum(v);
}
__device__ __forceinline__ void st16wt(void* p, const u32x4 v) { asm volatile("global_store_dwordx4 %0, %1, off sc1\n\ts_nop 1" :: "v"(p), "v"(v) : "memory"); }
typedef int i32x8 __attribute__((ext_vector_type(8)));
__device__ __forceinline__ unsigned pk4_fp8(float a, float b, float c, float d) { int w = 0; w = __builtin_amdgcn_cvt_pk_fp8_f32(a, b, w, false); w = __builtin_amdgcn_cvt_pk_fp8_f32(c, d, w, true); return (unsigned)w; }
__device__ __forceinline__ float fp8_rt(float a) { const int w = __builtin_amdgcn_cvt_pk_fp8_f32(a, a, 0, false); return __builtin_amdgcn_cvt_f32_fp8(w, 0); }
__device__ __forceinline__ void st8wt(void* p, const u32x2 v) { __hip_atomic_store((unsigned long long*)p, ((unsigned long long)v.y << 32) | v.x, __ATOMIC_RELAXED, __HIP_MEMORY_SCOPE_AGENT); }
#define LDS_WAIT() asm volatile("s_waitcnt lgkmcnt(0)" ::: "memory")
#define VM_WAIT() asm volatile("s_waitcnt vmcnt(0)" ::: "memory")

#define XB_TMO      128
#define XB_XCNT(j)  (256  + 64 * (j))
#define XB_XSUB(j)  (1280 + 64 * (j))
#define XB_XGEN(j)  (2304 + 64 * (j))
#define XB_TOP      3328
#define XB_TOPGEN   3392
#define XCD_BAR_WORDS 3456
#define XB_SPIN_CAP (1u << 18)

__device__ __forceinline__ unsigned xb_ld(unsigned* p)              { return __hip_atomic_load(p, __ATOMIC_RELAXED, __HIP_MEMORY_SCOPE_AGENT); }
__device__ __forceinline__ unsigned xb_add(unsigned* p, unsigned v) { return __hip_atomic_fetch_add(p, v, __ATOMIC_RELAXED, __HIP_MEMORY_SCOPE_AGENT); }
__device__ __forceinline__ unsigned xb_xcc_id() { return (unsigned)__builtin_amdgcn_s_getreg((3 << 11) | 20) & 0xFu; }
#define XB_SPIN(cond, bar) do { unsigned _sp = 0; while (cond) { __builtin_amdgcn_s_sleep(1); \
    if ((++_sp & 255u) == 0u) { if (xb_ld(&(bar)[XB_TMO])) break; if (_sp > XB_SPIN_CAP) { atomicAdd(&(bar)[XB_TMO], 1u); break; } } } } while (0)

struct XcdBarrier {
    unsigned* bar; unsigned x;
    volatile LAS unsigned* st;
};

__device__ __forceinline__ XcdBarrier xcd_barrier_post(unsigned* bar, volatile LAS unsigned* st) {
    XcdBarrier b; b.bar = bar; b.x = xb_xcc_id(); b.st = st;
    if (threadIdx.x == 0) (void)xb_add(&bar[XB_XCNT(b.x)], 1u);
    return b;
}
__device__ __forceinline__ void xcd_barrier_complete(unsigned* bar, unsigned x, unsigned& nloc, unsigned& nx) {
    const unsigned G = gridDim.x * gridDim.y * gridDim.z;
    unsigned sum, cnt, mine, sp = 0u;
    for (;;) {
        sum = 0u; cnt = 0u; mine = 0u;
#pragma unroll
        for (unsigned j = 0; j < 16; ++j) { const unsigned c = xb_ld(&bar[XB_XCNT(j)]); sum += c; cnt += (c > 0u) ? 1u : 0u; mine = (j == x) ? c : mine; }
        if (sum == G) break;
        __builtin_amdgcn_s_sleep(1);
        if ((++sp & 255u) == 0u) { if (xb_ld(&bar[XB_TMO])) break; if (sp > XB_SPIN_CAP) { atomicAdd(&bar[XB_TMO], 1u); break; } }
    }
    nloc = mine > 0u ? mine : 1u; nx = cnt > 0u ? cnt : 1u;
}

template <bool LOCAL = false>
__device__ __forceinline__ void xcd_barrier(const XcdBarrier& b_in) {
    XcdBarrier b = b_in; asm volatile("" : "+s"(b.bar), "+s"(b.x));
    asm volatile("s_waitcnt vmcnt(0)" ::: "memory");
    __syncthreads();
    if (threadIdx.x == 0) {
        unsigned* bar = b.bar;
        __builtin_amdgcn_s_waitcnt(0);
        unsigned nloc = b.st[0], nx = b.st[1];
        if (nloc == 0u) { xcd_barrier_complete(bar, b.x, nloc, nx); b.st[0] = nloc; b.st[1] = nx; }
        const unsigned old = xb_add(&bar[XB_XSUB(b.x)], 1u);
        const unsigned gen = old / nloc;
        if (old + 1u == (gen + 1u) * nloc) {
          if (!(LOCAL && b.st[2] != 0u)) {
            __builtin_amdgcn_fence(__ATOMIC_RELEASE, "agent");
            asm volatile("s_waitcnt vmcnt(0)" ::: "memory");
            const unsigned og = xb_add(&bar[XB_TOP], 1u);
            const unsigned tg = og / nx;
            if (og + 1u == (tg + 1u) * nx) xb_add(&bar[XB_TOPGEN], 1u);
            else XB_SPIN(xb_ld(&bar[XB_TOPGEN]) == tg, bar);
          }
            __builtin_amdgcn_fence(__ATOMIC_ACQUIRE, "agent");
            xb_add(&bar[XB_XGEN(b.x)], 1u);
            asm volatile("s_waitcnt vmcnt(0)" ::: "memory");
        } else {
            XB_SPIN(xb_ld(&bar[XB_XGEN(b.x)]) == gen, bar);
            __builtin_amdgcn_fence(__ATOMIC_ACQUIRE, "agent");
            asm volatile("s_waitcnt vmcnt(0)" ::: "memory");
        }
    }
    __syncthreads();
}

struct Params { const float* in[21]; float* out; unsigned char* ws; int ph_lo, ph_hi; };
enum { I_X = 0, I_CWIN, I_CK, I_CWOUT, I_AWIN, I_KVG, I_KIG, I_KIB, I_AWOUT, I_RELB, I_RWG, I_RBG, I_RWE, I_RBE, I_W1, I_W3, I_W2, I_L1G, I_L1B, I_L2G, I_L2B };

struct Frame {
    LAS unsigned char* lds;
    int G, bx;
    int batch, jb;
    unsigned char* ws;
};

__device__ __forceinline__ unsigned bf4_to_fp8(const u32x2 w) {
    return pk4_fp8(__builtin_bit_cast(float, w.x << 16), __builtin_bit_cast(float, w.x & 0xffff0000u), __builtin_bit_cast(float, w.y << 16), __builtin_bit_cast(float, w.y & 0xffff0000u));
}
template <bool F8 = false>
__device__ __forceinline__ void prol_item64(const float* W, int K, int ldw, int src0, int nvalid, const float* gk, const float* bk, float colscale,
                                            void* Btv, int ldbt, int n0, float* cs, float* bs, LAS unsigned char* scr, int lane) {
    const int kk = lane >> 4, c4 = lane & 15;
    float csum[4] = {0.f, 0.f, 0.f, 0.f}, bsum[4] = {0.f, 0.f, 0.f, 0.f};
    const bool cv = 4 * c4 < nvalid;
    const unsigned sbase = (unsigned)(size_t)scr;
    const unsigned q4 = (unsigned)(lane & 15) >> 2, p4 = (unsigned)lane & 3u;
    for (int k0 = 0; k0 < K; k0 += 64) {
        f32x4 v[16]; float gv[16], bv[16];
#pragma unroll
        for (int ld = 0; ld < 16; ++ld) { gv[ld] = gk ? gk[k0 + 4 * ld + kk] : 1.f; bv[ld] = bk ? bk[k0 + 4 * ld + kk] : 0.f; }
#pragma unroll
        for (int ld = 0; ld < 16; ++ld) v[ld] = cv ? *(const f32x4*)(W + (size_t)(k0 + 4 * ld + kk) * ldw + src0 + 4 * c4) : (f32x4){0.f, 0.f, 0.f, 0.f};
#pragma unroll
        for (int ld = 0; ld < 16; ++ld) {
            const float g = gv[ld] * colscale, bb = bv[ld] * colscale;
            unsigned h[4];
#pragma unroll
            for (int e = 0; e < 4; ++e) { if constexpr (F8) { const float r = fp8_rt(v[ld][e] * g); h[e] = __builtin_bit_cast(unsigned, r) >> 16; csum[e] += r; } else { h[e] = f2bf(v[ld][e] * g); csum[e] += bf2f(h[e]); } bsum[e] += v[ld][e] * bb; }
            *(LAS u32x2*)(scr + (4 * ld + kk) * 144 + c4 * 8) = (u32x2){h[0] | (h[1] << 16), h[2] | (h[3] << 16)};
        }
        LDS_WAIT(); asm volatile("" ::: "memory");
        u32x2 tr[4][2][2];
#pragma unroll
        for (int nt = 0; nt < 4; ++nt)
#pragma unroll
            for (int ch = 0; ch < 2; ++ch) {
                const unsigned a0 = sbase + (8u * (unsigned)(kk + 4 * ch) + q4) * 144u + (16u * nt + 4u * p4) * 2u, a1 = a0 + 4u * 144u;
                asm volatile("ds_read_b64_tr_b16 %0, %2\n\tds_read_b64_tr_b16 %1, %3" : "=&v"(tr[nt][ch][0]), "=&v"(tr[nt][ch][1]) : "v"(a0), "v"(a1) : "memory");
            }
        asm volatile("s_waitcnt lgkmcnt(0)" : "+v"(tr[0][0][0]), "+v"(tr[0][0][1]), "+v"(tr[0][1][0]), "+v"(tr[0][1][1]), "+v"(tr[1][0][0]), "+v"(tr[1][0][1]), "+v"(tr[1][1][0]), "+v"(tr[1][1][1]),
                     "+v"(tr[2][0][0]), "+v"(tr[2][0][1]), "+v"(tr[2][1][0]), "+v"(tr[2][1][1]), "+v"(tr[3][0][0]), "+v"(tr[3][0][1]), "+v"(tr[3][1][0]), "+v"(tr[3][1][1]) :: "memory");
#pragma unroll
        for (int nt = 0; nt < 4; ++nt)
#pragma unroll
            for (int ch = 0; ch < 2; ++ch) {
                if constexpr (F8) *(u32x2*)((unsigned char*)Btv + (size_t)(n0 + 16 * nt + (lane & 15)) * ldbt + k0 + 8 * (kk + 4 * ch)) = (u32x2){bf4_to_fp8(tr[nt][ch][0]), bf4_to_fp8(tr[nt][ch][1])};
                else { u32x4 o; o.x = tr[nt][ch][0].x; o.y = tr[nt][ch][0].y; o.z = tr[nt][ch][1].x; o.w = tr[nt][ch][1].y;
                    *(u32x4*)((bf16_t*)Btv + (size_t)(n0 + 16 * nt + (lane & 15)) * ldbt + k0 + 8 * (kk + 4 * ch)) = o; }
            }
    }
    if (cs) {
#pragma unroll
        for (int e = 0; e < 4; ++e) { csum[e] = rows_sum(csum[e]); bsum[e] = rows_sum(bsum[e]); }
        if (kk == 0) { *(f32x4*)(cs + n0 + 4 * c4) = (f32x4){csum[0], csum[1], csum[2], csum[3]}; *(f32x4*)(bs + n0 + 4 * c4) = (f32x4){bsum[0], bsum[1], bsum[2], bsum[3]}; }
    }
}

constexpr int PT_TILES = 3 * 4096, PT_GRAN = 2, PT_BUF = 50176;
struct PTile { const float* src; int ldw; unsigned char* bt; int ldbt; int kbase; int rowadd; int up; const float* gk; const float* bk; float* csp; };
__device__ __forceinline__ PTile pt_decode(const Params& P, unsigned char* ws, int T) {
    PTile t;
    if (T < 8192) { const int which = T >> 12, r = T & 4095, le = r >> 4, kt = r & 15, l = le >> 6;
        t.src = (which ? P.in[I_W3] : P.in[I_W1]) + (size_t)le * DM * DEXP + (size_t)kt * 64 * DEXP; t.ldw = DEXP; t.bt = ws + WS_WUP + (size_t)le * 512 * DM; t.ldbt = DM; t.kbase = 64 * kt;
        t.rowadd = 128 * which; t.up = 1; t.gk = P.in[I_L1G] + l * DM + 64 * kt; t.bk = P.in[I_L1B] + l * DM + 64 * kt; t.csp = (float*)(ws + WS_CSP) + ((size_t)kt * 256 + le) * 512;
    } else { const int r = T - 8192, le = r >> 4, kt = (r >> 2) & 3, nq = r & 3;
        t.src = P.in[I_W2] + (size_t)le * DEXP * DM + (size_t)kt * 64 * DM + 256 * nq; t.ldw = DM; t.bt = ws + WS_WDN + (size_t)le * DM * DEXP; t.ldbt = DEXP; t.kbase = 64 * kt;
        t.rowadd = 256 * nq; t.up = 0; t.gk = nullptr; t.bk = nullptr; t.csp = nullptr; }
    return t;
}
__device__ __forceinline__ void p0_expert_tiles(const Frame& F, const Params& P, int tid, int lane, int wave) {
    unsigned char* ws = F.ws;
    volatile LAS int* slot = (volatile LAS int*)(F.lds + LDS_MISC + 64);
    unsigned* qctr = (unsigned*)(ws + WS_CTL) + CW_QUEUE;
    if (tid == 0) { slot[0] = (int)atomicAdd(qctr, (unsigned)PT_GRAN); slot[1] = (int)atomicAdd(qctr, (unsigned)PT_GRAN); }
    __syncthreads();
    int g0 = slot[0], g1 = slot[1], par = 0;
    const unsigned g16 = (unsigned)lane >> 4, q4 = (unsigned)(lane & 15) >> 2, p4 = (unsigned)lane & 3u;
    f32x4 cur[PT_GRAN][8], nxt[PT_GRAN][8];
#define PT_LOAD(T, vv) do { const PTile _t = pt_decode(P, ws, (T)); _Pragma("unroll") for (int i = 0; i < 8; ++i) vv[i] = *(const f32x4*)(_t.src + (size_t)(8 * wave + i) * _t.ldw + 4 * lane); } while (0)
    if (g0 < PT_TILES) {
#pragma unroll
        for (int j = 0; j < PT_GRAN; ++j) PT_LOAD(g0 + j, cur[j]); }
    while (g0 < PT_TILES) {
        if (tid == 0) slot[2 + par] = (int)atomicAdd(qctr, (unsigned)PT_GRAN);
        if (g1 < PT_TILES) {
#pragma unroll
            for (int j = 0; j < PT_GRAN; ++j) PT_LOAD(g1 + j, nxt[j]); }
#pragma unroll
        for (int j = 0; j < PT_GRAN; ++j) {
            const PTile t = pt_decode(P, ws, g0 + j);
            LAS unsigned char* tile = F.lds + (j & 1) * PT_BUF;
            LAS float* part = (LAS float*)(F.lds + (j & 1) * PT_BUF + 33792);
            f32x4 pc = (f32x4){0.f, 0.f, 0.f, 0.f}, pb = (f32x4){0.f, 0.f, 0.f, 0.f};
#pragma unroll
            for (int i = 0; i < 8; ++i) {
                const float gvi = t.up ? t.gk[8 * wave + i] : 1.f, bvi = t.up ? t.bk[8 * wave + i] : 0.f;
                const int w8 = (int)pk4_fp8(cur[j][i][0] * gvi, cur[j][i][1] * gvi, cur[j][i][2] * gvi, cur[j][i][3] * gvi);
                const float r0 = __builtin_amdgcn_cvt_f32_fp8(w8, 0), r1 = __builtin_amdgcn_cvt_f32_fp8(w8, 1), r2 = __builtin_amdgcn_cvt_f32_fp8(w8, 2), r3 = __builtin_amdgcn_cvt_f32_fp8(w8, 3);
                pc[0] += r0; pc[1] += r1; pc[2] += r2; pc[3] += r3;
#pragma unroll
                for (int e = 0; e < 4; ++e) pb[e] += cur[j][i][e] * bvi;
                *(LAS u32x2*)(tile + (8 * wave + i) * 528 + lane * 8) = (u32x2){(__builtin_bit_cast(unsigned, r0) >> 16) | (__builtin_bit_cast(unsigned, r1) & 0xffff0000u),
                                                                                (__builtin_bit_cast(unsigned, r2) >> 16) | (__builtin_bit_cast(unsigned, r3) & 0xffff0000u)};
            }
            if (t.up) { *(LAS f32x4*)(part + wave * 256 + 4 * lane) = pc; *(LAS f32x4*)(part + 2048 + wave * 256 + 4 * lane) = pb; }
            __syncthreads();
            {
                u32x2 tr[2][4];
                const unsigned sbase = (unsigned)(size_t)tile;
#pragma unroll
                for (int jj = 0; jj < 2; ++jj)
#pragma unroll
                    for (int c = 0; c < 4; ++c) {
                        const unsigned a0 = sbase + (16u * g16 + 4u * c + q4) * 528u + (16u * (2 * wave + jj) + 4u * p4) * 2u;
                        asm volatile("ds_read_b64_tr_b16 %0, %1" : "=&v"(tr[jj][c]) : "v"(a0) : "memory");
                    }
                asm volatile("s_waitcnt lgkmcnt(0)" : "+v"(tr[0][0]), "+v"(tr[0][1]), "+v"(tr[0][2]), "+v"(tr[0][3]), "+v"(tr[1][0]), "+v"(tr[1][1]), "+v"(tr[1][2]), "+v"(tr[1][3]) :: "memory");
#pragma unroll
                for (int jj = 0; jj < 2; ++jj) {
                    const int n = 16 * (2 * wave + jj) + (lane & 15);
                    const int brow = t.up ? (n & 127) + 256 * (n >> 7) + t.rowadd : 128 * ((n >> 3) & 1) + 32 * (n >> 6) + 8 * ((n >> 4) & 3) + (n & 7) + t.rowadd;
                    u32x4 o; o.x = bf4_to_fp8(tr[jj][0]); o.y = bf4_to_fp8(tr[jj][1]); o.z = bf4_to_fp8(tr[jj][2]); o.w = bf4_to_fp8(tr[jj][3]);
                    *(u32x4*)(t.bt + (size_t)brow * t.ldbt + t.kbase + 16 * g16) = o;
                }
            }
            if (t.up && tid < 256) {
                float cs = part[tid], bs = part[2048 + tid];
#pragma unroll
                for (int w2 = 1; w2 < 8; ++w2) { cs += part[w2 * 256 + tid]; bs += part[2048 + w2 * 256 + tid]; }
                const int brow = (tid & 127) + 256 * (tid >> 7) + t.rowadd;
                t.csp[brow] = cs; t.csp[(size_t)32 * 4 * 64 * 512 + brow] = bs;
            }
        }
        g0 = g1; g1 = slot[2 + par]; par ^= 1;
#pragma unroll
        for (int j = 0; j < PT_GRAN; ++j)
#pragma unroll
            for (int i = 0; i < 8; ++i) cur[j][i] = nxt[j][i];
    }
    __syncthreads();
#undef PT_LOAD
}

__device__ __forceinline__ void p0_heavy_item(const Params& P, unsigned char* ws, int r, LAS unsigned char* scr, int lane) {
    constexpr int N_AO = 2 * 16 * 2, N_CI = 2 * 48, N_AI = 2 * 44;
    if (r < N_AO) {
        const int jl = r / 32, g = (r % 32) >> 1, kh = r & 1;
        prol_item64<true>(P.in[I_AWOUT] + (size_t)jl * 2048 * DM + (size_t)kh * 1024 * DM, 1024, DM, 64 * g, 64, nullptr, nullptr, 64.f,
                    ws + WS_WAO + (size_t)jl * DM * 2048 + kh * 1024, 2048, 64 * g, nullptr, nullptr, scr, lane);
        return; }
    r -= N_AO;
    if (r < N_CI) {
        const int jl = r / 48, g = r % 48, n0 = 64 * g;
        int src;
        if (n0 < 2048) { const int p = n0 >> 8, half = (n0 >> 7) & 1; src = (half ? 2048 : 1024) + 128 * p + (n0 & 127); } else src = n0 - 2048;
        const float* gk = jl ? P.in[I_L2G] + (2 * jl - 1) * DM : nullptr; const float* bk = jl ? P.in[I_L2B] + (2 * jl - 1) * DM : nullptr;
        prol_item64(P.in[I_CWIN] + (size_t)jl * DM * 3072, DM, 3072, src, 64, gk, bk, 1.f, (bf16_t*)(ws + WS_WCI) + (size_t)jl * 3072 * DM, DM, n0,
                    (float*)(ws + WS_CSCI) + jl * 3072, (float*)(ws + WS_BSCI) + jl * 3072, scr, lane);
        return; }
    r -= N_CI;
    if (r < N_AI) {
        const int jl = r / 44, g = r % 44, n0 = 64 * g;
        int src, nvalid = 64; float sc = 1.f;
        if (n0 < 2048) { src = n0; sc = 0.08838834764831845f; }
        else if (n0 < 2176) src = n0;
        else if (n0 < 2240) src = 2688;
        else if (n0 < 2304) { src = 2752; nvalid = 8; sc = 0.35355339059327373f; }
        else { src = 2176 + (n0 - 2304); sc = 0.125f; }
        if (n0 < 2048)
            prol_item64<true>(P.in[I_AWIN] + (size_t)jl * DM * AIW, DM, AIW, src, nvalid, P.in[I_L2G] + (2 * jl) * DM, P.in[I_L2B] + (2 * jl) * DM, 1.f,
                    ws + WS_WAI + (size_t)jl * AIWP * DM * 2, DM, n0, (float*)(ws + WS_CSAI) + jl * AIWP, (float*)(ws + WS_BSAI) + jl * AIWP, scr, lane);
        else
            prol_item64(P.in[I_AWIN] + (size_t)jl * DM * AIW, DM, AIW, src, nvalid, P.in[I_L2G] + (2 * jl) * DM, P.in[I_L2B] + (2 * jl) * DM, sc,
                    (bf16_t*)(ws + WS_WAI) + (size_t)jl * AIWP * DM, DM, n0, (float*)(ws + WS_CSAI) + jl * AIWP, (float*)(ws + WS_BSAI) + jl * AIWP, scr, lane);
        return; }
    r -= N_AI;
    {
        const int jl = r / 16, g = r % 16;
        prol_item64(P.in[I_CWOUT] + (size_t)jl * DM * DM, DM, DM, 64 * g, 64, nullptr, nullptr, 1.f, (bf16_t*)(ws + WS_WCO) + (size_t)jl * DM * DM, DM, 64 * g, nullptr, nullptr, scr, lane);
    }
}

__device__ __forceinline__ void p0_prologue(const Frame& F, const Params& P) {
    int tid = threadIdx.x; asm volatile("" : "+v"(tid)); const int lane = tid & 63, wave = __builtin_amdgcn_readfirstlane(tid >> 6);
    LAS unsigned char* scr = F.lds + LDS_STAGE + wave * 16896;
    const int gw = F.bx * NWAVES + wave, NGW = F.G * NWAVES;
    unsigned char* ws = F.ws;
    constexpr int N_DENSE = 2 * 16 * 2 + 2 * 48 + 2 * 44 + 2 * 16;
    if (gw < N_DENSE) p0_heavy_item(P, ws, gw, scr, lane);
    __syncthreads();
    p0_expert_tiles(F, P, tid, lane, wave);
    if (gw < 4 * 96) {
        const int l = gw / 96, n = gw % 96;
        const int ks = lane >> 1, fq0 = 2 * (lane & 1), nt = n >> 4;
        bf16_t* hi = (bf16_t*)(ws + WS_WR) + ((((size_t)(l * 32 + ks) * 2 + 0) * 6 + nt) * 64 + (n & 15) + 16 * fq0) * 8; bf16_t* lo = hi + (size_t)6 * 64 * 8;
        float csum = 0.f, bsum = 0.f; unsigned hw[8], lw[8];
        if (n < 72) {
            const float* Wc = n < 8 ? P.in[I_RWG] + (size_t)l * DM * 8 + n : P.in[I_RWE] + (size_t)l * DM * 64 + (n - 8); const int ldw = n < 8 ? 8 : 64;
            float w[16], g[16], b[16];
#pragma unroll
            for (int i = 0; i < 16; ++i) w[i] = Wc[(size_t)(16 * lane + i) * ldw];
#pragma unroll
            for (int i = 0; i < 4; ++i) { const f32x4 g4 = *(const f32x4*)(P.in[I_L1G] + l * DM + 16 * lane + 4 * i), b4 = *(const f32x4*)(P.in[I_L1B] + l * DM + 16 * lane + 4 * i);
#pragma unroll
                for (int e = 0; e < 4; ++e) { g[4 * i + e] = g4[e]; b[4 * i + e] = b4[e]; } }
            unsigned hb[16], lb[16];
#pragma unroll
            for (int i = 0; i < 16; ++i) { const float wf = w[i] * g[i]; hb[i] = f2bf(wf); const float h = bf2f(hb[i]); lb[i] = f2bf(wf - h); csum += h + bf2f(lb[i]); bsum += w[i] * b[i]; }
#pragma unroll
            for (int i = 0; i < 8; ++i) { hw[i] = hb[2 * i] | (hb[2 * i + 1] << 16); lw[i] = lb[2 * i] | (lb[2 * i + 1] << 16); }
        } else {
#pragma unroll
            for (int i = 0; i < 8; ++i) { hw[i] = 0u; lw[i] = 0u; }
        }
        *(u32x4*)hi = (u32x4){hw[0], hw[1], hw[2], hw[3]}; *(u32x4*)(hi + 16 * 8) = (u32x4){hw[4], hw[5], hw[6], hw[7]};
        *(u32x4*)lo = (u32x4){lw[0], lw[1], lw[2], lw[3]}; *(u32x4*)(lo + 16 * 8) = (u32x4){lw[4], lw[5], lw[6], lw[7]};
        csum = wave_sum(csum, lane); bsum = wave_sum(bsum, lane);
        if (lane == 0) { ((float*)(ws + WS_CSR))[l * 96 + n] = csum; ((float*)(ws + WS_BSR))[l * 96 + n] = bsum; }
    }
    for (int m0 = gw; m0 < T_TOK; m0 += 4 * NGW) {
        f32x4 xv[4][4];
#pragma unroll
        for (int r = 0; r < 4; ++r) { const GAS f32x4* xr = (const GAS f32x4*)(P.in[I_X] + (size_t)(m0 + r * NGW) * DM) + lane;
#pragma unroll
            for (int q = 0; q < 4; ++q) xv[r][q] = xr[64 * q]; }
#pragma unroll
        for (int r = 0; r < 4; ++r) { const int m = m0 + r * NGW;
            GAS u32x2* o = (GAS u32x2*)((bf16_t*)(ws + WS_ZA) + (size_t)m * DM) + lane;
#pragma unroll
            for (int q = 0; q < 4; ++q) { const f32x4 v = xv[r][q]; u32x2 w; w.x = pk2(v.x, v.y); w.y = pk2(v.z, v.w); o[64 * q] = w; }
            if (lane == 0) { float* st = (float*)(ws + WS_STA) + 2 * m; st[0] = 0.f; st[1] = 1.f; } }
    }
    if (F.bx == 0) { float* v = (float*)(ws + WS_VEC); for (int i = tid; i < 2048; i += NTHREADS) v[i] = i < 1024 ? 1.f : 0.f; }
}

__device__ __forceinline__ f32x2 stats_from_part(const float* part, int row);
template <bool FINAL>
__device__ __forceinline__ void combine_phase(const Frame& F, const bf16_t* zin, const float* stin, const float* partin, const float* g, const float* b, const unsigned char* y,
                                              bf16_t* zout, float* stout, const float* gout, const float* bout, float* out, unsigned char* z8out) {
    int tid = threadIdx.x; asm volatile("" : "+v"(tid)); const int lane = tid & 63, wave = __builtin_amdgcn_readfirstlane(tid >> 6); (void)lane; (void)wave;
    const int row0 = 2048 * F.batch + 64 * F.jb + 8 * wave;
    const int c0 = 8 * lane;
    float gv[2][8], bv[2][8];
#pragma unroll
    for (int j2 = 0; j2 < 2; ++j2) {
        const f32x4 g0 = *(const f32x4*)(g + c0 + 512 * j2), g1 = *(const f32x4*)(g + c0 + 512 * j2 + 4), b0 = *(const f32x4*)(b + c0 + 512 * j2), b1 = *(const f32x4*)(b + c0 + 512 * j2 + 4);
#pragma unroll
        for (int e = 0; e < 4; ++e) { gv[j2][e] = g0[e]; gv[j2][4 + e] = g1[e]; bv[j2][e] = b0[e]; bv[j2][4 + e] = b1[e]; }
    }
    for (int r2 = 0; r2 < 8; r2 += 8) {
      u32x4 zws[8][2]; u32x2 yws[8][2][2]; f32x2 sts[8];
#pragma unroll
      for (int rr = 0; rr < 8; ++rr) { const int row = row0 + r2 + rr;
          sts[rr] = partin ? stats_from_part(partin, row) : *(const f32x2*)(stin + 2 * row);
#pragma unroll
          for (int j2 = 0; j2 < 2; ++j2) { zws[rr][j2] = *(const u32x4*)(zin + (size_t)row * DM + c0 + 512 * j2);
              if (y) {
#pragma unroll
                  for (int sl = 0; sl < 2; ++sl) yws[rr][j2][sl] = *(const u32x2*)(y + ((size_t)row * 2 + sl) * DM + c0 + 512 * j2); } } }
#pragma unroll
      for (int rr = 0; rr < 8; ++rr) {
        const int row = row0 + r2 + rr;
        const f32x2 st = sts[rr];
        float v[2][8]; float s = 0.f;
#pragma unroll
        for (int j2 = 0; j2 < 2; ++j2) {
            const u32x4 zw = zws[rr][j2];
            float z[8] = {bflo(zw.x), bfhi(zw.x), bflo(zw.y), bfhi(zw.y), bflo(zw.z), bfhi(zw.z), bflo(zw.w), bfhi(zw.w)};
            float acc[8];
#pragma unroll
            for (int e = 0; e < 8; ++e) acc[e] = ALPHA * ((z[e] - st.x) * st.y * gv[j2][e] + bv[j2][e]);
            if (y) {
#pragma unroll
                for (int sl = 0; sl < 2; ++sl) {
                    const u32x2 yw = yws[rr][j2][sl];
                    acc[0] += 0.0625f * __builtin_amdgcn_cvt_f32_fp8((int)yw.x, 0); acc[1] += 0.0625f * __builtin_amdgcn_cvt_f32_fp8((int)yw.x, 1); acc[2] += 0.0625f * __builtin_amdgcn_cvt_f32_fp8((int)yw.x, 2); acc[3] += 0.0625f * __builtin_amdgcn_cvt_f32_fp8((int)yw.x, 3);
                    acc[4] += 0.0625f * __builtin_amdgcn_cvt_f32_fp8((int)yw.y, 0); acc[5] += 0.0625f * __builtin_amdgcn_cvt_f32_fp8((int)yw.y, 1); acc[6] += 0.0625f * __builtin_amdgcn_cvt_f32_fp8((int)yw.y, 2); acc[7] += 0.0625f * __builtin_amdgcn_cvt_f32_fp8((int)yw.y, 3);
                }
            }
            if (!FINAL) {
#pragma unroll
                for (int e = 0; e < 8; ++e) acc[e] = bf2f(f2bf(acc[e]));
            }
#pragma unroll
            for (int e = 0; e < 8; ++e) { v[j2][e] = acc[e]; s += acc[e]; }
        }
        const float mean = wave_sum(s, lane) * (1.f / DM);
        float s2 = 0.f;
#pragma unroll
        for (int j2 = 0; j2 < 2; ++j2)
#pragma unroll
            for (int e = 0; e < 8; ++e) { const float d = v[j2][e] - mean; s2 += d * d; }
        const float rstd = 1.f / sqrtf(wave_sum(s2, lane) * (1.f / DM) + LN_EPS);
        if (!FINAL) {
#pragma unroll
            for (int j2 = 0; j2 < 2; ++j2) {
                u32x4 o; o.x = pk2(v[j2][0], v[j2][1]); o.y = pk2(v[j2][2], v[j2][3]); o.z = pk2(v[j2][4], v[j2][5]); o.w = pk2(v[j2][6], v[j2][7]);
                *(u32x4*)(zout + (size_t)row * DM + c0 + 512 * j2) = o;
                if (z8out) *(u32x2*)(z8out + (size_t)row * DM + c0 + 512 * j2) = (u32x2){pk4_fp8(v[j2][0], v[j2][1], v[j2][2], v[j2][3]), pk4_fp8(v[j2][4], v[j2][5], v[j2][6], v[j2][7])};
            }
            if (lane == 0) { *(f32x2*)(stout + 2 * row) = (f32x2){mean, rstd}; }
        } else {
#pragma unroll
            for (int j2 = 0; j2 < 2; ++j2) {
                const f32x4 g0 = *(const f32x4*)(gout + c0 + 512 * j2), g1 = *(const f32x4*)(gout + c0 + 512 * j2 + 4), b0 = *(const f32x4*)(bout + c0 + 512 * j2), b1 = *(const f32x4*)(bout + c0 + 512 * j2 + 4);
                f32x4 o0, o1;
#pragma unroll
                for (int e = 0; e < 4; ++e) { o0[e] = (v[j2][e] - mean) * rstd * g0[e] + b0[e]; o1[e] = (v[j2][4 + e] - mean) * rstd * g1[e] + b1[e]; }
                *(f32x4*)(out + (size_t)row * DM + c0 + 512 * j2) = o0; *(f32x4*)(out + (size_t)row * DM + c0 + 512 * j2 + 4) = o1;
            }
        }
      }
    }
}

namespace pg8 {
constexpr int BM = 256, BK = 64, HALF = 128, HTB = HALF * BK * 2, STAGE_BYTES = 8 * HTB, NXCD = 8, WGM = 8;
__host__ __device__ __forceinline__ int lds_byte(int r, int c) { const int st = (r >> 4) * 2 + (c >> 5), rr = r & 15, cc = c & 31, ob = rr * 64 + cc * 2; return st * 1024 + (ob ^ (((ob >> 9) & 1) << 5)); }
__host__ __device__ __forceinline__ void stage_rc(int b, int& R, int& C) { const int st = b / 1024, sb = b % 1024, swz = sb ^ (((sb >> 9) & 1) << 5); R = (st >> 1) * 16 + swz / 64; C = (st & 1) * 32 + (swz % 64) / 2; }
__host__ __device__ __forceinline__ int perm32(int rho) { const int n = rho >> 4, i = rho & 15; return 8 * (i >> 2) + 4 * n + (i & 3); }

struct Unit { const char* A; const char* B; int pm, pn, x0, x1; };

struct StaticOrder {
    int nM, nN, nwg, G, c; const char* A; const char* B; size_t astep, bstep;
    __device__ void init(int M, int N, int G_, int c_, const void* A_, size_t lda_bytes, const void* B_, size_t ldb_bytes) { nM = M / BM; nN = N / BM; nwg = nM * nN; G = G_; c = c_; A = (const char*)A_; B = (const char*)B_; astep = lda_bytes * BM; bstep = ldb_bytes * BM; }
    __device__ bool next(int i, Unit& u) const {
        const long L = (long)i * G + c; if (L >= nwg) return false;
        int wgid = (int)L; { const int q = nwg / NXCD, r = nwg % NXCD, xcd = wgid % NXCD, off = wgid / NXCD; wgid = (xcd < r ? xcd * (q + 1) : r * (q + 1) + (xcd - r) * q) + off; }
        const int nig = WGM * nN, gid = wgid / nig, fm = gid * WGM, gsz = (nM - fm) < WGM ? (nM - fm) : WGM;
        u.pm = fm + ((wgid % nig) % gsz); u.pn = (wgid % nig) / gsz; u.A = A + (size_t)u.pm * astep; u.B = B + (size_t)u.pn * bstep; u.x0 = 0; u.x1 = 0; return true;
    }
    __device__ __forceinline__ const LAS unsigned* rowoff(int) const { return nullptr; }
    __device__ __forceinline__ void a_ready(const Unit&) const {}
};

__device__ __forceinline__ unsigned cvt_pk_bf16(float lo, float hi) { unsigned r; asm volatile("v_cvt_pk_bf16_f32 %0, %1, %2" : "=v"(r) : "v"(lo), "v"(hi)); return r; }

template <class Epi, class Sched, bool GATHER, bool FP8 = false>
__device__ __forceinline__ void gemm_phase(LAS unsigned char* lds, const int K, const unsigned lda_bytes, const unsigned ldb_bytes, const Sched& S, const Epi& E, const int b_e8m0 = 127) {
    int tid = threadIdx.x; asm volatile("" : "+v"(tid));
    const int wid = __builtin_amdgcn_readfirstlane(tid >> 6), lane = tid & 63, wr = wid >> 2, wc = wid & 3, fr = lane & 15, fq = lane >> 4;
    int nt = K / BK; asm volatile("" : "+s"(nt));
    unsigned voffA[2], voffB[2];
#pragma unroll
    for (int i = 0; i < 2; ++i) { int R, C; stage_rc(tid * 16 + i * 8192, R, C); const int Rb = (R & ~31) + perm32(R & 31);
        voffA[i] = (unsigned)R * lda_bytes + (unsigned)C * 2u; voffB[i] = (unsigned)Rb * ldb_bytes + (unsigned)C * 2u; }
#define PG8_GOFF(dst, ro) do { int _t = threadIdx.x; asm volatile("" : "+v"(_t)); _Pragma("unroll") for (int _i = 0; _i < 2; ++_i) { int _R, _C; stage_rc(_t * 16 + _i * 8192, _R, _C); \
        _Pragma("unroll") for (int _h = 0; _h < 2; ++_h) dst[_h][_i] = (ro)[_h * HALF + _R] + (unsigned)_C * 2u; } } while (0)
    const size_t kstep = (size_t)(BK * 2);
    const size_t hstepA = (size_t)HALF * lda_bytes, hstepB = (size_t)HALF * ldb_bytes;
    const unsigned ldsw = (unsigned)wid * 1024u;
    const int aoff = lds_byte(wr * 64 + fr, fq * 8), boff = lds_byte(wc * 32 + fr, fq * 8);
#define PG8_SA(b, h) (((b) * 2 + (h)) * HTB)
#define PG8_SB(b, h) ((4 + (b) * 2 + (h)) * HTB)
#define PG8_GLDS(src, bufoff, i) __builtin_amdgcn_global_load_lds((const unsigned*)(src), (LAS unsigned*)(lds + (bufoff) + ldsw + (i) * 8192), 16, 0, 0)
#define PG8_STAGE_B(bufoff, gbase) do { _Pragma("unroll") for (int _i = 0; _i < 2; ++_i) PG8_GLDS((const char*)(gbase) + voffB[_i], bufoff, _i); } while (0)
#define PG8_STAGE_A(bufoff, gbase, h, GO) do { _Pragma("unroll") for (int _i = 0; _i < 2; ++_i) { \
        if constexpr (GATHER) PG8_GLDS((const char*)(gbase) + (GO)[h][_i], bufoff, _i); else PG8_GLDS((const char*)(gbase) + (h) * hstepA + voffA[_i], bufoff, _i); } } while (0)
#define PG8_LDA(dst, b, h) do { _Pragma("unroll") for (int m = 0; m < 4; ++m) _Pragma("unroll") for (int k = 0; k < 2; ++k) dst[m][k] = *(const LAS bf16x8*)(lds + PG8_SA(b, h) + aoff + m * 2048 + k * 1024); } while (0)
#define PG8_LDB(dst, b, h) do { _Pragma("unroll") for (int n = 0; n < 2; ++n) _Pragma("unroll") for (int k = 0; k < 2; ++k) dst[n][k] = *(const LAS bf16x8*)(lds + PG8_SB(b, h) + boff + n * 2048 + k * 1024); } while (0)
#define PG8_MMA(ai, bj, At, Bt) do { __builtin_amdgcn_s_setprio(1); _Pragma("unroll") for (int m = 0; m < 4; ++m) _Pragma("unroll") for (int n = 0; n < 2; ++n) { \
        if constexpr (FP8) { const u32x4 b0 = __builtin_bit_cast(u32x4, Bt[n][0]), b1 = __builtin_bit_cast(u32x4, Bt[n][1]), a0 = __builtin_bit_cast(u32x4, At[m][0]), a1 = __builtin_bit_cast(u32x4, At[m][1]); \
            const i32x8 vb = {(int)b0.x, (int)b0.y, (int)b0.z, (int)b0.w, (int)b1.x, (int)b1.y, (int)b1.z, (int)b1.w}, va = {(int)a0.x, (int)a0.y, (int)a0.z, (int)a0.w, (int)a1.x, (int)a1.y, (int)a1.z, (int)a1.w}; \
            asm volatile("v_mfma_scale_f32_16x16x128_f8f6f4 %0, %1, %2, %0, %3, %4 op_sel_hi:[0,0,0]" : "+v"(acc[ai][bj][m][n]) : "v"(vb), "v"(va), "v"(fp8_bscale), "v"(fp8_scale)); } \
        else { _Pragma("unroll") for (int k = 0; k < 2; ++k) acc[ai][bj][m][n] = __builtin_amdgcn_mfma_f32_16x16x32_bf16(Bt[n][k], At[m][k], acc[ai][bj][m][n], 0, 0, 0); } } \
        __builtin_amdgcn_s_setprio(0); } while (0)
#define PG8_WAIT_V(n) asm volatile("s_waitcnt vmcnt(" #n ")" ::: "memory")
#define PG8_WAIT_L(n) asm volatile("s_waitcnt lgkmcnt(" #n ")" ::: "memory")
#define PG8_BAR __builtin_amdgcn_s_barrier()
#define PG8_SCHED __builtin_amdgcn_sched_barrier(0)
    Unit cur, nxt; int ui = 0;
    if (!S.next(0, cur)) return;
    int fp8_scale = 0x7F7F7F7F; asm volatile("" : "+v"(fp8_scale));
    int fp8_bscale = b_e8m0 * 0x01010101; asm volatile("" : "+v"(fp8_bscale));
    (void)fp8_scale; (void)fp8_bscale;
    f32x4 acc[2][2][4][2];
#pragma unroll
    for (int a = 0; a < 2; ++a)
#pragma unroll
        for (int b = 0; b < 2; ++b)
#pragma unroll
            for (int m = 0; m < 4; ++m)
#pragma unroll
                for (int n = 0; n < 2; ++n) acc[a][b][m][n] = (f32x4){0.f, 0.f, 0.f, 0.f};
    bf16x8 At[4][2], B0[2][2], B1[2][2];
    unsigned cG[2][2] = {{0u, 0u}, {0u, 0u}};
    if constexpr (GATHER) { const LAS unsigned* ro = S.rowoff(0); PG8_GOFF(cG, ro); }
    const char* cA = cur.A; const char* cB = cur.B;
    int eslot = 0;
    E.prefetch(cur, 0, wid, lane);
    S.a_ready(cur);
    PG8_STAGE_B(PG8_SB(0, 0), cB); PG8_STAGE_B(PG8_SB(0, 1), cB + hstepB); PG8_STAGE_A(PG8_SA(0, 0), cA, 0, cG); PG8_STAGE_A(PG8_SA(0, 1), cA, 1, cG);
    if (wr == 1) PG8_BAR;
    PG8_WAIT_V(2); PG8_BAR;
    PG8_STAGE_B(PG8_SB(1, 0), cB + kstep); PG8_STAGE_A(PG8_SA(1, 0), cA + kstep, 0, cG); PG8_STAGE_B(PG8_SB(1, 1), cB + hstepB + kstep);
    PG8_WAIT_V(6); PG8_BAR;
    for (;;) {
        const bool has_next = S.next(ui + 1, nxt);
        const int nslot = eslot == 2 ? 0 : eslot + 1;
        if (has_next) E.prefetch(nxt, nslot, wid, lane);
        const char* nA = has_next ? nxt.A : cA; const char* nB = has_next ? nxt.B : cB;
        for (int t = 0; t < nt; t += 2) {
            const bool last = (t == nt - 2);
            if (last && has_next) S.a_ready(nxt);
            const char* a1 = cA + (size_t)(t + 1) * kstep;
            const char* a2 = last ? nA : cA + (size_t)(t + 2) * kstep; const char* b2 = last ? nB : cB + (size_t)(t + 2) * kstep;
            const char* a3 = a2 + kstep; const char* b3 = b2 + kstep;
            unsigned g2[2][2] = {{0u, 0u}, {0u, 0u}};
            if constexpr (GATHER) { const LAS unsigned* ro = S.rowoff((last && has_next) ? ui + 1 : ui); PG8_GOFF(g2, ro); }
            PG8_LDB(B0, 0, 0); PG8_LDB(B1, 0, 1); PG8_SCHED; PG8_LDA(At, 0, 0); PG8_STAGE_A(PG8_SA(1, 1), a1, 1, cG);
            PG8_WAIT_V(8); PG8_WAIT_L(0); PG8_BAR; PG8_MMA(0, 0, At, B0); PG8_MMA(0, 1, At, B1); PG8_BAR; PG8_SCHED;
            PG8_LDA(At, 0, 1); PG8_STAGE_B(PG8_SB(0, 0), b2); PG8_STAGE_B(PG8_SB(0, 1), b2 + hstepB); PG8_STAGE_A(PG8_SA(0, 0), a2, 0, g2);
            PG8_WAIT_V(8); PG8_WAIT_L(0); PG8_BAR; PG8_MMA(1, 0, At, B0); PG8_MMA(1, 1, At, B1); PG8_BAR; PG8_SCHED;
            PG8_LDB(B0, 1, 0); PG8_LDB(B1, 1, 1); PG8_SCHED; PG8_LDA(At, 1, 0); PG8_STAGE_A(PG8_SA(0, 1), a2, 1, g2);
            PG8_WAIT_V(8); PG8_WAIT_L(0); PG8_BAR; PG8_MMA(0, 0, At, B0); PG8_MMA(0, 1, At, B1); PG8_BAR; PG8_SCHED;
            PG8_LDA(At, 1, 1); PG8_STAGE_B(PG8_SB(1, 0), b3); PG8_STAGE_B(PG8_SB(1, 1), b3 + hstepB); PG8_STAGE_A(PG8_SA(1, 0), a3, 0, g2);
            PG8_WAIT_V(8); PG8_WAIT_L(0); PG8_BAR; PG8_MMA(1, 0, At, B0); PG8_MMA(1, 1, At, B1); PG8_BAR; PG8_SCHED;
        }
        if constexpr (FP8) asm volatile("s_nop 15\n\ts_nop 15\n\ts_nop 7" ::: "memory");
        if (wr == 0) PG8_BAR;
        E(acc, cur, ui, wr, wc, fr, fq, eslot);
        if (!has_next) break;
#pragma unroll
        for (int a = 0; a < 2; ++a)
#pragma unroll
            for (int b = 0; b < 2; ++b)
#pragma unroll
                for (int m = 0; m < 4; ++m)
#pragma unroll
                    for (int n = 0; n < 2; ++n) acc[a][b][m][n] = (f32x4){0.f, 0.f, 0.f, 0.f};
        cur = nxt; cA = nA; cB = nB; ++ui; eslot = nslot;
        if constexpr (GATHER) { const LAS unsigned* ro = S.rowoff(ui); PG8_GOFF(cG, ro); }
        if (wr == 1) PG8_BAR;
    }
    PG8_WAIT_V(0);
    PG8_BAR;
#undef PG8_SA
#undef PG8_SB
#undef PG8_GLDS
#undef PG8_GOFF
#undef PG8_STAGE_A
#undef PG8_STAGE_B
#undef PG8_LDA
#undef PG8_LDB
#undef PG8_MMA
#undef PG8_WAIT_V
#undef PG8_WAIT_L
#undef PG8_BAR
#undef PG8_SCHED
}
}

__device__ __forceinline__ void ld8(const float* p, float (&v)[8]) { const f32x4 a = *(const f32x4*)p, b = *(const f32x4*)(p + 4); v[0] = a.x; v[1] = a.y; v[2] = a.z; v[3] = a.w; v[4] = b.x; v[5] = b.y; v[6] = b.z; v[7] = b.w; }
__device__ __forceinline__ void unpack8(const u32x4 w, float (&v)[8]) { v[0] = bflo(w.x); v[1] = bfhi(w.x); v[2] = bflo(w.y); v[3] = bfhi(w.y); v[4] = bflo(w.z); v[5] = bfhi(w.z); v[6] = bflo(w.w); v[7] = bfhi(w.w); }
__device__ __forceinline__ u32x4 pack8(const float (&v)[8]) { u32x4 o; o.x = pg8::cvt_pk_bf16(v[0], v[1]); o.y = pg8::cvt_pk_bf16(v[2], v[3]); o.z = pg8::cvt_pk_bf16(v[4], v[5]); o.w = pg8::cvt_pk_bf16(v[6], v[7]); return o; }

__device__ __forceinline__ void ld8l(const LAS float* p, float (&v)[8]) { const f32x4 a = *(const LAS f32x4*)p, b = *(const LAS f32x4*)(p + 4); v[0] = a.x; v[1] = a.y; v[2] = a.z; v[3] = a.w; v[4] = b.x; v[5] = b.y; v[6] = b.z; v[7] = b.w; }
__device__ __forceinline__ void epi_prefetch(LAS unsigned char* dst, const float* st256, const float* cs256, const float* bs256, int wid, int lane) {
    if (wid < 4) { const char* src = wid < 2 ? (const char*)st256 + wid * 1024 : (wid == 2 ? (const char*)cs256 : (const char*)bs256); int t = threadIdx.x; asm volatile("" : "+v"(t)); (void)lane;
        __builtin_amdgcn_global_load_lds((const unsigned*)(src + (t & 63) * 16), (LAS unsigned*)(dst + wid * 1024), 16, 0, 0); }
}
struct EpiConvIn {
    const float* st; const float* cs; const float* bs; bf16_t* u; bf16_t* bg; LAS unsigned char* aux;
    __device__ __forceinline__ void prefetch(const pg8::Unit& un, int slot, int wid, int lane) const { epi_prefetch(aux + slot * 4096, st + 2 * 256 * un.pm, cs + 256 * un.pn, bs + 256 * un.pn, wid, lane); }
    __device__ __forceinline__ void operator()(const f32x4 (&acc)[2][2][4][2], const pg8::Unit& un, int, int wr, int wc, int fr, int fq, int slot) const {
        const int colL = 32 * wc + 8 * fq;
        const LAS unsigned char* ep = aux + slot * 4096;
        float csv[2][8], bsv[2][8];
        ld8l((const LAS float*)(ep + 2048) + colL, csv[0]); ld8l((const LAS float*)(ep + 2048) + colL + 128, csv[1]); ld8l((const LAS float*)(ep + 3072) + colL, bsv[0]); ld8l((const LAS float*)(ep + 3072) + colL + 128, bsv[1]);
        f32x2 sv[2][4];
#pragma unroll
        for (int ai = 0; ai < 2; ++ai)
#pragma unroll
            for (int m = 0; m < 4; ++m) sv[ai][m] = ((const LAS f32x2*)ep)[128 * ai + 64 * wr + 16 * m + fr];
#pragma unroll
        for (int ai = 0; ai < 2; ++ai)
#pragma unroll
            for (int m = 0; m < 4; ++m) {
                const int row = 256 * un.pm + 128 * ai + 64 * wr + 16 * m + fr;
                const f32x2 s = sv[ai][m];
                float f[2][8];
#pragma unroll
                for (int bj = 0; bj < 2; ++bj)
#pragma unroll
                    for (int e = 0; e < 8; ++e) f[bj][e] = s.y * (acc[ai][bj][m][e >> 2][e & 3] - s.x * csv[bj][e]) + bsv[bj][e];
                if (un.pn < 8) {
                    float p[8];
#pragma unroll
                    for (int e = 0; e < 8; ++e) p[e] = f[0][e] * f[1][e];
                    *(u32x4*)(u + (size_t)row * DM + 128 * un.pn + colL) = pack8(p);
                } else {
                    *(u32x4*)(bg + (size_t)row * DM + 256 * (un.pn - 8) + colL) = pack8(f[0]);
                    *(u32x4*)(bg + (size_t)row * DM + 256 * (un.pn - 8) + 128 + colL) = pack8(f[1]);
                }
            }
    }
};

struct EpiRes {
    const bf16_t* zprev; const float* stprev; const float* gprev; const float* bprev; bf16_t* zout; float* part; unsigned char* z8;
    __device__ __forceinline__ void prefetch(const pg8::Unit&, int, int, int) const {}
    __device__ __forceinline__ void operator()(const f32x4 (&acc)[2][2][4][2], const pg8::Unit& un, int, int wr, int wc, int fr, int fq, int) const {
        const int cb = 256 * un.pn + 32 * wc + 8 * fq;
        float gv[2][8], bv[2][8];
        ld8(gprev + cb, gv[0]); ld8(gprev + cb + 128, gv[1]); ld8(bprev + cb, bv[0]); ld8(bprev + cb + 128, bv[1]);
#pragma unroll
        for (int ai = 0; ai < 2; ++ai) {
            f32x2 sv[4]; u32x4 zw[4][2];
#pragma unroll
            for (int m = 0; m < 4; ++m) { const int row = 256 * un.pm + 128 * ai + 64 * wr + 16 * m + fr; sv[m] = *(const f32x2*)(stprev + 2 * row);
#pragma unroll
                for (int bj = 0; bj < 2; ++bj) zw[m][bj] = *(const u32x4*)(zprev + (size_t)row * DM + cb + 128 * bj); }
#pragma unroll
            for (int m = 0; m < 4; ++m) {
                const int row = 256 * un.pm + 128 * ai + 64 * wr + 16 * m + fr;
                const f32x2 s = sv[m];
                float sum = 0.f, sq = 0.f;
#pragma unroll
                for (int bj = 0; bj < 2; ++bj) {
                    float z[8], v[8]; unpack8(zw[m][bj], z);
#pragma unroll
                    for (int e = 0; e < 8; ++e) v[e] = ALPHA * ((z[e] - s.x) * s.y * gv[bj][e] + bv[bj][e]) + acc[ai][bj][m][e >> 2][e & 3];
                    const u32x4 o = pack8(v);
                    *(u32x4*)(zout + (size_t)row * DM + cb + 128 * bj) = o;
                    *(u32x2*)(z8 + (size_t)row * DM + cb + 128 * bj) = (u32x2){pk4_fp8(v[0], v[1], v[2], v[3]), pk4_fp8(v[4], v[5], v[6], v[7])};
                    float r[8]; unpack8(o, r);
#pragma unroll
                    for (int e = 0; e < 8; ++e) { sum += r[e]; sq += r[e] * r[e]; }
                }
                sum = rows_sum(sum); sq = rows_sum(sq);
                if (fq == 0) *(f32x2*)(part + ((size_t)row * 16 + un.pn * 4 + wc) * 2) = (f32x2){sum, sq};
            }
        }
    }
};

__device__ __forceinline__ void conv_phase(const Frame& F, const bf16_t* u, const bf16_t* bg, const float* ck, bf16_t* y) {
    int tid = threadIdx.x; asm volatile("" : "+v"(tid)); const int lane = tid & 63, wave = __builtin_amdgcn_readfirstlane(tid >> 6); (void)lane; (void)wave;
    const int cg = tid & 127, rs = tid >> 7, t0 = 64 * F.jb + 16 * rs, c0 = 8 * cg;
    const size_t rowb = (size_t)2048 * F.batch;
    float k0[8], k1[8], k2[8], um2[8], um1[8];
    ld8(ck + c0, k0); ld8(ck + DM + c0, k1); ld8(ck + 2 * DM + c0, k2);
    if (t0 >= 2) { unpack8(*(const u32x4*)(u + (rowb + t0 - 2) * DM + c0), um2); unpack8(*(const u32x4*)(u + (rowb + t0 - 1) * DM + c0), um1); }
    else {
#pragma unroll
        for (int e = 0; e < 8; ++e) { um2[e] = 0.f; um1[e] = 0.f; } }
    for (int r4 = 0; r4 < 16; r4 += 16) {
        u32x4 uw[16], bw[16];
#pragma unroll
        for (int i = 0; i < 16; ++i) { const size_t row = rowb + t0 + r4 + i; uw[i] = *(const u32x4*)(u + row * DM + c0); bw[i] = *(const u32x4*)(bg + row * DM + c0); }
#pragma unroll
        for (int i = 0; i < 16; ++i) {
            const size_t row = rowb + t0 + r4 + i;
            float uc[8], b[8], o[8];
            unpack8(uw[i], uc); unpack8(bw[i], b);
#pragma unroll
            for (int e = 0; e < 8; ++e) { o[e] = b[e] * (k0[e] * um2[e] + k1[e] * um1[e] + k2[e] * uc[e]); um2[e] = um1[e]; um1[e] = uc[e]; }
            *(u32x4*)(y + row * DM + c0) = pack8(o);
        }
    }
}

__device__ __forceinline__ f32x2 stats_from_part(const float* part, int row) {
    float s = 0.f, q = 0.f;
#pragma unroll
    for (int i = 0; i < 8; ++i) { const f32x4 p = *(const f32x4*)(part + (size_t)row * 32 + 4 * i); s += p.x + p.z; q += p.y + p.w; }
    const float mu = s * (1.f / DM); float var = q * (1.f / DM) - mu * mu; var = var > 0.f ? var : 0.f;
    return (f32x2){mu, 1.f / sqrtf(var + LN_EPS)};
}


constexpr int RT_LG = 0, RT_ST = 64 * 97 * 4, RT_HIST = RT_ST + 512, RT_BASE = RT_HIST + 256, RT_SEL = RT_BASE + 256, RT_GATE = RT_SEL + 1024;
__device__ __forceinline__ void router_phase(const Frame& F, const bf16_t* z, const float* part, float* stout, const bf16_t* wr_hi, const float* csr, const float* bsr,
                                             const float* rbg, const float* rbe, unsigned* cnt, unsigned* list, float* gate) {
    int tid = threadIdx.x; asm volatile("" : "+v"(tid)); const int lane = tid & 63, wave = __builtin_amdgcn_readfirstlane(tid >> 6);
    LAS unsigned char* aux = F.lds + LDS_AUX;
    LAS float* lg = (LAS float*)(aux + RT_LG); LAS float* stl = (LAS float*)(aux + RT_ST); LAS unsigned* hist = (LAS unsigned*)(aux + RT_HIST); LAS unsigned* base = (LAS unsigned*)(aux + RT_BASE);
    LAS unsigned* sel = (LAS unsigned*)(aux + RT_SEL); LAS float* gl = (LAS float*)(aux + RT_GATE);
    const int row0 = 2048 * F.batch + 64 * F.jb;
    if (tid < 64) { f32x2 s; if (part) { s = stats_from_part(part, row0 + tid); *(f32x2*)(stout + 2 * (row0 + tid)) = s; } else s = *(const f32x2*)(stout + 2 * (row0 + tid));
        stl[2 * tid] = s.x; stl[2 * tid + 1] = s.y; hist[tid] = 0u; }
    const int fr = lane & 15, fq = lane >> 4;
    f32x4 acc[4][6];
#pragma unroll
    for (int m = 0; m < 4; ++m)
#pragma unroll
        for (int j = 0; j < 6; ++j) acc[m][j] = (f32x4){0.f, 0.f, 0.f, 0.f};
    const bf16_t* ap = z + (size_t)(row0 + fr) * DM + 8 * fq;
    const bf16_t* wf = wr_hi + (size_t)lane * 8;
#pragma unroll 1
    for (int k4 = 0; k4 < 4; ++k4) {
        const int ks = 4 * wave + k4;
        bf16x8 a[4], bh[6], bl[6];
#pragma unroll
        for (int m = 0; m < 4; ++m) a[m] = *(const bf16x8*)(ap + (size_t)(16 * m) * DM + 32 * ks);
#pragma unroll
        for (int j = 0; j < 6; ++j) { bh[j] = *(const bf16x8*)(wf + ((size_t)(ks * 2 + 0) * 6 + j) * 512); bl[j] = *(const bf16x8*)(wf + ((size_t)(ks * 2 + 1) * 6 + j) * 512); }
#pragma unroll
        for (int m = 0; m < 4; ++m)
#pragma unroll
            for (int j = 0; j < 6; ++j) { acc[m][j] = __builtin_amdgcn_mfma_f32_16x16x32_bf16(a[m], bh[j], acc[m][j], 0, 0, 0); acc[m][j] = __builtin_amdgcn_mfma_f32_16x16x32_bf16(a[m], bl[j], acc[m][j], 0, 0, 0); }
    }
    {
        LAS f32x4* slots = (LAS f32x4*)(F.lds + LDS_STAGE);
#pragma unroll
        for (int half = 4; half >= 1; half >>= 1) {
            __syncthreads();
            if (wave >= half && wave < 2 * half) {
#pragma unroll
                for (int m = 0; m < 4; ++m)
#pragma unroll
                    for (int j = 0; j < 6; ++j) slots[((wave - half) * 24 + m * 6 + j) * 64 + lane] = acc[m][j];
            }
            __syncthreads();
            if (wave < half) {
#pragma unroll
                for (int m = 0; m < 4; ++m)
#pragma unroll
                    for (int j = 0; j < 6; ++j) acc[m][j] += slots[(wave * 24 + m * 6 + j) * 64 + lane];
            }
        }
    }
    if (wave == 0) {
#pragma unroll
        for (int j = 0; j < 6; ++j) {
            const int n = 16 * j + fr;
            const float c = csr[n], b = bsr[n] + (n < 8 ? rbg[n] : (n < 72 ? rbe[n - 8] : 0.f));
#pragma unroll
            for (int m = 0; m < 4; ++m)
#pragma unroll
                for (int r = 0; r < 4; ++r) { const int tk = 16 * m + 4 * fq + r; lg[tk * 97 + n] = stl[2 * tk + 1] * (acc[m][j][r] - stl[2 * tk] * c) + b; }
        }
    }
    __syncthreads();
    if (tid < 64) {
        const LAS float* l = lg + tid * 97;
        int g = 0; float gm = l[0];
#pragma unroll
        for (int i = 1; i < 8; ++i) { const float v = l[i]; if (v > gm) { gm = v; g = i; } }
        float gs = 0.f;
#pragma unroll
        for (int i = 0; i < 8; ++i) gs += __expf(l[i] - gm);
        const float ggate = 1.f / gs;
        const LAS float* el = l + 8 + 8 * g;
        int i0 = 0; float v0 = el[0];
#pragma unroll
        for (int i = 1; i < 8; ++i) { const float v = el[i]; if (v > v0) { v0 = v; i0 = i; } }
        int i1 = -1; float v1 = 0.f;
#pragma unroll
        for (int i = 0; i < 8; ++i) { const float v = el[i]; if (i != i0 && (i1 < 0 || v > v1)) { v1 = v; i1 = i; } }
        const float ex = __expf(v1 - v0), p0 = 1.f / (1.f + ex), p1 = ex * p0;
        const unsigned e0 = 8 * g + i0, e1 = 8 * g + i1;
        const unsigned r0 = atomicAdd((unsigned*)(hist + e0), 1u), r1 = atomicAdd((unsigned*)(hist + e1), 1u);
        sel[4 * tid] = e0; sel[4 * tid + 1] = e1; sel[4 * tid + 2] = r0; sel[4 * tid + 3] = r1;
        gl[2 * tid] = p0 * ggate; gl[2 * tid + 1] = p1 * ggate;
    }
    __syncthreads();
    if (tid < 64) { const unsigned h = hist[tid]; base[tid] = h ? __hip_atomic_fetch_add(cnt + tid, h, __ATOMIC_RELAXED, __HIP_MEMORY_SCOPE_AGENT) : 0u; }
    __syncthreads();
    if (tid < 64) {
        const unsigned e0 = sel[4 * tid], e1 = sel[4 * tid + 1], tok = (unsigned)(row0 + tid);
        list[(size_t)e0 * 16384 + base[e0] + sel[4 * tid + 2]] = 2u * tok;
        list[(size_t)e1 * 16384 + base[e1] + sel[4 * tid + 3]] = 2u * tok + 1u;
        *(f32x2*)(gate + 2 * tok) = (f32x2){gl[2 * tid], gl[2 * tid + 1]};
    }
}

constexpr int MS_PRE = 0, MS_N = 272, MS_DESC = 288, MS_DDN = 320, MS_ROFF = 512, MS_RINFO = MS_ROFF + 2 * 1024, MS_RDN = MS_RINFO + 2 * 1024, MS_CL = MS_RDN + 6 * 1024, MS_GDN = MS_CL + 256, MS_STUP = MS_GDN + 6 * 1024, MS_EPI = MS_STUP + 2 * 2048  , MS_END = MS_EPI + 3 * 2048;
static_assert(MS_END <= 31744, "MoE tables exceed the AUX region");
constexpr int MOE_MAXDN = 6;
__device__ __forceinline__ void moe_build(const Frame& F, const unsigned* cnt, const unsigned* list, const float* st, const float* gate) {
    int tid = threadIdx.x; asm volatile("" : "+v"(tid));
    LAS unsigned char* aux = F.lds + LDS_AUX;
    LAS unsigned* pre = (LAS unsigned*)(aux + MS_PRE); LAS unsigned* nd = (LAS unsigned*)(aux + MS_N); LAS unsigned* desc = (LAS unsigned*)(aux + MS_DESC); LAS unsigned* ddn = (LAS unsigned*)(aux + MS_DDN);
    LAS unsigned* roff = (LAS unsigned*)(aux + MS_ROFF); LAS unsigned* rinfo = (LAS unsigned*)(aux + MS_RINFO); LAS unsigned* rdn = (LAS unsigned*)(aux + MS_RDN);
    LAS unsigned* cl = (LAS unsigned*)(aux + MS_CL);
    __syncthreads();
    if (tid < 64) {
        const int lane = tid;
        const unsigned c = cnt[lane], nb = (c + 255u) >> 8;
        unsigned incl = nb;
#pragma unroll
        for (int o = 1; o < 64; o <<= 1) { const unsigned t = (unsigned)__builtin_amdgcn_ds_bpermute(((lane - o) & 63) << 2, (int)incl); incl += lane >= o ? t : 0u; }
        const unsigned excl = incl - nb;
        cl[lane] = c; pre[lane] = excl; if (lane == 63) pre[64] = incl;
        const unsigned NB = (unsigned)__builtin_amdgcn_readlane((int)incl, 63), G = (unsigned)F.G, v = (unsigned)((F.bx & 7) * (F.G >> 3) + (F.bx >> 3));
        const unsigned tup = 2u * NB, tdn = 4u * NB, nup2 = tup > G ? tup - G : 0u, nlight = G - nup2;
        unsigned n = 0;
#pragma unroll
        for (int k = 0; k < 2; ++k) {
            const unsigned u = v + (unsigned)k * G;
            if (u < tup) { const unsigned gb = u >> 1, nt = u & 1u;
                const unsigned e = (unsigned)__builtin_popcountll(__builtin_amdgcn_ballot_w64(excl <= gb)) - 1u;
                if (lane == 0) { desc[4 * k] = e; desc[4 * k + 1] = gb; desc[4 * k + 2] = nt; desc[4 * k + 3] = 0u; }
                n = (unsigned)k + 1u; }
        }
        const unsigned pos0 = v >= nup2 ? v - nup2 : nlight + v;
        unsigned m = 0;
#pragma unroll
        for (int k = 0; k < MOE_MAXDN; ++k) {
            const unsigned d = pos0 < nlight ? pos0 + (unsigned)k * nlight : 0xffffffffu;
            if (d < tdn && k < 4) { const unsigned gb = d >> 2, nt = d & 3u;
                const unsigned e = (unsigned)__builtin_popcountll(__builtin_amdgcn_ballot_w64(excl <= gb)) - 1u;
                if (lane == 0) { ddn[4 * m] = e; ddn[4 * m + 1] = gb; ddn[4 * m + 2] = nt; ddn[4 * m + 3] = 0u; }
                m = m + 1u; }
        }
        {
            const unsigned done4 = 4u * nlight;
#pragma unroll
            for (int k = 0; k < 2; ++k) {
                const unsigned d = done4 + v + (unsigned)k * G;
                if (d < tdn) { const unsigned gb = d >> 2, nt = d & 3u;
                    const unsigned e = (unsigned)__builtin_popcountll(__builtin_amdgcn_ballot_w64(excl <= gb)) - 1u;
                    if (lane == 0) { ddn[4 * m] = e; ddn[4 * m + 1] = gb; ddn[4 * m + 2] = nt; ddn[4 * m + 3] = 0u; }
                    m = m + 1u; }
            }
        }
        if (lane == 0) { nd[0] = n; nd[1] = m; }
    }
    __syncthreads();
    const unsigned n = nd[0], m = nd[1];
    for (unsigned i = 0; i < n; ++i) {
        if (tid < 256) { const unsigned e = desc[4 * i], gb = desc[4 * i + 1], idx = (gb - pre[e]) * 256u + (unsigned)tid, c = cl[e];
            LAS f32x2* stup = (LAS f32x2*)(aux + MS_STUP);
            if (idx < c) { const unsigned ts = list[(size_t)e * 16384 + idx]; roff[i * 256 + tid] = (ts >> 1) * (unsigned)DM; rinfo[i * 256 + tid] = ts; stup[i * 256 + tid] = *(const f32x2*)(st + 2 * (ts >> 1)); }
            else { roff[i * 256 + tid] = 0u; rinfo[i * 256 + tid] = 0xffffffffu; stup[i * 256 + tid] = (f32x2){0.f, 1.f}; } }
    }
    for (unsigned i = 0; i < m; ++i) {
        if (tid >= 256) { const unsigned r = (unsigned)tid - 256u, e = ddn[4 * i], gb = ddn[4 * i + 1], idx = (gb - pre[e]) * 256u + r, c = cl[e];
            LAS float* gdn = (LAS float*)(aux + MS_GDN);
            if (idx < c) { const unsigned ts = list[(size_t)e * 16384 + idx]; rdn[i * 256 + r] = ts; gdn[i * 256 + r] = 16.f * gate[ts]; }
            else { rdn[i * 256 + r] = 0xffffffffu; gdn[i * 256 + r] = 0.f; } }
    }
    __syncthreads();
}
template <bool UP>
struct MoeSched {
    LAS unsigned char* aux; const char* Abase; const char* Wbase; unsigned* done;
    __device__ __forceinline__ bool next(int i, pg8::Unit& u) const {
        const unsigned n = ((const LAS unsigned*)(aux + MS_N))[UP ? 0 : 1]; if ((unsigned)i >= n) return false;
        const LAS unsigned* d = (const LAS unsigned*)(aux + (UP ? MS_DESC : MS_DDN)) + 4 * i; const unsigned e = d[0], gb = d[1], nt = d[2];
        if (UP) { u.A = Abase; u.B = Wbase + ((size_t)e * 512 + nt * 256) * DM; }
        else { u.A = Abase + (size_t)gb * 256 * DEXP; u.B = Wbase + ((size_t)e * DM + nt * 256) * DEXP; }
        u.pm = (int)gb; u.pn = (int)nt; u.x0 = (int)e; u.x1 = i; return true;
    }
    __device__ __forceinline__ const LAS unsigned* rowoff(int i) const { return (const LAS unsigned*)(aux + MS_ROFF) + 256 * i; }
    __device__ __forceinline__ void a_ready(const pg8::Unit& u) const {
        if (!UP) {
            int t = threadIdx.x; asm volatile("" : "+v"(t));
            if (__builtin_amdgcn_readfirstlane(t >> 6) == 0) {
                unsigned sp = 0;
                while ((unsigned)__builtin_amdgcn_readfirstlane((int)__hip_atomic_load(done + u.pm, __ATOMIC_RELAXED, __HIP_MEMORY_SCOPE_AGENT)) < 2u) { __builtin_amdgcn_s_sleep(2); if (++sp > (1u << 22)) break; }
                __builtin_amdgcn_fence(__ATOMIC_ACQUIRE, "agent");
                asm volatile("s_waitcnt vmcnt(0)" ::: "memory");
            }
            asm volatile("" ::: "memory"); __builtin_amdgcn_s_barrier(); asm volatile("" ::: "memory");
        }
    }
};
struct EpiUp {
    LAS unsigned char* aux; const float* st; const float* cs; const float* bs; unsigned char* h; unsigned* done;
    __device__ __forceinline__ void prefetch(const pg8::Unit& un, int slot, int wid, int lane) const {
        if (wid == 2 || wid == 3) { const char* s = (const char*)((wid == 2 ? cs : bs) + un.x0 * 512 + 256 * un.pn); int t = threadIdx.x; asm volatile("" : "+v"(t)); (void)lane;
            __builtin_amdgcn_global_load_lds((const unsigned*)(s + (t & 63) * 16), (LAS unsigned*)(aux + MS_EPI + slot * 2048 + (wid - 2) * 1024), 16, 0, 0); } }
    __device__ __forceinline__ void operator()(const f32x4 (&acc)[2][2][4][2], const pg8::Unit& un, int ui, int wr, int wc, int fr, int fq, int slot) const {
        asm volatile("" : "+v"(fr), "+v"(fq));
        const int colL = 32 * wc + 8 * fq;
        const LAS float* ep = (const LAS float*)(aux + MS_EPI + slot * 2048);
        float csv[2][8], bsv[2][8];
        ld8l(ep + colL, csv[0]); ld8l(ep + colL + 128, csv[1]); ld8l(ep + 256 + colL, bsv[0]); ld8l(ep + 256 + colL + 128, bsv[1]);
        const LAS unsigned* rinfo = (const LAS unsigned*)(aux + MS_RINFO) + 256 * ui;
        const LAS f32x2* stup = (const LAS f32x2*)(aux + MS_STUP) + 256 * ui; (void)rinfo;
        f32x2 sv[2][4];
#pragma unroll
        for (int ai = 0; ai < 2; ++ai)
#pragma unroll
            for (int m = 0; m < 4; ++m) sv[ai][m] = stup[128 * ai + 64 * wr + 16 * m + fr];
#pragma unroll
        for (int ai = 0; ai < 2; ++ai)
#pragma unroll
            for (int m = 0; m < 4; ++m) {
                const int r = 128 * ai + 64 * wr + 16 * m + fr;
                const f32x2 s = sv[ai][m];
                float p[8];
#pragma unroll
                for (int e = 0; e < 8; ++e) {
                    const float a1 = s.y * (acc[ai][0][m][e >> 2][e & 3] - s.x * csv[0][e]) + bsv[0][e];
                    const float a3 = s.y * (acc[ai][1][m][e >> 2][e & 3] - s.x * csv[1][e]) + bsv[1][e];
                    p[e] = a1 / (1.f + __expf(-a1)) * a3;
                }
                st8wt(h + ((size_t)un.pm * 256 + r) * DEXP + 128 * un.pn + colL, (u32x2){pk4_fp8(p[0], p[1], p[2], p[3]), pk4_fp8(p[4], p[5], p[6], p[7])});
            }
        asm volatile("s_waitcnt vmcnt(0)" ::: "memory");
        __builtin_amdgcn_s_barrier();
        if (wr == 0 && wc == 0 && fr == 0 && fq == 0) __hip_atomic_fetch_add(done + un.pm, 1u, __ATOMIC_RELAXED, __HIP_MEMORY_SCOPE_AGENT);
    }
};
struct EpiDown {
    LAS unsigned char* aux; const float* gate; unsigned char* y;
    __device__ __forceinline__ void prefetch(const pg8::Unit&, int, int, int) const {}
    __device__ __forceinline__ void operator()(const f32x4 (&acc)[2][2][4][2], const pg8::Unit& un, int ui, int wr, int wc, int fr, int fq, int) const {
        const int cb = 256 * un.pn + 64 * wc + 16 * fq;
        const LAS unsigned* rinfo = (const LAS unsigned*)(aux + MS_RDN) + 256 * ui;
        const LAS float* gdn = (const LAS float*)(aux + MS_GDN) + 256 * ui;
        unsigned tsv[2][4]; float gvv[2][4];
#pragma unroll
        for (int ai = 0; ai < 2; ++ai)
#pragma unroll
            for (int m = 0; m < 4; ++m) { const int r = 128 * ai + 64 * wr + 16 * m + fr; tsv[ai][m] = rinfo[r]; gvv[ai][m] = gdn[r]; }
#pragma unroll
        for (int ai = 0; ai < 2; ++ai)
#pragma unroll
            for (int m = 0; m < 4; ++m) {
                const unsigned ts = tsv[ai][m];
                if (ts != 0xffffffffu) {
                    const float g = gvv[ai][m];
                    u32x4 o;
#pragma unroll
                    for (int bj = 0; bj < 2; ++bj) {
                        float p[8];
#pragma unroll
                        for (int e = 0; e < 8; ++e) p[e] = g * acc[ai][bj][m][e >> 2][e & 3];
                        o[2 * bj] = pk4_fp8(p[0], p[1], p[2], p[3]); o[2 * bj + 1] = pk4_fp8(p[4], p[5], p[6], p[7]);
                    }
                    *(u32x4*)(y + (size_t)ts * DM + cb) = o;
                }
            }
    }
};


struct EpiAttnIn {
    const float* st; const float* cs; const float* bs; unsigned char* q; bf16_t* qi; float* misc; int pn0; LAS unsigned char* aux;
    __device__ __forceinline__ void prefetch(const pg8::Unit& un, int slot, int wid, int lane) const { epi_prefetch(aux + slot * 4096, st + 2 * 256 * un.pm, cs + 256 * (un.pn + pn0), bs + 256 * (un.pn + pn0), wid, lane); }
    __device__ __forceinline__ void operator()(const f32x4 (&acc)[2][2][4][2], const pg8::Unit& un, int, int wr, int wc, int fr, int fq, int slot) const {
        const int pn = un.pn + pn0;
        const int colL = 32 * wc + 8 * fq;
        const LAS unsigned char* ep = aux + slot * 4096;
        float csv[2][8], bsv[2][8];
        ld8l((const LAS float*)(ep + 2048) + colL, csv[0]); ld8l((const LAS float*)(ep + 2048) + colL + 128, csv[1]); ld8l((const LAS float*)(ep + 3072) + colL, bsv[0]); ld8l((const LAS float*)(ep + 3072) + colL + 128, bsv[1]);
        f32x2 sv[2][4];
#pragma unroll
        for (int ai = 0; ai < 2; ++ai)
#pragma unroll
            for (int m = 0; m < 4; ++m) sv[ai][m] = ((const LAS f32x2*)ep)[128 * ai + 64 * wr + 16 * m + fr];
#pragma unroll
        for (int ai = 0; ai < 2; ++ai)
#pragma unroll
            for (int m = 0; m < 4; ++m) {
                const int row = 256 * un.pm + 128 * ai + 64 * wr + 16 * m + fr;
                const f32x2 s = sv[ai][m];
#pragma unroll
                for (int bj = 0; bj < 2; ++bj) {
                    float f[8];
#pragma unroll
                    for (int e = 0; e < 8; ++e) f[e] = s.y * (acc[ai][bj][m][e >> 2][e & 3] - s.x * csv[bj][e]) + bsv[bj][e];
                    if (pn < 8) *(u32x2*)(q + (size_t)row * 2048 + 256 * pn + 128 * bj + colL) = (u32x2){pk4_fp8(f[0], f[1], f[2], f[3]), pk4_fp8(f[4], f[5], f[6], f[7])};
                    else if (pn == 8) { float* d = misc + (size_t)row * 256 + 128 * bj + colL; *(f32x4*)d = (f32x4){f[0], f[1], f[2], f[3]}; *(f32x4*)(d + 4) = (f32x4){f[4], f[5], f[6], f[7]}; }
                    else *(u32x4*)(qi + (size_t)row * 512 + 256 * (pn - 9) + 128 * bj + colL) = pack8(f);
                }
            }
    }
};

__device__ __forceinline__ void attn_norm_phase(const Frame& F, const float* misc, const float* kvg, const float* kig, const float* kib, unsigned char* ckv8, bf16_t* ki) {
    int tid = threadIdx.x; asm volatile("" : "+v"(tid)); const int lane = tid & 63, wave = __builtin_amdgcn_readfirstlane(tid >> 6);
    const int row0 = 2048 * F.batch + 64 * F.jb + 8 * wave;
    const float g0 = kvg[2 * lane], g1 = kvg[2 * lane + 1], kg = kig[lane], kb = kib[lane];
    f32x2 cv[8]; float kv[8];
#pragma unroll
    for (int r = 0; r < 8; ++r) { cv[r] = *(const f32x2*)(misc + (size_t)(row0 + r) * 256 + 2 * lane); kv[r] = misc[(size_t)(row0 + r) * 256 + 128 + lane]; }
#pragma unroll
    for (int r = 0; r < 8; ++r) {
        const int row = row0 + r;
        const f32x2 c = cv[r];
        const float k = kv[r];
        const float ss = wave_sum(c.x * c.x + c.y * c.y, lane);
        const float rinv = 1.f / sqrtf(ss * (1.f / 128.f) + RMS_EPS);
        ((unsigned short*)(ckv8 + (size_t)row * 128))[lane] = (unsigned short)__builtin_amdgcn_cvt_pk_fp8_f32(c.x * rinv * g0, c.y * rinv * g1, 0, false);
        const float mu = wave_sum(k, lane) * (1.f / 64.f); const float d = k - mu;
        const float var = wave_sum(d * d, lane) * (1.f / 64.f);
        ki[(size_t)row * 64 + lane] = (bf16_t)f2bf(d * (1.f / sqrtf(var + LN_EPS)) * kg + kb);
    }
}

__device__ __forceinline__ unsigned sortable(float f) { const unsigned u = __builtin_bit_cast(unsigned, f); return (u & 0x80000000u) ? ~u : (u | 0x80000000u); }
__device__ __forceinline__ unsigned radix_select256(const unsigned (&k)[32], int nvalid, LAS unsigned* hist, int lane) {
    unsigned prefix = 0u, pmask = 0u, krem = 256u;
#pragma unroll 1
    for (int shift = 24; shift >= 0; shift -= 8) {
#pragma unroll
        for (int j = 0; j < 4; ++j) hist[lane + 64 * j] = 0u;
        asm volatile("s_waitcnt lgkmcnt(0)" ::: "memory");
#pragma unroll
        for (int g8 = 0; g8 < 4; ++g8) if (512 * g8 < nvalid) {
#pragma unroll
            for (int i = 8 * g8; i < 8 * g8 + 8; ++i) { const unsigned key = k[i]; if (key != 0u && (key & pmask) == prefix) __hip_atomic_fetch_add(hist + ((key >> shift) & 255u), 1u, __ATOMIC_RELAXED, __HIP_MEMORY_SCOPE_WAVEFRONT); } }
        asm volatile("s_waitcnt lgkmcnt(0)" ::: "memory");
        unsigned h[4];
#pragma unroll
        for (int j = 0; j < 4; ++j) h[j] = hist[255 - 4 * lane - j];
        const unsigned local = (h[0] + h[1]) + (h[2] + h[3]);
        unsigned incl = local;
#pragma unroll
        for (int o = 1; o < 64; o <<= 1) { const unsigned t = (unsigned)__builtin_amdgcn_ds_bpermute(((lane - o) & 63) << 2, (int)incl); incl += lane >= o ? t : 0u; }
        const unsigned long long m = __builtin_amdgcn_ballot_w64(incl >= krem);
        const int L = __builtin_ctzll(m);
        unsigned cum = (unsigned)__builtin_amdgcn_readlane((int)(incl - local), L);
        const unsigned c0 = (unsigned)__builtin_amdgcn_readlane((int)h[0], L), c1 = (unsigned)__builtin_amdgcn_readlane((int)h[1], L), c2 = (unsigned)__builtin_amdgcn_readlane((int)h[2], L), c3 = (unsigned)__builtin_amdgcn_readlane((int)h[3], L);
        unsigned bin, cb;
        if (cum + c0 >= krem) { bin = 255u - 4u * L; cb = c0; }
        else { cum += c0; if (cum + c1 >= krem) { bin = 254u - 4u * L; cb = c1; } else { cum += c1; if (cum + c2 >= krem) { bin = 253u - 4u * L; cb = c2; } else { cum += c2; bin = 252u - 4u * L; cb = c3; } } }
        krem -= cum; prefix |= bin << shift; pmask |= 255u << shift;
        if (cb == krem) break;
    }
    return prefix;
}

__device__ __forceinline__ void index_unit(const Frame& F, const bf16_t* qi, const float* misc, const bf16_t* ki, unsigned short* sel, int b, int t0, int lane, int wave) {
    const int hh = lane >> 5, l31 = lane & 31;
    const size_t rb = (size_t)b * 2048;
    LAS unsigned* sc = (LAS unsigned*)(F.lds + LDS_STAGE);
    const LAS unsigned* bkt = (const LAS unsigned*)(F.lds + LDS_AUX);
#define IDX_PACK(key, t) ({ const int _k = (key), _d = (t) - _k; (unsigned short)(_k | (int)(bkt[_d < 0 ? 0 : (_d > 127 ? 127 : _d)] << 11)); })
    if (t0 < 256) {
#pragma unroll
        for (int qq = 0; qq < 2; ++qq) { const int t = t0 + 2 * wave + qq;
#pragma unroll
            for (int j = 0; j < 4; ++j) { const int idx = lane + 64 * j; sel[(rb + t) * 256 + idx] = idx <= t ? IDX_PACK(idx, t) : (unsigned short)0; } }
        return;
    }
    const int nkt = (t0 + 16 + 31) >> 5;
    {
        LAS unsigned char* aq_l = F.lds + LDS_AUX + 10240; LAS float* w_l = (LAS float*)(F.lds + LDS_AUX + 26624);
        { const char* src = (const char*)(qi + (rb + t0) * 512);
#pragma unroll
          for (int j = 0; j < 2; ++j) __builtin_amdgcn_global_load_lds((const unsigned*)(src + (2 * wave + j) * 1024 + lane * 16), (LAS unsigned*)(aq_l + (2 * wave + j) * 1024), 16, 0, 0);
          if (wave < 2) { const int i = 64 * wave + lane; w_l[i] = misc[(rb + t0 + (i >> 3)) * 256 + 192 + (i & 7)]; } }
        asm volatile("s_waitcnt vmcnt(0)" ::: "memory");
        __syncthreads();
        bf16x8 aq[4][4];
        { const int r = l31, head = (r & 3) + 4 * ((r >> 3) & 1), query = (r >> 4) + 2 * ((r >> 2) & 1);
#pragma unroll
          for (int mt = 0; mt < 4; ++mt) { const LAS unsigned char* ap = aq_l + ((4 * mt + query) * 8 + head) * 128 + 16 * hh;
#pragma unroll
              for (int ks = 0; ks < 4; ++ks) aq[mt][ks] = *(const LAS bf16x8*)(ap + 32 * ks); } }
        const bf16_t* kp = ki + (rb + l31) * 64 + 8 * hh;
        bf16x8 bk[4], bn[4];
        if (wave < nkt) {
#pragma unroll
            for (int ks = 0; ks < 4; ++ks) bk[ks] = *(const bf16x8*)(kp + (size_t)wave * 2048 + 16 * ks); }
        for (int kt = wave; kt < nkt; kt += 8) {
            const int ktn = kt + 8 < nkt ? kt + 8 : kt;
#pragma unroll
            for (int ks = 0; ks < 4; ++ks) bn[ks] = *(const bf16x8*)(kp + (size_t)ktn * 2048 + 16 * ks);
            const int key = 32 * kt + l31;
#pragma unroll
            for (int mt = 0; mt < 4; ++mt) {
                f32x16 acc;
#pragma unroll
                for (int e = 0; e < 16; ++e) acc[e] = 0.f;
#pragma unroll
                for (int ks = 0; ks < 4; ++ks) acc = __builtin_amdgcn_mfma_f32_32x32x16_bf16(aq[mt][ks], bk[ks], acc, 0, 0, 0);
                float s0 = 0.f, s1 = 0.f;
                {
                    const LAS f32x4* wp = (const LAS f32x4*)(w_l + (4 * mt + 2 * hh) * 8); const f32x4 wa = wp[0], wb = wp[1], wc = wp[2], wd = wp[3];
                    const float w0[8] = {wa.x, wa.y, wa.z, wa.w, wb.x, wb.y, wb.z, wb.w}, w1[8] = {wc.x, wc.y, wc.z, wc.w, wd.x, wd.y, wd.z, wd.w};
#pragma unroll
                    for (int e = 0; e < 8; ++e) { s0 += fmaxf(acc[e], 0.f) * w0[e]; s1 += fmaxf(acc[8 + e], 0.f) * w1[e]; }
                }
                const int tq = t0 + 4 * mt + 2 * hh;
                sc[(4 * mt + 2 * hh) * 2048 + key] = key <= tq ? sortable(s0) : 0u;
                sc[(4 * mt + 2 * hh + 1) * 2048 + key] = key <= tq + 1 ? sortable(s1) : 0u;
            }
#pragma unroll
            for (int ks = 0; ks < 4; ++ks) bk[ks] = bn[ks];
        }
    }
    __syncthreads();
    {
    unsigned ka[32], kb[32];
    const int nvalid = 32 * nkt;
#pragma unroll
    for (int i = 0; i < 32; ++i) { const int key = 64 * i + lane; const bool v = key < nvalid; ka[i] = v ? sc[(2 * wave) * 2048 + key] : 0u; kb[i] = v ? sc[(2 * wave + 1) * 2048 + key] : 0u; }
    LAS unsigned* hist = (LAS unsigned*)(F.lds + LDS_AUX + 1024 + wave * 1024);
    const unsigned Ta = radix_select256(ka, nvalid, hist, lane), Tb = radix_select256(kb, nvalid, hist, lane);
#pragma unroll
    for (int qq = 0; qq < 2; ++qq) {
        const unsigned T = qq ? Tb : Ta;
        unsigned nge = 0u;
#pragma unroll
        for (int g8 = 0; g8 < 4; ++g8) if (512 * g8 < nvalid) {
#pragma unroll
            for (int i = 8 * g8; i < 8 * g8 + 8; ++i) nge += (unsigned)__builtin_popcountll(__builtin_amdgcn_ballot_w64((qq ? kb[i] : ka[i]) >= T)); }
        LAS unsigned short* out = (LAS unsigned short*)hist + 256 * qq;
        unsigned base = 0u;
        if (nge == 256u) {
#pragma unroll
            for (int i = 0; i < 32; ++i) if (64 * i < nvalid) {
                const unsigned k = qq ? kb[i] : ka[i];
                const bool take = k >= T;
                const unsigned long long mtk = __builtin_amdgcn_ballot_w64(take);
                const unsigned tkbelow = __builtin_amdgcn_mbcnt_hi((unsigned)(mtk >> 32), __builtin_amdgcn_mbcnt_lo((unsigned)mtk, 0u));
                if (take) out[base + tkbelow] = IDX_PACK(64 * i + lane, t0 + 2 * wave + qq);
                base += (unsigned)__builtin_popcountll(mtk);
            }
        } else {
            unsigned ngt = 0u;
#pragma unroll
            for (int i = 0; i < 32; ++i) ngt += (unsigned)__builtin_popcountll(__builtin_amdgcn_ballot_w64((qq ? kb[i] : ka[i]) > T));
            const unsigned need = 256u - ngt;
            unsigned tbase = 0u;
#pragma unroll 4
            for (int i = 0; i < 32; ++i) if (64 * i < nvalid) {
                const unsigned k = qq ? kb[i] : ka[i];
                const bool eq = (k == T), gt = (k > T);
                const unsigned long long meq = __builtin_amdgcn_ballot_w64(eq);
                const unsigned eqbelow = __builtin_amdgcn_mbcnt_hi((unsigned)(meq >> 32), __builtin_amdgcn_mbcnt_lo((unsigned)meq, 0u));
                const bool take = gt || (eq && (tbase + eqbelow) < need);
                tbase += (unsigned)__builtin_popcountll(meq);
                const unsigned long long mtk = __builtin_amdgcn_ballot_w64(take);
                const unsigned tkbelow = __builtin_amdgcn_mbcnt_hi((unsigned)(mtk >> 32), __builtin_amdgcn_mbcnt_lo((unsigned)mtk, 0u));
                if (take) out[base + tkbelow] = IDX_PACK(64 * i + lane, t0 + 2 * wave + qq);
                base += (unsigned)__builtin_popcountll(mtk);
            }
        }
    }
    asm volatile("s_waitcnt lgkmcnt(0)" ::: "memory");
    *(u32x4*)(sel + (rb + t0 + 2 * wave + (lane >> 5)) * 256 + 8 * (lane & 31)) = *(const LAS u32x4*)((const LAS unsigned char*)hist + 16 * lane);
    }
    __syncthreads();
#undef IDX_PACK
}
__device__ __forceinline__ void index_phase(const Frame& F, const bf16_t* qi, const float* misc, const bf16_t* ki, unsigned short* sel) {
    int tid = threadIdx.x; asm volatile("" : "+v"(tid)); const int lane = tid & 63, wave = __builtin_amdgcn_readfirstlane(tid >> 6);
    if (tid < 128) { unsigned bk = (unsigned)tid; if (tid >= 16) { int v = 16 + (int)(__logf((float)tid / 16.f) / 2.0794415416798357f * 16.f); bk = (unsigned)(v < 31 ? v : 31); } ((LAS unsigned*)(F.lds + LDS_AUX))[tid] = bk; }
    __syncthreads();
    const int us[4] = {127 - F.jb, 64 + F.jb, 63 - F.jb, F.jb};
    for (int k = 0; k < 4; ++k) index_unit(F, qi, misc, ki, sel, F.batch, 16 * us[k], lane, wave);
}

constexpr int AT_P = 0  , AT_SCT = 8704  , AT_BIAS = 16896, AT_Q = 18944  , AT_SEL = 27136  ;
static_assert(AT_SEL + 3 * 1024 <= 31744, "attention tables exceed the AUX region");
__device__ __forceinline__ unsigned at_f(unsigned row) { return ((row >> 2) & 1u) | (((row >> 1) & 1u) << 1) | (((row >> 3) & 1u) << 2); }
__device__ __forceinline__ void attn_phase(const Frame& F, const unsigned char* q8, const unsigned char* ckv8, const unsigned short* sel, const float* relb, unsigned char* o) {
    int tid = threadIdx.x; asm volatile("" : "+v"(tid)); const int lane = tid & 63, wave = __builtin_amdgcn_readfirstlane(tid >> 6);
    const int fr = lane & 15, fq = lane >> 4;
    LAS unsigned char* aux = F.lds + LDS_AUX;
    LAS float* biast = (LAS float*)(aux + AT_BIAS);
    for (int i = tid; i < 512; i += NTHREADS) biast[i] = relb[i];
    const size_t rb = (size_t)F.batch * 2048;
    const int us0 = 127 - F.jb, us1 = 64 + F.jb, us2 = 63 - F.jb, us3 = F.jb;
#define AT_T(it) (16 * ((it) < 8 ? us0 : ((it) < 16 ? us1 : ((it) < 24 ? us2 : us3))) + 2 * ((it) & 7))
    const unsigned char* ckvb = ckv8 + rb * 128;
    const unsigned dl8 = (unsigned)lane >> 3, dp = (unsigned)lane & 7u;
#define AT_DMA_SEL(t, slot) do { if (wave == 0) \
        __builtin_amdgcn_global_load_lds((const unsigned*)((const unsigned char*)(sel + (rb + (t)) * 256) + 16 * lane), (LAS unsigned*)(aux + AT_SEL + (slot) * 1024), 16, 0, 16); } while (0)
#define AT_DMA_Q(t, buf) do { if (wave == 1) { _Pragma("unroll") for (int j = 0; j < 4; ++j) { const unsigned R = 8u * j + dl8; \
        __builtin_amdgcn_global_load_lds((const unsigned*)(q8 + (rb + (t)) * 2048 + R * 128u + ((dp ^ at_f(R)) << 4)), (LAS unsigned*)(aux + AT_Q + (buf) * 4096 + j * 1024), 16, 0, 0); } } } while (0)
#define AT_GATHER(buf, slot) do { const LAS unsigned short* sp = (const LAS unsigned short*)(aux + AT_SEL + (slot) * 1024) + 32 * wave + dl8; unsigned svv[8]; \
        _Pragma("unroll") for (int j = 0; j < 8; ++j) svv[j] = sp[256 * (j >> 2) + 8 * (j & 3)]; \
        asm volatile("s_waitcnt lgkmcnt(0)" : "+v"(svv[0]), "+v"(svv[1]), "+v"(svv[2]), "+v"(svv[3]), "+v"(svv[4]), "+v"(svv[5]), "+v"(svv[6]), "+v"(svv[7]) :: "memory");     \
        _Pragma("unroll") for (int j = 0; j < 8; ++j) { const unsigned row = 32u * wave + 8u * (j & 3) + dl8; \
        __builtin_amdgcn_global_load_lds((const unsigned*)(ckvb + (size_t)(svv[j] & 2047u) * 128 + ((dp ^ at_f(row)) << 4)), (LAS unsigned*)(F.lds + ((buf) * 2 + (j >> 2)) * 32768 + (32 * wave + 8 * (j & 3)) * 128), 16, 0, 0); } } while (0)
    AT_DMA_SEL(AT_T(0), 0); AT_DMA_SEL(AT_T(1), 1); AT_DMA_Q(AT_T(0), 0);
    asm volatile("s_waitcnt vmcnt(0)" ::: "memory");
    __syncthreads();
    AT_GATHER(0, 0);
    const bf16x8 ones = {0x3F80, 0x3F80, 0x3F80, 0x3F80, 0x3F80, 0x3F80, 0x3F80, 0x3F80};
    const unsigned fsw = at_f((unsigned)fr);
    int s_cur = 0;
    for (int it = 0; it < 32; ++it) {
        const int t0 = AT_T(it), cur = it & 1;
        const int s_nxt = s_cur == 2 ? 0 : s_cur + 1, s_nn = s_nxt == 2 ? 0 : s_nxt + 1;
        asm volatile("s_waitcnt vmcnt(0) lgkmcnt(0)" ::: "memory");
        __builtin_amdgcn_s_barrier();
        if (it < 31) { AT_GATHER(cur ^ 1, s_nxt); AT_DMA_Q(AT_T(it + 1), cur ^ 1); if (it < 30) AT_DMA_SEL(AT_T(it + 2), s_nn); }
        {
            i32x8 qv[2], kv[2][2]; u32x2 pcw[2][2];
#pragma unroll
            for (int qq = 0; qq < 2; ++qq) {
                const LAS unsigned char* qrow = aux + AT_Q + cur * 4096 + (16 * qq + fr) * 128;
                const u32x4 qb0 = *(const LAS u32x4*)(qrow + (((2u * fq) ^ fsw) << 4)), qb1 = *(const LAS u32x4*)(qrow + (((2u * fq + 1u) ^ fsw) << 4));
                qv[qq] = (i32x8){(int)qb0.x, (int)qb0.y, (int)qb0.z, (int)qb0.w, (int)qb1.x, (int)qb1.y, (int)qb1.z, (int)qb1.w};
                const LAS unsigned char* srow = aux + AT_SEL + s_cur * 1024 + qq * 512 + (32 * wave + 4 * fq) * 2;
#pragma unroll
                for (int mt = 0; mt < 2; ++mt) {
                    const LAS unsigned char* krow = F.lds + (cur * 2 + qq) * 32768 + (32 * wave + 16 * mt + fr) * 128;
                    const u32x4 k0 = *(const LAS u32x4*)(krow + (((2u * fq) ^ fsw) << 4)), k1 = *(const LAS u32x4*)(krow + (((2u * fq + 1u) ^ fsw) << 4));
                    kv[qq][mt] = (i32x8){(int)k0.x, (int)k0.y, (int)k0.z, (int)k0.w, (int)k1.x, (int)k1.y, (int)k1.z, (int)k1.w};
                    pcw[qq][mt] = *(const LAS u32x2*)(srow + 32 * mt);
                }
            }
            float bv[2][2][4];
#pragma unroll
            for (int qq = 0; qq < 2; ++qq)
#pragma unroll
                for (int mt = 0; mt < 2; ++mt) {
                    const unsigned pw[2] = {pcw[qq][mt].x, pcw[qq][mt].y};
#pragma unroll
                    for (int r = 0; r < 4; ++r) { const unsigned bucket = ((pw[r >> 1] >> (16 * (r & 1))) & 0xffffu) >> 11; bv[qq][mt][r] = biast[bucket * 16 + fr]; }
                }
            f32x4 sacc[2][2];
#pragma unroll
            for (int qq = 0; qq < 2; ++qq)
#pragma unroll
                for (int mt = 0; mt < 2; ++mt)
                    sacc[qq][mt] = __builtin_amdgcn_mfma_scale_f32_16x16x128_f8f6f4(kv[qq][mt], qv[qq], (f32x4){0.f, 0.f, 0.f, 0.f}, 0, 0, 0, 0x7F7F7F7F, 0, 0x7F7F7F7F);
#pragma unroll
            for (int qq = 0; qq < 2; ++qq) {
                const int nsel = t0 + qq + 1 < TOPK ? t0 + qq + 1 : TOPK;
                float v2[2][4]; float mx = -115.f;
#pragma unroll
                for (int mt = 0; mt < 2; ++mt)
#pragma unroll
                    for (int r = 0; r < 4; ++r) {
                        const int slot = 32 * wave + 16 * mt + 4 * fq + r;
                        const float v = fminf(sacc[qq][mt][r] * 0.08838834764831845f + bv[qq][mt][r], 80.f) * 1.4426950408889634f;
                        v2[mt][r] = slot < nsel ? v : -1e30f; mx = fmaxf(mx, v2[mt][r]);
                    }
                {
                    const unsigned mb = __builtin_bit_cast(unsigned, mx);
                    const auto s16 = __builtin_amdgcn_permlane16_swap(mb, mb, false, false);
                    const float m1 = fmaxf(__builtin_bit_cast(float, (unsigned)s16[0]), __builtin_bit_cast(float, (unsigned)s16[1]));
                    const unsigned m1b = __builtin_bit_cast(unsigned, m1);
                    const auto s32 = __builtin_amdgcn_permlane32_swap(m1b, m1b, false, false);
                    mx = fmaxf(__builtin_bit_cast(float, (unsigned)s32[0]), __builtin_bit_cast(float, (unsigned)s32[1]));
                }
                const float ef = floorf(mx) + 1.f;
                LAS unsigned char* prow = aux + AT_P + qq * 4352 + fr * 272 + 32 * wave + 4 * fq;
#pragma unroll
                for (int mt = 0; mt < 2; ++mt)
                    *(LAS unsigned*)(prow + 16 * mt) = pk4_fp8(__builtin_amdgcn_exp2f(v2[mt][0] - ef), __builtin_amdgcn_exp2f(v2[mt][1] - ef), __builtin_amdgcn_exp2f(v2[mt][2] - ef), __builtin_amdgcn_exp2f(v2[mt][3] - ef));
                if (fq == 0) *(LAS unsigned char*)(aux + AT_SCT + qq * 128 + fr * 8 + wave) = (unsigned char)(127 + (int)ef);
            }
        }
        asm volatile("s_waitcnt lgkmcnt(0)" ::: "memory"); __builtin_amdgcn_s_barrier(); asm volatile("" ::: "memory");
        {
            const int qq = wave >> 2; const unsigned db = (unsigned)wave & 3u;
            const unsigned img = (unsigned)(size_t)(F.lds + (cur * 2 + qq) * 32768);
            const LAS unsigned char* pbase = aux + AT_P + qq * 4352 + fr * 272 + 16 * fq;
            const LAS unsigned char* sbase = aux + AT_SCT + qq * 128 + fr * 8 + fq;
            f32x4 oe = (f32x4){0.f, 0.f, 0.f, 0.f}, oo = (f32x4){0.f, 0.f, 0.f, 0.f}, tacc = (f32x4){0.f, 0.f, 0.f, 0.f};
            const unsigned r4 = (unsigned)(lane & 15) >> 2, c4 = (unsigned)lane & 3u;
            u32x2 ta[2][8]; u32x4 pf[2][2]; unsigned sb[2];
#pragma unroll
            for (int kb = 0; kb < 2; ++kb)
#pragma unroll
                for (int j = 0; j < 8; ++j) {
                    const unsigned row = 128u * kb + 64u * (j >> 2) + 16u * fq + 4u * (j & 3) + r4;
                    const unsigned a0 = img + row * 128u + (((2u * db + (c4 >> 1)) ^ at_f(row)) << 4) + 8u * (c4 & 1u);
                    asm volatile("ds_read_b64_tr_b16 %0, %1" : "=&v"(ta[kb][j]) : "v"(a0) : "memory");
                }
#pragma unroll
            for (int kb = 0; kb < 2; ++kb) { pf[kb][0] = *(const LAS u32x4*)(pbase + 128 * kb); pf[kb][1] = *(const LAS u32x4*)(pbase + 128 * kb + 64); sb[kb] = *(sbase + 4 * kb); }
            asm volatile("s_waitcnt lgkmcnt(0)" : "+v"(ta[0][0]), "+v"(ta[0][1]), "+v"(ta[0][2]), "+v"(ta[0][3]), "+v"(ta[0][4]), "+v"(ta[0][5]), "+v"(ta[0][6]), "+v"(ta[0][7]),
                         "+v"(ta[1][0]), "+v"(ta[1][1]), "+v"(ta[1][2]), "+v"(ta[1][3]), "+v"(ta[1][4]), "+v"(ta[1][5]), "+v"(ta[1][6]), "+v"(ta[1][7]) :: "memory");
            const i32x8 onesv = {0x38383838, 0x38383838, 0x38383838, 0x38383838, 0x38383838, 0x38383838, 0x38383838, 0x38383838};
#pragma unroll
            for (int kb = 0; kb < 2; ++kb) {
                i32x8 ev, od;
#pragma unroll
                for (int j = 0; j < 8; ++j) { ev[j] = (int)__builtin_amdgcn_perm(ta[kb][j].y, ta[kb][j].x, 0x06040200u); od[j] = (int)__builtin_amdgcn_perm(ta[kb][j].y, ta[kb][j].x, 0x07050301u); }
                const i32x8 pv8 = {(int)pf[kb][0].x, (int)pf[kb][0].y, (int)pf[kb][0].z, (int)pf[kb][0].w, (int)pf[kb][1].x, (int)pf[kb][1].y, (int)pf[kb][1].z, (int)pf[kb][1].w};
                oe = __builtin_amdgcn_mfma_scale_f32_16x16x128_f8f6f4(ev, pv8, oe, 0, 0, 0, 0x7F7F7F7F, 0, (int)sb[kb]);
                oo = __builtin_amdgcn_mfma_scale_f32_16x16x128_f8f6f4(od, pv8, oo, 0, 0, 0, 0x7F7F7F7F, 0, (int)sb[kb]);
                tacc = __builtin_amdgcn_mfma_scale_f32_16x16x128_f8f6f4(onesv, pv8, tacc, 0, 0, 0, 0x7F7F7F7F, 0, (int)sb[kb]);
            }
            const float inv = __builtin_amdgcn_rcpf(tacc[0]);
            *(u32x2*)(o + ((rb + t0 + qq) * 16 + fr) * 128 + 32 * db + 8 * fq) = (u32x2){pk4_fp8(oe[0] * inv, oo[0] * inv, oe[1] * inv, oo[1] * inv), pk4_fp8(oe[2] * inv, oo[2] * inv, oe[3] * inv, oo[3] * inv)};
        }
        s_cur = s_nxt;
    }
    asm volatile("s_waitcnt vmcnt(0)" ::: "memory");
    __syncthreads();
#undef AT_DMA_SEL
#undef AT_DMA_Q
#undef AT_GATHER
#undef AT_T
}

__global__ void __launch_bounds__(NTHREADS, 2) fwd_kernel(Params P) {
    extern __shared__ __attribute__((aligned(16))) unsigned char lds_raw[];
    Frame F;
    F.lds = (LAS unsigned char*)lds_raw;
    F.G = gridDim.x; F.bx = blockIdx.x; F.batch = F.bx & 7; F.jb = F.bx >> 3; F.ws = P.ws;
    unsigned char* ws = P.ws;
    for (int u = threadIdx.x; u < 256; u += NTHREADS) ((LAS unsigned*)(F.lds + LDS_MISC))[u] = 0u;
    __syncthreads();
    XcdBarrier bar = xcd_barrier_post((unsigned*)(ws + WS_CTL) + CW_BAR, (volatile LAS unsigned*)(F.lds + LDS_MISC));
#define GRID_BAR() xcd_barrier<false>(bar)
#define GRID_BAR_L() xcd_barrier<true>(bar)
    if (threadIdx.x == 0) (void)xb_add((unsigned*)(ws + WS_CTL) + CW_XCC + F.bx, bar.x + 1u);

    bf16_t* zA; bf16_t* zB; float* stA; float* stB;
    const float* ones; const float* zeros;

    p0_prologue(F, P);
    GRID_BAR();
    {
        volatile LAS unsigned* okw = (volatile LAS unsigned*)(F.lds + LDS_MISC) + 3;
        if (threadIdx.x == 0) okw[0] = (F.G == 256) ? 1u : 0u;
        __syncthreads();
        if (threadIdx.x < 256 && (int)threadIdx.x < F.G) { unsigned* tab = (unsigned*)(ws + WS_CTL) + CW_XCC; const unsigned v = xb_ld(tab + threadIdx.x), r = xb_ld(tab + (threadIdx.x & 7)); if (v == 0u || v != r) okw[0] = 0u; }
        __syncthreads();
        if (threadIdx.x == 0) ((volatile LAS unsigned*)(F.lds + LDS_MISC))[2] = okw[0];
        __syncthreads();
    }
    {
        const float* csp = (const float*)(ws + WS_CSP); float* cs = (float*)(ws + WS_CSUP); float* bs = (float*)(ws + WS_BSUP);
        constexpr int NV = 4 * 64 * 512;
        for (int i = F.bx * NTHREADS + (int)threadIdx.x; i < NV; i += F.G * NTHREADS) {
            float a = 0.f, b = 0.f;
#pragma unroll 8
            for (int kt = 0; kt < 16; ++kt) { a += csp[(size_t)kt * NV + i]; b += csp[(size_t)(32 + kt) * NV + i]; }
            cs[i] = a; bs[i] = b;
        }
    }

    for (int layer = 0; layer < DEPTH; ++layer) {
        asm volatile("" : "+s"(ws));
        zA = (bf16_t*)(ws + WS_ZA); zB = (bf16_t*)(ws + WS_ZB); stA = (float*)(ws + WS_STA); stB = (float*)(ws + WS_STB); ones = (const float*)(ws + WS_VEC); zeros = ones + 1024;
        const float* gprev = layer ? P.in[I_L2G] + (layer - 1) * DM : ones;
        const float* bprev = layer ? P.in[I_L2B] + (layer - 1) * DM : zeros;
        const int jl = layer >> 1;
        bool have_part = false;
        if ((layer & 1) == 0) {
            {
                pg8::StaticOrder S; S.init(T_TOK, 3072, F.G, F.bx, zA, DM * 2, (const bf16_t*)(ws + WS_WCI) + (size_t)jl * 3072 * DM, DM * 2);
                EpiConvIn E{stA, (const float*)(ws + WS_CSCI) + jl * 3072, (const float*)(ws + WS_BSCI) + jl * 3072, (bf16_t*)(ws + WS_U), (bf16_t*)(ws + WS_BG), F.lds + LDS_AUX};
                pg8::gemm_phase<EpiConvIn, pg8::StaticOrder, false>(F.lds + LDS_STAGE, DM, DM * 2, DM * 2, S, E);
            }
            GRID_BAR_L();
            conv_phase(F, (const bf16_t*)(ws + WS_U), (const bf16_t*)(ws + WS_BG), P.in[I_CK] + (size_t)jl * 3 * DM, (bf16_t*)(ws + WS_Y));
            GRID_BAR_L();
            {
                pg8::StaticOrder S; S.init(T_TOK, DM, F.G, F.bx, (const bf16_t*)(ws + WS_Y), DM * 2, (const bf16_t*)(ws + WS_WCO) + (size_t)jl * DM * DM, DM * 2);
                EpiRes E{zA, stA, gprev, bprev, zB, (float*)(ws + WS_PART), ws + WS_Z8};
                pg8::gemm_phase<EpiRes, pg8::StaticOrder, false>(F.lds + LDS_STAGE, DM, DM * 2, DM * 2, S, E);
            }
            have_part = true;
            GRID_BAR_L();
        } else {
            {
                pg8::StaticOrder S; S.init(T_TOK, 2048, F.G, F.bx, ws + WS_ZA8, DM, ws + WS_WAI + (size_t)jl * AIWP * DM * 2, DM);
                EpiAttnIn E{stA, (const float*)(ws + WS_CSAI) + jl * AIWP, (const float*)(ws + WS_BSAI) + jl * AIWP, ws + WS_Q, (bf16_t*)(ws + WS_QI), (float*)(ws + WS_MISC), 0, F.lds + LDS_AUX};
                pg8::gemm_phase<EpiAttnIn, pg8::StaticOrder, false, true>(F.lds + LDS_STAGE, DM / 2, DM, DM, S, E);
            }
            {
                pg8::StaticOrder S; S.init(T_TOK, AIWP - 2048, F.G, F.bx, zA, DM * 2, (const bf16_t*)(ws + WS_WAI) + (size_t)jl * AIWP * DM + (size_t)2048 * DM, DM * 2);
                EpiAttnIn E{stA, (const float*)(ws + WS_CSAI) + jl * AIWP, (const float*)(ws + WS_BSAI) + jl * AIWP, ws + WS_Q, (bf16_t*)(ws + WS_QI), (float*)(ws + WS_MISC), 8, F.lds + LDS_AUX + 12288};
                pg8::gemm_phase<EpiAttnIn, pg8::StaticOrder, false>(F.lds + LDS_STAGE, DM, DM * 2, DM * 2, S, E);
            }
            GRID_BAR_L();
            attn_norm_phase(F, (const float*)(ws + WS_MISC), P.in[I_KVG] + jl * KVL, P.in[I_KIG] + jl * IDXD, P.in[I_KIB] + jl * IDXD, ws + WS_CKV, (bf16_t*)(ws + WS_KI));
            GRID_BAR_L();
            index_phase(F, (const bf16_t*)(ws + WS_QI), (const float*)(ws + WS_MISC), (const bf16_t*)(ws + WS_KI), (unsigned short*)(ws + WS_SEL));
            asm volatile("s_waitcnt vmcnt(0)" ::: "memory"); __syncthreads();
            attn_phase(F, ws + WS_Q, ws + WS_CKV, (const unsigned short*)(ws + WS_SEL), P.in[I_RELB], ws + WS_O);
            GRID_BAR_L();
            {
                pg8::StaticOrder S; S.init(T_TOK, DM, F.G, F.bx, ws + WS_O, 2048, ws + WS_WAO + (size_t)jl * DM * 2048, 2048);
                EpiRes E{zA, stA, gprev, bprev, zB, (float*)(ws + WS_PART), ws + WS_Z8};
                pg8::gemm_phase<EpiRes, pg8::StaticOrder, false, true>(F.lds + LDS_STAGE, 2048 / 2, 2048, 2048, S, E, 127 - 6);
            }
            have_part = true;
            GRID_BAR_L();
        }
        const float* partin = have_part ? (const float*)(ws + WS_PART) : nullptr;
        const unsigned char* ym = nullptr;
        {
            unsigned* cnt = (unsigned*)(ws + WS_CTL) + CW_CNT + 64 * layer; unsigned* list = (unsigned*)(ws + WS_LIST); float* gate = (float*)(ws + WS_GATE);
            const bf16_t* wrh = (const bf16_t*)(ws + WS_WR) + (size_t)layer * 32 * 2 * 6 * 512;
            router_phase(F, zB, partin, stB, wrh, (const float*)(ws + WS_CSR) + layer * 96, (const float*)(ws + WS_BSR) + layer * 96, P.in[I_RBG] + layer * 8, P.in[I_RBE] + layer * 64, cnt, list, gate);
            partin = nullptr;
            GRID_BAR();
            {
                unsigned* done = (unsigned*)(ws + WS_CTL) + CW_DONE + 256 * layer;
                moe_build(F, cnt, list, stB, gate);
                {
                    MoeSched<true> S{F.lds + LDS_AUX, (const char*)(ws + WS_Z8), (const char*)(ws + WS_WUP) + (size_t)layer * 64 * 512 * DM, done};
                    EpiUp E{F.lds + LDS_AUX, stB, (const float*)(ws + WS_CSUP) + (size_t)layer * 64 * 512, (const float*)(ws + WS_BSUP) + (size_t)layer * 64 * 512, ws + WS_H, done};
                    pg8::gemm_phase<EpiUp, MoeSched<true>, true, true>(F.lds + LDS_STAGE, DM / 2, DM, DM, S, E);
                }
                {
                    MoeSched<false> S{F.lds + LDS_AUX, (const char*)(ws + WS_H), (const char*)(ws + WS_WDN) + (size_t)layer * 64 * DM * DEXP, done};
                    EpiDown E{F.lds + LDS_AUX, gate, ws + WS_YM};
                    pg8::gemm_phase<EpiDown, MoeSched<false>, false, true>(F.lds + LDS_STAGE, DEXP / 2, DEXP, DEXP, S, E);
                }
            }
            GRID_BAR();
            ym = ws + WS_YM;
        }
        if (layer < DEPTH - 1) combine_phase<false>(F, zB, stB, partin, P.in[I_L1G] + layer * DM, P.in[I_L1B] + layer * DM, ym, zA, stA, nullptr, nullptr, nullptr, (layer & 1) ? nullptr : ws + WS_ZA8);
        else combine_phase<true>(F, zB, stB, partin, P.in[I_L1G] + layer * DM, P.in[I_L1B] + layer * DM, ym, nullptr, nullptr, P.in[I_L2G] + layer * DM, P.in[I_L2B] + layer * DM, P.out, nullptr);
        if (layer < DEPTH - 1) GRID_BAR_L();
    }
}

extern "C" void kernel_launch(void* const* d_in, const int* in_sizes, int n_in, void* d_out, int out_size, void* d_ws, size_t ws_size, hipStream_t stream) {
    static int grid = 0;
    if (!grid) {
        if (n_in != 21 || out_size != T_TOK * DM || ws_size < WS_END) { fprintf(stderr, "kernel_launch: unexpected shapes (n_in %d out %d ws %zu need %zu)\n", n_in, out_size, ws_size, (size_t)WS_END); grid = -1; return; }
        int dev = 0, cus = 0, per_cu = 0;
        hipGetDevice(&dev); hipDeviceGetAttribute(&cus, hipDeviceAttributeMultiprocessorCount, dev);
        if (hipFuncSetAttribute((const void*)fwd_kernel, hipFuncAttributeMaxDynamicSharedMemorySize, LDS_BYTES) != hipSuccess) { fprintf(stderr, "kernel_launch: hipFuncSetAttribute failed\n"); grid = -1; return; }
        hipOccupancyMaxActiveBlocksPerMultiprocessor(&per_cu, (const void*)fwd_kernel, NTHREADS, LDS_BYTES);
        if (per_cu < 1) fprintf(stderr, "kernel_launch: occupancy query reports %d\n", per_cu);
        grid = 256;
        if (cus != 256) fprintf(stderr, "kernel_launch: %d CUs (built for 256)\n", cus);
    }
    if (grid <= 0) return;
    hipMemsetAsync((char*)d_ws + WS_CTL, 0, CTL_BYTES, stream);
    Params p{};
    for (int i = 0; i < 21; ++i) p.in[i] = (const float*)d_in[i];
    p.out = (float*)d_out; p.ws = (unsigned char*)d_ws; p.ph_lo = 0; p.ph_hi = 1000;
    hipLaunchKernelGGL(fwd_kernel, dim3(grid), dim3(NTHREADS), LDS_BYTES, stream, p);
}
```

```cpp
#include <hip/hip_runtime.h>
#include <cstdio>
#include <cstdint>

#define LAS __attribute__((address_space(3)))
#define GAS __attribute__((address_space(1)))
typedef unsigned short bf16_t;
typedef short bf16x8 __attribute__((ext_vector_type(8)));
typedef float f32x4 __attribute__((ext_vector_type(4)));
typedef float f32x2 __attribute__((ext_vector_type(2)));
typedef float f32x16 __attribute__((ext_vector_type(16)));
typedef unsigned u32x4 __attribute__((ext_vector_type(4)));
typedef unsigned u32x2 __attribute__((ext_vector_type(2)));

constexpr int T_TOK = 16384, DM = 1024, NBATCH = 8, SEQ = 2048, DEPTH = 4;
constexpr int NH = 16, KVL = 128, NIH = 8, IDXD = 64, TOPK = 256;
constexpr int AIW = 2760, AIWP = 2816;
constexpr int NGRP = 8, EPG = 8, NEXP = 64, DEXP = 256;
constexpr float LN_EPS = 1e-5f, RMS_EPS = 1e-6f;
constexpr float ALPHA = 1.6817928305074290f;
constexpr int NWAVES = 8, NTHREADS = 512;
constexpr int MAXBLK = 192;

constexpr size_t MiB = 1u << 20;
constexpr size_t alup(size_t x) { return (x + MiB - 1) & ~(MiB - 1); }
constexpr size_t WS_CTL = 0, CTL_BYTES = MiB;
constexpr size_t WS_VEC = WS_CTL + CTL_BYTES;
constexpr size_t WS_CSCI = WS_VEC + MiB;
constexpr size_t WS_BSCI = WS_CSCI + 2 * 3072 * 4;
constexpr size_t WS_CSAI = WS_BSCI + 2 * 3072 * 4;
constexpr size_t WS_BSAI = WS_CSAI + 2 * AIWP * 4;
constexpr size_t WS_CSR  = WS_BSAI + 2 * AIWP * 4;
constexpr size_t WS_BSR  = WS_CSR + 4 * 96 * 4;
constexpr size_t WS_CSUP = alup(WS_BSR + 4 * 96 * 4);
constexpr size_t WS_BSUP = WS_CSUP + (size_t)4 * 64 * 512 * 4;
constexpr size_t WS_WCI  = alup(WS_BSUP + (size_t)4 * 64 * 512 * 4);
constexpr size_t WS_WCO  = WS_WCI + (size_t)2 * 3072 * 1024 * 2;
constexpr size_t WS_WAI  = WS_WCO + (size_t)2 * 1024 * 1024 * 2;
constexpr size_t WS_WAO  = alup(WS_WAI + (size_t)2 * AIWP * 1024 * 2);
constexpr size_t WS_WR   = WS_WAO + (size_t)2 * 1024 * 2048 * 2;
constexpr size_t WS_WUP  = alup(WS_WR + (size_t)4 * 2 * 96 * 1024 * 2);
constexpr size_t WS_WDN  = WS_WUP + (size_t)4 * 64 * 512 * 1024 * 2;
constexpr size_t WS_ZA   = WS_WDN + (size_t)4 * 64 * 1024 * 256 * 2;
constexpr size_t WS_ZB   = WS_ZA + (size_t)T_TOK * DM * 2;
constexpr size_t WS_STA  = WS_ZB + (size_t)T_TOK * DM * 2;
constexpr size_t WS_STB  = WS_STA + (size_t)T_TOK * 8;
constexpr size_t WS_PART = alup(WS_STB + (size_t)T_TOK * 8);
constexpr size_t WS_U    = WS_PART + (size_t)T_TOK * 16 * 8;
constexpr size_t WS_BG   = WS_U + (size_t)T_TOK * DM * 2;
constexpr size_t WS_Y    = WS_BG + (size_t)T_TOK * DM * 2;
constexpr size_t WS_Q    = WS_Y + (size_t)T_TOK * DM * 2;
constexpr size_t WS_QI   = WS_Q + (size_t)T_TOK * 2048 * 2;
constexpr size_t WS_MISC = WS_QI + (size_t)T_TOK * 512 * 2;
constexpr size_t WS_CKV  = WS_MISC + (size_t)T_TOK * 256 * 4;
constexpr size_t WS_KI   = WS_CKV + (size_t)T_TOK * 128 * 2;
constexpr size_t WS_SEL  = WS_KI + (size_t)T_TOK * 64 * 2;
constexpr size_t WS_O    = WS_SEL + (size_t)T_TOK * 256 * 2;
constexpr size_t WS_LIST = WS_O + (size_t)T_TOK * 2048 * 2;
constexpr size_t WS_GATE = WS_LIST + (size_t)64 * 16384 * 4;
constexpr size_t WS_H    = alup(WS_GATE + (size_t)T_TOK * 8);
constexpr size_t WS_YM   = WS_H + (size_t)MAXBLK * 256 * 256 * 2;
constexpr size_t WS_CSP  = WS_YM + (size_t)T_TOK * 2 * DM * 2;
constexpr size_t WS_Z8   = WS_CSP + (size_t)2 * 32 * 4 * 64 * 512 * 4;
constexpr size_t WS_ZA8  = WS_Z8 + (size_t)T_TOK * DM;
constexpr size_t WS_END  = WS_ZA8 + (size_t)T_TOK * DM;

constexpr int CW_BAR = 4096;
constexpr int CW_CNT = 16384;
constexpr int CW_XCC = 8192;
constexpr int CW_QUEUE = 20480;
constexpr int CW_DONE = 24576;

constexpr int LDS_STAGE = 0, STAGE_BYTES_ALL = 131072;
constexpr int LDS_AUX = 131072;
constexpr int LDS_MISC = 131072 + 31744;
constexpr int LDS_BYTES = 163840;

__device__ __forceinline__ unsigned f2bf(float f) { unsigned u = __builtin_bit_cast(unsigned, f); return (u + 0x7fffu + ((u >> 16) & 1u)) >> 16; }
__device__ __forceinline__ float bf2f(unsigned b) { return __builtin_bit_cast(float, b << 16); }
__device__ __forceinline__ unsigned pk2(float lo, float hi) { return f2bf(lo) | (f2bf(hi) << 16); }
__device__ __forceinline__ float bflo(unsigned w) { return __builtin_bit_cast(float, w << 16); }
__device__ __forceinline__ float bfhi(unsigned w) { return __builtin_bit_cast(float, w & 0xffff0000u); }
__device__ __forceinline__ float shx(float v, int o, int lane) { return __builtin_bit_cast(float, __builtin_amdgcn_ds_bpermute((lane ^ o) << 2, __builtin_bit_cast(int, v))); }
__device__ __forceinline__ float dpp_f(float v, const int ctrl_sel) {
    const int x = __builtin_bit_cast(int, v);
    return __builtin_bit_cast(float, ctrl_sel == 0 ? __builtin_amdgcn_update_dpp(x, x, 0xB1, 0xF, 0xF, false)
                                   : ctrl_sel == 1 ? __builtin_amdgcn_update_dpp(x, x, 0x4E, 0xF, 0xF, false)
                                   : ctrl_sel == 2 ? __builtin_amdgcn_update_dpp(x, x, 0x141, 0xF, 0xF, false)
                                                   : __builtin_amdgcn_update_dpp(x, x, 0x140, 0xF, 0xF, false));
}
__device__ __forceinline__ float rows_sum(float v) {
    const unsigned a = __builtin_bit_cast(unsigned, v);
    const auto s16 = __builtin_amdgcn_permlane16_swap(a, a, false, false);
    const float m1 = __builtin_bit_cast(float, (unsigned)s16[0]) + __builtin_bit_cast(float, (unsigned)s16[1]);
    const unsigned b = __builtin_bit_cast(unsigned, m1);
    const auto s32 = __builtin_amdgcn_permlane32_swap(b, b, false, false);
    return __builtin_bit_cast(float, (unsigned)s32[0]) + __builtin_bit_cast(float, (unsigned)s32[1]);
}
__device__ __forceinline__ unsigned wave_incl_scan(unsigned v) {
    int x = (int)v;
    x += __builtin_amdgcn_update_dpp(0, x, 0x111, 0xF, 0xF, true);
    x += __builtin_amdgcn_update_dpp(0, x, 0x112, 0xF, 0xF, true);
    x += __builtin_amdgcn_update_dpp(0, x, 0x114, 0xF, 0xF, true);
    x += __builtin_amdgcn_update_dpp(0, x, 0x118, 0xF, 0xF, true);
    x += __builtin_amdgcn_update_dpp(0, x, 0x142, 0xA, 0xF, false);
    x += __builtin_amdgcn_update_dpp(0, x, 0x143, 0xC, 0xF, false);
    return (unsigned)x;
}
__device__ __forceinline__ float wave_sum(float v, int lane) {
    (void)lane;
    v += dpp_f(v, 0); v += dpp_f(v, 1); v += dpp_f(v, 2); v += dpp_f(v, 3);
    return rows_sum(v);
}
__device__ __forceinline__ void st16wt(void* p, const u32x4 v) { asm volatile("global_store_dwordx4 %0, %1, off sc1\n\ts_nop 1" :: "v"(p), "v"(v) : "memory"); }
typedef int i32x8 __attribute__((ext_vector_type(8)));
__device__ __forceinline__ unsigned pk4_fp8(float a, float b, float c, float d) { int w = 0; w = __builtin_amdgcn_cvt_pk_fp8_f32(a, b, w, false); w = __builtin_amdgcn_cvt_pk_fp8_f32(c, d, w, true); return (unsigned)w; }
__device__ __forceinline__ float fp8_rt(float a) { const int w = __builtin_amdgcn_cvt_pk_fp8_f32(a, a, 0, false); return __builtin_amdgcn_cvt_f32_fp8(w, 0); }
__device__ __forceinline__ void st8wt(void* p, const u32x2 v) { __hip_atomic_store((unsigned long long*)p, ((unsigned long long)v.y << 32) | v.x, __ATOMIC_RELAXED, __HIP_MEMORY_SCOPE_AGENT); }
#define LDS_WAIT() asm volatile("s_waitcnt lgkmcnt(0)" ::: "memory")
#define VM_WAIT() asm volatile("s_waitcnt vmcnt(0)" ::: "memory")

#define XB_TMO      128
#define XB_XCNT(j)  (256  + 64 * (j))
#define XB_XSUB(j)  (1280 + 64 * (j))
#define XB_XGEN(j)  (2304 + 64 * (j))
#define XB_TOP      3328
#define XB_TOPGEN   3392
#define XCD_BAR_WORDS 3456
#define XB_SPIN_CAP (1u << 18)

__device__ __forceinline__ unsigned xb_ld(unsigned* p)              { return __hip_atomic_load(p, __ATOMIC_RELAXED, __HIP_MEMORY_SCOPE_AGENT); }
__device__ __forceinline__ unsigned xb_add(unsigned* p, unsigned v) { return __hip_atomic_fetch_add(p, v, __ATOMIC_RELAXED, __HIP_MEMORY_SCOPE_AGENT); }
__device__ __forceinline__ unsigned xb_xcc_id() { return (unsigned)__builtin_amdgcn_s_getreg((3 << 11) | 20) & 0xFu; }
#define XB_SPIN(cond, bar) do { unsigned _sp = 0; while (cond) { __builtin_amdgcn_s_sleep(1); \
    if ((++_sp & 255u) == 0u) { if (xb_ld(&(bar)[XB_TMO])) break; if (_sp > XB_SPIN_CAP) { atomicAdd(&(bar)[XB_TMO], 1u); break; } } } } while (0)

struct XcdBarrier {
    unsigned* bar; unsigned x;
    volatile LAS unsigned* st;
};

__device__ __forceinline__ XcdBarrier xcd_barrier_post(unsigned* bar, volatile LAS unsigned* st) {
    XcdBarrier b; b.bar = bar; b.x = xb_xcc_id(); b.st = st;
    if (threadIdx.x == 0) (void)xb_add(&bar[XB_XCNT(b.x)], 1u);
    return b;
}
__device__ __forceinline__ void xcd_barrier_complete(unsigned* bar, unsigned x, unsigned& nloc, unsigned& nx) {
    const unsigned G = gridDim.x * gridDim.y * gridDim.z;
    unsigned sum, cnt, mine, sp = 0u;
    for (;;) {
        sum = 0u; cnt = 0u; mine = 0u;
#pragma unroll
        for (unsigned j = 0; j < 16; ++j) { const unsigned c = xb_ld(&bar[XB_XCNT(j)]); sum += c; cnt += (c > 0u) ? 1u : 0u; mine = (j == x) ? c : mine; }
        if (sum == G) break;
        __builtin_amdgcn_s_sleep(1);
        if ((++sp & 255u) == 0u) { if (xb_ld(&bar[XB_TMO])) break; if (sp > XB_SPIN_CAP) { atomicAdd(&bar[XB_TMO], 1u); break; } }
    }
    nloc = mine > 0u ? mine : 1u; nx = cnt > 0u ? cnt : 1u;
}

template <bool LOCAL = false>
__device__ __forceinline__ void xcd_barrier(const XcdBarrier& b_in) {
    XcdBarrier b = b_in; asm volatile("" : "+s"(b.bar), "+s"(b.x));
    asm volatile("s_waitcnt vmcnt(0)" ::: "memory");
    __syncthreads();
    if (threadIdx.x == 0) {
        unsigned* bar = b.bar;
        __builtin_amdgcn_s_waitcnt(0);
        unsigned nloc = b.st[0], nx = b.st[1];
        if (nloc == 0u) { xcd_barrier_complete(bar, b.x, nloc, nx); b.st[0] = nloc; b.st[1] = nx; }
        const unsigned old = xb_add(&bar[XB_XSUB(b.x)], 1u);
        const unsigned gen = old / nloc;
        if (old + 1u == (gen + 1u) * nloc) {
          if (!(LOCAL && b.st[2] != 0u)) {
            __builtin_amdgcn_fence(__ATOMIC_RELEASE, "agent");
            asm volatile("s_waitcnt vmcnt(0)" ::: "memory");
            const unsigned og = xb_add(&bar[XB_TOP], 1u);
            const unsigned tg = og / nx;
            if (og + 1u == (tg + 1u) * nx) xb_add(&bar[XB_TOPGEN], 1u);
            else XB_SPIN(xb_ld(&bar[XB_TOPGEN]) == tg, bar);
          }
            __builtin_amdgcn_fence(__ATOMIC_ACQUIRE, "agent");
            xb_add(&bar[XB_XGEN(b.x)], 1u);
            asm volatile("s_waitcnt vmcnt(0)" ::: "memory");
        } else {
            XB_SPIN(xb_ld(&bar[XB_XGEN(b.x)]) == gen, bar);
            __builtin_amdgcn_fence(__ATOMIC_ACQUIRE, "agent");
            asm volatile("s_waitcnt vmcnt(0)" ::: "memory");
        }
    }
    __syncthreads();
}

struct Params { const float* in[21]; float* out; unsigned char* ws; int ph_lo, ph_hi; };
enum { I_X = 0, I_CWIN, I_CK, I_CWOUT, I_AWIN, I_KVG, I_KIG, I_KIB, I_AWOUT, I_RELB, I_RWG, I_RBG, I_RWE, I_RBE, I_W1, I_W3, I_W2, I_L1G, I_L1B, I_L2G, I_L2B };

struct Frame {
    LAS unsigned char* lds;
    int G, bx;
    int batch, jb;
    unsigned char* ws;
};

__device__ __forceinline__ unsigned bf4_to_fp8(const u32x2 w) {
    return pk4_fp8(__builtin_bit_cast(float, w.x << 16), __builtin_bit_cast(float, w.x & 0xffff0000u), __builtin_bit_cast(float, w.y << 16), __builtin_bit_cast(float, w.y & 0xffff0000u));
}
template <bool F8 = false>
__device__ __forceinline__ void prol_item64(const float* W, int K, int ldw, int src0, int nvalid, const float* gk, const float* bk, float colscale,
                                            void* Btv, int ldbt, int n0, float* cs, float* bs, LAS unsigned char* scr, int lane) {
    const int kk = lane >> 4, c4 = lane & 15;
    float csum[4] = {0.f, 0.f, 0.f, 0.f}, bsum[4] = {0.f, 0.f, 0.f, 0.f};
    const bool cv = 4 * c4 < nvalid;
    const unsigned sbase = (unsigned)(size_t)scr;
    const unsigned q4 = (unsigned)(lane & 15) >> 2, p4 = (unsigned)lane & 3u;
    for (int k0 = 0; k0 < K; k0 += 64) {
        f32x4 v[16]; float gv[16], bv[16];
#pragma unroll
        for (int ld = 0; ld < 16; ++ld) { gv[ld] = gk ? gk[k0 + 4 * ld + kk] : 1.f; bv[ld] = bk ? bk[k0 + 4 * ld + kk] : 0.f; }
#pragma unroll
        for (int ld = 0; ld < 16; ++ld) v[ld] = cv ? *(const f32x4*)(W + (size_t)(k0 + 4 * ld + kk) * ldw + src0 + 4 * c4) : (f32x4){0.f, 0.f, 0.f, 0.f};
#pragma unroll
        for (int ld = 0; ld < 16; ++ld) {
            const float g = gv[ld] * colscale, bb = bv[ld] * colscale;
            unsigned h[4];
#pragma unroll
            for (int e = 0; e < 4; ++e) { if constexpr (F8) { const float r = fp8_rt(v[ld][e] * g); h[e] = __builtin_bit_cast(unsigned, r) >> 16; csum[e] += r; } else { h[e] = f2bf(v[ld][e] * g); csum[e] += bf2f(h[e]); } bsum[e] += v[ld][e] * bb; }
            *(LAS u32x2*)(scr + (4 * ld + kk) * 144 + c4 * 8) = (u32x2){h[0] | (h[1] << 16), h[2] | (h[3] << 16)};
        }
        LDS_WAIT(); asm volatile("" ::: "memory");
        u32x2 tr[4][2][2];
#pragma unroll
        for (int nt = 0; nt < 4; ++nt)
#pragma unroll
            for (int ch = 0; ch < 2; ++ch) {
                const unsigned a0 = sbase + (8u * (unsigned)(kk + 4 * ch) + q4) * 144u + (16u * nt + 4u * p4) * 2u, a1 = a0 + 4u * 144u;
                asm volatile("ds_read_b64_tr_b16 %0, %2\n\tds_read_b64_tr_b16 %1, %3" : "=&v"(tr[nt][ch][0]), "=&v"(tr[nt][ch][1]) : "v"(a0), "v"(a1) : "memory");
            }
        asm volatile("s_waitcnt lgkmcnt(0)" : "+v"(tr[0][0][0]), "+v"(tr[0][0][1]), "+v"(tr[0][1][0]), "+v"(tr[0][1][1]), "+v"(tr[1][0][0]), "+v"(tr[1][0][1]), "+v"(tr[1][1][0]), "+v"(tr[1][1][1]),
                     "+v"(tr[2][0][0]), "+v"(tr[2][0][1]), "+v"(tr[2][1][0]), "+v"(tr[2][1][1]), "+v"(tr[3][0][0]), "+v"(tr[3][0][1]), "+v"(tr[3][1][0]), "+v"(tr[3][1][1]) :: "memory");
#pragma unroll
        for (int nt = 0; nt < 4; ++nt)
#pragma unroll
            for (int ch = 0; ch < 2; ++ch) {
                if constexpr (F8) *(u32x2*)((unsigned char*)Btv + (size_t)(n0 + 16 * nt + (lane & 15)) * ldbt + k0 + 8 * (kk + 4 * ch)) = (u32x2){bf4_to_fp8(tr[nt][ch][0]), bf4_to_fp8(tr[nt][ch][1])};
                else { u32x4 o; o.x = tr[nt][ch][0].x; o.y = tr[nt][ch][0].y; o.z = tr[nt][ch][1].x; o.w = tr[nt][ch][1].y;
                    *(u32x4*)((bf16_t*)Btv + (size_t)(n0 + 16 * nt + (lane & 15)) * ldbt + k0 + 8 * (kk + 4 * ch)) = o; }
            }
    }
    if (cs) {
#pragma unroll
        for (int e = 0; e < 4; ++e) { csum[e] = rows_sum(csum[e]); bsum[e] = rows_sum(bsum[e]); }
        if (kk == 0) { *(f32x4*)(cs + n0 + 4 * c4) = (f32x4){csum[0], csum[1], csum[2], csum[3]}; *(f32x4*)(bs + n0 + 4 * c4) = (f32x4){bsum[0], bsum[1], bsum[2], bsum[3]}; }
    }
}

constexpr int PT_TILES = 3 * 4096, PT_GRAN = 2, PT_BUF = 50176;
struct PTile { const float* src; int ldw; unsigned char* bt; int ldbt; int kbase; int rowadd; int up; const float* gk; const float* bk; float* csp; };
__device__ __forceinline__ PTile pt_decode(const Params& P, unsigned char* ws, int T) {
    PTile t;
    if (T < 8192) { const int which = T >> 12, r = T & 4095, le = r >> 4, kt = r & 15, l = le >> 6;
        t.src = (which ? P.in[I_W3] : P.in[I_W1]) + (size_t)le * DM * DEXP + (size_t)kt * 64 * DEXP; t.ldw = DEXP; t.bt = ws + WS_WUP + (size_t)le * 512 * DM; t.ldbt = DM; t.kbase = 64 * kt;
        t.rowadd = 128 * which; t.up = 1; t.gk = P.in[I_L1G] + l * DM + 64 * kt; t.bk = P.in[I_L1B] + l * DM + 64 * kt; t.csp = (float*)(ws + WS_CSP) + ((size_t)kt * 256 + le) * 512;
    } else { const int r = T - 8192, le = r >> 4, kt = (r >> 2) & 3, nq = r & 3;
        t.src = P.in[I_W2] + (size_t)le * DEXP * DM + (size_t)kt * 64 * DM + 256 * nq; t.ldw = DM; t.bt = ws + WS_WDN + (size_t)le * DM * DEXP; t.ldbt = DEXP; t.kbase = 64 * kt;
        t.rowadd = 256 * nq; t.up = 0; t.gk = nullptr; t.bk = nullptr; t.csp = nullptr; }
    return t;
}
__device__ __forceinline__ void p0_expert_tiles(const Frame& F, const Params& P, int tid, int lane, int wave) {
    unsigned char* ws = F.ws;
    volatile LAS int* slot = (volatile LAS int*)(F.lds + LDS_MISC + 64);
    unsigned* qctr = (unsigned*)(ws + WS_CTL) + CW_QUEUE;
    if (tid == 0) { slot[0] = (int)atomicAdd(qctr, (unsigned)PT_GRAN); slot[1] = (int)atomicAdd(qctr, (unsigned)PT_GRAN); }
    __syncthreads();
    int g0 = slot[0], g1 = slot[1], par = 0;
    const unsigned g16 = (unsigned)lane >> 4, q4 = (unsigned)(lane & 15) >> 2, p4 = (unsigned)lane & 3u;
    f32x4 cur[PT_GRAN][8], nxt[PT_GRAN][8];
#define PT_LOAD(T, vv) do { const PTile _t = pt_decode(P, ws, (T)); _Pragma("unroll") for (int i = 0; i < 8; ++i) vv[i] = *(const f32x4*)(_t.src + (size_t)(8 * wave + i) * _t.ldw + 4 * lane); } while (0)
    if (g0 < PT_TILES) {
#pragma unroll
        for (int j = 0; j < PT_GRAN; ++j) PT_LOAD(g0 + j, cur[j]); }
    while (g0 < PT_TILES) {
        if (tid == 0) slot[2 + par] = (int)atomicAdd(qctr, (unsigned)PT_GRAN);
        if (g1 < PT_TILES) {
#pragma unroll
            for (int j = 0; j < PT_GRAN; ++j) PT_LOAD(g1 + j, nxt[j]); }
#pragma unroll
        for (int j = 0; j < PT_GRAN; ++j) {
            const PTile t = pt_decode(P, ws, g0 + j);
            LAS unsigned char* tile = F.lds + (j & 1) * PT_BUF;
            LAS float* part = (LAS float*)(F.lds + (j & 1) * PT_BUF + 33792);
            f32x4 pc = (f32x4){0.f, 0.f, 0.f, 0.f}, pb = (f32x4){0.f, 0.f, 0.f, 0.f};
#pragma unroll
            for (int i = 0; i < 8; ++i) {
                const float gvi = t.up ? t.gk[8 * wave + i] : 1.f, bvi = t.up ? t.bk[8 * wave + i] : 0.f;
                const int w8 = (int)pk4_fp8(cur[j][i][0] * gvi, cur[j][i][1] * gvi, cur[j][i][2] * gvi, cur[j][i][3] * gvi);
                const float r0 = __builtin_amdgcn_cvt_f32_fp8(w8, 0), r1 = __builtin_amdgcn_cvt_f32_fp8(w8, 1), r2 = __builtin_amdgcn_cvt_f32_fp8(w8, 2), r3 = __builtin_amdgcn_cvt_f32_fp8(w8, 3);
                pc[0] += r0; pc[1] += r1; pc[2] += r2; pc[3] += r3;
#pragma unroll
                for (int e = 0; e < 4; ++e) pb[e] += cur[j][i][e] * bvi;
                *(LAS u32x2*)(tile + (8 * wave + i) * 528 + lane * 8) = (u32x2){(__builtin_bit_cast(unsigned, r0) >> 16) | (__builtin_bit_cast(unsigned, r1) & 0xffff0000u),
                                                                                (__builtin_bit_cast(unsigned, r2) >> 16) | (__builtin_bit_cast(unsigned, r3) & 0xffff0000u)};
            }
            if (t.up) { *(LAS f32x4*)(part + wave * 256 + 4 * lane) = pc; *(LAS f32x4*)(part + 2048 + wave * 256 + 4 * lane) = pb; }
            __syncthreads();
            {
                u32x2 tr[2][4];
                const unsigned sbase = (unsigned)(size_t)tile;
#pragma unroll
                for (int jj = 0; jj < 2; ++jj)
#pragma unroll
                    for (int c = 0; c < 4; ++c) {
                        const unsigned a0 = sbase + (16u * g16 + 4u * c + q4) * 528u + (16u * (2 * wave + jj) + 4u * p4) * 2u;
                        asm volatile("ds_read_b64_tr_b16 %0, %1" : "=&v"(tr[jj][c]) : "v"(a0) : "memory");
                    }
                asm volatile("s_waitcnt lgkmcnt(0)" : "+v"(tr[0][0]), "+v"(tr[0][1]), "+v"(tr[0][2]), "+v"(tr[0][3]), "+v"(tr[1][0]), "+v"(tr[1][1]), "+v"(tr[1][2]), "+v"(tr[1][3]) :: "memory");
#pragma unroll
                for (int jj = 0; jj < 2; ++jj) {
                    const int n = 16 * (2 * wave + jj) + (lane & 15);
                    const int brow = t.up ? (n & 127) + 256 * (n >> 7) + t.rowadd : 128 * ((n >> 3) & 1) + 32 * (n >> 6) + 8 * ((n >> 4) & 3) + (n & 7) + t.rowadd;
                    u32x4 o; o.x = bf4_to_fp8(tr[jj][0]); o.y = bf4_to_fp8(tr[jj][1]); o.z = bf4_to_fp8(tr[jj][2]); o.w = bf4_to_fp8(tr[jj][3]);
                    *(u32x4*)(t.bt + (size_t)brow * t.ldbt + t.kbase + 16 * g16) = o;
                }
            }
            if (t.up && tid < 256) {
                float cs = part[tid], bs = part[2048 + tid];
#pragma unroll
                for (int w2 = 1; w2 < 8; ++w2) { cs += part[w2 * 256 + tid]; bs += part[2048 + w2 * 256 + tid]; }
                const int brow = (tid & 127) + 256 * (tid >> 7) + t.rowadd;
                t.csp[brow] = cs; t.csp[(size_t)32 * 4 * 64 * 512 + brow] = bs;
            }
        }
        g0 = g1; g1 = slot[2 + par]; par ^= 1;
#pragma unroll
        for (int j = 0; j < PT_GRAN; ++j)
#pragma unroll
            for (int i = 0; i < 8; ++i) cur[j][i] = nxt[j][i];
    }
    __syncthreads();
#undef PT_LOAD
}

__device__ __forceinline__ void p0_heavy_item(const Params& P, unsigned char* ws, int r, LAS unsigned char* scr, int lane) {
    constexpr int N_AO = 2 * 16 * 2, N_CI = 2 * 48, N_AI = 2 * 44;
    if (r < N_AO) {
        const int jl = r / 32, g = (r % 32) >> 1, kh = r & 1;
        prol_item64<true>(P.in[I_AWOUT] + (size_t)jl * 2048 * DM + (size_t)kh * 1024 * DM, 1024, DM, 64 * g, 64, nullptr, nullptr, 64.f,
                    ws + WS_WAO + (size_t)jl * DM * 2048 + kh * 1024, 2048, 64 * g, nullptr, nullptr, scr, lane);
        return; }
    r -= N_AO;
    if (r < N_CI) {
        const int jl = r / 48, g = r % 48, n0 = 64 * g;
        int src;
        if (n0 < 2048) { const int p = n0 >> 8, half = (n0 >> 7) & 1; src = (half ? 2048 : 1024) + 128 * p + (n0 & 127); } else src = n0 - 2048;
        const float* gk = jl ? P.in[I_L2G] + (2 * jl - 1) * DM : nullptr; const float* bk = jl ? P.in[I_L2B] + (2 * jl - 1) * DM : nullptr;
        prol_item64(P.in[I_CWIN] + (size_t)jl * DM * 3072, DM, 3072, src, 64, gk, bk, 1.f, (bf16_t*)(ws + WS_WCI) + (size_t)jl * 3072 * DM, DM, n0,
                    (float*)(ws + WS_CSCI) + jl * 3072, (float*)(ws + WS_BSCI) + jl * 3072, scr, lane);
        return; }
    r -= N_CI;
    if (r < N_AI) {
        const int jl = r / 44, g = r % 44, n0 = 64 * g;
        int src, nvalid = 64; float sc = 1.f;
        if (n0 < 2048) { src = n0; sc = 0.08838834764831845f; }
        else if (n0 < 2176) src = n0;
        else if (n0 < 2240) src = 2688;
        else if (n0 < 2304) { src = 2752; nvalid = 8; sc = 0.35355339059327373f; }
        else { src = 2176 + (n0 - 2304); sc = 0.125f; }
        if (n0 < 2048)
            prol_item64<true>(P.in[I_AWIN] + (size_t)jl * DM * AIW, DM, AIW, src, nvalid, P.in[I_L2G] + (2 * jl) * DM, P.in[I_L2B] + (2 * jl) * DM, 1.f,
                    ws + WS_WAI + (size_t)jl * AIWP * DM * 2, DM, n0, (float*)(ws + WS_CSAI) + jl * AIWP, (float*)(ws + WS_BSAI) + jl * AIWP, scr, lane);
        else
            prol_item64(P.in[I_AWIN] + (size_t)jl * DM * AIW, DM, AIW, src, nvalid, P.in[I_L2G] + (2 * jl) * DM, P.in[I_L2B] + (2 * jl) * DM, sc,
                    (bf16_t*)(ws + WS_WAI) + (size_t)jl * AIWP * DM, DM, n0, (float*)(ws + WS_CSAI) + jl * AIWP, (float*)(ws + WS_BSAI) + jl * AIWP, scr, lane);
        return; }
    r -= N_AI;
    {
        const int jl = r / 16, g = r % 16;
        prol_item64(P.in[I_CWOUT] + (size_t)jl * DM * DM, DM, DM, 64 * g, 64, nullptr, nullptr, 1.f, (bf16_t*)(ws + WS_WCO) + (size_t)jl * DM * DM, DM, 64 * g, nullptr, nullptr, scr, lane);
    }
}

__device__ __forceinline__ void p0_prologue(const Frame& F, const Params& P) {
    int tid = threadIdx.x; asm volatile("" : "+v"(tid)); const int lane = tid & 63, wave = __builtin_amdgcn_readfirstlane(tid >> 6);
    LAS unsigned char* scr = F.lds + LDS_STAGE + wave * 16896;
    const int gw = F.bx * NWAVES + wave, NGW = F.G * NWAVES;
    unsigned char* ws = F.ws;
    constexpr int N_DENSE = 2 * 16 * 2 + 2 * 48 + 2 * 44 + 2 * 16;
    if (gw < N_DENSE) p0_heavy_item(P, ws, gw, scr, lane);
    __syncthreads();
    p0_expert_tiles(F, P, tid, lane, wave);
    if (gw < 4 * 96) {
        const int l = gw / 96, n = gw % 96;
        const int ks = lane >> 1, fq0 = 2 * (lane & 1), nt = n >> 4;
        bf16_t* hi = (bf16_t*)(ws + WS_WR) + ((((size_t)(l * 32 + ks) * 2 + 0) * 6 + nt) * 64 + (n & 15) + 16 * fq0) * 8; bf16_t* lo = hi + (size_t)6 * 64 * 8;
        float csum = 0.f, bsum = 0.f; unsigned hw[8], lw[8];
        if (n < 72) {
            const float* Wc = n < 8 ? P.in[I_RWG] + (size_t)l * DM * 8 + n : P.in[I_RWE] + (size_t)l * DM * 64 + (n - 8); const int ldw = n < 8 ? 8 : 64;
            float w[16], g[16], b[16];
#pragma unroll
            for (int i = 0; i < 16; ++i) w[i] = Wc[(size_t)(16 * lane + i) * ldw];
#pragma unroll
            for (int i = 0; i < 4; ++i) { const f32x4 g4 = *(const f32x4*)(P.in[I_L1G] + l * DM + 16 * lane + 4 * i), b4 = *(const f32x4*)(P.in[I_L1B] + l * DM + 16 * lane + 4 * i);
#pragma unroll
                for (int e = 0; e < 4; ++e) { g[4 * i + e] = g4[e]; b[4 * i + e] = b4[e]; } }
            unsigned hb[16], lb[16];
#pragma unroll
            for (int i = 0; i < 16; ++i) { const float wf = w[i] * g[i]; hb[i] = f2bf(wf); const float h = bf2f(hb[i]); lb[i] = f2bf(wf - h); csum += h + bf2f(lb[i]); bsum += w[i] * b[i]; }
#pragma unroll
            for (int i = 0; i < 8; ++i) { hw[i] = hb[2 * i] | (hb[2 * i + 1] << 16); lw[i] = lb[2 * i] | (lb[2 * i + 1] << 16); }
        } else {
#pragma unroll
            for (int i = 0; i < 8; ++i) { hw[i] = 0u; lw[i] = 0u; }
        }
        *(u32x4*)hi = (u32x4){hw[0], hw[1], hw[2], hw[3]}; *(u32x4*)(hi + 16 * 8) = (u32x4){hw[4], hw[5], hw[6], hw[7]};
        *(u32x4*)lo = (u32x4){lw[0], lw[1], lw[2], lw[3]}; *(u32x4*)(lo + 16 * 8) = (u32x4){lw[4], lw[5], lw[6], lw[7]};
        csum = wave_sum(csum, lane); bsum = wave_sum(bsum, lane);
        if (lane == 0) { ((float*)(ws + WS_CSR))[l * 96 + n] = csum; ((float*)(ws + WS_BSR))[l * 96 + n] = bsum; }
    }
    for (int m0 = gw; m0 < T_TOK; m0 += 4 * NGW) {
        f32x4 xv[4][4];
#pragma unroll
        for (int r = 0; r < 4; ++r) { const GAS f32x4* xr = (const GAS f32x4*)(P.in[I_X] + (size_t)(m0 + r * NGW) * DM) + lane;
#pragma unroll
            for (int q = 0; q < 4; ++q) xv[r][q] = xr[64 * q]; }
#pragma unroll
        for (int r = 0; r < 4; ++r) { const int m = m0 + r * NGW;
            GAS u32x2* o = (GAS u32x2*)((bf16_t*)(ws + WS_ZA) + (size_t)m * DM) + lane;
#pragma unroll
            for (int q = 0; q < 4; ++q) { const f32x4 v = xv[r][q]; u32x2 w; w.x = pk2(v.x, v.y); w.y = pk2(v.z, v.w); o[64 * q] = w; }
            if (lane == 0) { float* st = (float*)(ws + WS_STA) + 2 * m; st[0] = 0.f; st[1] = 1.f; } }
    }
    if (F.bx == 0) { float* v = (float*)(ws + WS_VEC); for (int i = tid; i < 2048; i += NTHREADS) v[i] = i < 1024 ? 1.f : 0.f; }
}

__device__ __forceinline__ f32x2 stats_from_part(const float* part, int row);
template <bool FINAL>
__device__ __forceinline__ void combine_phase(const Frame& F, const bf16_t* zin, const float* stin, const float* partin, const float* g, const float* b, const unsigned char* y,
                                              bf16_t* zout, float* stout, const float* gout, const float* bout, float* out, unsigned char* z8out) {
    int tid = threadIdx.x; asm volatile("" : "+v"(tid)); const int lane = tid & 63, wave = __builtin_amdgcn_readfirstlane(tid >> 6); (void)lane; (void)wave;
    const int row0 = 2048 * F.batch + 64 * F.jb + 8 * wave;
    const int c0 = 8 * lane;
    float gv[2][8], bv[2][8];
#pragma unroll
    for (int j2 = 0; j2 < 2; ++j2) {
        const f32x4 g0 = *(const f32x4*)(g + c0 + 512 * j2), g1 = *(const f32x4*)(g + c0 + 512 * j2 + 4), b0 = *(const f32x4*)(b + c0 + 512 * j2), b1 = *(const f32x4*)(b + c0 + 512 * j2 + 4);
#pragma unroll
        for (int e = 0; e < 4; ++e) { gv[j2][e] = g0[e]; gv[j2][4 + e] = g1[e]; bv[j2][e] = b0[e]; bv[j2][4 + e] = b1[e]; }
    }
    for (int r2 = 0; r2 < 8; r2 += 8) {
      u32x4 zws[8][2]; u32x2 yws[8][2][2]; f32x2 sts[8];
#pragma unroll
      for (int rr = 0; rr < 8; ++rr) { const int row = row0 + r2 + rr;
          sts[rr] = partin ? stats_from_part(partin, row) : *(const f32x2*)(stin + 2 * row);
#pragma unroll
          for (int j2 = 0; j2 < 2; ++j2) { zws[rr][j2] = *(const u32x4*)(zin + (size_t)row * DM + c0 + 512 * j2);
              if (y) {
#pragma unroll
                  for (int sl = 0; sl < 2; ++sl) yws[rr][j2][sl] = *(const u32x2*)(y + ((size_t)row * 2 + sl) * DM + c0 + 512 * j2); } } }
#pragma unroll
      for (int rr = 0; rr < 8; ++rr) {
        const int row = row0 + r2 + rr;
        const f32x2 st = sts[rr];
        float v[2][8]; float s = 0.f;
#pragma unroll
        for (int j2 = 0; j2 < 2; ++j2) {
            const u32x4 zw = zws[rr][j2];
            float z[8] = {bflo(zw.x), bfhi(zw.x), bflo(zw.y), bfhi(zw.y), bflo(zw.z), bfhi(zw.z), bflo(zw.w), bfhi(zw.w)};
            float acc[8];
#pragma unroll
            for (int e = 0; e < 8; ++e) acc[e] = ALPHA * ((z[e] - st.x) * st.y * gv[j2][e] + bv[j2][e]);
            if (y) {
#pragma unroll
                for (int sl = 0; sl < 2; ++sl) {
                    const u32x2 yw = yws[rr][j2][sl];
                    acc[0] += 0.0625f * __builtin_amdgcn_cvt_f32_fp8((int)yw.x, 0); acc[1] += 0.0625f * __builtin_amdgcn_cvt_f32_fp8((int)yw.x, 1); acc[2] += 0.0625f * __builtin_amdgcn_cvt_f32_fp8((int)yw.x, 2); acc[3] += 0.0625f * __builtin_amdgcn_cvt_f32_fp8((int)yw.x, 3);
                    acc[4] += 0.0625f * __builtin_amdgcn_cvt_f32_fp8((int)yw.y, 0); acc[5] += 0.0625f * __builtin_amdgcn_cvt_f32_fp8((int)yw.y, 1); acc[6] += 0.0625f * __builtin_amdgcn_cvt_f32_fp8((int)yw.y, 2); acc[7] += 0.0625f * __builtin_amdgcn_cvt_f32_fp8((int)yw.y, 3);
                }
            }
            if (!FINAL) {
#pragma unroll
                for (int e = 0; e < 8; ++e) acc[e] = bf2f(f2bf(acc[e]));
            }
#pragma unroll
            for (int e = 0; e < 8; ++e) { v[j2][e] = acc[e]; s += acc[e]; }
        }
        const float mean = wave_sum(s, lane) * (1.f / DM);
        float s2 = 0.f;
#pragma unroll
        for (int j2 = 0; j2 < 2; ++j2)
#pragma unroll
            for (int e = 0; e < 8; ++e) { const float d = v[j2][e] - mean; s2 += d * d; }
        const float rstd = 1.f / sqrtf(wave_sum(s2, lane) * (1.f / DM) + LN_EPS);
        if (!FINAL) {
#pragma unroll
            for (int j2 = 0; j2 < 2; ++j2) {
                u32x4 o; o.x = pk2(v[j2][0], v[j2][1]); o.y = pk2(v[j2][2], v[j2][3]); o.z = pk2(v[j2][4], v[j2][5]); o.w = pk2(v[j2][6], v[j2][7]);
                *(u32x4*)(zout + (size_t)row * DM + c0 + 512 * j2) = o;
                if (z8out) *(u32x2*)(z8out + (size_t)row * DM + c0 + 512 * j2) = (u32x2){pk4_fp8(v[j2][0], v[j2][1], v[j2][2], v[j2][3]), pk4_fp8(v[j2][4], v[j2][5], v[j2][6], v[j2][7])};
            }
            if (lane == 0) { *(f32x2*)(stout + 2 * row) = (f32x2){mean, rstd}; }
        } else {
#pragma unroll
            for (int j2 = 0; j2 < 2; ++j2) {
                const f32x4 g0 = *(const f32x4*)(gout + c0 + 512 * j2), g1 = *(const f32x4*)(gout + c0 + 512 * j2 + 4), b0 = *(const f32x4*)(bout + c0 + 512 * j2), b1 = *(const f32x4*)(bout + c0 + 512 * j2 + 4);
                f32x4 o0, o1;
#pragma unroll
                for (int e = 0; e < 4; ++e) { o0[e] = (v[j2][e] - mean) * rstd * g0[e] + b0[e]; o1[e] = (v[j2][4 + e] - mean) * rstd * g1[e] + b1[e]; }
                *(f32x4*)(out + (size_t)row * DM + c0 + 512 * j2) = o0; *(f32x4*)(out + (size_t)row * DM + c0 + 512 * j2 + 4) = o1;
            }
        }
      }
    }
}

namespace pg8 {
constexpr int BM = 256, BK = 64, HALF = 128, HTB = HALF * BK * 2, STAGE_BYTES = 8 * HTB, NXCD = 8, WGM = 8;
__host__ __device__ __forceinline__ int lds_byte(int r, int c) { const int st = (r >> 4) * 2 + (c >> 5), rr = r & 15, cc = c & 31, ob = rr * 64 + cc * 2; return st * 1024 + (ob ^ (((ob >> 9) & 1) << 5)); }
__host__ __device__ __forceinline__ void stage_rc(int b, int& R, int& C) { const int st = b / 1024, sb = b % 1024, swz = sb ^ (((sb >> 9) & 1) << 5); R = (st >> 1) * 16 + swz / 64; C = (st & 1) * 32 + (swz % 64) / 2; }
__host__ __device__ __forceinline__ int perm32(int rho) { const int n = rho >> 4, i = rho & 15; return 8 * (i >> 2) + 4 * n + (i & 3); }

struct Unit { const char* A; const char* B; int pm, pn, x0, x1; };

struct StaticOrder {
    int nM, nN, nwg, G, c; const char* A; const char* B; size_t astep, bstep;
    __device__ void init(int M, int N, int G_, int c_, const void* A_, size_t lda_bytes, const void* B_, size_t ldb_bytes) { nM = M / BM; nN = N / BM; nwg = nM * nN; G = G_; c = c_; A = (const char*)A_; B = (const char*)B_; astep = lda_bytes * BM; bstep = ldb_bytes * BM; }
    __device__ bool next(int i, Unit& u) const {
        const long L = (long)i * G + c; if (L >= nwg) return false;
        int wgid = (int)L; { const int q = nwg / NXCD, r = nwg % NXCD, xcd = wgid % NXCD, off = wgid / NXCD; wgid = (xcd < r ? xcd * (q + 1) : r * (q + 1) + (xcd - r) * q) + off; }
        const int nig = WGM * nN, gid = wgid / nig, fm = gid * WGM, gsz = (nM - fm) < WGM ? (nM - fm) : WGM;
        u.pm = fm + ((wgid % nig) % gsz); u.pn = (wgid % nig) / gsz; u.A = A + (size_t)u.pm * astep; u.B = B + (size_t)u.pn * bstep; u.x0 = 0; u.x1 = 0; return true;
    }
    __device__ __forceinline__ const LAS unsigned* rowoff(int) const { return nullptr; }
    __device__ __forceinline__ void a_ready(const Unit&) const {}
};

__device__ __forceinline__ unsigned cvt_pk_bf16(float lo, float hi) { unsigned r; asm volatile("v_cvt_pk_bf16_f32 %0, %1, %2" : "=v"(r) : "v"(lo), "v"(hi)); return r; }

template <class Epi, class Sched, bool GATHER, bool FP8 = false>
__device__ __forceinline__ void gemm_phase(LAS unsigned char* lds, const int K, const unsigned lda_bytes, const unsigned ldb_bytes, const Sched& S, const Epi& E, const int b_e8m0 = 127) {
    int tid = threadIdx.x; asm volatile("" : "+v"(tid));
    const int wid = __builtin_amdgcn_readfirstlane(tid >> 6), lane = tid & 63, wr = wid >> 2, wc = wid & 3, fr = lane & 15, fq = lane >> 4;
    int nt = K / BK; asm volatile("" : "+s"(nt));
    unsigned voffA[2], voffB[2];
#pragma unroll
    for (int i = 0; i < 2; ++i) { int R, C; stage_rc(tid * 16 + i * 8192, R, C); const int Rb = (R & ~31) + perm32(R & 31);
        voffA[i] = (unsigned)R * lda_bytes + (unsigned)C * 2u; voffB[i] = (unsigned)Rb * ldb_bytes + (unsigned)C * 2u; }
#define PG8_GOFF(dst, ro) do { int _t = threadIdx.x; asm volatile("" : "+v"(_t)); _Pragma("unroll") for (int _i = 0; _i < 2; ++_i) { int _R, _C; stage_rc(_t * 16 + _i * 8192, _R, _C); \
        _Pragma("unroll") for (int _h = 0; _h < 2; ++_h) dst[_h][_i] = (ro)[_h * HALF + _R] + (unsigned)_C * 2u; } } while (0)
    const size_t kstep = (size_t)(BK * 2);
    const size_t hstepA = (size_t)HALF * lda_bytes, hstepB = (size_t)HALF * ldb_bytes;
    const unsigned ldsw = (unsigned)wid * 1024u;
    const int aoff = lds_byte(wr * 64 + fr, fq * 8), boff = lds_byte(wc * 32 + fr, fq * 8);
#define PG8_SA(b, h) (((b) * 2 + (h)) * HTB)
#define PG8_SB(b, h) ((4 + (b) * 2 + (h)) * HTB)
#define PG8_GLDS(src, bufoff, i) __builtin_amdgcn_global_load_lds((const unsigned*)(src), (LAS unsigned*)(lds + (bufoff) + ldsw + (i) * 8192), 16, 0, 0)
#define PG8_STAGE_B(bufoff, gbase) do { _Pragma("unroll") for (int _i = 0; _i < 2; ++_i) PG8_GLDS((const char*)(gbase) + voffB[_i], bufoff, _i); } while (0)
#define PG8_STAGE_A(bufoff, gbase, h, GO) do { _Pragma("unroll") for (int _i = 0; _i < 2; ++_i) { \
        if constexpr (GATHER) PG8_GLDS((const char*)(gbase) + (GO)[h][_i], bufoff, _i); else PG8_GLDS((const char*)(gbase) + (h) * hstepA + voffA[_i], bufoff, _i); } } while (0)
#define PG8_LDA(dst, b, h) do { _Pragma("unroll") for (int m = 0; m < 4; ++m) _Pragma("unroll") for (int k = 0; k < 2; ++k) dst[m][k] = *(const LAS bf16x8*)(lds + PG8_SA(b, h) + aoff + m * 2048 + k * 1024); } while (0)
#define PG8_LDB(dst, b, h) do { _Pragma("unroll") for (int n = 0; n < 2; ++n) _Pragma("unroll") for (int k = 0; k < 2; ++k) dst[n][k] = *(const LAS bf16x8*)(lds + PG8_SB(b, h) + boff + n * 2048 + k * 1024); } while (0)
#define PG8_MMA(ai, bj, At, Bt) do { __builtin_amdgcn_s_setprio(1); _Pragma("unroll") for (int m = 0; m < 4; ++m) _Pragma("unroll") for (int n = 0; n < 2; ++n) { \
        if constexpr (FP8) { const u32x4 b0 = __builtin_bit_cast(u32x4, Bt[n][0]), b1 = __builtin_bit_cast(u32x4, Bt[n][1]), a0 = __builtin_bit_cast(u32x4, At[m][0]), a1 = __builtin_bit_cast(u32x4, At[m][1]); \
            const i32x8 vb = {(int)b0.x, (int)b0.y, (int)b0.z, (int)b0.w, (int)b1.x, (int)b1.y, (int)b1.z, (int)b1.w}, va = {(int)a0.x, (int)a0.y, (int)a0.z, (int)a0.w, (int)a1.x, (int)a1.y, (int)a1.z, (int)a1.w}; \
            asm volatile("v_mfma_scale_f32_16x16x128_f8f6f4 %0, %1, %2, %0, %3, %4 op_sel_hi:[0,0,0]" : "+v"(acc[ai][bj][m][n]) : "v"(vb), "v"(va), "v"(fp8_bscale), "v"(fp8_scale)); } \
        else { _Pragma("unroll") for (int k = 0; k < 2; ++k) acc[ai][bj][m][n] = __builtin_amdgcn_mfma_f32_16x16x32_bf16(Bt[n][k], At[m][k], acc[ai][bj][m][n], 0, 0, 0); } } \
        __builtin_amdgcn_s_setprio(0); } while (0)
#define PG8_WAIT_V(n) asm volatile("s_waitcnt vmcnt(" #n ")" ::: "memory")
#define PG8_WAIT_L(n) asm volatile("s_waitcnt lgkmcnt(" #n ")" ::: "memory")
#define PG8_BAR __builtin_amdgcn_s_barrier()
#define PG8_SCHED __builtin_amdgcn_sched_barrier(0)
    Unit cur, nxt; int ui = 0;
    if (!S.next(0, cur)) return;
    int fp8_scale = 0x7F7F7F7F; asm volatile("" : "+v"(fp8_scale));
    int fp8_bscale = b_e8m0 * 0x01010101; asm volatile("" : "+v"(fp8_bscale));
    (void)fp8_scale; (void)fp8_bscale;
    f32x4 acc[2][2][4][2];
#pragma unroll
    for (int a = 0; a < 2; ++a)
#pragma unroll
        for (int b = 0; b < 2; ++b)
#pragma unroll
            for (int m = 0; m < 4; ++m)
#pragma unroll
                for (int n = 0; n < 2; ++n) acc[a][b][m][n] = (f32x4){0.f, 0.f, 0.f, 0.f};
    bf16x8 At[4][2], B0[2][2], B1[2][2];
    unsigned cG[2][2] = {{0u, 0u}, {0u, 0u}};
    if constexpr (GATHER) { const LAS unsigned* ro = S.rowoff(0); PG8_GOFF(cG, ro); }
    const char* cA = cur.A; const char* cB = cur.B;
    int eslot = 0;
    E.prefetch(cur, 0, wid, lane);
    S.a_ready(cur);
    PG8_STAGE_B(PG8_SB(0, 0), cB); PG8_STAGE_B(PG8_SB(0, 1), cB + hstepB); PG8_STAGE_A(PG8_SA(0, 0), cA, 0, cG); PG8_STAGE_A(PG8_SA(0, 1), cA, 1, cG);
    if (wr == 1) PG8_BAR;
    PG8_WAIT_V(2); PG8_BAR;
    PG8_STAGE_B(PG8_SB(1, 0), cB + kstep); PG8_STAGE_A(PG8_SA(1, 0), cA + kstep, 0, cG); PG8_STAGE_B(PG8_SB(1, 1), cB + hstepB + kstep);
    PG8_WAIT_V(6); PG8_BAR;
    for (;;) {
        const bool has_next = S.next(ui + 1, nxt);
        const int nslot = eslot == 2 ? 0 : eslot + 1;
        if (has_next) E.prefetch(nxt, nslot, wid, lane);
        const char* nA = has_next ? nxt.A : cA; const char* nB = has_next ? nxt.B : cB;
        for (int t = 0; t < nt; t += 2) {
            const bool last = (t == nt - 2);
            if (last && has_next) S.a_ready(nxt);
            const char* a1 = cA + (size_t)(t + 1) * kstep;
            const char* a2 = last ? nA : cA + (size_t)(t + 2) * kstep; const char* b2 = last ? nB : cB + (size_t)(t + 2) * kstep;
            const char* a3 = a2 + kstep; const char* b3 = b2 + kstep;
            unsigned g2[2][2] = {{0u, 0u}, {0u, 0u}};
            if constexpr (GATHER) { const LAS unsigned* ro = S.rowoff((last && has_next) ? ui + 1 : ui); PG8_GOFF(g2, ro); }
            PG8_LDB(B0, 0, 0); PG8_LDB(B1, 0, 1); PG8_SCHED; PG8_LDA(At, 0, 0); PG8_STAGE_A(PG8_SA(1, 1), a1, 1, cG);
            PG8_WAIT_V(8); PG8_WAIT_L(0); PG8_BAR; PG8_MMA(0, 0, At, B0); PG8_MMA(0, 1, At, B1); PG8_BAR; PG8_SCHED;
            PG8_LDA(At, 0, 1); PG8_STAGE_B(PG8_SB(0, 0), b2); PG8_STAGE_B(PG8_SB(0, 1), b2 + hstepB); PG8_STAGE_A(PG8_SA(0, 0), a2, 0, g2);
            PG8_WAIT_V(8); PG8_WAIT_L(0); PG8_BAR; PG8_MMA(1, 0, At, B0); PG8_MMA(1, 1, At, B1); PG8_BAR; PG8_SCHED;
            PG8_LDB(B0, 1, 0); PG8_LDB(B1, 1, 1); PG8_SCHED; PG8_LDA(At, 1, 0); PG8_STAGE_A(PG8_SA(0, 1), a2, 1, g2);
            PG8_WAIT_V(8); PG8_WAIT_L(0); PG8_BAR; PG8_MMA(0, 0, At, B0); PG8_MMA(0, 1, At, B1); PG8_BAR; PG8_SCHED;
            PG8_LDA(At, 1, 1); PG8_STAGE_B(PG8_SB(1, 0), b3); PG8_STAGE_B(PG8_SB(1, 1), b3 + hstepB); PG8_STAGE_A(PG8_SA(1, 0), a3, 0, g2);
            PG8_WAIT_V(8); PG8_WAIT_L(0); PG8_BAR; PG8_MMA(1, 0, At, B0); PG8_MMA(1, 1, At, B1); PG8_BAR; PG8_SCHED;
        }
        if constexpr (FP8) asm volatile("s_nop 15\n\ts_nop 15\n\ts_nop 7" ::: "memory");
        if (wr == 0) PG8_BAR;
        E(acc, cur, ui, wr, wc, fr, fq, eslot);
        if (!has_next) break;
#pragma unroll
        for (int a = 0; a < 2; ++a)
#pragma unroll
            for (int b = 0; b < 2; ++b)
#pragma unroll
                for (int m = 0; m < 4; ++m)
#pragma unroll
                    for (int n = 0; n < 2; ++n) acc[a][b][m][n] = (f32x4){0.f, 0.f, 0.f, 0.f};
        cur = nxt; cA = nA; cB = nB; ++ui; eslot = nslot;
        if constexpr (GATHER) { const LAS unsigned* ro = S.rowoff(ui); PG8_GOFF(cG, ro); }
        if (wr == 1) PG8_BAR;
    }
    PG8_WAIT_V(0);
    PG8_BAR;
#undef PG8_SA
#undef PG8_SB
#undef PG8_GLDS
#undef PG8_GOFF
#undef PG8_STAGE_A
#undef PG8_STAGE_B
#undef PG8_LDA
#undef PG8_LDB
#undef PG8_MMA
#undef PG8_WAIT_V
#undef PG8_WAIT_L
#undef PG8_BAR
#undef PG8_SCHED
}
}

__device__ __forceinline__ void ld8(const float* p, float (&v)[8]) { const f32x4 a = *(const f32x4*)p, b = *(const f32x4*)(p + 4); v[0] = a.x; v[1] = a.y; v[2] = a.z; v[3] = a.w; v[4] = b.x; v[5] = b.y; v[6] = b.z; v[7] = b.w; }
__device__ __forceinline__ void unpack8(const u32x4 w, float (&v)[8]) { v[0] = bflo(w.x); v[1] = bfhi(w.x); v[2] = bflo(w.y); v[3] = bfhi(w.y); v[4] = bflo(w.z); v[5] = bfhi(w.z); v[6] = bflo(w.w); v[7] = bfhi(w.w); }
__device__ __forceinline__ u32x4 pack8(const float (&v)[8]) { u32x4 o; o.x = pg8::cvt_pk_bf16(v[0], v[1]); o.y = pg8::cvt_pk_bf16(v[2], v[3]); o.z = pg8::cvt_pk_bf16(v[4], v[5]); o.w = pg8::cvt_pk_bf16(v[6], v[7]); return o; }

__device__ __forceinline__ void ld8l(const LAS float* p, float (&v)[8]) { const f32x4 a = *(const LAS f32x4*)p, b = *(const LAS f32x4*)(p + 4); v[0] = a.x; v[1] = a.y; v[2] = a.z; v[3] = a.w; v[4] = b.x; v[5] = b.y; v[6] = b.z; v[7] = b.w; }
__device__ __forceinline__ void epi_prefetch(LAS unsigned char* dst, const float* st256, const float* cs256, const float* bs256, int wid, int lane) {
    if (wid < 4) { const char* src = wid < 2 ? (const char*)st256 + wid * 1024 : (wid == 2 ? (const char*)cs256 : (const char*)bs256); int t = threadIdx.x; asm volatile("" : "+v"(t)); (void)lane;
        __builtin_amdgcn_global_load_lds((const unsigned*)(src + (t & 63) * 16), (LAS unsigned*)(dst + wid * 1024), 16, 0, 0); }
}
struct EpiConvIn {
    const float* st; const float* cs; const float* bs; bf16_t* u; bf16_t* bg; LAS unsigned char* aux;
    __device__ __forceinline__ void prefetch(const pg8::Unit& un, int slot, int wid, int lane) const { epi_prefetch(aux + slot * 4096, st + 2 * 256 * un.pm, cs + 256 * un.pn, bs + 256 * un.pn, wid, lane); }
    __device__ __forceinline__ void operator()(const f32x4 (&acc)[2][2][4][2], const pg8::Unit& un, int, int wr, int wc, int fr, int fq, int slot) const {
        const int colL = 32 * wc + 8 * fq;
        const LAS unsigned char* ep = aux + slot * 4096;
        float csv[2][8], bsv[2][8];
        ld8l((const LAS float*)(ep + 2048) + colL, csv[0]); ld8l((const LAS float*)(ep + 2048) + colL + 128, csv[1]); ld8l((const LAS float*)(ep + 3072) + colL, bsv[0]); ld8l((const LAS float*)(ep + 3072) + colL + 128, bsv[1]);
        f32x2 sv[2][4];
#pragma unroll
        for (int ai = 0; ai < 2; ++ai)
#pragma unroll
            for (int m = 0; m < 4; ++m) sv[ai][m] = ((const LAS f32x2*)ep)[128 * ai + 64 * wr + 16 * m + fr];
#pragma unroll
        for (int ai = 0; ai < 2; ++ai)
#pragma unroll
            for (int m = 0; m < 4; ++m) {
                const int row = 256 * un.pm + 128 * ai + 64 * wr + 16 * m + fr;
                const f32x2 s = sv[ai][m];
                float f[2][8];
#pragma unroll
                for (int bj = 0; bj < 2; ++bj)
#pragma unroll
                    for (int e = 0; e < 8; ++e) f[bj][e] = s.y * (acc[ai][bj][m][e >> 2][e & 3] - s.x * csv[bj][e]) + bsv[bj][e];
                if (un.pn < 8) {
                    float p[8];
#pragma unroll
                    for (int e = 0; e < 8; ++e) p[e] = f[0][e] * f[1][e];
                    *(u32x4*)(u + (size_t)row * DM + 128 * un.pn + colL) = pack8(p);
                } else {
                    *(u32x4*)(bg + (size_t)row * DM + 256 * (un.pn - 8) + colL) = pack8(f[0]);
                    *(u32x4*)(bg + (size_t)row * DM + 256 * (un.pn - 8) + 128 + colL) = pack8(f[1]);
                }
            }
    }
};

struct EpiRes {
    const bf16_t* zprev; const float* stprev; const float* gprev; const float* bprev; bf16_t* zout; float* part; unsigned char* z8;
    __device__ __forceinline__ void prefetch(const pg8::Unit&, int, int, int) const {}
    __device__ __forceinline__ void operator()(const f32x4 (&acc)[2][2][4][2], const pg8::Unit& un, int, int wr, int wc, int fr, int fq, int) const {
        const int cb = 256 * un.pn + 32 * wc + 8 * fq;
        float gv[2][8], bv[2][8];
        ld8(gprev + cb, gv[0]); ld8(gprev + cb + 128, gv[1]); ld8(bprev + cb, bv[0]); ld8(bprev + cb + 128, bv[1]);
#pragma unroll
        for (int ai = 0; ai < 2; ++ai) {
            f32x2 sv[4]; u32x4 zw[4][2];
#pragma unroll
            for (int m = 0; m < 4; ++m) { const int row = 256 * un.pm + 128 * ai + 64 * wr + 16 * m + fr; sv[m] = *(const f32x2*)(stprev + 2 * row);
#pragma unroll
                for (int bj = 0; bj < 2; ++bj) zw[m][bj] = *(const u32x4*)(zprev + (size_t)row * DM + cb + 128 * bj); }
#pragma unroll
            for (int m = 0; m < 4; ++m) {
                const int row = 256 * un.pm + 128 * ai + 64 * wr + 16 * m + fr;
                const f32x2 s = sv[m];
                float sum = 0.f, sq = 0.f;
#pragma unroll
                for (int bj = 0; bj < 2; ++bj) {
                    float z[8], v[8]; unpack8(zw[m][bj], z);
#pragma unroll
                    for (int e = 0; e < 8; ++e) v[e] = ALPHA * ((z[e] - s.x) * s.y * gv[bj][e] + bv[bj][e]) + acc[ai][bj][m][e >> 2][e & 3];
                    const u32x4 o = pack8(v);
                    *(u32x4*)(zout + (size_t)row * DM + cb + 128 * bj) = o;
                    *(u32x2*)(z8 + (size_t)row * DM + cb + 128 * bj) = (u32x2){pk4_fp8(v[0], v[1], v[2], v[3]), pk4_fp8(v[4], v[5], v[6], v[7])};
                    float r[8]; unpack8(o, r);
#pragma unroll
                    for (int e = 0; e < 8; ++e) { sum += r[e]; sq += r[e] * r[e]; }
                }
                sum = rows_sum(sum); sq = rows_sum(sq);
                if (fq == 0) *(f32x2*)(part + ((size_t)row * 16 + un.pn * 4 + wc) * 2) = (f32x2){sum, sq};
            }
        }
    }
};

__device__ __forceinline__ void conv_phase(const Frame& F, const bf16_t* u, const bf16_t* bg, const float* ck, bf16_t* y) {
    int tid = threadIdx.x; asm volatile("" : "+v"(tid)); const int lane = tid & 63, wave = __builtin_amdgcn_readfirstlane(tid >> 6); (void)lane; (void)wave;
    const int cg = tid & 127, rs = tid >> 7, t0 = 64 * F.jb + 16 * rs, c0 = 8 * cg;
    const size_t rowb = (size_t)2048 * F.batch;
    float k0[8], k1[8], k2[8], um2[8], um1[8];
    ld8(ck + c0, k0); ld8(ck + DM + c0, k1); ld8(ck + 2 * DM + c0, k2);
    if (t0 >= 2) { unpack8(*(const u32x4*)(u + (rowb + t0 - 2) * DM + c0), um2); unpack8(*(const u32x4*)(u + (rowb + t0 - 1) * DM + c0), um1); }
    else {
#pragma unroll
        for (int e = 0; e < 8; ++e) { um2[e] = 0.f; um1[e] = 0.f; } }
    for (int r4 = 0; r4 < 16; r4 += 16) {
        u32x4 uw[16], bw[16];
#pragma unroll
        for (int i = 0; i < 16; ++i) { const size_t row = rowb + t0 + r4 + i; uw[i] = *(const u32x4*)(u + row * DM + c0); bw[i] = *(const u32x4*)(bg + row * DM + c0); }
#pragma unroll
        for (int i = 0; i < 16; ++i) {
            const size_t row = rowb + t0 + r4 + i;
            float uc[8], b[8], o[8];
            unpack8(uw[i], uc); unpack8(bw[i], b);
#pragma unroll
            for (int e = 0; e < 8; ++e) { o[e] = b[e] * (k0[e] * um2[e] + k1[e] * um1[e] + k2[e] * uc[e]); um2[e] = um1[e]; um1[e] = uc[e]; }
            *(u32x4*)(y + row * DM + c0) = pack8(o);
        }
    }
}

__device__ __forceinline__ f32x2 stats_from_part(const float* part, int row) {
    float s = 0.f, q = 0.f;
#pragma unroll
    for (int i = 0; i < 8; ++i) { const f32x4 p = *(const f32x4*)(part + (size_t)row * 32 + 4 * i); s += p.x + p.z; q += p.y + p.w; }
    const float mu = s * (1.f / DM); float var = q * (1.f / DM) - mu * mu; var = var > 0.f ? var : 0.f;
    return (f32x2){mu, 1.f / sqrtf(var + LN_EPS)};
}


constexpr int RT_LG = 0, RT_ST = 64 * 97 * 4, RT_HIST = RT_ST + 512, RT_BASE = RT_HIST + 256, RT_SEL = RT_BASE + 256, RT_GATE = RT_SEL + 1024;
__device__ __forceinline__ void router_phase(const Frame& F, const bf16_t* z, const float* part, float* stout, const bf16_t* wr_hi, const float* csr, const float* bsr,
                                             const float* rbg, const float* rbe, unsigned* cnt, unsigned* list, float* gate) {
    int tid = threadIdx.x; asm volatile("" : "+v"(tid)); const int lane = tid & 63, wave = __builtin_amdgcn_readfirstlane(tid >> 6);
    LAS unsigned char* aux = F.lds + LDS_AUX;
    LAS float* lg = (LAS float*)(aux + RT_LG); LAS float* stl = (LAS float*)(aux + RT_ST); LAS unsigned* hist = (LAS unsigned*)(aux + RT_HIST); LAS unsigned* base = (LAS unsigned*)(aux + RT_BASE);
    LAS unsigned* sel = (LAS unsigned*)(aux + RT_SEL); LAS float* gl = (LAS float*)(aux + RT_GATE);
    const int row0 = 2048 * F.batch + 64 * F.jb;
    if (tid < 64) { f32x2 s; if (part) { s = stats_from_part(part, row0 + tid); *(f32x2*)(stout + 2 * (row0 + tid)) = s; } else s = *(const f32x2*)(stout + 2 * (row0 + tid));
        stl[2 * tid] = s.x; stl[2 * tid + 1] = s.y; hist[tid] = 0u; }
    const int fr = lane & 15, fq = lane >> 4;
    f32x4 acc[4][6];
#pragma unroll
    for (int m = 0; m < 4; ++m)
#pragma unroll
        for (int j = 0; j < 6; ++j) acc[m][j] = (f32x4){0.f, 0.f, 0.f, 0.f};
    const bf16_t* ap = z + (size_t)(row0 + fr) * DM + 8 * fq;
    const bf16_t* wf = wr_hi + (size_t)lane * 8;
#pragma unroll 1
    for (int k4 = 0; k4 < 4; ++k4) {
        const int ks = 4 * wave + k4;
        bf16x8 a[4], bh[6], bl[6];
#pragma unroll
        for (int m = 0; m < 4; ++m) a[m] = *(const bf16x8*)(ap + (size_t)(16 * m) * DM + 32 * ks);
#pragma unroll
        for (int j = 0; j < 6; ++j) { bh[j] = *(const bf16x8*)(wf + ((size_t)(ks * 2 + 0) * 6 + j) * 512); bl[j] = *(const bf16x8*)(wf + ((size_t)(ks * 2 + 1) * 6 + j) * 512); }
#pragma unroll
        for (int m = 0; m < 4; ++m)
#pragma unroll
            for (int j = 0; j < 6; ++j) { acc[m][j] = __builtin_amdgcn_mfma_f32_16x16x32_bf16(a[m], bh[j], acc[m][j], 0, 0, 0); acc[m][j] = __builtin_amdgcn_mfma_f32_16x16x32_bf16(a[m], bl[j], acc[m][j], 0, 0, 0); }
    }
    {
        LAS f32x4* slots = (LAS f32x4*)(F.lds + LDS_STAGE);
#pragma unroll
        for (int half = 4; half >= 1; half >>= 1) {
            __syncthreads();
            if (wave >= half && wave < 2 * half) {
#pragma unroll
                for (int m = 0; m < 4; ++m)
#pragma unroll
                    for (int j = 0; j < 6; ++j) slots[((wave - half) * 24 + m * 6 + j) * 64 + lane] = acc[m][j];
            }
            __syncthreads();
            if (wave < half) {
#pragma unroll
                for (int m = 0; m < 4; ++m)
#pragma unroll
                    for (int j = 0; j < 6; ++j) acc[m][j] += slots[(wave * 24 + m * 6 + j) * 64 + lane];
            }
        }
    }
    if (wave == 0) {
#pragma unroll
        for (int j = 0; j < 6; ++j) {
            const int n = 16 * j + fr;
            const float c = csr[n], b = bsr[n] + (n < 8 ? rbg[n] : (n < 72 ? rbe[n - 8] : 0.f));
#pragma unroll
            for (int m = 0; m < 4; ++m)
#pragma unroll
                for (int r = 0; r < 4; ++r) { const int tk = 16 * m + 4 * fq + r; lg[tk * 97 + n] = stl[2 * tk + 1] * (acc[m][j][r] - stl[2 * tk] * c) + b; }
        }
    }
    __syncthreads();
    if (tid < 64) {
        const LAS float* l = lg + tid * 97;
        int g = 0; float gm = l[0];
#pragma unroll
        for (int i = 1; i < 8; ++i) { const float v = l[i]; if (v > gm) { gm = v; g = i; } }
        float gs = 0.f;
#pragma unroll
        for (int i = 0; i < 8; ++i) gs += __expf(l[i] - gm);
        const float ggate = 1.f / gs;
        const LAS float* el = l + 8 + 8 * g;
        int i0 = 0; float v0 = el[0];
#pragma unroll
        for (int i = 1; i < 8; ++i) { const float v = el[i]; if (v > v0) { v0 = v; i0 = i; } }
        int i1 = -1; float v1 = 0.f;
#pragma unroll
        for (int i = 0; i < 8; ++i) { const float v = el[i]; if (i != i0 && (i1 < 0 || v > v1)) { v1 = v; i1 = i; } }
        const float ex = __expf(v1 - v0), p0 = 1.f / (1.f + ex), p1 = ex * p0;
        const unsigned e0 = 8 * g + i0, e1 = 8 * g + i1;
        const unsigned r0 = atomicAdd((unsigned*)(hist + e0), 1u), r1 = atomicAdd((unsigned*)(hist + e1), 1u);
        sel[4 * tid] = e0; sel[4 * tid + 1] = e1; sel[4 * tid + 2] = r0; sel[4 * tid + 3] = r1;
        gl[2 * tid] = p0 * ggate; gl[2 * tid + 1] = p1 * ggate;
    }
    __syncthreads();
    if (tid < 64) { const unsigned h = hist[tid]; base[tid] = h ? __hip_atomic_fetch_add(cnt + tid, h, __ATOMIC_RELAXED, __HIP_MEMORY_SCOPE_AGENT) : 0u; }
    __syncthreads();
    if (tid < 64) {
        const unsigned e0 = sel[4 * tid], e1 = sel[4 * tid + 1], tok = (unsigned)(row0 + tid);
        list[(size_t)e0 * 16384 + base[e0] + sel[4 * tid + 2]] = 2u * tok;
        list[(size_t)e1 * 16384 + base[e1] + sel[4 * tid + 3]] = 2u * tok + 1u;
        *(f32x2*)(gate + 2 * tok) = (f32x2){gl[2 * tid], gl[2 * tid + 1]};
    }
}

constexpr int MS_PRE = 0, MS_N = 272, MS_DESC = 288, MS_DDN = 320, MS_ROFF = 512, MS_RINFO = MS_ROFF + 2 * 1024, MS_RDN = MS_RINFO + 2 * 1024, MS_CL = MS_RDN + 6 * 1024, MS_GDN = MS_CL + 256, MS_STUP = MS_GDN + 6 * 1024, MS_EPI = MS_STUP + 2 * 2048  , MS_END = MS_EPI + 3 * 2048;
static_assert(MS_END <= 31744, "MoE tables exceed the AUX region");
constexpr int MOE_MAXDN = 6;
__device__ __forceinline__ void moe_build(const Frame& F, const unsigned* cnt, const unsigned* list, const float* st, const float* gate) {
    int tid = threadIdx.x; asm volatile("" : "+v"(tid));
    LAS unsigned char* aux = F.lds + LDS_AUX;
    LAS unsigned* pre = (LAS unsigned*)(aux + MS_PRE); LAS unsigned* nd = (LAS unsigned*)(aux + MS_N); LAS unsigned* desc = (LAS unsigned*)(aux + MS_DESC); LAS unsigned* ddn = (LAS unsigned*)(aux + MS_DDN);
    LAS unsigned* roff = (LAS unsigned*)(aux + MS_ROFF); LAS unsigned* rinfo = (LAS unsigned*)(aux + MS_RINFO); LAS unsigned* rdn = (LAS unsigned*)(aux + MS_RDN);
    LAS unsigned* cl = (LAS unsigned*)(aux + MS_CL);
    __syncthreads();
    if (tid < 64) {
        const int lane = tid;
        const unsigned c = cnt[lane], nb = (c + 255u) >> 8;
        unsigned incl = nb;
#pragma unroll
        for (int o = 1; o < 64; o <<= 1) { const unsigned t = (unsigned)__builtin_amdgcn_ds_bpermute(((lane - o) & 63) << 2, (int)incl); incl += lane >= o ? t : 0u; }
        const unsigned excl = incl - nb;
        cl[lane] = c; pre[lane] = excl; if (lane == 63) pre[64] = incl;
        const unsigned NB = (unsigned)__builtin_amdgcn_readlane((int)incl, 63), G = (unsigned)F.G, v = (unsigned)((F.bx & 7) * (F.G >> 3) + (F.bx >> 3));
        const unsigned tup = 2u * NB, tdn = 4u * NB, nup2 = tup > G ? tup - G : 0u, nlight = G - nup2;
        unsigned n = 0;
#pragma unroll
        for (int k = 0; k < 2; ++k) {
            const unsigned u = v + (unsigned)k * G;
            if (u < tup) { const unsigned gb = u >> 1, nt = u & 1u;
                const unsigned e = (unsigned)__builtin_popcountll(__builtin_amdgcn_ballot_w64(excl <= gb)) - 1u;
                if (lane == 0) { desc[4 * k] = e; desc[4 * k + 1] = gb; desc[4 * k + 2] = nt; desc[4 * k + 3] = 0u; }
                n = (unsigned)k + 1u; }
        }
        const unsigned pos0 = v >= nup2 ? v - nup2 : nlight + v;
        unsigned m = 0;
#pragma unroll
        for (int k = 0; k < MOE_MAXDN; ++k) {
            const unsigned d = pos0 < nlight ? pos0 + (unsigned)k * nlight : 0xffffffffu;
            if (d < tdn && k < 4) { const unsigned gb = d >> 2, nt = d & 3u;
                const unsigned e = (unsigned)__builtin_popcountll(__builtin_amdgcn_ballot_w64(excl <= gb)) - 1u;
                if (lane == 0) { ddn[4 * m] = e; ddn[4 * m + 1] = gb; ddn[4 * m + 2] = nt; ddn[4 * m + 3] = 0u; }
                m = m + 1u; }
        }
        {
            const unsigned done4 = 4u * nlight;
#pragma unroll
            for (int k = 0; k < 2; ++k) {
                const unsigned d = done4 + v + (unsigned)k * G;
                if (d < tdn) { const unsigned gb = d >> 2, nt = d & 3u;
                    const unsigned e = (unsigned)__builtin_popcountll(__builtin_amdgcn_ballot_w64(excl <= gb)) - 1u;
                    if (lane == 0) { ddn[4 * m] = e; ddn[4 * m + 1] = gb; ddn[4 * m + 2] = nt; ddn[4 * m + 3] = 0u; }
                    m = m + 1u; }
            }
        }
        if (lane == 0) { nd[0] = n; nd[1] = m; }
    }
    __syncthreads();
    const unsigned n = nd[0], m = nd[1];
    for (unsigned i = 0; i < n; ++i) {
        if (tid < 256) { const unsigned e = desc[4 * i], gb = desc[4 * i + 1], idx = (gb - pre[e]) * 256u + (unsigned)tid, c = cl[e];
            LAS f32x2* stup = (LAS f32x2*)(aux + MS_STUP);
            if (idx < c) { const unsigned ts = list[(size_t)e * 16384 + idx]; roff[i * 256 + tid] = (ts >> 1) * (unsigned)DM; rinfo[i * 256 + tid] = ts; stup[i * 256 + tid] = *(const f32x2*)(st + 2 * (ts >> 1)); }
            else { roff[i * 256 + tid] = 0u; rinfo[i * 256 + tid] = 0xffffffffu; stup[i * 256 + tid] = (f32x2){0.f, 1.f}; } }
    }
    for (unsigned i = 0; i < m; ++i) {
        if (tid >= 256) { const unsigned r = (unsigned)tid - 256u, e = ddn[4 * i], gb = ddn[4 * i + 1], idx = (gb - pre[e]) * 256u + r, c = cl[e];
            LAS float* gdn = (LAS float*)(aux + MS_GDN);
            if (idx < c) { const unsigned ts = list[(size_t)e * 16384 + idx]; rdn[i * 256 + r] = ts; gdn[i * 256 + r] = 16.f * gate[ts]; }
            else { rdn[i * 256 + r] = 0xffffffffu; gdn[i * 256 + r] = 0.f; } }
    }
    __syncthreads();
}
template <bool UP>
struct MoeSched {
    LAS unsigned char* aux; const char* Abase; const char* Wbase; unsigned* done;
    __device__ __forceinline__ bool next(int i, pg8::Unit& u) const {
        const unsigned n = ((const LAS unsigned*)(aux + MS_N))[UP ? 0 : 1]; if ((unsigned)i >= n) return false;
        const LAS unsigned* d = (const LAS unsigned*)(aux + (UP ? MS_DESC : MS_DDN)) + 4 * i; const unsigned e = d[0], gb = d[1], nt = d[2];
        if (UP) { u.A = Abase; u.B = Wbase + ((size_t)e * 512 + nt * 256) * DM; }
        else { u.A = Abase + (size_t)gb * 256 * DEXP; u.B = Wbase + ((size_t)e * DM + nt * 256) * DEXP; }
        u.pm = (int)gb; u.pn = (int)nt; u.x0 = (int)e; u.x1 = i; return true;
    }
    __device__ __forceinline__ const LAS unsigned* rowoff(int i) const { return (const LAS unsigned*)(aux + MS_ROFF) + 256 * i; }
    __device__ __forceinline__ void a_ready(const pg8::Unit& u) const {
        if (!UP) {
            int t = threadIdx.x; asm volatile("" : "+v"(t));
            if (__builtin_amdgcn_readfirstlane(t >> 6) == 0) {
                unsigned sp = 0;
                while ((unsigned)__builtin_amdgcn_readfirstlane((int)__hip_atomic_load(done + u.pm, __ATOMIC_RELAXED, __HIP_MEMORY_SCOPE_AGENT)) < 2u) { __builtin_amdgcn_s_sleep(2); if (++sp > (1u << 22)) break; }
                __builtin_amdgcn_fence(__ATOMIC_ACQUIRE, "agent");
                asm volatile("s_waitcnt vmcnt(0)" ::: "memory");
            }
            asm volatile("" ::: "memory"); __builtin_amdgcn_s_barrier(); asm volatile("" ::: "memory");
        }
    }
};
struct EpiUp {
    LAS unsigned char* aux; const float* st; const float* cs; const float* bs; unsigned char* h; unsigned* done;
    __device__ __forceinline__ void prefetch(const pg8::Unit& un, int slot, int wid, int lane) const {
        if (wid == 2 || wid == 3) { const char* s = (const char*)((wid == 2 ? cs : bs) + un.x0 * 512 + 256 * un.pn); int t = threadIdx.x; asm volatile("" : "+v"(t)); (void)lane;
            __builtin_amdgcn_global_load_lds((const unsigned*)(s + (t & 63) * 16), (LAS unsigned*)(aux + MS_EPI + slot * 2048 + (wid - 2) * 1024), 16, 0, 0); } }
    __device__ __forceinline__ void operator()(const f32x4 (&acc)[2][2][4][2], const pg8::Unit& un, int ui, int wr, int wc, int fr, int fq, int slot) const {
        asm volatile("" : "+v"(fr), "+v"(fq));
        const int colL = 32 * wc + 8 * fq;
        const LAS float* ep = (const LAS float*)(aux + MS_EPI + slot * 2048);
        float csv[2][8], bsv[2][8];
        ld8l(ep + colL, csv[0]); ld8l(ep + colL + 128, csv[1]); ld8l(ep + 256 + colL, bsv[0]); ld8l(ep + 256 + colL + 128, bsv[1]);
        const LAS unsigned* rinfo = (const LAS unsigned*)(aux + MS_RINFO) + 256 * ui;
        const LAS f32x2* stup = (const LAS f32x2*)(aux + MS_STUP) + 256 * ui; (void)rinfo;
        f32x2 sv[2][4];
#pragma unroll
        for (int ai = 0; ai < 2; ++ai)
#pragma unroll
            for (int m = 0; m < 4; ++m) sv[ai][m] = stup[128 * ai + 64 * wr + 16 * m + fr];
#pragma unroll
        for (int ai = 0; ai < 2; ++ai)
#pragma unroll
            for (int m = 0; m < 4; ++m) {
                const int r = 128 * ai + 64 * wr + 16 * m + fr;
                const f32x2 s = sv[ai][m];
                float p[8];
#pragma unroll
                for (int e = 0; e < 8; ++e) {
                    const float a1 = s.y * (acc[ai][0][m][e >> 2][e & 3] - s.x * csv[0][e]) + bsv[0][e];
                    const float a3 = s.y * (acc[ai][1][m][e >> 2][e & 3] - s.x * csv[1][e]) + bsv[1][e];
                    p[e] = a1 / (1.f + __expf(-a1)) * a3;
                }
                st8wt(h + ((size_t)un.pm * 256 + r) * DEXP + 128 * un.pn + colL, (u32x2){pk4_fp8(p[0], p[1], p[2], p[3]), pk4_fp8(p[4], p[5], p[6], p[7])});
            }
        asm volatile("s_waitcnt vmcnt(0)" ::: "memory");
        __builtin_amdgcn_s_barrier();
        if (wr == 0 && wc == 0 && fr == 0 && fq == 0) __hip_atomic_fetch_add(done + un.pm, 1u, __ATOMIC_RELAXED, __HIP_MEMORY_SCOPE_AGENT);
    }
};
struct EpiDown {
    LAS unsigned char* aux; const float* gate; unsigned char* y;
    __device__ __forceinline__ void prefetch(const pg8::Unit&, int, int, int) const {}
    __device__ __forceinline__ void operator()(const f32x4 (&acc)[2][2][4][2], const pg8::Unit& un, int ui, int wr, int wc, int fr, int fq, int) const {
        const int cb = 256 * un.pn + 64 * wc + 16 * fq;
        const LAS unsigned* rinfo = (const LAS unsigned*)(aux + MS_RDN) + 256 * ui;
        const LAS float* gdn = (const LAS float*)(aux + MS_GDN) + 256 * ui;
        unsigned tsv[2][4]; float gvv[2][4];
#pragma unroll
        for (int ai = 0; ai < 2; ++ai)
#pragma unroll
            for (int m = 0; m < 4; ++m) { const int r = 128 * ai + 64 * wr + 16 * m + fr; tsv[ai][m] = rinfo[r]; gvv[ai][m] = gdn[r]; }
#pragma unroll
        for (int ai = 0; ai < 2; ++ai)
#pragma unroll
            for (int m = 0; m < 4; ++m) {
                const unsigned ts = tsv[ai][m];
                if (ts != 0xffffffffu) {
                    const float g = gvv[ai][m];
                    u32x4 o;
#pragma unroll
                    for (int bj = 0; bj < 2; ++bj) {
                        float p[8];
#pragma unroll
                        for (int e = 0; e < 8; ++e) p[e] = g * acc[ai][bj][m][e >> 2][e & 3];
                        o[2 * bj] = pk4_fp8(p[0], p[1], p[2], p[3]); o[2 * bj + 1] = pk4_fp8(p[4], p[5], p[6], p[7]);
                    }
                    *(u32x4*)(y + (size_t)ts * DM + cb) = o;
                }
            }
    }
};


struct EpiAttnIn {
    const float* st; const float* cs; const float* bs; unsigned char* q; bf16_t* qi; float* misc; int pn0; LAS unsigned char* aux;
    __device__ __forceinline__ void prefetch(const pg8::Unit& un, int slot, int wid, int lane) const { epi_prefetch(aux + slot * 4096, st + 2 * 256 * un.pm, cs + 256 * (un.pn + pn0), bs + 256 * (un.pn + pn0), wid, lane); }
    __device__ __forceinline__ void operator()(const f32x4 (&acc)[2][2][4][2], const pg8::Unit& un, int, int wr, int wc, int fr, int fq, int slot) const {
        const int pn = un.pn + pn0;
        const int colL = 32 * wc + 8 * fq;
        const LAS unsigned char* ep = aux + slot * 4096;
        float csv[2][8], bsv[2][8];
        ld8l((const LAS float*)(ep + 2048) + colL, csv[0]); ld8l((const LAS float*)(ep + 2048) + colL + 128, csv[1]); ld8l((const LAS float*)(ep + 3072) + colL, bsv[0]); ld8l((const LAS float*)(ep + 3072) + colL + 128, bsv[1]);
        f32x2 sv[2][4];
#pragma unroll
        for (int ai = 0; ai < 2; ++ai)
#pragma unroll
            for (int m = 0; m < 4; ++m) sv[ai][m] = ((const LAS f32x2*)ep)[128 * ai + 64 * wr + 16 * m + fr];
#pragma unroll
        for (int ai = 0; ai < 2; ++ai)
#pragma unroll
            for (int m = 0; m < 4; ++m) {
                const int row = 256 * un.pm + 128 * ai + 64 * wr + 16 * m + fr;
                const f32x2 s = sv[ai][m];
#pragma unroll
                for (int bj = 0; bj < 2; ++bj) {
                    float f[8];
#pragma unroll
                    for (int e = 0; e < 8; ++e) f[e] = s.y * (acc[ai][bj][m][e >> 2][e & 3] - s.x * csv[bj][e]) + bsv[bj][e];
                    if (pn < 8) *(u32x2*)(q + (size_t)row * 2048 + 256 * pn + 128 * bj + colL) = (u32x2){pk4_fp8(f[0], f[1], f[2], f[3]), pk4_fp8(f[4], f[5], f[6], f[7])};
                    else if (pn == 8) { float* d = misc + (size_t)row * 256 + 128 * bj + colL; *(f32x4*)d = (f32x4){f[0], f[1], f[2], f[3]}; *(f32x4*)(d + 4) = (f32x4){f[4], f[5], f[6], f[7]}; }
                    else *(u32x4*)(qi + (size_t)row * 512 + 256 * (pn - 9) + 128 * bj + colL) = pack8(f);
                }
            }
    }
};

__device__ __forceinline__ void attn_norm_phase(const Frame& F, const float* misc, const float* kvg, const float* kig, const float* kib, unsigned char* ckv8, bf16_t* ki) {
    int tid = threadIdx.x; asm volatile("" : "+v"(tid)); const int lane = tid & 63, wave = __builtin_amdgcn_readfirstlane(tid >> 6);
    const int row0 = 2048 * F.batch + 64 * F.jb + 8 * wave;
    const float g0 = kvg[2 * lane], g1 = kvg[2 * lane + 1], kg = kig[lane], kb = kib[lane];
    f32x2 cv[8]; float kv[8];
#pragma unroll
    for (int r = 0; r < 8; ++r) { cv[r] = *(const f32x2*)(misc + (size_t)(row0 + r) * 256 + 2 * lane); kv[r] = misc[(size_t)(row0 + r) * 256 + 128 + lane]; }
#pragma unroll
    for (int r = 0; r < 8; ++r) {
        const int row = row0 + r;
        const f32x2 c = cv[r];
        const float k = kv[r];
        const float ss = wave_sum(c.x * c.x + c.y * c.y, lane);
        const float rinv = 1.f / sqrtf(ss * (1.f / 128.f) + RMS_EPS);
        ((unsigned short*)(ckv8 + (size_t)row * 128))[lane] = (unsigned short)__builtin_amdgcn_cvt_pk_fp8_f32(c.x * rinv * g0, c.y * rinv * g1, 0, false);
        const float mu = wave_sum(k, lane) * (1.f / 64.f); const float d = k - mu;
        const float var = wave_sum(d * d, lane) * (1.f / 64.f);
        ki[(size_t)row * 64 + lane] = (bf16_t)f2bf(d * (1.f / sqrtf(var + LN_EPS)) * kg + kb);
    }
}

__device__ __forceinline__ unsigned sortable(float f) { const unsigned u = __builtin_bit_cast(unsigned, f); return (u & 0x80000000u) ? ~u : (u | 0x80000000u); }
__device__ __forceinline__ unsigned radix_select256(const unsigned (&k)[32], int nvalid, LAS unsigned* hist, int lane) {
    unsigned prefix = 0u, pmask = 0u, krem = 256u;
#pragma unroll 1
    for (int shift = 24; shift >= 0; shift -= 8) {
#pragma unroll
        for (int j = 0; j < 4; ++j) hist[lane + 64 * j] = 0u;
        asm volatile("s_waitcnt lgkmcnt(0)" ::: "memory");
#pragma unroll
        for (int g8 = 0; g8 < 4; ++g8) if (512 * g8 < nvalid) {
#pragma unroll
            for (int i = 8 * g8; i < 8 * g8 + 8; ++i) { const unsigned key = k[i]; if (key != 0u && (key & pmask) == prefix) __hip_atomic_fetch_add(hist + ((key >> shift) & 255u), 1u, __ATOMIC_RELAXED, __HIP_MEMORY_SCOPE_WAVEFRONT); } }
        asm volatile("s_waitcnt lgkmcnt(0)" ::: "memory");
        unsigned h[4];
#pragma unroll
        for (int j = 0; j < 4; ++j) h[j] = hist[255 - 4 * lane - j];
        const unsigned local = (h[0] + h[1]) + (h[2] + h[3]);
        const unsigned incl = wave_incl_scan(local);
        const unsigned long long m = __builtin_amdgcn_ballot_w64(incl >= krem);
        const int L = __builtin_ctzll(m);
        unsigned cum = (unsigned)__builtin_amdgcn_readlane((int)(incl - local), L);
        const unsigned c0 = (unsigned)__builtin_amdgcn_readlane((int)h[0], L), c1 = (unsigned)__builtin_amdgcn_readlane((int)h[1], L), c2 = (unsigned)__builtin_amdgcn_readlane((int)h[2], L), c3 = (unsigned)__builtin_amdgcn_readlane((int)h[3], L);
        unsigned bin, cb;
        if (cum + c0 >= krem) { bin = 255u - 4u * L; cb = c0; }
        else { cum += c0; if (cum + c1 >= krem) { bin = 254u - 4u * L; cb = c1; } else { cum += c1; if (cum + c2 >= krem) { bin = 253u - 4u * L; cb = c2; } else { cum += c2; bin = 252u - 4u * L; cb = c3; } } }
        krem -= cum; prefix |= bin << shift; pmask |= 255u << shift;
        if (cb == krem) break;
    }
    return prefix;
}

__device__ __forceinline__ void index_unit(const Frame& F, const bf16_t* qi, const float* misc, const bf16_t* ki, unsigned short* sel, int b, int t0, int lane, int wave) {
    const int hh = lane >> 5, l31 = lane & 31;
    const size_t rb = (size_t)b * 2048;
    LAS unsigned* sc = (LAS unsigned*)(F.lds + LDS_STAGE);
    const LAS unsigned* bkt = (const LAS unsigned*)(F.lds + LDS_AUX);
#define IDX_PACK(key, t) ({ const int _k = (key), _d = (t) - _k; (unsigned short)(_k | (int)(bkt[_d < 0 ? 0 : (_d > 127 ? 127 : _d)] << 11)); })
    if (t0 < 256) {
#pragma unroll
        for (int qq = 0; qq < 2; ++qq) { const int t = t0 + 2 * wave + qq;
#pragma unroll
            for (int j = 0; j < 4; ++j) { const int idx = lane + 64 * j; sel[(rb + t) * 256 + idx] = idx <= t ? IDX_PACK(idx, t) : (unsigned short)0; } }
        return;
    }
    const int nkt = (t0 + 16 + 31) >> 5;
    {
        LAS unsigned char* aq_l = F.lds + LDS_AUX + 10240; LAS float* w_l = (LAS float*)(F.lds + LDS_AUX + 26624);
        { const char* src = (const char*)(qi + (rb + t0) * 512);
#pragma unroll
          for (int j = 0; j < 2; ++j) __builtin_amdgcn_global_load_lds((const unsigned*)(src + (2 * wave + j) * 1024 + lane * 16), (LAS unsigned*)(aq_l + (2 * wave + j) * 1024), 16, 0, 0);
          if (wave < 2) { const int i = 64 * wave + lane; w_l[i] = misc[(rb + t0 + (i >> 3)) * 256 + 192 + (i & 7)]; } }
        asm volatile("s_waitcnt vmcnt(0)" ::: "memory");
        __syncthreads();
        bf16x8 aq[4][4];
        { const int r = l31, head = (r & 3) + 4 * ((r >> 3) & 1), query = (r >> 4) + 2 * ((r >> 2) & 1);
#pragma unroll
          for (int mt = 0; mt < 4; ++mt) { const LAS unsigned char* ap = aq_l + ((4 * mt + query) * 8 + head) * 128 + 16 * hh;
#pragma unroll
              for (int ks = 0; ks < 4; ++ks) aq[mt][ks] = *(const LAS bf16x8*)(ap + 32 * ks); } }
        const bf16_t* kp = ki + (rb + l31) * 64 + 8 * hh;
        bf16x8 bk[4], bn[4];
        if (wave < nkt) {
#pragma unroll
            for (int ks = 0; ks < 4; ++ks) bk[ks] = *(const bf16x8*)(kp + (size_t)wave * 2048 + 16 * ks); }
        for (int kt = wave; kt < nkt; kt += 8) {
            const int ktn = kt + 8 < nkt ? kt + 8 : kt;
#pragma unroll
            for (int ks = 0; ks < 4; ++ks) bn[ks] = *(const bf16x8*)(kp + (size_t)ktn * 2048 + 16 * ks);
            const int key = 32 * kt + l31;
#pragma unroll
            for (int mt = 0; mt < 4; ++mt) {
                f32x16 acc;
#pragma unroll
                for (int e = 0; e < 16; ++e) acc[e] = 0.f;
#pragma unroll
                for (int ks = 0; ks < 4; ++ks) acc = __builtin_amdgcn_mfma_f32_32x32x16_bf16(aq[mt][ks], bk[ks], acc, 0, 0, 0);
                float s0 = 0.f, s1 = 0.f;
                {
                    const LAS f32x4* wp = (const LAS f32x4*)(w_l + (4 * mt + 2 * hh) * 8); const f32x4 wa = wp[0], wb = wp[1], wc = wp[2], wd = wp[3];
                    const float w0[8] = {wa.x, wa.y, wa.z, wa.w, wb.x, wb.y, wb.z, wb.w}, w1[8] = {wc.x, wc.y, wc.z, wc.w, wd.x, wd.y, wd.z, wd.w};
#pragma unroll
                    for (int e = 0; e < 8; ++e) { s0 += fmaxf(acc[e], 0.f) * w0[e]; s1 += fmaxf(acc[8 + e], 0.f) * w1[e]; }
                }
                const int tq = t0 + 4 * mt + 2 * hh;
                sc[(4 * mt + 2 * hh) * 2048 + key] = key <= tq ? sortable(s0) : 0u;
                sc[(4 * mt + 2 * hh + 1) * 2048 + key] = key <= tq + 1 ? sortable(s1) : 0u;
            }
#pragma unroll
            for (int ks = 0; ks < 4; ++ks) bk[ks] = bn[ks];
        }
    }
    __syncthreads();
    {
    unsigned ka[32], kb[32];
    const int nvalid = 32 * nkt;
#pragma unroll
    for (int i = 0; i < 32; ++i) { const int key = 64 * i + lane; const bool v = key < nvalid; ka[i] = v ? sc[(2 * wave) * 2048 + key] : 0u; kb[i] = v ? sc[(2 * wave + 1) * 2048 + key] : 0u; }
    LAS unsigned* hist = (LAS unsigned*)(F.lds + LDS_AUX + 1024 + wave * 1024);
    const unsigned Ta = radix_select256(ka, nvalid, hist, lane), Tb = radix_select256(kb, nvalid, hist, lane);
#pragma unroll
    for (int qq = 0; qq < 2; ++qq) {
        const unsigned T = qq ? Tb : Ta;
        unsigned nge = 0u;
#pragma unroll
        for (int g8 = 0; g8 < 4; ++g8) if (512 * g8 < nvalid) {
#pragma unroll
            for (int i = 8 * g8; i < 8 * g8 + 8; ++i) nge += (unsigned)__builtin_popcountll(__builtin_amdgcn_ballot_w64((qq ? kb[i] : ka[i]) >= T)); }
        LAS unsigned short* out = (LAS unsigned short*)hist + 256 * qq;
        unsigned base = 0u;
        if (nge == 256u) {
#pragma unroll
            for (int i = 0; i < 32; ++i) if (64 * i < nvalid) {
                const unsigned k = qq ? kb[i] : ka[i];
                const bool take = k >= T;
                const unsigned long long mtk = __builtin_amdgcn_ballot_w64(take);
                const unsigned tkbelow = __builtin_amdgcn_mbcnt_hi((unsigned)(mtk >> 32), __builtin_amdgcn_mbcnt_lo((unsigned)mtk, 0u));
                if (take) out[base + tkbelow] = IDX_PACK(64 * i + lane, t0 + 2 * wave + qq);
                base += (unsigned)__builtin_popcountll(mtk);
            }
        } else {
            unsigned ngt = 0u;
#pragma unroll
            for (int i = 0; i < 32; ++i) ngt += (unsigned)__builtin_popcountll(__builtin_amdgcn_ballot_w64((qq ? kb[i] : ka[i]) > T));
            const unsigned need = 256u - ngt;
            unsigned tbase = 0u;
#pragma unroll 4
            for (int i = 0; i < 32; ++i) if (64 * i < nvalid) {
                const unsigned k = qq ? kb[i] : ka[i];
                const bool eq = (k == T), gt = (k > T);
                const unsigned long long meq = __builtin_amdgcn_ballot_w64(eq);
                const unsigned eqbelow = __builtin_amdgcn_mbcnt_hi((unsigned)(meq >> 32), __builtin_amdgcn_mbcnt_lo((unsigned)meq, 0u));
                const bool take = gt || (eq && (tbase + eqbelow) < need);
                tbase += (unsigned)__builtin_popcountll(meq);
                const unsigned long long mtk = __builtin_amdgcn_ballot_w64(take);
                const unsigned tkbelow = __builtin_amdgcn_mbcnt_hi((unsigned)(mtk >> 32), __builtin_amdgcn_mbcnt_lo((unsigned)mtk, 0u));
                if (take) out[base + tkbelow] = IDX_PACK(64 * i + lane, t0 + 2 * wave + qq);
                base += (unsigned)__builtin_popcountll(mtk);
            }
        }
    }
    asm volatile("s_waitcnt lgkmcnt(0)" ::: "memory");
    *(u32x4*)(sel + (rb + t0 + 2 * wave + (lane >> 5)) * 256 + 8 * (lane & 31)) = *(const LAS u32x4*)((const LAS unsigned char*)hist + 16 * lane);
    }
    __syncthreads();
#undef IDX_PACK
}
__device__ __forceinline__ void index_phase(const Frame& F, const bf16_t* qi, const float* misc, const bf16_t* ki, unsigned short* sel) {
    int tid = threadIdx.x; asm volatile("" : "+v"(tid)); const int lane = tid & 63, wave = __builtin_amdgcn_readfirstlane(tid >> 6);
    if (tid < 128) { unsigned bk = (unsigned)tid; if (tid >= 16) { int v = 16 + (int)(__logf((float)tid / 16.f) / 2.0794415416798357f * 16.f); bk = (unsigned)(v < 31 ? v : 31); } ((LAS unsigned*)(F.lds + LDS_AUX))[tid] = bk; }
    __syncthreads();
    const int us[4] = {127 - F.jb, 64 + F.jb, 63 - F.jb, F.jb};
    for (int k = 0; k < 4; ++k) index_unit(F, qi, misc, ki, sel, F.batch, 16 * us[k], lane, wave);
}

constexpr int AT_P = 0  , AT_SCT = 8704  , AT_BIAS = 16896, AT_Q = 18944  , AT_SEL = 27136  ;
static_assert(AT_SEL + 3 * 1024 <= 31744, "attention tables exceed the AUX region");
__device__ __forceinline__ unsigned at_f(unsigned row) { return ((row >> 2) & 1u) | (((row >> 1) & 1u) << 1) | (((row >> 3) & 1u) << 2); }
__device__ __forceinline__ void attn_phase(const Frame& F, const unsigned char* q8, const unsigned char* ckv8, const unsigned short* sel, const float* relb, unsigned char* o) {
    int tid = threadIdx.x; asm volatile("" : "+v"(tid)); const int lane = tid & 63, wave = __builtin_amdgcn_readfirstlane(tid >> 6);
    const int fr = lane & 15, fq = lane >> 4;
    LAS unsigned char* aux = F.lds + LDS_AUX;
    LAS float* biast = (LAS float*)(aux + AT_BIAS);
    for (int i = tid; i < 512; i += NTHREADS) biast[i] = relb[i];
    const size_t rb = (size_t)F.batch * 2048;
    const int us0 = 127 - F.jb, us1 = 64 + F.jb, us2 = 63 - F.jb, us3 = F.jb;
#define AT_T(it) (16 * ((it) < 8 ? us0 : ((it) < 16 ? us1 : ((it) < 24 ? us2 : us3))) + 2 * ((it) & 7))
    const unsigned char* ckvb = ckv8 + rb * 128;
    const unsigned dl8 = (unsigned)lane >> 3, dp = (unsigned)lane & 7u;
#define AT_DMA_SEL(t, slot) do { if (wave == 0) \
        __builtin_amdgcn_global_load_lds((const unsigned*)((const unsigned char*)(sel + (rb + (t)) * 256) + 16 * lane), (LAS unsigned*)(aux + AT_SEL + (slot) * 1024), 16, 0, 16); } while (0)
#define AT_DMA_Q(t, buf) do { if (wave == 1) { _Pragma("unroll") for (int j = 0; j < 4; ++j) { const unsigned R = 8u * j + dl8; \
        __builtin_amdgcn_global_load_lds((const unsigned*)(q8 + (rb + (t)) * 2048 + R * 128u + ((dp ^ at_f(R)) << 4)), (LAS unsigned*)(aux + AT_Q + (buf) * 4096 + j * 1024), 16, 0, 0); } } } while (0)
#define AT_GATHER(buf, slot) do { const LAS unsigned short* sp = (const LAS unsigned short*)(aux + AT_SEL + (slot) * 1024) + 32 * wave + dl8; unsigned svv[8]; \
        _Pragma("unroll") for (int j = 0; j < 8; ++j) svv[j] = sp[256 * (j >> 2) + 8 * (j & 3)]; \
        asm volatile("s_waitcnt lgkmcnt(0)" : "+v"(svv[0]), "+v"(svv[1]), "+v"(svv[2]), "+v"(svv[3]), "+v"(svv[4]), "+v"(svv[5]), "+v"(svv[6]), "+v"(svv[7]) :: "memory");     \
        _Pragma("unroll") for (int j = 0; j < 8; ++j) { const unsigned row = 32u * wave + 8u * (j & 3) + dl8; \
        __builtin_amdgcn_global_load_lds((const unsigned*)(ckvb + (size_t)(svv[j] & 2047u) * 128 + ((dp ^ at_f(row)) << 4)), (LAS unsigned*)(F.lds + ((buf) * 2 + (j >> 2)) * 32768 + (32 * wave + 8 * (j & 3)) * 128), 16, 0, 0); } } while (0)
    AT_DMA_SEL(AT_T(0), 0); AT_DMA_SEL(AT_T(1), 1); AT_DMA_Q(AT_T(0), 0);
    asm volatile("s_waitcnt vmcnt(0)" ::: "memory");
    __syncthreads();
    AT_GATHER(0, 0);
    const bf16x8 ones = {0x3F80, 0x3F80, 0x3F80, 0x3F80, 0x3F80, 0x3F80, 0x3F80, 0x3F80};
    const unsigned fsw = at_f((unsigned)fr);
    int s_cur = 0;
    for (int it = 0; it < 32; ++it) {
        const int t0 = AT_T(it), cur = it & 1;
        const int s_nxt = s_cur == 2 ? 0 : s_cur + 1, s_nn = s_nxt == 2 ? 0 : s_nxt + 1;
        asm volatile("s_waitcnt vmcnt(0) lgkmcnt(0)" ::: "memory");
        __builtin_amdgcn_s_barrier();
        if (it < 31) { AT_GATHER(cur ^ 1, s_nxt); AT_DMA_Q(AT_T(it + 1), cur ^ 1); if (it < 30) AT_DMA_SEL(AT_T(it + 2), s_nn); }
        {
            i32x8 qv[2], kv[2][2]; u32x2 pcw[2][2];
#pragma unroll
            for (int qq = 0; qq < 2; ++qq) {
                const LAS unsigned char* qrow = aux + AT_Q + cur * 4096 + (16 * qq + fr) * 128;
                const u32x4 qb0 = *(const LAS u32x4*)(qrow + (((2u * fq) ^ fsw) << 4)), qb1 = *(const LAS u32x4*)(qrow + (((2u * fq + 1u) ^ fsw) << 4));
                qv[qq] = (i32x8){(int)qb0.x, (int)qb0.y, (int)qb0.z, (int)qb0.w, (int)qb1.x, (int)qb1.y, (int)qb1.z, (int)qb1.w};
                const LAS unsigned char* srow = aux + AT_SEL + s_cur * 1024 + qq * 512 + (32 * wave + 4 * fq) * 2;
#pragma unroll
                for (int mt = 0; mt < 2; ++mt) {
                    const LAS unsigned char* krow = F.lds + (cur * 2 + qq) * 32768 + (32 * wave + 16 * mt + fr) * 128;
                    const u32x4 k0 = *(const LAS u32x4*)(krow + (((2u * fq) ^ fsw) << 4)), k1 = *(const LAS u32x4*)(krow + (((2u * fq + 1u) ^ fsw) << 4));
                    kv[qq][mt] = (i32x8){(int)k0.x, (int)k0.y, (int)k0.z, (int)k0.w, (int)k1.x, (int)k1.y, (int)k1.z, (int)k1.w};
                    pcw[qq][mt] = *(const LAS u32x2*)(srow + 32 * mt);
                }
            }
            float bv[2][2][4];
#pragma unroll
            for (int qq = 0; qq < 2; ++qq)
#pragma unroll
                for (int mt = 0; mt < 2; ++mt) {
                    const unsigned pw[2] = {pcw[qq][mt].x, pcw[qq][mt].y};
#pragma unroll
                    for (int r = 0; r < 4; ++r) { const unsigned bucket = ((pw[r >> 1] >> (16 * (r & 1))) & 0xffffu) >> 11; bv[qq][mt][r] = biast[bucket * 16 + fr]; }
                }
            f32x4 sacc[2][2];
#pragma unroll
            for (int qq = 0; qq < 2; ++qq)
#pragma unroll
                for (int mt = 0; mt < 2; ++mt)
                    sacc[qq][mt] = __builtin_amdgcn_mfma_scale_f32_16x16x128_f8f6f4(kv[qq][mt], qv[qq], (f32x4){0.f, 0.f, 0.f, 0.f}, 0, 0, 0, 0x7F7F7F7F, 0, 0x7F7F7F7F);
#pragma unroll
            for (int qq = 0; qq < 2; ++qq) {
                const int nsel = t0 + qq + 1 < TOPK ? t0 + qq + 1 : TOPK;
                float v2[2][4]; float mx = -115.f;
#pragma unroll
                for (int mt = 0; mt < 2; ++mt)
#pragma unroll
                    for (int r = 0; r < 4; ++r) {
                        const int slot = 32 * wave + 16 * mt + 4 * fq + r;
                        const float v = fminf(sacc[qq][mt][r] * 0.08838834764831845f + bv[qq][mt][r], 80.f) * 1.4426950408889634f;
                        v2[mt][r] = slot < nsel ? v : -1e30f; mx = fmaxf(mx, v2[mt][r]);
                    }
                {
                    const unsigned mb = __builtin_bit_cast(unsigned, mx);
                    const auto s16 = __builtin_amdgcn_permlane16_swap(mb, mb, false, false);
                    const float m1 = fmaxf(__builtin_bit_cast(float, (unsigned)s16[0]), __builtin_bit_cast(float, (unsigned)s16[1]));
                    const unsigned m1b = __builtin_bit_cast(unsigned, m1);
                    const auto s32 = __builtin_amdgcn_permlane32_swap(m1b, m1b, false, false);
                    mx = fmaxf(__builtin_bit_cast(float, (unsigned)s32[0]), __builtin_bit_cast(float, (unsigned)s32[1]));
                }
                const float ef = floorf(mx) + 1.f;
                LAS unsigned char* prow = aux + AT_P + qq * 4352 + fr * 272 + 32 * wave + 4 * fq;
#pragma unroll
                for (int mt = 0; mt < 2; ++mt)
                    *(LAS unsigned*)(prow + 16 * mt) = pk4_fp8(__builtin_amdgcn_exp2f(v2[mt][0] - ef), __builtin_amdgcn_exp2f(v2[mt][1] - ef), __builtin_amdgcn_exp2f(v2[mt][2] - ef), __builtin_amdgcn_exp2f(v2[mt][3] - ef));
                if (fq == 0) *(LAS unsigned char*)(aux + AT_SCT + qq * 128 + fr * 8 + wave) = (unsigned char)(127 + (int)ef);
            }
        }
        asm volatile("s_waitcnt lgkmcnt(0)" ::: "memory"); __builtin_amdgcn_s_barrier(); asm volatile("" ::: "memory");
        {
            const int qq = wave >> 2; const unsigned db = (unsigned)wave & 3u;
            const unsigned img = (unsigned)(size_t)(F.lds + (cur * 2 + qq) * 32768);
            const LAS unsigned char* pbase = aux + AT_P + qq * 4352 + fr * 272 + 16 * fq;
            const LAS unsigned char* sbase = aux + AT_SCT + qq * 128 + fr * 8 + fq;
            f32x4 oe = (f32x4){0.f, 0.f, 0.f, 0.f}, oo = (f32x4){0.f, 0.f, 0.f, 0.f}, tacc = (f32x4){0.f, 0.f, 0.f, 0.f};
            const unsigned r4 = (unsigned)(lane & 15) >> 2, c4 = (unsigned)lane & 3u;
            u32x2 ta[2][8]; u32x4 pf[2][2]; unsigned sb[2];
#pragma unroll
            for (int kb = 0; kb < 2; ++kb)
#pragma unroll
                for (int j = 0; j < 8; ++j) {
                    const unsigned row = 128u * kb + 64u * (j >> 2) + 16u * fq + 4u * (j & 3) + r4;
                    const unsigned a0 = img + row * 128u + (((2u * db + (c4 >> 1)) ^ at_f(row)) << 4) + 8u * (c4 & 1u);
                    asm volatile("ds_read_b64_tr_b16 %0, %1" : "=&v"(ta[kb][j]) : "v"(a0) : "memory");
                }
#pragma unroll
            for (int kb = 0; kb < 2; ++kb) { pf[kb][0] = *(const LAS u32x4*)(pbase + 128 * kb); pf[kb][1] = *(const LAS u32x4*)(pbase + 128 * kb + 64); sb[kb] = *(sbase + 4 * kb); }
            asm volatile("s_waitcnt lgkmcnt(0)" : "+v"(ta[0][0]), "+v"(ta[0][1]), "+v"(ta[0][2]), "+v"(ta[0][3]), "+v"(ta[0][4]), "+v"(ta[0][5]), "+v"(ta[0][6]), "+v"(ta[0][7]),
                         "+v"(ta[1][0]), "+v"(ta[1][1]), "+v"(ta[1][2]), "+v"(ta[1][3]), "+v"(ta[1][4]), "+v"(ta[1][5]), "+v"(ta[1][6]), "+v"(ta[1][7]) :: "memory");
            const i32x8 onesv = {0x38383838, 0x38383838, 0x38383838, 0x38383838, 0x38383838, 0x38383838, 0x38383838, 0x38383838};
#pragma unroll
            for (int kb = 0; kb < 2; ++kb) {
                i32x8 ev, od;
#pragma unroll
                for (int j = 0; j < 8; ++j) { ev[j] = (int)__builtin_amdgcn_perm(ta[kb][j].y, ta[kb][j].x, 0x06040200u); od[j] = (int)__builtin_amdgcn_perm(ta[kb][j].y, ta[kb][j].x, 0x07050301u); }
                const i32x8 pv8 = {(int)pf[kb][0].x, (int)pf[kb][0].y, (int)pf[kb][0].z, (int)pf[kb][0].w, (int)pf[kb][1].x, (int)pf[kb][1].y, (int)pf[kb][1].z, (int)pf[kb][1].w};
                oe = __builtin_amdgcn_mfma_scale_f32_16x16x128_f8f6f4(ev, pv8, oe, 0, 0, 0, 0x7F7F7F7F, 0, (int)sb[kb]);
                oo = __builtin_amdgcn_mfma_scale_f32_16x16x128_f8f6f4(od, pv8, oo, 0, 0, 0, 0x7F7F7F7F, 0, (int)sb[kb]);
                tacc = __builtin_amdgcn_mfma_scale_f32_16x16x128_f8f6f4(onesv, pv8, tacc, 0, 0, 0, 0x7F7F7F7F, 0, (int)sb[kb]);
            }
            const float inv = __builtin_amdgcn_rcpf(tacc[0]);
            *(u32x2*)(o + ((rb + t0 + qq) * 16 + fr) * 128 + 32 * db + 8 * fq) = (u32x2){pk4_fp8(oe[0] * inv, oo[0] * inv, oe[1] * inv, oo[1] * inv), pk4_fp8(oe[2] * inv, oo[2] * inv, oe[3] * inv, oo[3] * inv)};
        }
        s_cur = s_nxt;
    }
    asm volatile("s_waitcnt vmcnt(0)" ::: "memory");
    __syncthreads();
#undef AT_DMA_SEL
#undef AT_DMA_Q
#undef AT_GATHER
#undef AT_T
}

__global__ void __launch_bounds__(NTHREADS, 2) fwd_kernel(Params P) {
    extern __shared__ __attribute__((aligned(16))) unsigned char lds_raw[];
    Frame F;
    F.lds = (LAS unsigned char*)lds_raw;
    F.G = gridDim.x; F.bx = blockIdx.x; F.batch = F.bx & 7; F.jb = F.bx >> 3; F.ws = P.ws;
    unsigned char* ws = P.ws;
    for (int u = threadIdx.x; u < 256; u += NTHREADS) ((LAS unsigned*)(F.lds + LDS_MISC))[u] = 0u;
    __syncthreads();
    XcdBarrier bar = xcd_barrier_post((unsigned*)(ws + WS_CTL) + CW_BAR, (volatile LAS unsigned*)(F.lds + LDS_MISC));
#define GRID_BAR() xcd_barrier<false>(bar)
#define GRID_BAR_L() xcd_barrier<true>(bar)
    if (threadIdx.x == 0) (void)xb_add((unsigned*)(ws + WS_CTL) + CW_XCC + F.bx, bar.x + 1u);

    bf16_t* zA; bf16_t* zB; float* stA; float* stB;
    const float* ones; const float* zeros;

    p0_prologue(F, P);
    GRID_BAR();
    {
        volatile LAS unsigned* okw = (volatile LAS unsigned*)(F.lds + LDS_MISC) + 3;
        if (threadIdx.x == 0) okw[0] = (F.G == 256) ? 1u : 0u;
        __syncthreads();
        if (threadIdx.x < 256 && (int)threadIdx.x < F.G) { unsigned* tab = (unsigned*)(ws + WS_CTL) + CW_XCC; const unsigned v = xb_ld(tab + threadIdx.x), r = xb_ld(tab + (threadIdx.x & 7)); if (v == 0u || v != r) okw[0] = 0u; }
        __syncthreads();
        if (threadIdx.x == 0) ((volatile LAS unsigned*)(F.lds + LDS_MISC))[2] = okw[0];
        __syncthreads();
    }
    {
        const float* csp = (const float*)(ws + WS_CSP); float* cs = (float*)(ws + WS_CSUP); float* bs = (float*)(ws + WS_BSUP);
        constexpr int NV = 4 * 64 * 512;
        for (int i = F.bx * NTHREADS + (int)threadIdx.x; i < NV; i += F.G * NTHREADS) {
            float a = 0.f, b = 0.f;
#pragma unroll 8
            for (int kt = 0; kt < 16; ++kt) { a += csp[(size_t)kt * NV + i]; b += csp[(size_t)(32 + kt) * NV + i]; }
            cs[i] = a; bs[i] = b;
        }
    }

    for (int layer = 0; layer < DEPTH; ++layer) {
        asm volatile("" : "+s"(ws));
        zA = (bf16_t*)(ws + WS_ZA); zB = (bf16_t*)(ws + WS_ZB); stA = (float*)(ws + WS_STA); stB = (float*)(ws + WS_STB); ones = (const float*)(ws + WS_VEC); zeros = ones + 1024;
        const float* gprev = layer ? P.in[I_L2G] + (layer - 1) * DM : ones;
        const float* bprev = layer ? P.in[I_L2B] + (layer - 1) * DM : zeros;
        const int jl = layer >> 1;
        bool have_part = false;
        if ((layer & 1) == 0) {
            {
                pg8::StaticOrder S; S.init(T_TOK, 3072, F.G, F.bx, zA, DM * 2, (const bf16_t*)(ws + WS_WCI) + (size_t)jl * 3072 * DM, DM * 2);
                EpiConvIn E{stA, (const float*)(ws + WS_CSCI) + jl * 3072, (const float*)(ws + WS_BSCI) + jl * 3072, (bf16_t*)(ws + WS_U), (bf16_t*)(ws + WS_BG), F.lds + LDS_AUX};
                pg8::gemm_phase<EpiConvIn, pg8::StaticOrder, false>(F.lds + LDS_STAGE, DM, DM * 2, DM * 2, S, E);
            }
            GRID_BAR_L();
            conv_phase(F, (const bf16_t*)(ws + WS_U), (const bf16_t*)(ws + WS_BG), P.in[I_CK] + (size_t)jl * 3 * DM, (bf16_t*)(ws + WS_Y));
            GRID_BAR_L();
            {
                pg8::StaticOrder S; S.init(T_TOK, DM, F.G, F.bx, (const bf16_t*)(ws + WS_Y), DM * 2, (const bf16_t*)(ws + WS_WCO) + (size_t)jl * DM * DM, DM * 2);
                EpiRes E{zA, stA, gprev, bprev, zB, (float*)(ws + WS_PART), ws + WS_Z8};
                pg8::gemm_phase<EpiRes, pg8::StaticOrder, false>(F.lds + LDS_STAGE, DM, DM * 2, DM * 2, S, E);
            }
            have_part = true;
            GRID_BAR_L();
        } else {
            {
                pg8::StaticOrder S; S.init(T_TOK, 2048, F.G, F.bx, ws + WS_ZA8, DM, ws + WS_WAI + (size_t)jl * AIWP * DM * 2, DM);
                EpiAttnIn E{stA, (const float*)(ws + WS_CSAI) + jl * AIWP, (const float*)(ws + WS_BSAI) + jl * AIWP, ws + WS_Q, (bf16_t*)(ws + WS_QI), (float*)(ws + WS_MISC), 0, F.lds + LDS_AUX};
                pg8::gemm_phase<EpiAttnIn, pg8::StaticOrder, false, true>(F.lds + LDS_STAGE, DM / 2, DM, DM, S, E);
            }
            {
                pg8::StaticOrder S; S.init(T_TOK, AIWP - 2048, F.G, F.bx, zA, DM * 2, (const bf16_t*)(ws + WS_WAI) + (size_t)jl * AIWP * DM + (size_t)2048 * DM, DM * 2);
                EpiAttnIn E{stA, (const float*)(ws + WS_CSAI) + jl * AIWP, (const float*)(ws + WS_BSAI) + jl * AIWP, ws + WS_Q, (bf16_t*)(ws + WS_QI), (float*)(ws + WS_MISC), 8, F.lds + LDS_AUX + 12288};
                pg8::gemm_phase<EpiAttnIn, pg8::StaticOrder, false>(F.lds + LDS_STAGE, DM, DM * 2, DM * 2, S, E);
            }
            GRID_BAR_L();
            attn_norm_phase(F, (const float*)(ws + WS_MISC), P.in[I_KVG] + jl * KVL, P.in[I_KIG] + jl * IDXD, P.in[I_KIB] + jl * IDXD, ws + WS_CKV, (bf16_t*)(ws + WS_KI));
            GRID_BAR_L();
            index_phase(F, (const bf16_t*)(ws + WS_QI), (const float*)(ws + WS_MISC), (const bf16_t*)(ws + WS_KI), (unsigned short*)(ws + WS_SEL));
            asm volatile("s_waitcnt vmcnt(0)" ::: "memory"); __syncthreads();
            attn_phase(F, ws + WS_Q, ws + WS_CKV, (const unsigned short*)(ws + WS_SEL), P.in[I_RELB], ws + WS_O);
            GRID_BAR_L();
            {
                pg8::StaticOrder S; S.init(T_TOK, DM, F.G, F.bx, ws + WS_O, 2048, ws + WS_WAO + (size_t)jl * DM * 2048, 2048);
                EpiRes E{zA, stA, gprev, bprev, zB, (float*)(ws + WS_PART), ws + WS_Z8};
                pg8::gemm_phase<EpiRes, pg8::StaticOrder, false, true>(F.lds + LDS_STAGE, 2048 / 2, 2048, 2048, S, E, 127 - 6);
            }
            have_part = true;
            GRID_BAR_L();
        }
        const float* partin = have_part ? (const float*)(ws + WS_PART) : nullptr;
        const unsigned char* ym = nullptr;
        {
            unsigned* cnt = (unsigned*)(ws + WS_CTL) + CW_CNT + 64 * layer; unsigned* list = (unsigned*)(ws + WS_LIST); float* gate = (float*)(ws + WS_GATE);
            const bf16_t* wrh = (const bf16_t*)(ws + WS_WR) + (size_t)layer * 32 * 2 * 6 * 512;
            router_phase(F, zB, partin, stB, wrh, (const float*)(ws + WS_CSR) + layer * 96, (const float*)(ws + WS_BSR) + layer * 96, P.in[I_RBG] + layer * 8, P.in[I_RBE] + layer * 64, cnt, list, gate);
            partin = nullptr;
            GRID_BAR();
            {
                unsigned* done = (unsigned*)(ws + WS_CTL) + CW_DONE + 256 * layer;
                moe_build(F, cnt, list, stB, gate);
                {
                    MoeSched<true> S{F.lds + LDS_AUX, (const char*)(ws + WS_Z8), (const char*)(ws + WS_WUP) + (size_t)layer * 64 * 512 * DM, done};
                    EpiUp E{F.lds + LDS_AUX, stB, (const float*)(ws + WS_CSUP) + (size_t)layer * 64 * 512, (const float*)(ws + WS_BSUP) + (size_t)layer * 64 * 512, ws + WS_H, done};
                    pg8::gemm_phase<EpiUp, MoeSched<true>, true, true>(F.lds + LDS_STAGE, DM / 2, DM, DM, S, E);
                }
                {
                    MoeSched<false> S{F.lds + LDS_AUX, (const char*)(ws + WS_H), (const char*)(ws + WS_WDN) + (size_t)layer * 64 * DM * DEXP, done};
                    EpiDown E{F.lds + LDS_AUX, gate, ws + WS_YM};
                    pg8::gemm_phase<EpiDown, MoeSched<false>, false, true>(F.lds + LDS_STAGE, DEXP / 2, DEXP, DEXP, S, E);
                }
            }
            GRID_BAR();
            ym = ws + WS_YM;
        }
        if (layer < DEPTH - 1) combine_phase<false>(F, zB, stB, partin, P.in[I_L1G] + layer * DM, P.in[I_L1B] + layer * DM, ym, zA, stA, nullptr, nullptr, nullptr, (layer & 1) ? nullptr : ws + WS_ZA8);
        else combine_phase<true>(F, zB, stB, partin, P.in[I_L1G] + layer * DM, P.in[I_L1B] + layer * DM, ym, nullptr, nullptr, P.in[I_L2G] + layer * DM, P.in[I_L2B] + layer * DM, P.out, nullptr);
        if (layer < DEPTH - 1) GRID_BAR_L();
    }
}

extern "C" void kernel_launch(void* const* d_in, const int* in_sizes, int n_in, void* d_out, int out_size, void* d_ws, size_t ws_size, hipStream_t stream) {
    static int grid = 0;
    if (!grid) {
        if (n_in != 21 || out_size != T_TOK * DM || ws_size < WS_END) { fprintf(stderr, "kernel_launch: unexpected shapes (n_in %d out %d ws %zu need %zu)\n", n_in, out_size, ws_size, (size_t)WS_END); grid = -1; return; }
        int dev = 0, cus = 0, per_cu = 0;
        hipGetDevice(&dev); hipDeviceGetAttribute(&cus, hipDeviceAttributeMultiprocessorCount, dev);
        if (hipFuncSetAttribute((const void*)fwd_kernel, hipFuncAttributeMaxDynamicSharedMemorySize, LDS_BYTES) != hipSuccess) { fprintf(stderr, "kernel_launch: hipFuncSetAttribute failed\n"); grid = -1; return; }
        hipOccupancyMaxActiveBlocksPerMultiprocessor(&per_cu, (const void*)fwd_kernel, NTHREADS, LDS_BYTES);
        if (per_cu < 1) fprintf(stderr, "kernel_launch: occupancy query reports %d\n", per_cu);
        grid = 256;
        if (cus != 256) fprintf(stderr, "kernel_launch: %d CUs (built for 256)\n", cus);
    }
    if (grid <= 0) return;
    hipMemsetAsync((char*)d_ws + WS_CTL, 0, CTL_BYTES, stream);
    Params p{};
    for (int i = 0; i < 21; ++i) p.in[i] = (const float*)d_in[i];
    p.out = (float*)d_out; p.ws = (unsigned char*)d_ws; p.ph_lo = 0; p.ph_hi = 1000;
    hipLaunchKernelGGL(fwd_kernel, dim3(grid), dim3(NTHREADS), LDS_BYTES, stream, p);
}
```

```cpp
#include <hip/hip_runtime.h>
#include <cstdio>
#include <cstdint>

#define LAS __attribute__((address_space(3)))
#define GAS __attribute__((address_space(1)))
typedef unsigned short bf16_t;
typedef short bf16x8 __attribute__((ext_vector_type(8)));
typedef float f32x4 __attribute__((ext_vector_type(4)));
typedef float f32x2 __attribute__((ext_vector_type(2)));
typedef float f32x16 __attribute__((ext_vector_type(16)));
typedef unsigned u32x4 __attribute__((ext_vector_type(4)));
typedef unsigned u32x2 __attribute__((ext_vector_type(2)));

constexpr int T_TOK = 16384, DM = 1024, NBATCH = 8, SEQ = 2048, DEPTH = 4;
constexpr int NH = 16, KVL = 128, NIH = 8, IDXD = 64, TOPK = 256;
constexpr int AIW = 2760, AIWP = 2816;
constexpr int NGRP = 8, EPG = 8, NEXP = 64, DEXP = 256;
constexpr float LN_EPS = 1e-5f, RMS_EPS = 1e-6f;
constexpr float ALPHA = 1.6817928305074290f;
constexpr int NWAVES = 8, NTHREADS = 512;
constexpr int MAXBLK = 192;

constexpr size_t MiB = 1u << 20;
constexpr size_t alup(size_t x) { return (x + MiB - 1) & ~(MiB - 1); }
constexpr size_t WS_CTL = 0, CTL_BYTES = MiB;
constexpr size_t WS_VEC = WS_CTL + CTL_BYTES;
constexpr size_t WS_CSCI = WS_VEC + MiB;
constexpr size_t WS_BSCI = WS_CSCI + 2 * 3072 * 4;
constexpr size_t WS_CSAI = WS_BSCI + 2 * 3072 * 4;
constexpr size_t WS_BSAI = WS_CSAI + 2 * AIWP * 4;
constexpr size_t WS_CSR  = WS_BSAI + 2 * AIWP * 4;
constexpr size_t WS_BSR  = WS_CSR + 4 * 96 * 4;
constexpr size_t WS_CSUP = alup(WS_BSR + 4 * 96 * 4);
constexpr size_t WS_BSUP = WS_CSUP + (size_t)4 * 64 * 512 * 4;
constexpr size_t WS_WCI  = alup(WS_BSUP + (size_t)4 * 64 * 512 * 4);
constexpr size_t WS_WCO  = WS_WCI + (size_t)2 * 3072 * 1024 * 2;
constexpr size_t WS_WAI  = WS_WCO + (size_t)2 * 1024 * 1024 * 2;
constexpr size_t WS_WAO  = alup(WS_WAI + (size_t)2 * AIWP * 1024 * 2);
constexpr size_t WS_WR   = WS_WAO + (size_t)2 * 1024 * 2048 * 2;
constexpr size_t WS_WUP  = alup(WS_WR + (size_t)4 * 2 * 96 * 1024 * 2);
constexpr size_t WS_WDN  = WS_WUP + (size_t)4 * 64 * 512 * 1024 * 2;
constexpr size_t WS_ZA   = WS_WDN + (size_t)4 * 64 * 1024 * 256 * 2;
constexpr size_t WS_ZB   = WS_ZA + (size_t)T_TOK * DM * 2;
constexpr size_t WS_STA  = WS_ZB + (size_t)T_TOK * DM * 2;
constexpr size_t WS_STB  = WS_STA + (size_t)T_TOK * 8;
constexpr size_t WS_PART = alup(WS_STB + (size_t)T_TOK * 8);
constexpr size_t WS_U    = WS_PART + (size_t)T_TOK * 16 * 8;
constexpr size_t WS_BG   = WS_U + (size_t)T_TOK * DM * 2;
constexpr size_t WS_Y    = WS_BG + (size_t)T_TOK * DM * 2;
constexpr size_t WS_Q    = WS_Y + (size_t)T_TOK * DM * 2;
constexpr size_t WS_QI   = WS_Q + (size_t)T_TOK * 2048 * 2;
constexpr size_t WS_MISC = WS_QI + (size_t)T_TOK * 512 * 2;
constexpr size_t WS_CKV  = WS_MISC + (size_t)T_TOK * 256 * 4;
constexpr size_t WS_KI   = WS_CKV + (size_t)T_TOK * 128 * 2;
constexpr size_t WS_SEL  = WS_KI + (size_t)T_TOK * 64 * 2;
constexpr size_t WS_O    = WS_SEL + (size_t)T_TOK * 256 * 2;
constexpr size_t WS_LIST = WS_O + (size_t)T_TOK * 2048 * 2;
constexpr size_t WS_GATE = WS_LIST + (size_t)64 * 16384 * 4;
constexpr size_t WS_H    = alup(WS_GATE + (size_t)T_TOK * 8);
constexpr size_t WS_YM   = WS_H + (size_t)MAXBLK * 256 * 256 * 2;
constexpr size_t WS_CSP  = WS_YM + (size_t)T_TOK * 2 * DM * 2;
constexpr size_t WS_Z8   = WS_CSP + (size_t)2 * 32 * 4 * 64 * 512 * 4;
constexpr size_t WS_ZA8  = WS_Z8 + (size_t)T_TOK * DM;
constexpr size_t WS_END  = WS_ZA8 + (size_t)T_TOK * DM;

constexpr int CW_BAR = 4096;
constexpr int CW_CNT = 16384;
constexpr int CW_XCC = 8192;
constexpr int CW_QUEUE = 20480;
constexpr int CW_DONE = 24576;

constexpr int LDS_STAGE = 0, STAGE_BYTES_ALL = 131072;
constexpr int LDS_AUX = 131072;
constexpr int LDS_MISC = 131072 + 31744;
constexpr int LDS_BYTES = 163840;

__device__ __forceinline__ unsigned f2bf(float f) { unsigned u = __builtin_bit_cast(unsigned, f); return (u + 0x7fffu + ((u >> 16) & 1u)) >> 16; }
__device__ __forceinline__ float bf2f(unsigned b) { return __builtin_bit_cast(float, b << 16); }
__device__ __forceinline__ unsigned pk2(float lo, float hi) { return f2bf(lo) | (f2bf(hi) << 16); }
__device__ __forceinline__ float bflo(unsigned w) { return __builtin_bit_cast(float, w << 16); }
__device__ __forceinline__ float bfhi(unsigned w) { return __builtin_bit_cast(float, w & 0xffff0000u); }
__device__ __forceinline__ float shx(float v, int o, int lane) { return __builtin_bit_cast(float, __builtin_amdgcn_ds_bpermute((lane ^ o) << 2, __builtin_bit_cast(int, v))); }
__device__ __forceinline__ float dpp_f(float v, const int ctrl_sel) {
    const int x = __builtin_bit_cast(int, v);
    return __builtin_bit_cast(float, ctrl_sel == 0 ? __builtin_amdgcn_update_dpp(x, x, 0xB1, 0xF, 0xF, false)
                                   : ctrl_sel == 1 ? __builtin_amdgcn_update_dpp(x, x, 0x4E, 0xF, 0xF, false)
                                   : ctrl_sel == 2 ? __builtin_amdgcn_update_dpp(x, x, 0x141, 0xF, 0xF, false)
                                                   : __builtin_amdgcn_update_dpp(x, x, 0x140, 0xF, 0xF, false));
}
__device__ __forceinline__ float rows_sum(float v) {
    const unsigned a = __builtin_bit_cast(unsigned, v);
    const auto s16 = __builtin_amdgcn_permlane16_swap(a, a, false, false);
    const float m1 = __builtin_bit_cast(float, (unsigned)s16[0]) + __builtin_bit_cast(float, (unsigned)s16[1]);
    const unsigned b = __builtin_bit_cast(unsigned, m1);
    const auto s32 = __builtin_amdgcn_permlane32_swap(b, b, false, false);
    return __builtin_bit_cast(float, (unsigned)s32[0]) + __builtin_bit_cast(float, (unsigned)s32[1]);
}
__device__ __forceinline__ unsigned wave_incl_scan(unsigned v) {
    int x = (int)v;
    x += __builtin_amdgcn_update_dpp(0, x, 0x111, 0xF, 0xF, true);
    x += __builtin_amdgcn_update_dpp(0, x, 0x112, 0xF, 0xF, true);
    x += __builtin_amdgcn_update_dpp(0, x, 0x114, 0xF, 0xF, true);
    x += __builtin_amdgcn_update_dpp(0, x, 0x118, 0xF, 0xF, true);
    x += __builtin_amdgcn_update_dpp(0, x, 0x142, 0xA, 0xF, false);
    x += __builtin_amdgcn_update_dpp(0, x, 0x143, 0xC, 0xF, false);
    return (unsigned)x;
}
__device__ __forceinline__ unsigned dpp_u(unsigned v, const int ctrl_sel) {
    const int x = (int)v;
    return (unsigned)(ctrl_sel == 0 ? __builtin_amdgcn_update_dpp(x, x, 0xB1, 0xF, 0xF, false) : ctrl_sel == 1 ? __builtin_amdgcn_update_dpp(x, x, 0x4E, 0xF, 0xF, false)
                    : ctrl_sel == 2 ? __builtin_amdgcn_update_dpp(x, x, 0x141, 0xF, 0xF, false) : __builtin_amdgcn_update_dpp(x, x, 0x140, 0xF, 0xF, false));
}
__device__ __forceinline__ unsigned wave_max_u(unsigned v) {
    v = max(v, dpp_u(v, 0)); v = max(v, dpp_u(v, 1)); v = max(v, dpp_u(v, 2)); v = max(v, dpp_u(v, 3));
    const auto s16 = __builtin_amdgcn_permlane16_swap(v, v, false, false); v = max((unsigned)s16[0], (unsigned)s16[1]);
    const auto s32 = __builtin_amdgcn_permlane32_swap(v, v, false, false); return max((unsigned)s32[0], (unsigned)s32[1]);
}
__device__ __forceinline__ unsigned wave_sum_u(unsigned v) {
    v += dpp_u(v, 0); v += dpp_u(v, 1); v += dpp_u(v, 2); v += dpp_u(v, 3);
    const auto s16 = __builtin_amdgcn_permlane16_swap(v, v, false, false); v = (unsigned)s16[0] + (unsigned)s16[1];
    const auto s32 = __builtin_amdgcn_permlane32_swap(v, v, false, false); return (unsigned)s32[0] + (unsigned)s32[1];
}
__device__ __forceinline__ float wave_sum(float v, int lane) {
    (void)lane;
    v += dpp_f(v, 0); v += dpp_f(v, 1); v += dpp_f(v, 2); v += dpp_f(v, 3);
    return rows_sum(v);
}
__device__ __forceinline__ void st16wt(void* p, const u32x4 v) { asm volatile("global_store_dwordx4 %0, %1, off sc1\n\ts_nop 1" :: "v"(p), "v"(v) : "memory"); }
typedef int i32x8 __attribute__((ext_vector_type(8)));
__device__ __forceinline__ unsigned pk4_fp8(float a, float b, float c, float d) { int w = 0; w = __builtin_amdgcn_cvt_pk_fp8_f32(a, b, w, false); w = __builtin_amdgcn_cvt_pk_fp8_f32(c, d, w, true); return (unsigned)w; }
__device__ __forceinline__ float fp8_rt(float a) { const int w = __builtin_amdgcn_cvt_pk_fp8_f32(a, a, 0, false); return __builtin_amdgcn_cvt_f32_fp8(w, 0); }
__device__ __forceinline__ void st8wt(void* p, const u32x2 v) { __hip_atomic_store((unsigned long long*)p, ((unsigned long long)v.y << 32) | v.x, __ATOMIC_RELAXED, __HIP_MEMORY_SCOPE_AGENT); }
#define LDS_WAIT() asm volatile("s_waitcnt lgkmcnt(0)" ::: "memory")
#define VM_WAIT() asm volatile("s_waitcnt vmcnt(0)" ::: "memory")

#define XB_TMO      128
#define XB_XCNT(j)  (256  + 64 * (j))
#define XB_XSUB(j)  (1280 + 64 * (j))
#define XB_XGEN(j)  (2304 + 64 * (j))
#define XB_TOP      3328
#define XB_TOPGEN   3392
#define XCD_BAR_WORDS 3456
#define XB_SPIN_CAP (1u << 18)

__device__ __forceinline__ unsigned xb_ld(unsigned* p)              { return __hip_atomic_load(p, __ATOMIC_RELAXED, __HIP_MEMORY_SCOPE_AGENT); }
__device__ __forceinline__ unsigned xb_add(unsigned* p, unsigned v) { return __hip_atomic_fetch_add(p, v, __ATOMIC_RELAXED, __HIP_MEMORY_SCOPE_AGENT); }
__device__ __forceinline__ unsigned xb_xcc_id() { return (unsigned)__builtin_amdgcn_s_getreg((3 << 11) | 20) & 0xFu; }
#define XB_SPIN(cond, bar) do { unsigned _sp = 0; while (cond) { __builtin_amdgcn_s_sleep(1); \
    if ((++_sp & 255u) == 0u) { if (xb_ld(&(bar)[XB_TMO])) break; if (_sp > XB_SPIN_CAP) { atomicAdd(&(bar)[XB_TMO], 1u); break; } } } } while (0)

struct XcdBarrier {
    unsigned* bar; unsigned x;
    volatile LAS unsigned* st;
};

__device__ __forceinline__ XcdBarrier xcd_barrier_post(unsigned* bar, volatile LAS unsigned* st) {
    XcdBarrier b; b.bar = bar; b.x = xb_xcc_id(); b.st = st;
    if (threadIdx.x == 0) (void)xb_add(&bar[XB_XCNT(b.x)], 1u);
    return b;
}
__device__ __forceinline__ void xcd_barrier_complete(unsigned* bar, unsigned x, unsigned& nloc, unsigned& nx) {
    const unsigned G = gridDim.x * gridDim.y * gridDim.z;
    unsigned sum, cnt, mine, sp = 0u;
    for (;;) {
        sum = 0u; cnt = 0u; mine = 0u;
#pragma unroll
        for (unsigned j = 0; j < 16; ++j) { const unsigned c = xb_ld(&bar[XB_XCNT(j)]); sum += c; cnt += (c > 0u) ? 1u : 0u; mine = (j == x) ? c : mine; }
        if (sum == G) break;
        __builtin_amdgcn_s_sleep(1);
        if ((++sp & 255u) == 0u) { if (xb_ld(&bar[XB_TMO])) break; if (sp > XB_SPIN_CAP) { atomicAdd(&bar[XB_TMO], 1u); break; } }
    }
    nloc = mine > 0u ? mine : 1u; nx = cnt > 0u ? cnt : 1u;
}

template <bool LOCAL = false>
__device__ __forceinline__ void xcd_barrier(const XcdBarrier& b_in) {
    XcdBarrier b = b_in; asm volatile("" : "+s"(b.bar), "+s"(b.x));
    asm volatile("s_waitcnt vmcnt(0)" ::: "memory");
    __syncthreads();
    if (threadIdx.x == 0) {
        unsigned* bar = b.bar;
        __builtin_amdgcn_s_waitcnt(0);
        unsigned nloc = b.st[0], nx = b.st[1];
        if (nloc == 0u) { xcd_barrier_complete(bar, b.x, nloc, nx); b.st[0] = nloc; b.st[1] = nx; }
        const unsigned old = xb_add(&bar[XB_XSUB(b.x)], 1u);
        const unsigned gen = old / nloc;
        if (old + 1u == (gen + 1u) * nloc) {
          if (!(LOCAL && b.st[2] != 0u)) {
            __builtin_amdgcn_fence(__ATOMIC_RELEASE, "agent");
            asm volatile("s_waitcnt vmcnt(0)" ::: "memory");
            const unsigned og = xb_add(&bar[XB_TOP], 1u);
            const unsigned tg = og / nx;
            if (og + 1u == (tg + 1u) * nx) xb_add(&bar[XB_TOPGEN], 1u);
            else XB_SPIN(xb_ld(&bar[XB_TOPGEN]) == tg, bar);
          }
            __builtin_amdgcn_fence(__ATOMIC_ACQUIRE, "agent");
            xb_add(&bar[XB_XGEN(b.x)], 1u);
            asm volatile("s_waitcnt vmcnt(0)" ::: "memory");
        } else {
            XB_SPIN(xb_ld(&bar[XB_XGEN(b.x)]) == gen, bar);
            __builtin_amdgcn_fence(__ATOMIC_ACQUIRE, "agent");
            asm volatile("s_waitcnt vmcnt(0)" ::: "memory");
        }
    }
    __syncthreads();
}

struct Params { const float* in[21]; float* out; unsigned char* ws; int ph_lo, ph_hi; };
enum { I_X = 0, I_CWIN, I_CK, I_CWOUT, I_AWIN, I_KVG, I_KIG, I_KIB, I_AWOUT, I_RELB, I_RWG, I_RBG, I_RWE, I_RBE, I_W1, I_W3, I_W2, I_L1G, I_L1B, I_L2G, I_L2B };

struct Frame {
    LAS unsigned char* lds;
    int G, bx;
    int batch, jb;
    unsigned char* ws;
};

__device__ __forceinline__ unsigned bf4_to_fp8(const u32x2 w) {
    return pk4_fp8(__builtin_bit_cast(float, w.x << 16), __builtin_bit_cast(float, w.x & 0xffff0000u), __builtin_bit_cast(float, w.y << 16), __builtin_bit_cast(float, w.y & 0xffff0000u));
}
template <bool F8 = false>
__device__ __forceinline__ void prol_item64(const float* W, int K, int ldw, int src0, int nvalid, const float* gk, const float* bk, float colscale,
                                            void* Btv, int ldbt, int n0, float* cs, float* bs, LAS unsigned char* scr, int lane) {
    const int kk = lane >> 4, c4 = lane & 15;
    float csum[4] = {0.f, 0.f, 0.f, 0.f}, bsum[4] = {0.f, 0.f, 0.f, 0.f};
    const bool cv = 4 * c4 < nvalid;
    const unsigned sbase = (unsigned)(size_t)scr;
    const unsigned q4 = (unsigned)(lane & 15) >> 2, p4 = (unsigned)lane & 3u;
    for (int k0 = 0; k0 < K; k0 += 64) {
        f32x4 v[16]; float gv[16], bv[16];
#pragma unroll
        for (int ld = 0; ld < 16; ++ld) { gv[ld] = gk ? gk[k0 + 4 * ld + kk] : 1.f; bv[ld] = bk ? bk[k0 + 4 * ld + kk] : 0.f; }
#pragma unroll
        for (int ld = 0; ld < 16; ++ld) v[ld] = cv ? *(const f32x4*)(W + (size_t)(k0 + 4 * ld + kk) * ldw + src0 + 4 * c4) : (f32x4){0.f, 0.f, 0.f, 0.f};
#pragma unroll
        for (int ld = 0; ld < 16; ++ld) {
            const float g = gv[ld] * colscale, bb = bv[ld] * colscale;
            unsigned h[4];
#pragma unroll
            for (int e = 0; e < 4; ++e) { if constexpr (F8) { const float r = fp8_rt(v[ld][e] * g); h[e] = __builtin_bit_cast(unsigned, r) >> 16; csum[e] += r; } else { h[e] = f2bf(v[ld][e] * g); csum[e] += bf2f(h[e]); } bsum[e] += v[ld][e] * bb; }
            *(LAS u32x2*)(scr + (4 * ld + kk) * 144 + c4 * 8) = (u32x2){h[0] | (h[1] << 16), h[2] | (h[3] << 16)};
        }
        LDS_WAIT(); asm volatile("" ::: "memory");
        u32x2 tr[4][2][2];
#pragma unroll
        for (int nt = 0; nt < 4; ++nt)
#pragma unroll
            for (int ch = 0; ch < 2; ++ch) {
                const unsigned a0 = sbase + (8u * (unsigned)(kk + 4 * ch) + q4) * 144u + (16u * nt + 4u * p4) * 2u, a1 = a0 + 4u * 144u;
                asm volatile("ds_read_b64_tr_b16 %0, %2\n\tds_read_b64_tr_b16 %1, %3" : "=&v"(tr[nt][ch][0]), "=&v"(tr[nt][ch][1]) : "v"(a0), "v"(a1) : "memory");
            }
        asm volatile("s_waitcnt lgkmcnt(0)" : "+v"(tr[0][0][0]), "+v"(tr[0][0][1]), "+v"(tr[0][1][0]), "+v"(tr[0][1][1]), "+v"(tr[1][0][0]), "+v"(tr[1][0][1]), "+v"(tr[1][1][0]), "+v"(tr[1][1][1]),
                     "+v"(tr[2][0][0]), "+v"(tr[2][0][1]), "+v"(tr[2][1][0]), "+v"(tr[2][1][1]), "+v"(tr[3][0][0]), "+v"(tr[3][0][1]), "+v"(tr[3][1][0]), "+v"(tr[3][1][1]) :: "memory");
#pragma unroll
        for (int nt = 0; nt < 4; ++nt)
#pragma unroll
            for (int ch = 0; ch < 2; ++ch) {
                if constexpr (F8) *(u32x2*)((unsigned char*)Btv + (size_t)(n0 + 16 * nt + (lane & 15)) * ldbt + k0 + 8 * (kk + 4 * ch)) = (u32x2){bf4_to_fp8(tr[nt][ch][0]), bf4_to_fp8(tr[nt][ch][1])};
                else { u32x4 o; o.x = tr[nt][ch][0].x; o.y = tr[nt][ch][0].y; o.z = tr[nt][ch][1].x; o.w = tr[nt][ch][1].y;
                    *(u32x4*)((bf16_t*)Btv + (size_t)(n0 + 16 * nt + (lane & 15)) * ldbt + k0 + 8 * (kk + 4 * ch)) = o; }
            }
    }
    if (cs) {
#pragma unroll
        for (int e = 0; e < 4; ++e) { csum[e] = rows_sum(csum[e]); bsum[e] = rows_sum(bsum[e]); }
        if (kk == 0) { *(f32x4*)(cs + n0 + 4 * c4) = (f32x4){csum[0], csum[1], csum[2], csum[3]}; *(f32x4*)(bs + n0 + 4 * c4) = (f32x4){bsum[0], bsum[1], bsum[2], bsum[3]}; }
    }
}

constexpr int PT_TILES = 3 * 4096, PT_GRAN = 2, PT_BUF = 50176;
struct PTile { const float* src; int ldw; unsigned char* bt; int ldbt; int kbase; int rowadd; int up; const float* gk; const float* bk; float* csp; };
__device__ __forceinline__ PTile pt_decode(const Params& P, unsigned char* ws, int T) {
    PTile t;
    if (T < 8192) { const int which = T >> 12, r = T & 4095, le = r >> 4, kt = r & 15, l = le >> 6;
        t.src = (which ? P.in[I_W3] : P.in[I_W1]) + (size_t)le * DM * DEXP + (size_t)kt * 64 * DEXP; t.ldw = DEXP; t.bt = ws + WS_WUP + (size_t)le * 512 * DM; t.ldbt = DM; t.kbase = 64 * kt;
        t.rowadd = 128 * which; t.up = 1; t.gk = P.in[I_L1G] + l * DM + 64 * kt; t.bk = P.in[I_L1B] + l * DM + 64 * kt; t.csp = (float*)(ws + WS_CSP) + ((size_t)kt * 256 + le) * 512;
    } else { const int r = T - 8192, le = r >> 4, kt = (r >> 2) & 3, nq = r & 3;
        t.src = P.in[I_W2] + (size_t)le * DEXP * DM + (size_t)kt * 64 * DM + 256 * nq; t.ldw = DM; t.bt = ws + WS_WDN + (size_t)le * DM * DEXP; t.ldbt = DEXP; t.kbase = 64 * kt;
        t.rowadd = 256 * nq; t.up = 0; t.gk = nullptr; t.bk = nullptr; t.csp = nullptr; }
    return t;
}
__device__ __forceinline__ void p0_expert_tiles(const Frame& F, const Params& P, int tid, int lane, int wave) {
    unsigned char* ws = F.ws;
    volatile LAS int* slot = (volatile LAS int*)(F.lds + LDS_MISC + 64);
    unsigned* qctr = (unsigned*)(ws + WS_CTL) + CW_QUEUE;
    if (tid == 0) { slot[0] = (int)atomicAdd(qctr, (unsigned)PT_GRAN); slot[1] = (int)atomicAdd(qctr, (unsigned)PT_GRAN); }
    __syncthreads();
    int g0 = slot[0], g1 = slot[1], par = 0;
    const unsigned g16 = (unsigned)lane >> 4, q4 = (unsigned)(lane & 15) >> 2, p4 = (unsigned)lane & 3u;
    f32x4 cur[PT_GRAN][8], nxt[PT_GRAN][8];
#define PT_LOAD(T, vv) do { const PTile _t = pt_decode(P, ws, (T)); _Pragma("unroll") for (int i = 0; i < 8; ++i) vv[i] = *(const f32x4*)(_t.src + (size_t)(8 * wave + i) * _t.ldw + 4 * lane); } while (0)
    if (g0 < PT_TILES) {
#pragma unroll
        for (int j = 0; j < PT_GRAN; ++j) PT_LOAD(g0 + j, cur[j]); }
    while (g0 < PT_TILES) {
        if (tid == 0) slot[2 + par] = (int)atomicAdd(qctr, (unsigned)PT_GRAN);
        if (g1 < PT_TILES) {
#pragma unroll
            for (int j = 0; j < PT_GRAN; ++j) PT_LOAD(g1 + j, nxt[j]); }
#pragma unroll
        for (int j = 0; j < PT_GRAN; ++j) {
            const PTile t = pt_decode(P, ws, g0 + j);
            LAS unsigned char* tile = F.lds + (j & 1) * PT_BUF;
            LAS float* part = (LAS float*)(F.lds + (j & 1) * PT_BUF + 33792);
            f32x4 pc = (f32x4){0.f, 0.f, 0.f, 0.f}, pb = (f32x4){0.f, 0.f, 0.f, 0.f};
#pragma unroll
            for (int i = 0; i < 8; ++i) {
                const float gvi = t.up ? t.gk[8 * wave + i] : 1.f, bvi = t.up ? t.bk[8 * wave + i] : 0.f;
                const int w8 = (int)pk4_fp8(cur[j][i][0] * gvi, cur[j][i][1] * gvi, cur[j][i][2] * gvi, cur[j][i][3] * gvi);
                const float r0 = __builtin_amdgcn_cvt_f32_fp8(w8, 0), r1 = __builtin_amdgcn_cvt_f32_fp8(w8, 1), r2 = __builtin_amdgcn_cvt_f32_fp8(w8, 2), r3 = __builtin_amdgcn_cvt_f32_fp8(w8, 3);
                pc[0] += r0; pc[1] += r1; pc[2] += r2; pc[3] += r3;
#pragma unroll
                for (int e = 0; e < 4; ++e) pb[e] += cur[j][i][e] * bvi;
                *(LAS u32x2*)(tile + (8 * wave + i) * 528 + lane * 8) = (u32x2){(__builtin_bit_cast(unsigned, r0) >> 16) | (__builtin_bit_cast(unsigned, r1) & 0xffff0000u),
                                                                                (__builtin_bit_cast(unsigned, r2) >> 16) | (__builtin_bit_cast(unsigned, r3) & 0xffff0000u)};
            }
            if (t.up) { *(LAS f32x4*)(part + wave * 256 + 4 * lane) = pc; *(LAS f32x4*)(part + 2048 + wave * 256 + 4 * lane) = pb; }
            __syncthreads();
            {
                u32x2 tr[2][4];
                const unsigned sbase = (unsigned)(size_t)tile;
#pragma unroll
                for (int jj = 0; jj < 2; ++jj)
#pragma unroll
                    for (int c = 0; c < 4; ++c) {
                        const unsigned a0 = sbase + (16u * g16 + 4u * c + q4) * 528u + (16u * (2 * wave + jj) + 4u * p4) * 2u;
                        asm volatile("ds_read_b64_tr_b16 %0, %1" : "=&v"(tr[jj][c]) : "v"(a0) : "memory");
                    }
                asm volatile("s_waitcnt lgkmcnt(0)" : "+v"(tr[0][0]), "+v"(tr[0][1]), "+v"(tr[0][2]), "+v"(tr[0][3]), "+v"(tr[1][0]), "+v"(tr[1][1]), "+v"(tr[1][2]), "+v"(tr[1][3]) :: "memory");
#pragma unroll
                for (int jj = 0; jj < 2; ++jj) {
                    const int n = 16 * (2 * wave + jj) + (lane & 15);
                    const int brow = t.up ? (n & 127) + 256 * (n >> 7) + t.rowadd : 128 * ((n >> 3) & 1) + 32 * (n >> 6) + 8 * ((n >> 4) & 3) + (n & 7) + t.rowadd;
                    u32x4 o; o.x = bf4_to_fp8(tr[jj][0]); o.y = bf4_to_fp8(tr[jj][1]); o.z = bf4_to_fp8(tr[jj][2]); o.w = bf4_to_fp8(tr[jj][3]);
                    *(u32x4*)(t.bt + (size_t)brow * t.ldbt + t.kbase + 16 * g16) = o;
                }
            }
            if (t.up && tid < 256) {
                float cs = part[tid], bs = part[2048 + tid];
#pragma unroll
                for (int w2 = 1; w2 < 8; ++w2) { cs += part[w2 * 256 + tid]; bs += part[2048 + w2 * 256 + tid]; }
                const int brow = (tid & 127) + 256 * (tid >> 7) + t.rowadd;
                t.csp[brow] = cs; t.csp[(size_t)32 * 4 * 64 * 512 + brow] = bs;
            }
        }
        g0 = g1; g1 = slot[2 + par]; par ^= 1;
#pragma unroll
        for (int j = 0; j < PT_GRAN; ++j)
#pragma unroll
            for (int i = 0; i < 8; ++i) cur[j][i] = nxt[j][i];
    }
    __syncthreads();
#undef PT_LOAD
}

__device__ __forceinline__ void p0_heavy_item(const Params& P, unsigned char* ws, int r, LAS unsigned char* scr, int lane) {
    constexpr int N_AO = 2 * 16 * 2, N_CI = 2 * 48, N_AI = 2 * 44;
    if (r < N_AO) {
        const int jl = r / 32, g = (r % 32) >> 1, kh = r & 1;
        prol_item64<true>(P.in[I_AWOUT] + (size_t)jl * 2048 * DM + (size_t)kh * 1024 * DM, 1024, DM, 64 * g, 64, nullptr, nullptr, 64.f,
                    ws + WS_WAO + (size_t)jl * DM * 2048 + kh * 1024, 2048, 64 * g, nullptr, nullptr, scr, lane);
        return; }
    r -= N_AO;
    if (r < N_CI) {
        const int jl = r / 48, g = r % 48, n0 = 64 * g;
        int src;
        if (n0 < 2048) { const int p = n0 >> 8, half = (n0 >> 7) & 1; src = (half ? 2048 : 1024) + 128 * p + (n0 & 127); } else src = n0 - 2048;
        const float* gk = jl ? P.in[I_L2G] + (2 * jl - 1) * DM : nullptr; const float* bk = jl ? P.in[I_L2B] + (2 * jl - 1) * DM : nullptr;
        prol_item64(P.in[I_CWIN] + (size_t)jl * DM * 3072, DM, 3072, src, 64, gk, bk, 1.f, (bf16_t*)(ws + WS_WCI) + (size_t)jl * 3072 * DM, DM, n0,
                    (float*)(ws + WS_CSCI) + jl * 3072, (float*)(ws + WS_BSCI) + jl * 3072, scr, lane);
        return; }
    r -= N_CI;
    if (r < N_AI) {
        const int jl = r / 44, g = r % 44, n0 = 64 * g;
        int src, nvalid = 64; float sc = 1.f;
        if (n0 < 2048) { src = n0; sc = 0.08838834764831845f; }
        else if (n0 < 2176) src = n0;
        else if (n0 < 2240) src = 2688;
        else if (n0 < 2304) { src = 2752; nvalid = 8; sc = 0.35355339059327373f; }
        else { src = 2176 + (n0 - 2304); sc = 0.125f; }
        if (n0 < 2048)
            prol_item64<true>(P.in[I_AWIN] + (size_t)jl * DM * AIW, DM, AIW, src, nvalid, P.in[I_L2G] + (2 * jl) * DM, P.in[I_L2B] + (2 * jl) * DM, 1.f,
                    ws + WS_WAI + (size_t)jl * AIWP * DM * 2, DM, n0, (float*)(ws + WS_CSAI) + jl * AIWP, (float*)(ws + WS_BSAI) + jl * AIWP, scr, lane);
        else
            prol_item64(P.in[I_AWIN] + (size_t)jl * DM * AIW, DM, AIW, src, nvalid, P.in[I_L2G] + (2 * jl) * DM, P.in[I_L2B] + (2 * jl) * DM, sc,
                    (bf16_t*)(ws + WS_WAI) + (size_t)jl * AIWP * DM, DM, n0, (float*)(ws + WS_CSAI) + jl * AIWP, (float*)(ws + WS_BSAI) + jl * AIWP, scr, lane);
        return; }
    r -= N_AI;
    {
        const int jl = r / 16, g = r % 16;
        prol_item64(P.in[I_CWOUT] + (size_t)jl * DM * DM, DM, DM, 64 * g, 64, nullptr, nullptr, 1.f, (bf16_t*)(ws + WS_WCO) + (size_t)jl * DM * DM, DM, 64 * g, nullptr, nullptr, scr, lane);
    }
}

__device__ __forceinline__ void p0_prologue(const Frame& F, const Params& P) {
    int tid = threadIdx.x; asm volatile("" : "+v"(tid)); const int lane = tid & 63, wave = __builtin_amdgcn_readfirstlane(tid >> 6);
    LAS unsigned char* scr = F.lds + LDS_STAGE + wave * 16896;
    const int gw = F.bx * NWAVES + wave, NGW = F.G * NWAVES;
    unsigned char* ws = F.ws;
    constexpr int N_DENSE = 2 * 16 * 2 + 2 * 48 + 2 * 44 + 2 * 16;
    if (gw < N_DENSE) p0_heavy_item(P, ws, gw, scr, lane);
    __syncthreads();
    p0_expert_tiles(F, P, tid, lane, wave);
    if (gw < 4 * 96) {
        const int l = gw / 96, n = gw % 96;
        const int ks = lane >> 1, fq0 = 2 * (lane & 1), nt = n >> 4;
        bf16_t* hi = (bf16_t*)(ws + WS_WR) + ((((size_t)(l * 32 + ks) * 2 + 0) * 6 + nt) * 64 + (n & 15) + 16 * fq0) * 8; bf16_t* lo = hi + (size_t)6 * 64 * 8;
        float csum = 0.f, bsum = 0.f; unsigned hw[8], lw[8];
        if (n < 72) {
            const float* Wc = n < 8 ? P.in[I_RWG] + (size_t)l * DM * 8 + n : P.in[I_RWE] + (size_t)l * DM * 64 + (n - 8); const int ldw = n < 8 ? 8 : 64;
            float w[16], g[16], b[16];
#pragma unroll
            for (int i = 0; i < 16; ++i) w[i] = Wc[(size_t)(16 * lane + i) * ldw];
#pragma unroll
            for (int i = 0; i < 4; ++i) { const f32x4 g4 = *(const f32x4*)(P.in[I_L1G] + l * DM + 16 * lane + 4 * i), b4 = *(const f32x4*)(P.in[I_L1B] + l * DM + 16 * lane + 4 * i);
#pragma unroll
                for (int e = 0; e < 4; ++e) { g[4 * i + e] = g4[e]; b[4 * i + e] = b4[e]; } }
            unsigned hb[16], lb[16];
#pragma unroll
            for (int i = 0; i < 16; ++i) { const float wf = w[i] * g[i]; hb[i] = f2bf(wf); const float h = bf2f(hb[i]); lb[i] = f2bf(wf - h); csum += h + bf2f(lb[i]); bsum += w[i] * b[i]; }
#pragma unroll
            for (int i = 0; i < 8; ++i) { hw[i] = hb[2 * i] | (hb[2 * i + 1] << 16); lw[i] = lb[2 * i] | (lb[2 * i + 1] << 16); }
        } else {
#pragma unroll
            for (int i = 0; i < 8; ++i) { hw[i] = 0u; lw[i] = 0u; }
        }
        *(u32x4*)hi = (u32x4){hw[0], hw[1], hw[2], hw[3]}; *(u32x4*)(hi + 16 * 8) = (u32x4){hw[4], hw[5], hw[6], hw[7]};
        *(u32x4*)lo = (u32x4){lw[0], lw[1], lw[2], lw[3]}; *(u32x4*)(lo + 16 * 8) = (u32x4){lw[4], lw[5], lw[6], lw[7]};
        csum = wave_sum(csum, lane); bsum = wave_sum(bsum, lane);
        if (lane == 0) { ((float*)(ws + WS_CSR))[l * 96 + n] = csum; ((float*)(ws + WS_BSR))[l * 96 + n] = bsum; }
    }
    for (int m0 = gw; m0 < T_TOK; m0 += 4 * NGW) {
        f32x4 xv[4][4];
#pragma unroll
        for (int r = 0; r < 4; ++r) { const GAS f32x4* xr = (const GAS f32x4*)(P.in[I_X] + (size_t)(m0 + r * NGW) * DM) + lane;
#pragma unroll
            for (int q = 0; q < 4; ++q) xv[r][q] = xr[64 * q]; }
#pragma unroll
        for (int r = 0; r < 4; ++r) { const int m = m0 + r * NGW;
            GAS u32x2* o = (GAS u32x2*)((bf16_t*)(ws + WS_ZA) + (size_t)m * DM) + lane;
#pragma unroll
            for (int q = 0; q < 4; ++q) { const f32x4 v = xv[r][q]; u32x2 w; w.x = pk2(v.x, v.y); w.y = pk2(v.z, v.w); o[64 * q] = w; }
            if (lane == 0) { float* st = (float*)(ws + WS_STA) + 2 * m; st[0] = 0.f; st[1] = 1.f; } }
    }
    if (F.bx == 0) { float* v = (float*)(ws + WS_VEC); for (int i = tid; i < 2048; i += NTHREADS) v[i] = i < 1024 ? 1.f : 0.f; }
}

__device__ __forceinline__ f32x2 stats_from_part(const float* part, int row);
template <bool FINAL>
__device__ __forceinline__ void combine_phase(const Frame& F, const bf16_t* zin, const float* stin, const float* partin, const float* g, const float* b, const unsigned char* y,
                                              bf16_t* zout, float* stout, const float* gout, const float* bout, float* out, unsigned char* z8out) {
    int tid = threadIdx.x; asm volatile("" : "+v"(tid)); const int lane = tid & 63, wave = __builtin_amdgcn_readfirstlane(tid >> 6); (void)lane; (void)wave;
    const int row0 = 2048 * F.batch + 64 * F.jb + 8 * wave;
    const int c0 = 8 * lane;
    float gv[2][8], bv[2][8];
#pragma unroll
    for (int j2 = 0; j2 < 2; ++j2) {
        const f32x4 g0 = *(const f32x4*)(g + c0 + 512 * j2), g1 = *(const f32x4*)(g + c0 + 512 * j2 + 4), b0 = *(const f32x4*)(b + c0 + 512 * j2), b1 = *(const f32x4*)(b + c0 + 512 * j2 + 4);
#pragma unroll
        for (int e = 0; e < 4; ++e) { gv[j2][e] = g0[e]; gv[j2][4 + e] = g1[e]; bv[j2][e] = b0[e]; bv[j2][4 + e] = b1[e]; }
    }
    for (int r2 = 0; r2 < 8; r2 += 8) {
      u32x4 zws[8][2]; u32x2 yws[8][2][2]; f32x2 sts[8];
#pragma unroll
      for (int rr = 0; rr < 8; ++rr) { const int row = row0 + r2 + rr;
          sts[rr] = partin ? stats_from_part(partin, row) : *(const f32x2*)(stin + 2 * row);
#pragma unroll
          for (int j2 = 0; j2 < 2; ++j2) { zws[rr][j2] = *(const u32x4*)(zin + (size_t)row * DM + c0 + 512 * j2);
              if (y) {
#pragma unroll
                  for (int sl = 0; sl < 2; ++sl) yws[rr][j2][sl] = *(const u32x2*)(y + ((size_t)row * 2 + sl) * DM + c0 + 512 * j2); } } }
#pragma unroll
      for (int rr = 0; rr < 8; ++rr) {
        const int row = row0 + r2 + rr;
        const f32x2 st = sts[rr];
        float v[2][8]; float s = 0.f;
#pragma unroll
        for (int j2 = 0; j2 < 2; ++j2) {
            const u32x4 zw = zws[rr][j2];
            float z[8] = {bflo(zw.x), bfhi(zw.x), bflo(zw.y), bfhi(zw.y), bflo(zw.z), bfhi(zw.z), bflo(zw.w), bfhi(zw.w)};
            float acc[8];
#pragma unroll
            for (int e = 0; e < 8; ++e) acc[e] = ALPHA * ((z[e] - st.x) * st.y * gv[j2][e] + bv[j2][e]);
            if (y) {
#pragma unroll
                for (int sl = 0; sl < 2; ++sl) {
                    const u32x2 yw = yws[rr][j2][sl];
                    acc[0] += 0.0625f * __builtin_amdgcn_cvt_f32_fp8((int)yw.x, 0); acc[1] += 0.0625f * __builtin_amdgcn_cvt_f32_fp8((int)yw.x, 1); acc[2] += 0.0625f * __builtin_amdgcn_cvt_f32_fp8((int)yw.x, 2); acc[3] += 0.0625f * __builtin_amdgcn_cvt_f32_fp8((int)yw.x, 3);
                    acc[4] += 0.0625f * __builtin_amdgcn_cvt_f32_fp8((int)yw.y, 0); acc[5] += 0.0625f * __builtin_amdgcn_cvt_f32_fp8((int)yw.y, 1); acc[6] += 0.0625f * __builtin_amdgcn_cvt_f32_fp8((int)yw.y, 2); acc[7] += 0.0625f * __builtin_amdgcn_cvt_f32_fp8((int)yw.y, 3);
                }
            }
            if (!FINAL) {
#pragma unroll
                for (int e = 0; e < 8; ++e) acc[e] = bf2f(f2bf(acc[e]));
            }
#pragma unroll
            for (int e = 0; e < 8; ++e) { v[j2][e] = acc[e]; s += acc[e]; }
        }
        const float mean = wave_sum(s, lane) * (1.f / DM);
        float s2 = 0.f;
#pragma unroll
        for (int j2 = 0; j2 < 2; ++j2)
#pragma unroll
            for (int e = 0; e < 8; ++e) { const float d = v[j2][e] - mean; s2 += d * d; }
        const float rstd = 1.f / sqrtf(wave_sum(s2, lane) * (1.f / DM) + LN_EPS);
        if (!FINAL) {
#pragma unroll
            for (int j2 = 0; j2 < 2; ++j2) {
                u32x4 o; o.x = pk2(v[j2][0], v[j2][1]); o.y = pk2(v[j2][2], v[j2][3]); o.z = pk2(v[j2][4], v[j2][5]); o.w = pk2(v[j2][6], v[j2][7]);
                *(u32x4*)(zout + (size_t)row * DM + c0 + 512 * j2) = o;
                if (z8out) *(u32x2*)(z8out + (size_t)row * DM + c0 + 512 * j2) = (u32x2){pk4_fp8(v[j2][0], v[j2][1], v[j2][2], v[j2][3]), pk4_fp8(v[j2][4], v[j2][5], v[j2][6], v[j2][7])};
            }
            if (lane == 0) { *(f32x2*)(stout + 2 * row) = (f32x2){mean, rstd}; }
        } else {
#pragma unroll
            for (int j2 = 0; j2 < 2; ++j2) {
                const f32x4 g0 = *(const f32x4*)(gout + c0 + 512 * j2), g1 = *(const f32x4*)(gout + c0 + 512 * j2 + 4), b0 = *(const f32x4*)(bout + c0 + 512 * j2), b1 = *(const f32x4*)(bout + c0 + 512 * j2 + 4);
                f32x4 o0, o1;
#pragma unroll
                for (int e = 0; e < 4; ++e) { o0[e] = (v[j2][e] - mean) * rstd * g0[e] + b0[e]; o1[e] = (v[j2][4 + e] - mean) * rstd * g1[e] + b1[e]; }
                *(f32x4*)(out + (size_t)row * DM + c0 + 512 * j2) = o0; *(f32x4*)(out + (size_t)row * DM + c0 + 512 * j2 + 4) = o1;
            }
        }
      }
    }
}

namespace pg8 {
constexpr int BM = 256, BK = 64, HALF = 128, HTB = HALF * BK * 2, STAGE_BYTES = 8 * HTB, NXCD = 8, WGM = 8;
__host__ __device__ __forceinline__ int lds_byte(int r, int c) { const int st = (r >> 4) * 2 + (c >> 5), rr = r & 15, cc = c & 31, ob = rr * 64 + cc * 2; return st * 1024 + (ob ^ (((ob >> 9) & 1) << 5)); }
__host__ __device__ __forceinline__ void stage_rc(int b, int& R, int& C) { const int st = b / 1024, sb = b % 1024, swz = sb ^ (((sb >> 9) & 1) << 5); R = (st >> 1) * 16 + swz / 64; C = (st & 1) * 32 + (swz % 64) / 2; }
__host__ __device__ __forceinline__ int perm32(int rho) { const int n = rho >> 4, i = rho & 15; return 8 * (i >> 2) + 4 * n + (i & 3); }

struct Unit { const char* A; const char* B; int pm, pn, x0, x1; };

struct StaticOrder {
    int nM, nN, nwg, G, c; const char* A; const char* B; size_t astep, bstep;
    __device__ void init(int M, int N, int G_, int c_, const void* A_, size_t lda_bytes, const void* B_, size_t ldb_bytes) { nM = M / BM; nN = N / BM; nwg = nM * nN; G = G_; c = c_; A = (const char*)A_; B = (const char*)B_; astep = lda_bytes * BM; bstep = ldb_bytes * BM; }
    __device__ bool next(int i, Unit& u) const {
        const long L = (long)i * G + c; if (L >= nwg) return false;
        int wgid = (int)L; { const int q = nwg / NXCD, r = nwg % NXCD, xcd = wgid % NXCD, off = wgid / NXCD; wgid = (xcd < r ? xcd * (q + 1) : r * (q + 1) + (xcd - r) * q) + off; }
        const int nig = WGM * nN, gid = wgid / nig, fm = gid * WGM, gsz = (nM - fm) < WGM ? (nM - fm) : WGM;
        u.pm = fm + ((wgid % nig) % gsz); u.pn = (wgid % nig) / gsz; u.A = A + (size_t)u.pm * astep; u.B = B + (size_t)u.pn * bstep; u.x0 = 0; u.x1 = 0; return true;
    }
    __device__ __forceinline__ const LAS unsigned* rowoff(int) const { return nullptr; }
    __device__ __forceinline__ void a_ready(const Unit&) const {}
};

__device__ __forceinline__ unsigned cvt_pk_bf16(float lo, float hi) { unsigned r; asm volatile("v_cvt_pk_bf16_f32 %0, %1, %2" : "=v"(r) : "v"(lo), "v"(hi)); return r; }

template <class Epi, class Sched, bool GATHER, bool FP8 = false>
__device__ __forceinline__ void gemm_phase(LAS unsigned char* lds, const int K, const unsigned lda_bytes, const unsigned ldb_bytes, const Sched& S, const Epi& E, const int b_e8m0 = 127) {
    int tid = threadIdx.x; asm volatile("" : "+v"(tid));
    const int wid = __builtin_amdgcn_readfirstlane(tid >> 6), lane = tid & 63, wr = wid >> 2, wc = wid & 3, fr = lane & 15, fq = lane >> 4;
    int nt = K / BK; asm volatile("" : "+s"(nt));
    unsigned voffA[2], voffB[2];
#pragma unroll
    for (int i = 0; i < 2; ++i) { int R, C; stage_rc(tid * 16 + i * 8192, R, C); const int Rb = (R & ~31) + perm32(R & 31);
        voffA[i] = (unsigned)R * lda_bytes + (unsigned)C * 2u; voffB[i] = (unsigned)Rb * ldb_bytes + (unsigned)C * 2u; }
#define PG8_GOFF(dst, ro) do { int _t = threadIdx.x; asm volatile("" : "+v"(_t)); _Pragma("unroll") for (int _i = 0; _i < 2; ++_i) { int _R, _C; stage_rc(_t * 16 + _i * 8192, _R, _C); \
        _Pragma("unroll") for (int _h = 0; _h < 2; ++_h) dst[_h][_i] = (ro)[_h * HALF + _R] + (unsigned)_C * 2u; } } while (0)
    const size_t kstep = (size_t)(BK * 2);
    const size_t hstepA = (size_t)HALF * lda_bytes, hstepB = (size_t)HALF * ldb_bytes;
    const unsigned ldsw = (unsigned)wid * 1024u;
    const int aoff = lds_byte(wr * 64 + fr, fq * 8), boff = lds_byte(wc * 32 + fr, fq * 8);
#define PG8_SA(b, h) (((b) * 2 + (h)) * HTB)
#define PG8_SB(b, h) ((4 + (b) * 2 + (h)) * HTB)
#define PG8_GLDS(src, bufoff, i) __builtin_amdgcn_global_load_lds((const unsigned*)(src), (LAS unsigned*)(lds + (bufoff) + ldsw + (i) * 8192), 16, 0, 0)
#define PG8_STAGE_B(bufoff, gbase) do { _Pragma("unroll") for (int _i = 0; _i < 2; ++_i) PG8_GLDS((const char*)(gbase) + voffB[_i], bufoff, _i); } while (0)
#define PG8_STAGE_A(bufoff, gbase, h, GO) do { _Pragma("unroll") for (int _i = 0; _i < 2; ++_i) { \
        if constexpr (GATHER) PG8_GLDS((const char*)(gbase) + (GO)[h][_i], bufoff, _i); else PG8_GLDS((const char*)(gbase) + (h) * hstepA + voffA[_i], bufoff, _i); } } while (0)
#define PG8_LDA(dst, b, h) do { _Pragma("unroll") for (int m = 0; m < 4; ++m) _Pragma("unroll") for (int k = 0; k < 2; ++k) dst[m][k] = *(const LAS bf16x8*)(lds + PG8_SA(b, h) + aoff + m * 2048 + k * 1024); } while (0)
#define PG8_LDB(dst, b, h) do { _Pragma("unroll") for (int n = 0; n < 2; ++n) _Pragma("unroll") for (int k = 0; k < 2; ++k) dst[n][k] = *(const LAS bf16x8*)(lds + PG8_SB(b, h) + boff + n * 2048 + k * 1024); } while (0)
#define PG8_MMA(ai, bj, At, Bt) do { __builtin_amdgcn_s_setprio(1); _Pragma("unroll") for (int m = 0; m < 4; ++m) _Pragma("unroll") for (int n = 0; n < 2; ++n) { \
        if constexpr (FP8) { const u32x4 b0 = __builtin_bit_cast(u32x4, Bt[n][0]), b1 = __builtin_bit_cast(u32x4, Bt[n][1]), a0 = __builtin_bit_cast(u32x4, At[m][0]), a1 = __builtin_bit_cast(u32x4, At[m][1]); \
            const i32x8 vb = {(int)b0.x, (int)b0.y, (int)b0.z, (int)b0.w, (int)b1.x, (int)b1.y, (int)b1.z, (int)b1.w}, va = {(int)a0.x, (int)a0.y, (int)a0.z, (int)a0.w, (int)a1.x, (int)a1.y, (int)a1.z, (int)a1.w}; \
            asm volatile("v_mfma_scale_f32_16x16x128_f8f6f4 %0, %1, %2, %0, %3, %4 op_sel_hi:[0,0,0]" : "+v"(acc[ai][bj][m][n]) : "v"(vb), "v"(va), "v"(fp8_bscale), "v"(fp8_scale)); } \
        else { _Pragma("unroll") for (int k = 0; k < 2; ++k) acc[ai][bj][m][n] = __builtin_amdgcn_mfma_f32_16x16x32_bf16(Bt[n][k], At[m][k], acc[ai][bj][m][n], 0, 0, 0); } } \
        __builtin_amdgcn_s_setprio(0); } while (0)
#define PG8_WAIT_V(n) asm volatile("s_waitcnt vmcnt(" #n ")" ::: "memory")
#define PG8_WAIT_L(n) asm volatile("s_waitcnt lgkmcnt(" #n ")" ::: "memory")
#define PG8_BAR __builtin_amdgcn_s_barrier()
#define PG8_SCHED __builtin_amdgcn_sched_barrier(0)
    Unit cur, nxt; int ui = 0;
    if (!S.next(0, cur)) return;
    int fp8_scale = 0x7F7F7F7F; asm volatile("" : "+v"(fp8_scale));
    int fp8_bscale = b_e8m0 * 0x01010101; asm volatile("" : "+v"(fp8_bscale));
    (void)fp8_scale; (void)fp8_bscale;
    f32x4 acc[2][2][4][2];
#pragma unroll
    for (int a = 0; a < 2; ++a)
#pragma unroll
        for (int b = 0; b < 2; ++b)
#pragma unroll
            for (int m = 0; m < 4; ++m)
#pragma unroll
                for (int n = 0; n < 2; ++n) acc[a][b][m][n] = (f32x4){0.f, 0.f, 0.f, 0.f};
    bf16x8 At[4][2], B0[2][2], B1[2][2];
    unsigned cG[2][2] = {{0u, 0u}, {0u, 0u}};
    if constexpr (GATHER) { const LAS unsigned* ro = S.rowoff(0); PG8_GOFF(cG, ro); }
    const char* cA = cur.A; const char* cB = cur.B;
    int eslot = 0;
    E.prefetch(cur, 0, wid, lane);
    S.a_ready(cur);
    PG8_STAGE_B(PG8_SB(0, 0), cB); PG8_STAGE_B(PG8_SB(0, 1), cB + hstepB); PG8_STAGE_A(PG8_SA(0, 0), cA, 0, cG); PG8_STAGE_A(PG8_SA(0, 1), cA, 1, cG);
    if (wr == 1) PG8_BAR;
    PG8_WAIT_V(2); PG8_BAR;
    PG8_STAGE_B(PG8_SB(1, 0), cB + kstep); PG8_STAGE_A(PG8_SA(1, 0), cA + kstep, 0, cG); PG8_STAGE_B(PG8_SB(1, 1), cB + hstepB + kstep);
    PG8_WAIT_V(6); PG8_BAR;
    for (;;) {
        const bool has_next = S.next(ui + 1, nxt);
        const int nslot = eslot == 2 ? 0 : eslot + 1;
        if (has_next) E.prefetch(nxt, nslot, wid, lane);
        const char* nA = has_next ? nxt.A : cA; const char* nB = has_next ? nxt.B : cB;
        for (int t = 0; t < nt; t += 2) {
            const bool last = (t == nt - 2);
            if (last && has_next) S.a_ready(nxt);
            const char* a1 = cA + (size_t)(t + 1) * kstep;
            const char* a2 = last ? nA : cA + (size_t)(t + 2) * kstep; const char* b2 = last ? nB : cB + (size_t)(t + 2) * kstep;
            const char* a3 = a2 + kstep; const char* b3 = b2 + kstep;
            unsigned g2[2][2] = {{0u, 0u}, {0u, 0u}};
            if constexpr (GATHER) { const LAS unsigned* ro = S.rowoff((last && has_next) ? ui + 1 : ui); PG8_GOFF(g2, ro); }
            PG8_LDB(B0, 0, 0); PG8_LDB(B1, 0, 1); PG8_SCHED; PG8_LDA(At, 0, 0); PG8_STAGE_A(PG8_SA(1, 1), a1, 1, cG);
            PG8_WAIT_V(8); PG8_WAIT_L(0); PG8_BAR; PG8_MMA(0, 0, At, B0); PG8_MMA(0, 1, At, B1); PG8_BAR; PG8_SCHED;
            PG8_LDA(At, 0, 1); PG8_STAGE_B(PG8_SB(0, 0), b2); PG8_STAGE_B(PG8_SB(0, 1), b2 + hstepB); PG8_STAGE_A(PG8_SA(0, 0), a2, 0, g2);
            PG8_WAIT_V(8); PG8_WAIT_L(0); PG8_BAR; PG8_MMA(1, 0, At, B0); PG8_MMA(1, 1, At, B1); PG8_BAR; PG8_SCHED;
            PG8_LDB(B0, 1, 0); PG8_LDB(B1, 1, 1); PG8_SCHED; PG8_LDA(At, 1, 0); PG8_STAGE_A(PG8_SA(0, 1), a2, 1, g2);
            PG8_WAIT_V(8); PG8_WAIT_L(0); PG8_BAR; PG8_MMA(0, 0, At, B0); PG8_MMA(0, 1, At, B1); PG8_BAR; PG8_SCHED;
            PG8_LDA(At, 1, 1); PG8_STAGE_B(PG8_SB(1, 0), b3); PG8_STAGE_B(PG8_SB(1, 1), b3 + hstepB); PG8_STAGE_A(PG8_SA(1, 0), a3, 0, g2);
            PG8_WAIT_V(8); PG8_WAIT_L(0); PG8_BAR; PG8_MMA(1, 0, At, B0); PG8_MMA(1, 1, At, B1); PG8_BAR; PG8_SCHED;
        }
        if constexpr (FP8) asm volatile("s_nop 15\n\ts_nop 15\n\ts_nop 7" ::: "memory");
        if (wr == 0) PG8_BAR;
        E(acc, cur, ui, wr, wc, fr, fq, eslot);
        if (!has_next) break;
#pragma unroll
        for (int a = 0; a < 2; ++a)
#pragma unroll
            for (int b = 0; b < 2; ++b)
#pragma unroll
                for (int m = 0; m < 4; ++m)
#pragma unroll
                    for (int n = 0; n < 2; ++n) acc[a][b][m][n] = (f32x4){0.f, 0.f, 0.f, 0.f};
        cur = nxt; cA = nA; cB = nB; ++ui; eslot = nslot;
        if constexpr (GATHER) { const LAS unsigned* ro = S.rowoff(ui); PG8_GOFF(cG, ro); }
        if (wr == 1) PG8_BAR;
    }
    PG8_WAIT_V(0);
    PG8_BAR;
#undef PG8_SA
#undef PG8_SB
#undef PG8_GLDS
#undef PG8_GOFF
#undef PG8_STAGE_A
#undef PG8_STAGE_B
#undef PG8_LDA
#undef PG8_LDB
#undef PG8_MMA
#undef PG8_WAIT_V
#undef PG8_WAIT_L
#undef PG8_BAR
#undef PG8_SCHED
}
}

__device__ __forceinline__ void ld8(const float* p, float (&v)[8]) { const f32x4 a = *(const f32x4*)p, b = *(const f32x4*)(p + 4); v[0] = a.x; v[1] = a.y; v[2] = a.z; v[3] = a.w; v[4] = b.x; v[5] = b.y; v[6] = b.z; v[7] = b.w; }
__device__ __forceinline__ void unpack8(const u32x4 w, float (&v)[8]) { v[0] = bflo(w.x); v[1] = bfhi(w.x); v[2] = bflo(w.y); v[3] = bfhi(w.y); v[4] = bflo(w.z); v[5] = bfhi(w.z); v[6] = bflo(w.w); v[7] = bfhi(w.w); }
__device__ __forceinline__ u32x4 pack8(const float (&v)[8]) { u32x4 o; o.x = pg8::cvt_pk_bf16(v[0], v[1]); o.y = pg8::cvt_pk_bf16(v[2], v[3]); o.z = pg8::cvt_pk_bf16(v[4], v[5]); o.w = pg8::cvt_pk_bf16(v[6], v[7]); return o; }

__device__ __forceinline__ void ld8l(const LAS float* p, float (&v)[8]) { const f32x4 a = *(const LAS f32x4*)p, b = *(const LAS f32x4*)(p + 4); v[0] = a.x; v[1] = a.y; v[2] = a.z; v[3] = a.w; v[4] = b.x; v[5] = b.y; v[6] = b.z; v[7] = b.w; }
__device__ __forceinline__ void epi_prefetch(LAS unsigned char* dst, const float* st256, const float* cs256, const float* bs256, int wid, int lane) {
    if (wid < 4) { const char* src = wid < 2 ? (const char*)st256 + wid * 1024 : (wid == 2 ? (const char*)cs256 : (const char*)bs256); int t = threadIdx.x; asm volatile("" : "+v"(t)); (void)lane;
        __builtin_amdgcn_global_load_lds((const unsigned*)(src + (t & 63) * 16), (LAS unsigned*)(dst + wid * 1024), 16, 0, 0); }
}
struct EpiConvIn {
    const float* st; const float* cs; const float* bs; bf16_t* u; bf16_t* bg; LAS unsigned char* aux;
    __device__ __forceinline__ void prefetch(const pg8::Unit& un, int slot, int wid, int lane) const { epi_prefetch(aux + slot * 4096, st + 2 * 256 * un.pm, cs + 256 * un.pn, bs + 256 * un.pn, wid, lane); }
    __device__ __forceinline__ void operator()(const f32x4 (&acc)[2][2][4][2], const pg8::Unit& un, int, int wr, int wc, int fr, int fq, int slot) const {
        const int colL = 32 * wc + 8 * fq;
        const LAS unsigned char* ep = aux + slot * 4096;
        float csv[2][8], bsv[2][8];
        ld8l((const LAS float*)(ep + 2048) + colL, csv[0]); ld8l((const LAS float*)(ep + 2048) + colL + 128, csv[1]); ld8l((const LAS float*)(ep + 3072) + colL, bsv[0]); ld8l((const LAS float*)(ep + 3072) + colL + 128, bsv[1]);
        f32x2 sv[2][4];
#pragma unroll
        for (int ai = 0; ai < 2; ++ai)
#pragma unroll
            for (int m = 0; m < 4; ++m) sv[ai][m] = ((const LAS f32x2*)ep)[128 * ai + 64 * wr + 16 * m + fr];
#pragma unroll
        for (int ai = 0; ai < 2; ++ai)
#pragma unroll
            for (int m = 0; m < 4; ++m) {
                const int row = 256 * un.pm + 128 * ai + 64 * wr + 16 * m + fr;
                const f32x2 s = sv[ai][m];
                float f[2][8];
#pragma unroll
                for (int bj = 0; bj < 2; ++bj)
#pragma unroll
                    for (int e = 0; e < 8; ++e) f[bj][e] = s.y * (acc[ai][bj][m][e >> 2][e & 3] - s.x * csv[bj][e]) + bsv[bj][e];
                if (un.pn < 8) {
                    float p[8];
#pragma unroll
                    for (int e = 0; e < 8; ++e) p[e] = f[0][e] * f[1][e];
                    *(u32x4*)(u + (size_t)row * DM + 128 * un.pn + colL) = pack8(p);
                } else {
                    *(u32x4*)(bg + (size_t)row * DM + 256 * (un.pn - 8) + colL) = pack8(f[0]);
                    *(u32x4*)(bg + (size_t)row * DM + 256 * (un.pn - 8) + 128 + colL) = pack8(f[1]);
                }
            }
    }
};

struct EpiRes {
    const bf16_t* zprev; const float* stprev; const float* gprev; const float* bprev; bf16_t* zout; float* part; unsigned char* z8;
    __device__ __forceinline__ void prefetch(const pg8::Unit&, int, int, int) const {}
    __device__ __forceinline__ void operator()(const f32x4 (&acc)[2][2][4][2], const pg8::Unit& un, int, int wr, int wc, int fr, int fq, int) const {
        const int cb = 256 * un.pn + 32 * wc + 8 * fq;
        float gv[2][8], bv[2][8];
        ld8(gprev + cb, gv[0]); ld8(gprev + cb + 128, gv[1]); ld8(bprev + cb, bv[0]); ld8(bprev + cb + 128, bv[1]);
#pragma unroll
        for (int ai = 0; ai < 2; ++ai) {
            f32x2 sv[4]; u32x4 zw[4][2];
#pragma unroll
            for (int m = 0; m < 4; ++m) { const int row = 256 * un.pm + 128 * ai + 64 * wr + 16 * m + fr; sv[m] = *(const f32x2*)(stprev + 2 * row);
#pragma unroll
                for (int bj = 0; bj < 2; ++bj) zw[m][bj] = *(const u32x4*)(zprev + (size_t)row * DM + cb + 128 * bj); }
#pragma unroll
            for (int m = 0; m < 4; ++m) {
                const int row = 256 * un.pm + 128 * ai + 64 * wr + 16 * m + fr;
                const f32x2 s = sv[m];
                float sum = 0.f, sq = 0.f;
#pragma unroll
                for (int bj = 0; bj < 2; ++bj) {
                    float z[8], v[8]; unpack8(zw[m][bj], z);
#pragma unroll
                    for (int e = 0; e < 8; ++e) v[e] = ALPHA * ((z[e] - s.x) * s.y * gv[bj][e] + bv[bj][e]) + acc[ai][bj][m][e >> 2][e & 3];
                    const u32x4 o = pack8(v);
                    *(u32x4*)(zout + (size_t)row * DM + cb + 128 * bj) = o;
                    *(u32x2*)(z8 + (size_t)row * DM + cb + 128 * bj) = (u32x2){pk4_fp8(v[0], v[1], v[2], v[3]), pk4_fp8(v[4], v[5], v[6], v[7])};
                    float r[8]; unpack8(o, r);
#pragma unroll
                    for (int e = 0; e < 8; ++e) { sum += r[e]; sq += r[e] * r[e]; }
                }
                sum = rows_sum(sum); sq = rows_sum(sq);
                if (fq == 0) *(f32x2*)(part + ((size_t)row * 16 + un.pn * 4 + wc) * 2) = (f32x2){sum, sq};
            }
        }
    }
};

__device__ __forceinline__ void conv_phase(const Frame& F, const bf16_t* u, const bf16_t* bg, const float* ck, bf16_t* y) {
    int tid = threadIdx.x; asm volatile("" : "+v"(tid)); const int lane = tid & 63, wave = __builtin_amdgcn_readfirstlane(tid >> 6); (void)lane; (void)wave;
    const int cg = tid & 127, rs = tid >> 7, t0 = 64 * F.jb + 16 * rs, c0 = 8 * cg;
    const size_t rowb = (size_t)2048 * F.batch;
    float k0[8], k1[8], k2[8], um2[8], um1[8];
    ld8(ck + c0, k0); ld8(ck + DM + c0, k1); ld8(ck + 2 * DM + c0, k2);
    if (t0 >= 2) { unpack8(*(const u32x4*)(u + (rowb + t0 - 2) * DM + c0), um2); unpack8(*(const u32x4*)(u + (rowb + t0 - 1) * DM + c0), um1); }
    else {
#pragma unroll
        for (int e = 0; e < 8; ++e) { um2[e] = 0.f; um1[e] = 0.f; } }
    for (int r4 = 0; r4 < 16; r4 += 16) {
        u32x4 uw[16], bw[16];
#pragma unroll
        for (int i = 0; i < 16; ++i) { const size_t row = rowb + t0 + r4 + i; uw[i] = *(const u32x4*)(u + row * DM + c0); bw[i] = *(const u32x4*)(bg + row * DM + c0); }
#pragma unroll
        for (int i = 0; i < 16; ++i) {
            const size_t row = rowb + t0 + r4 + i;
            float uc[8], b[8], o[8];
            unpack8(uw[i], uc); unpack8(bw[i], b);
#pragma unroll
            for (int e = 0; e < 8; ++e) { o[e] = b[e] * (k0[e] * um2[e] + k1[e] * um1[e] + k2[e] * uc[e]); um2[e] = um1[e]; um1[e] = uc[e]; }
            *(u32x4*)(y + row * DM + c0) = pack8(o);
        }
    }
}

__device__ __forceinline__ f32x2 stats_from_part(const float* part, int row) {
    float s = 0.f, q = 0.f;
#pragma unroll
    for (int i = 0; i < 8; ++i) { const f32x4 p = *(const f32x4*)(part + (size_t)row * 32 + 4 * i); s += p.x + p.z; q += p.y + p.w; }
    const float mu = s * (1.f / DM); float var = q * (1.f / DM) - mu * mu; var = var > 0.f ? var : 0.f;
    return (f32x2){mu, 1.f / sqrtf(var + LN_EPS)};
}


constexpr int RT_LG = 0, RT_ST = 64 * 97 * 4, RT_HIST = RT_ST + 512, RT_BASE = RT_HIST + 256, RT_SEL = RT_BASE + 256, RT_GATE = RT_SEL + 1024;
__device__ __forceinline__ void router_phase(const Frame& F, const bf16_t* z, const float* part, float* stout, const bf16_t* wr_hi, const float* csr, const float* bsr,
                                             const float* rbg, const float* rbe, unsigned* cnt, unsigned* list, float* gate) {
    int tid = threadIdx.x; asm volatile("" : "+v"(tid)); const int lane = tid & 63, wave = __builtin_amdgcn_readfirstlane(tid >> 6);
    LAS unsigned char* aux = F.lds + LDS_AUX;
    LAS float* lg = (LAS float*)(aux + RT_LG); LAS float* stl = (LAS float*)(aux + RT_ST); LAS unsigned* hist = (LAS unsigned*)(aux + RT_HIST); LAS unsigned* base = (LAS unsigned*)(aux + RT_BASE);
    LAS unsigned* sel = (LAS unsigned*)(aux + RT_SEL); LAS float* gl = (LAS float*)(aux + RT_GATE);
    const int row0 = 2048 * F.batch + 64 * F.jb;
    if (tid < 64) { f32x2 s; if (part) { s = stats_from_part(part, row0 + tid); *(f32x2*)(stout + 2 * (row0 + tid)) = s; } else s = *(const f32x2*)(stout + 2 * (row0 + tid));
        stl[2 * tid] = s.x; stl[2 * tid + 1] = s.y; hist[tid] = 0u; }
    const int fr = lane & 15, fq = lane >> 4;
    f32x4 acc[4][6];
#pragma unroll
    for (int m = 0; m < 4; ++m)
#pragma unroll
        for (int j = 0; j < 6; ++j) acc[m][j] = (f32x4){0.f, 0.f, 0.f, 0.f};
    const bf16_t* ap = z + (size_t)(row0 + fr) * DM + 8 * fq;
    const bf16_t* wf = wr_hi + (size_t)lane * 8;
#pragma unroll 1
    for (int k4 = 0; k4 < 4; ++k4) {
        const int ks = 4 * wave + k4;
        bf16x8 a[4], bh[6], bl[6];
#pragma unroll
        for (int m = 0; m < 4; ++m) a[m] = *(const bf16x8*)(ap + (size_t)(16 * m) * DM + 32 * ks);
#pragma unroll
        for (int j = 0; j < 6; ++j) { bh[j] = *(const bf16x8*)(wf + ((size_t)(ks * 2 + 0) * 6 + j) * 512); bl[j] = *(const bf16x8*)(wf + ((size_t)(ks * 2 + 1) * 6 + j) * 512); }
#pragma unroll
        for (int m = 0; m < 4; ++m)
#pragma unroll
            for (int j = 0; j < 6; ++j) { acc[m][j] = __builtin_amdgcn_mfma_f32_16x16x32_bf16(a[m], bh[j], acc[m][j], 0, 0, 0); acc[m][j] = __builtin_amdgcn_mfma_f32_16x16x32_bf16(a[m], bl[j], acc[m][j], 0, 0, 0); }
    }
    {
        LAS f32x4* slots = (LAS f32x4*)(F.lds + LDS_STAGE);
#pragma unroll
        for (int half = 4; half >= 1; half >>= 1) {
            __syncthreads();
            if (wave >= half && wave < 2 * half) {
#pragma unroll
                for (int m = 0; m < 4; ++m)
#pragma unroll
                    for (int j = 0; j < 6; ++j) slots[((wave - half) * 24 + m * 6 + j) * 64 + lane] = acc[m][j];
            }
            __syncthreads();
            if (wave < half) {
#pragma unroll
                for (int m = 0; m < 4; ++m)
#pragma unroll
                    for (int j = 0; j < 6; ++j) acc[m][j] += slots[(wave * 24 + m * 6 + j) * 64 + lane];
            }
        }
    }
    if (wave == 0) {
#pragma unroll
        for (int j = 0; j < 6; ++j) {
            const int n = 16 * j + fr;
            const float c = csr[n], b = bsr[n] + (n < 8 ? rbg[n] : (n < 72 ? rbe[n - 8] : 0.f));
#pragma unroll
            for (int m = 0; m < 4; ++m)
#pragma unroll
                for (int r = 0; r < 4; ++r) { const int tk = 16 * m + 4 * fq + r; lg[tk * 97 + n] = stl[2 * tk + 1] * (acc[m][j][r] - stl[2 * tk] * c) + b; }
        }
    }
    __syncthreads();
    if (tid < 64) {
        const LAS float* l = lg + tid * 97;
        int g = 0; float gm = l[0];
#pragma unroll
        for (int i = 1; i < 8; ++i) { const float v = l[i]; if (v > gm) { gm = v; g = i; } }
        float gs = 0.f;
#pragma unroll
        for (int i = 0; i < 8; ++i) gs += __expf(l[i] - gm);
        const float ggate = 1.f / gs;
        const LAS float* el = l + 8 + 8 * g;
        int i0 = 0; float v0 = el[0];
#pragma unroll
        for (int i = 1; i < 8; ++i) { const float v = el[i]; if (v > v0) { v0 = v; i0 = i; } }
        int i1 = -1; float v1 = 0.f;
#pragma unroll
        for (int i = 0; i < 8; ++i) { const float v = el[i]; if (i != i0 && (i1 < 0 || v > v1)) { v1 = v; i1 = i; } }
        const float ex = __expf(v1 - v0), p0 = 1.f / (1.f + ex), p1 = ex * p0;
        const unsigned e0 = 8 * g + i0, e1 = 8 * g + i1;
        const unsigned r0 = atomicAdd((unsigned*)(hist + e0), 1u), r1 = atomicAdd((unsigned*)(hist + e1), 1u);
        sel[4 * tid] = e0; sel[4 * tid + 1] = e1; sel[4 * tid + 2] = r0; sel[4 * tid + 3] = r1;
        gl[2 * tid] = p0 * ggate; gl[2 * tid + 1] = p1 * ggate;
    }
    __syncthreads();
    if (tid < 64) { const unsigned h = hist[tid]; base[tid] = h ? __hip_atomic_fetch_add(cnt + tid, h, __ATOMIC_RELAXED, __HIP_MEMORY_SCOPE_AGENT) : 0u; }
    __syncthreads();
    if (tid < 64) {
        const unsigned e0 = sel[4 * tid], e1 = sel[4 * tid + 1], tok = (unsigned)(row0 + tid);
        list[(size_t)e0 * 16384 + base[e0] + sel[4 * tid + 2]] = 2u * tok;
        list[(size_t)e1 * 16384 + base[e1] + sel[4 * tid + 3]] = 2u * tok + 1u;
        *(f32x2*)(gate + 2 * tok) = (f32x2){gl[2 * tid], gl[2 * tid + 1]};
    }
}

constexpr int MS_PRE = 0, MS_N = 272, MS_DESC = 288, MS_DDN = 320, MS_ROFF = 512, MS_RINFO = MS_ROFF + 2 * 1024, MS_RDN = MS_RINFO + 2 * 1024, MS_CL = MS_RDN + 6 * 1024, MS_GDN = MS_CL + 256, MS_STUP = MS_GDN + 6 * 1024, MS_EPI = MS_STUP + 2 * 2048  , MS_END = MS_EPI + 3 * 2048;
static_assert(MS_END <= 31744, "MoE tables exceed the AUX region");
constexpr int MOE_MAXDN = 6;
__device__ __forceinline__ void moe_build(const Frame& F, const unsigned* cnt, const unsigned* list, const float* st, const float* gate) {
    int tid = threadIdx.x; asm volatile("" : "+v"(tid));
    LAS unsigned char* aux = F.lds + LDS_AUX;
    LAS unsigned* pre = (LAS unsigned*)(aux + MS_PRE); LAS unsigned* nd = (LAS unsigned*)(aux + MS_N); LAS unsigned* desc = (LAS unsigned*)(aux + MS_DESC); LAS unsigned* ddn = (LAS unsigned*)(aux + MS_DDN);
    LAS unsigned* roff = (LAS unsigned*)(aux + MS_ROFF); LAS unsigned* rinfo = (LAS unsigned*)(aux + MS_RINFO); LAS unsigned* rdn = (LAS unsigned*)(aux + MS_RDN);
    LAS unsigned* cl = (LAS unsigned*)(aux + MS_CL);
    __syncthreads();
    if (tid < 64) {
        const int lane = tid;
        const unsigned c = cnt[lane], nb = (c + 255u) >> 8;
        unsigned incl = nb;
#pragma unroll
        for (int o = 1; o < 64; o <<= 1) { const unsigned t = (unsigned)__builtin_amdgcn_ds_bpermute(((lane - o) & 63) << 2, (int)incl); incl += lane >= o ? t : 0u; }
        const unsigned excl = incl - nb;
        cl[lane] = c; pre[lane] = excl; if (lane == 63) pre[64] = incl;
        const unsigned NB = (unsigned)__builtin_amdgcn_readlane((int)incl, 63), G = (unsigned)F.G, v = (unsigned)((F.bx & 7) * (F.G >> 3) + (F.bx >> 3));
        const unsigned tup = 2u * NB, tdn = 4u * NB, nup2 = tup > G ? tup - G : 0u, nlight = G - nup2;
        unsigned n = 0;
#pragma unroll
        for (int k = 0; k < 2; ++k) {
            const unsigned u = v + (unsigned)k * G;
            if (u < tup) { const unsigned gb = u >> 1, nt = u & 1u;
                const unsigned e = (unsigned)__builtin_popcountll(__builtin_amdgcn_ballot_w64(excl <= gb)) - 1u;
                if (lane == 0) { desc[4 * k] = e; desc[4 * k + 1] = gb; desc[4 * k + 2] = nt; desc[4 * k + 3] = 0u; }
                n = (unsigned)k + 1u; }
        }
        const unsigned pos0 = v >= nup2 ? v - nup2 : nlight + v;
        unsigned m = 0;
#pragma unroll
        for (int k = 0; k < MOE_MAXDN; ++k) {
            const unsigned d = pos0 < nlight ? pos0 + (unsigned)k * nlight : 0xffffffffu;
            if (d < tdn && k < 4) { const unsigned gb = d >> 2, nt = d & 3u;
                const unsigned e = (unsigned)__builtin_popcountll(__builtin_amdgcn_ballot_w64(excl <= gb)) - 1u;
                if (lane == 0) { ddn[4 * m] = e; ddn[4 * m + 1] = gb; ddn[4 * m + 2] = nt; ddn[4 * m + 3] = 0u; }
                m = m + 1u; }
        }
        {
            const unsigned done4 = 4u * nlight;
#pragma unroll
            for (int k = 0; k < 2; ++k) {
                const unsigned d = done4 + v + (unsigned)k * G;
                if (d < tdn) { const unsigned gb = d >> 2, nt = d & 3u;
                    const unsigned e = (unsigned)__builtin_popcountll(__builtin_amdgcn_ballot_w64(excl <= gb)) - 1u;
                    if (lane == 0) { ddn[4 * m] = e; ddn[4 * m + 1] = gb; ddn[4 * m + 2] = nt; ddn[4 * m + 3] = 0u; }
                    m = m + 1u; }
            }
        }
        if (lane == 0) { nd[0] = n; nd[1] = m; }
    }
    __syncthreads();
    const unsigned n = nd[0], m = nd[1];
    for (unsigned i = 0; i < n; ++i) {
        if (tid < 256) { const unsigned e = desc[4 * i], gb = desc[4 * i + 1], idx = (gb - pre[e]) * 256u + (unsigned)tid, c = cl[e];
            LAS f32x2* stup = (LAS f32x2*)(aux + MS_STUP);
            if (idx < c) { const unsigned ts = list[(size_t)e * 16384 + idx]; roff[i * 256 + tid] = (ts >> 1) * (unsigned)DM; rinfo[i * 256 + tid] = ts; stup[i * 256 + tid] = *(const f32x2*)(st + 2 * (ts >> 1)); }
            else { roff[i * 256 + tid] = 0u; rinfo[i * 256 + tid] = 0xffffffffu; stup[i * 256 + tid] = (f32x2){0.f, 1.f}; } }
    }
    for (unsigned i = 0; i < m; ++i) {
        if (tid >= 256) { const unsigned r = (unsigned)tid - 256u, e = ddn[4 * i], gb = ddn[4 * i + 1], idx = (gb - pre[e]) * 256u + r, c = cl[e];
            LAS float* gdn = (LAS float*)(aux + MS_GDN);
            if (idx < c) { const unsigned ts = list[(size_t)e * 16384 + idx]; rdn[i * 256 + r] = ts; gdn[i * 256 + r] = 16.f * gate[ts]; }
            else { rdn[i * 256 + r] = 0xffffffffu; gdn[i * 256 + r] = 0.f; } }
    }
    __syncthreads();
}
template <bool UP>
struct MoeSched {
    LAS unsigned char* aux; const char* Abase; const char* Wbase; unsigned* done;
    __device__ __forceinline__ bool next(int i, pg8::Unit& u) const {
        const unsigned n = ((const LAS unsigned*)(aux + MS_N))[UP ? 0 : 1]; if ((unsigned)i >= n) return false;
        const LAS unsigned* d = (const LAS unsigned*)(aux + (UP ? MS_DESC : MS_DDN)) + 4 * i; const unsigned e = d[0], gb = d[1], nt = d[2];
        if (UP) { u.A = Abase; u.B = Wbase + ((size_t)e * 512 + nt * 256) * DM; }
        else { u.A = Abase + (size_t)gb * 256 * DEXP; u.B = Wbase + ((size_t)e * DM + nt * 256) * DEXP; }
        u.pm = (int)gb; u.pn = (int)nt; u.x0 = (int)e; u.x1 = i; return true;
    }
    __device__ __forceinline__ const LAS unsigned* rowoff(int i) const { return (const LAS unsigned*)(aux + MS_ROFF) + 256 * i; }
    __device__ __forceinline__ void a_ready(const pg8::Unit& u) const {
        if (!UP) {
            int t = threadIdx.x; asm volatile("" : "+v"(t));
            if (__builtin_amdgcn_readfirstlane(t >> 6) == 0) {
                unsigned sp = 0;
                while ((unsigned)__builtin_amdgcn_readfirstlane((int)__hip_atomic_load(done + u.pm, __ATOMIC_RELAXED, __HIP_MEMORY_SCOPE_AGENT)) < 2u) { __builtin_amdgcn_s_sleep(2); if (++sp > (1u << 22)) break; }
                __builtin_amdgcn_fence(__ATOMIC_ACQUIRE, "agent");
                asm volatile("s_waitcnt vmcnt(0)" ::: "memory");
            }
            asm volatile("" ::: "memory"); __builtin_amdgcn_s_barrier(); asm volatile("" ::: "memory");
        }
    }
};
struct EpiUp {
    LAS unsigned char* aux; const float* st; const float* cs; const float* bs; unsigned char* h; unsigned* done;
    __device__ __forceinline__ void prefetch(const pg8::Unit& un, int slot, int wid, int lane) const {
        if (wid == 2 || wid == 3) { const char* s = (const char*)((wid == 2 ? cs : bs) + un.x0 * 512 + 256 * un.pn); int t = threadIdx.x; asm volatile("" : "+v"(t)); (void)lane;
            __builtin_amdgcn_global_load_lds((const unsigned*)(s + (t & 63) * 16), (LAS unsigned*)(aux + MS_EPI + slot * 2048 + (wid - 2) * 1024), 16, 0, 0); } }
    __device__ __forceinline__ void operator()(const f32x4 (&acc)[2][2][4][2], const pg8::Unit& un, int ui, int wr, int wc, int fr, int fq, int slot) const {
        asm volatile("" : "+v"(fr), "+v"(fq));
        const int colL = 32 * wc + 8 * fq;
        const LAS float* ep = (const LAS float*)(aux + MS_EPI + slot * 2048);
        float csv[2][8], bsv[2][8];
        ld8l(ep + colL, csv[0]); ld8l(ep + colL + 128, csv[1]); ld8l(ep + 256 + colL, bsv[0]); ld8l(ep + 256 + colL + 128, bsv[1]);
        const LAS unsigned* rinfo = (const LAS unsigned*)(aux + MS_RINFO) + 256 * ui;
        const LAS f32x2* stup = (const LAS f32x2*)(aux + MS_STUP) + 256 * ui; (void)rinfo;
        f32x2 sv[2][4];
#pragma unroll
        for (int ai = 0; ai < 2; ++ai)
#pragma unroll
            for (int m = 0; m < 4; ++m) sv[ai][m] = stup[128 * ai + 64 * wr + 16 * m + fr];
#pragma unroll
        for (int ai = 0; ai < 2; ++ai)
#pragma unroll
            for (int m = 0; m < 4; ++m) {
                const int r = 128 * ai + 64 * wr + 16 * m + fr;
                const f32x2 s = sv[ai][m];
                float p[8];
#pragma unroll
                for (int e = 0; e < 8; ++e) {
                    const float a1 = s.y * (acc[ai][0][m][e >> 2][e & 3] - s.x * csv[0][e]) + bsv[0][e];
                    const float a3 = s.y * (acc[ai][1][m][e >> 2][e & 3] - s.x * csv[1][e]) + bsv[1][e];
                    p[e] = a1 / (1.f + __expf(-a1)) * a3;
                }
                st8wt(h + ((size_t)un.pm * 256 + r) * DEXP + 128 * un.pn + colL, (u32x2){pk4_fp8(p[0], p[1], p[2], p[3]), pk4_fp8(p[4], p[5], p[6], p[7])});
            }
        asm volatile("s_waitcnt vmcnt(0)" ::: "memory");
        __builtin_amdgcn_s_barrier();
        if (wr == 0 && wc == 0 && fr == 0 && fq == 0) __hip_atomic_fetch_add(done + un.pm, 1u, __ATOMIC_RELAXED, __HIP_MEMORY_SCOPE_AGENT);
    }
};
struct EpiDown {
    LAS unsigned char* aux; const float* gate; unsigned char* y;
    __device__ __forceinline__ void prefetch(const pg8::Unit&, int, int, int) const {}
    __device__ __forceinline__ void operator()(const f32x4 (&acc)[2][2][4][2], const pg8::Unit& un, int ui, int wr, int wc, int fr, int fq, int) const {
        const int cb = 256 * un.pn + 64 * wc + 16 * fq;
        const LAS unsigned* rinfo = (const LAS unsigned*)(aux + MS_RDN) + 256 * ui;
        const LAS float* gdn = (const LAS float*)(aux + MS_GDN) + 256 * ui;
        unsigned tsv[2][4]; float gvv[2][4];
#pragma unroll
        for (int ai = 0; ai < 2; ++ai)
#pragma unroll
            for (int m = 0; m < 4; ++m) { const int r = 128 * ai + 64 * wr + 16 * m + fr; tsv[ai][m] = rinfo[r]; gvv[ai][m] = gdn[r]; }
#pragma unroll
        for (int ai = 0; ai < 2; ++ai)
#pragma unroll
            for (int m = 0; m < 4; ++m) {
                const unsigned ts = tsv[ai][m];
                if (ts != 0xffffffffu) {
                    const float g = gvv[ai][m];
                    u32x4 o;
#pragma unroll
                    for (int bj = 0; bj < 2; ++bj) {
                        float p[8];
#pragma unroll
                        for (int e = 0; e < 8; ++e) p[e] = g * acc[ai][bj][m][e >> 2][e & 3];
                        o[2 * bj] = pk4_fp8(p[0], p[1], p[2], p[3]); o[2 * bj + 1] = pk4_fp8(p[4], p[5], p[6], p[7]);
                    }
                    *(u32x4*)(y + (size_t)ts * DM + cb) = o;
                }
            }
    }
};


struct EpiAttnIn {
    const float* st; const float* cs; const float* bs; unsigned char* q; bf16_t* qi; float* misc; int pn0; LAS unsigned char* aux;
    __device__ __forceinline__ void prefetch(const pg8::Unit& un, int slot, int wid, int lane) const { epi_prefetch(aux + slot * 4096, st + 2 * 256 * un.pm, cs + 256 * (un.pn + pn0), bs + 256 * (un.pn + pn0), wid, lane); }
    __device__ __forceinline__ void operator()(const f32x4 (&acc)[2][2][4][2], const pg8::Unit& un, int, int wr, int wc, int fr, int fq, int slot) const {
        const int pn = un.pn + pn0;
        const int colL = 32 * wc + 8 * fq;
        const LAS unsigned char* ep = aux + slot * 4096;
        float csv[2][8], bsv[2][8];
        ld8l((const LAS float*)(ep + 2048) + colL, csv[0]); ld8l((const LAS float*)(ep + 2048) + colL + 128, csv[1]); ld8l((const LAS float*)(ep + 3072) + colL, bsv[0]); ld8l((const LAS float*)(ep + 3072) + colL + 128, bsv[1]);
        f32x2 sv[2][4];
#pragma unroll
        for (int ai = 0; ai < 2; ++ai)
#pragma unroll
            for (int m = 0; m < 4; ++m) sv[ai][m] = ((const LAS f32x2*)ep)[128 * ai + 64 * wr + 16 * m + fr];
#pragma unroll
        for (int ai = 0; ai < 2; ++ai)
#pragma unroll
            for (int m = 0; m < 4; ++m) {
                const int row = 256 * un.pm + 128 * ai + 64 * wr + 16 * m + fr;
                const f32x2 s = sv[ai][m];
#pragma unroll
                for (int bj = 0; bj < 2; ++bj) {
                    float f[8];
#pragma unroll
                    for (int e = 0; e < 8; ++e) f[e] = s.y * (acc[ai][bj][m][e >> 2][e & 3] - s.x * csv[bj][e]) + bsv[bj][e];
                    if (pn < 8) *(u32x2*)(q + (size_t)row * 2048 + 256 * pn + 128 * bj + colL) = (u32x2){pk4_fp8(f[0], f[1], f[2], f[3]), pk4_fp8(f[4], f[5], f[6], f[7])};
                    else if (pn == 8) { float* d = misc + (size_t)row * 256 + 128 * bj + colL; *(f32x4*)d = (f32x4){f[0], f[1], f[2], f[3]}; *(f32x4*)(d + 4) = (f32x4){f[4], f[5], f[6], f[7]}; }
                    else *(u32x4*)(qi + (size_t)row * 512 + 256 * (pn - 9) + 128 * bj + colL) = pack8(f);
                }
            }
    }
};

__device__ __forceinline__ void attn_norm_phase(const Frame& F, const float* misc, const float* kvg, const float* kig, const float* kib, unsigned char* ckv8, bf16_t* ki) {
    int tid = threadIdx.x; asm volatile("" : "+v"(tid)); const int lane = tid & 63, wave = __builtin_amdgcn_readfirstlane(tid >> 6);
    const int row0 = 2048 * F.batch + 64 * F.jb + 8 * wave;
    const float g0 = kvg[2 * lane], g1 = kvg[2 * lane + 1], kg = kig[lane], kb = kib[lane];
    f32x2 cv[8]; float kv[8];
#pragma unroll
    for (int r = 0; r < 8; ++r) { cv[r] = *(const f32x2*)(misc + (size_t)(row0 + r) * 256 + 2 * lane); kv[r] = misc[(size_t)(row0 + r) * 256 + 128 + lane]; }
#pragma unroll
    for (int r = 0; r < 8; ++r) {
        const int row = row0 + r;
        const f32x2 c = cv[r];
        const float k = kv[r];
        const float ss = wave_sum(c.x * c.x + c.y * c.y, lane);
        const float rinv = 1.f / sqrtf(ss * (1.f / 128.f) + RMS_EPS);
        ((unsigned short*)(ckv8 + (size_t)row * 128))[lane] = (unsigned short)__builtin_amdgcn_cvt_pk_fp8_f32(c.x * rinv * g0, c.y * rinv * g1, 0, false);
        const float mu = wave_sum(k, lane) * (1.f / 64.f); const float d = k - mu;
        const float var = wave_sum(d * d, lane) * (1.f / 64.f);
        ki[(size_t)row * 64 + lane] = (bf16_t)f2bf(d * (1.f / sqrtf(var + LN_EPS)) * kg + kb);
    }
}

__device__ __forceinline__ unsigned sortable(float f) { const unsigned u = __builtin_bit_cast(unsigned, f); return (u & 0x80000000u) ? ~u : (u | 0x80000000u); }
__device__ __forceinline__ unsigned radix_select256(const unsigned (&k)[32], int nvalid, LAS unsigned* hist, int lane) {
    unsigned prefix = 0u, pmask = 0u, krem = 256u;
    int shift0 = 24;
    {
        unsigned mxk = 0u;
#pragma unroll
        for (int i = 0; i < 32; ++i) mxk = max(mxk, k[i]);
        unsigned dg = (unsigned)__builtin_amdgcn_readfirstlane((int)(wave_max_u(mxk) >> 24)), cum = 0u;
        bool found = false, whole = false;
#pragma unroll 1
        for (int c4 = 0; c4 < 4; ++c4) {
            unsigned c = 0u;
#pragma unroll
            for (int i = 0; i < 32; ++i) c += (k[i] != 0u && (k[i] >> 24) == dg) ? 1u : 0u;
            c = (unsigned)__builtin_amdgcn_readfirstlane((int)wave_sum_u(c));
            if (cum + c >= krem) { krem -= cum; prefix = dg << 24; pmask = 0xff000000u; found = true; whole = (c == krem); break; }
            cum += c;
            if (dg == 0u) break;
            dg -= 1u;
        }
        if (found) { if (whole) return prefix; shift0 = 16; }
    }
#pragma unroll 1
    for (int shift = shift0; shift >= 0; shift -= 8) {
#pragma unroll
        for (int j = 0; j < 4; ++j) hist[lane + 64 * j] = 0u;
        asm volatile("s_waitcnt lgkmcnt(0)" ::: "memory");
#pragma unroll
        for (int g8 = 0; g8 < 4; ++g8) if (512 * g8 < nvalid) {
#pragma unroll
            for (int i = 8 * g8; i < 8 * g8 + 8; ++i) { const unsigned key = k[i]; if (key != 0u && (key & pmask) == prefix) __hip_atomic_fetch_add(hist + ((key >> shift) & 255u), 1u, __ATOMIC_RELAXED, __HIP_MEMORY_SCOPE_WAVEFRONT); } }
        asm volatile("s_waitcnt lgkmcnt(0)" ::: "memory");
        unsigned h[4];
#pragma unroll
        for (int j = 0; j < 4; ++j) h[j] = hist[255 - 4 * lane - j];
        const unsigned local = (h[0] + h[1]) + (h[2] + h[3]);
        const unsigned incl = wave_incl_scan(local);
        const unsigned long long m = __builtin_amdgcn_ballot_w64(incl >= krem);
        const int L = __builtin_ctzll(m);
        unsigned cum = (unsigned)__builtin_amdgcn_readlane((int)(incl - local), L);
        const unsigned c0 = (unsigned)__builtin_amdgcn_readlane((int)h[0], L), c1 = (unsigned)__builtin_amdgcn_readlane((int)h[1], L), c2 = (unsigned)__builtin_amdgcn_readlane((int)h[2], L), c3 = (unsigned)__builtin_amdgcn_readlane((int)h[3], L);
        unsigned bin, cb;
        if (cum + c0 >= krem) { bin = 255u - 4u * L; cb = c0; }
        else { cum += c0; if (cum + c1 >= krem) { bin = 254u - 4u * L; cb = c1; } else { cum += c1; if (cum + c2 >= krem) { bin = 253u - 4u * L; cb = c2; } else { cum += c2; bin = 252u - 4u * L; cb = c3; } } }
        krem -= cum; prefix |= bin << shift; pmask |= 255u << shift;
        if (cb == krem) break;
    }
    return prefix;
}

__device__ __forceinline__ void index_unit(const Frame& F, const bf16_t* qi, const float* misc, const bf16_t* ki, unsigned short* sel, int b, int t0, int lane, int wave) {
    const int hh = lane >> 5, l31 = lane & 31;
    const size_t rb = (size_t)b * 2048;
    LAS unsigned* sc = (LAS unsigned*)(F.lds + LDS_STAGE);
    const LAS unsigned* bkt = (const LAS unsigned*)(F.lds + LDS_AUX);
#define IDX_PACK(key, t) ({ const int _k = (key), _d = (t) - _k; (unsigned short)(_k | (int)(bkt[_d < 0 ? 0 : (_d > 127 ? 127 : _d)] << 11)); })
    if (t0 < 256) {
#pragma unroll
        for (int qq = 0; qq < 2; ++qq) { const int t = t0 + 2 * wave + qq;
#pragma unroll
            for (int j = 0; j < 4; ++j) { const int idx = lane + 64 * j; sel[(rb + t) * 256 + idx] = idx <= t ? IDX_PACK(idx, t) : (unsigned short)0; } }
        return;
    }
    const int nkt = (t0 + 16 + 31) >> 5;
    {
        LAS unsigned char* aq_l = F.lds + LDS_AUX + 10240; LAS float* w_l = (LAS float*)(F.lds + LDS_AUX + 26624);
        { const char* src = (const char*)(qi + (rb + t0) * 512);
#pragma unroll
          for (int j = 0; j < 2; ++j) __builtin_amdgcn_global_load_lds((const unsigned*)(src + (2 * wave + j) * 1024 + lane * 16), (LAS unsigned*)(aq_l + (2 * wave + j) * 1024), 16, 0, 0);
          if (wave < 2) { const int i = 64 * wave + lane; w_l[i] = misc[(rb + t0 + (i >> 3)) * 256 + 192 + (i & 7)]; } }
        asm volatile("s_waitcnt vmcnt(0)" ::: "memory");
        __syncthreads();
        bf16x8 aq[4][4];
        { const int r = l31, head = (r & 3) + 4 * ((r >> 3) & 1), query = (r >> 4) + 2 * ((r >> 2) & 1);
#pragma unroll
          for (int mt = 0; mt < 4; ++mt) { const LAS unsigned char* ap = aq_l + ((4 * mt + query) * 8 + head) * 128 + 16 * hh;
#pragma unroll
              for (int ks = 0; ks < 4; ++ks) aq[mt][ks] = *(const LAS bf16x8*)(ap + 32 * ks); } }
        const bf16_t* kp = ki + (rb + l31) * 64 + 8 * hh;
        bf16x8 bk[4], bn[4];
        if (wave < nkt) {
#pragma unroll
            for (int ks = 0; ks < 4; ++ks) bk[ks] = *(const bf16x8*)(kp + (size_t)wave * 2048 + 16 * ks); }
        for (int kt = wave; kt < nkt; kt += 8) {
            const int ktn = kt + 8 < nkt ? kt + 8 : kt;
#pragma unroll
            for (int ks = 0; ks < 4; ++ks) bn[ks] = *(const bf16x8*)(kp + (size_t)ktn * 2048 + 16 * ks);
            const int key = 32 * kt + l31;
#pragma unroll
            for (int mt = 0; mt < 4; ++mt) {
                f32x16 acc;
#pragma unroll
                for (int e = 0; e < 16; ++e) acc[e] = 0.f;
#pragma unroll
                for (int ks = 0; ks < 4; ++ks) acc = __builtin_amdgcn_mfma_f32_32x32x16_bf16(aq[mt][ks], bk[ks], acc, 0, 0, 0);
                float s0 = 0.f, s1 = 0.f;
                {
                    const LAS f32x4* wp = (const LAS f32x4*)(w_l + (4 * mt + 2 * hh) * 8); const f32x4 wa = wp[0], wb = wp[1], wc = wp[2], wd = wp[3];
                    const float w0[8] = {wa.x, wa.y, wa.z, wa.w, wb.x, wb.y, wb.z, wb.w}, w1[8] = {wc.x, wc.y, wc.z, wc.w, wd.x, wd.y, wd.z, wd.w};
#pragma unroll
                    for (int e = 0; e < 8; ++e) { s0 += fmaxf(acc[e], 0.f) * w0[e]; s1 += fmaxf(acc[8 + e], 0.f) * w1[e]; }
                }
                const int tq = t0 + 4 * mt + 2 * hh;
                sc[(4 * mt + 2 * hh) * 2048 + key] = key <= tq ? sortable(s0) : 0u;
                sc[(4 * mt + 2 * hh + 1) * 2048 + key] = key <= tq + 1 ? sortable(s1) : 0u;
            }
#pragma unroll
            for (int ks = 0; ks < 4; ++ks) bk[ks] = bn[ks];
        }
    }
    __syncthreads();
    {
    unsigned ka[32], kb[32];
    const int nvalid = 32 * nkt;
#pragma unroll
    for (int i = 0; i < 32; ++i) { const int key = 64 * i + lane; const bool v = key < nvalid; ka[i] = v ? sc[(2 * wave) * 2048 + key] : 0u; kb[i] = v ? sc[(2 * wave + 1) * 2048 + key] : 0u; }
    LAS unsigned* hist = (LAS unsigned*)(F.lds + LDS_AUX + 1024 + wave * 1024);
    const unsigned Ta = radix_select256(ka, nvalid, hist, lane), Tb = radix_select256(kb, nvalid, hist, lane);
#pragma unroll
    for (int qq = 0; qq < 2; ++qq) {
        const unsigned T = qq ? Tb : Ta;
        unsigned nge = 0u;
#pragma unroll
        for (int g8 = 0; g8 < 4; ++g8) if (512 * g8 < nvalid) {
#pragma unroll
            for (int i = 8 * g8; i < 8 * g8 + 8; ++i) nge += (unsigned)__builtin_popcountll(__builtin_amdgcn_ballot_w64((qq ? kb[i] : ka[i]) >= T)); }
        LAS unsigned short* out = (LAS unsigned short*)hist + 256 * qq;
        unsigned base = 0u;
        if (nge == 256u) {
#pragma unroll
            for (int i = 0; i < 32; ++i) if (64 * i < nvalid) {
                const unsigned k = qq ? kb[i] : ka[i];
                const bool take = k >= T;
                const unsigned long long mtk = __builtin_amdgcn_ballot_w64(take);
                const unsigned tkbelow = __builtin_amdgcn_mbcnt_hi((unsigned)(mtk >> 32), __builtin_amdgcn_mbcnt_lo((unsigned)mtk, 0u));
                if (take) out[base + tkbelow] = IDX_PACK(64 * i + lane, t0 + 2 * wave + qq);
                base += (unsigned)__builtin_popcountll(mtk);
            }
        } else {
            unsigned ngt = 0u;
#pragma unroll
            for (int i = 0; i < 32; ++i) ngt += (unsigned)__builtin_popcountll(__builtin_amdgcn_ballot_w64((qq ? kb[i] : ka[i]) > T));
            const unsigned need = 256u - ngt;
            unsigned tbase = 0u;
#pragma unroll 4
            for (int i = 0; i < 32; ++i) if (64 * i < nvalid) {
                const unsigned k = qq ? kb[i] : ka[i];
                const bool eq = (k == T), gt = (k > T);
                const unsigned long long meq = __builtin_amdgcn_ballot_w64(eq);
                const unsigned eqbelow = __builtin_amdgcn_mbcnt_hi((unsigned)(meq >> 32), __builtin_amdgcn_mbcnt_lo((unsigned)meq, 0u));
                const bool take = gt || (eq && (tbase + eqbelow) < need);
                tbase += (unsigned)__builtin_popcountll(meq);
                const unsigned long long mtk = __builtin_amdgcn_ballot_w64(take);
                const unsigned tkbelow = __builtin_amdgcn_mbcnt_hi((unsigned)(mtk >> 32), __builtin_amdgcn_mbcnt_lo((unsigned)mtk, 0u));
                if (take) out[base + tkbelow] = IDX_PACK(64 * i + lane, t0 + 2 * wave + qq);
                base += (unsigned)__builtin_popcountll(mtk);
            }
        }
    }
    asm volatile("s_waitcnt lgkmcnt(0)" ::: "memory");
    *(u32x4*)(sel + (rb + t0 + 2 * wave + (lane >> 5)) * 256 + 8 * (lane & 31)) = *(const LAS u32x4*)((const LAS unsigned char*)hist + 16 * lane);
    }
    __syncthreads();
#undef IDX_PACK
}
__device__ __forceinline__ void index_phase(const Frame& F, const bf16_t* qi, const float* misc, const bf16_t* ki, unsigned short* sel) {
    int tid = threadIdx.x; asm volatile("" : "+v"(tid)); const int lane = tid & 63, wave = __builtin_amdgcn_readfirstlane(tid >> 6);
    if (tid < 128) { unsigned bk = (unsigned)tid; if (tid >= 16) { int v = 16 + (int)(__logf((float)tid / 16.f) / 2.0794415416798357f * 16.f); bk = (unsigned)(v < 31 ? v : 31); } ((LAS unsigned*)(F.lds + LDS_AUX))[tid] = bk; }
    __syncthreads();
    const int us[4] = {127 - F.jb, 64 + F.jb, 63 - F.jb, F.jb};
    for (int k = 0; k < 4; ++k) index_unit(F, qi, misc, ki, sel, F.batch, 16 * us[k], lane, wave);
}

constexpr int AT_P = 0  , AT_SCT = 8704  , AT_BIAS = 16896, AT_Q = 18944  , AT_SEL = 27136  ;
static_assert(AT_SEL + 3 * 1024 <= 31744, "attention tables exceed the AUX region");
__device__ __forceinline__ unsigned at_f(unsigned row) { return ((row >> 2) & 1u) | (((row >> 1) & 1u) << 1) | (((row >> 3) & 1u) << 2); }
__device__ __forceinline__ void attn_phase(const Frame& F, const unsigned char* q8, const unsigned char* ckv8, const unsigned short* sel, const float* relb, unsigned char* o) {
    int tid = threadIdx.x; asm volatile("" : "+v"(tid)); const int lane = tid & 63, wave = __builtin_amdgcn_readfirstlane(tid >> 6);
    const int fr = lane & 15, fq = lane >> 4;
    LAS unsigned char* aux = F.lds + LDS_AUX;
    LAS float* biast = (LAS float*)(aux + AT_BIAS);
    for (int i = tid; i < 512; i += NTHREADS) biast[i] = relb[i];
    const size_t rb = (size_t)F.batch * 2048;
    const int us0 = 127 - F.jb, us1 = 64 + F.jb, us2 = 63 - F.jb, us3 = F.jb;
#define AT_T(it) (16 * ((it) < 8 ? us0 : ((it) < 16 ? us1 : ((it) < 24 ? us2 : us3))) + 2 * ((it) & 7))
    const unsigned char* ckvb = ckv8 + rb * 128;
    const unsigned dl8 = (unsigned)lane >> 3, dp = (unsigned)lane & 7u;
#define AT_DMA_SEL(t, slot) do { if (wave == 0) \
        __builtin_amdgcn_global_load_lds((const unsigned*)((const unsigned char*)(sel + (rb + (t)) * 256) + 16 * lane), (LAS unsigned*)(aux + AT_SEL + (slot) * 1024), 16, 0, 16); } while (0)
#define AT_DMA_Q(t, buf) do { if (wave == 1) { _Pragma("unroll") for (int j = 0; j < 4; ++j) { const unsigned R = 8u * j + dl8; \
        __builtin_amdgcn_global_load_lds((const unsigned*)(q8 + (rb + (t)) * 2048 + R * 128u + ((dp ^ at_f(R)) << 4)), (LAS unsigned*)(aux + AT_Q + (buf) * 4096 + j * 1024), 16, 0, 0); } } } while (0)
#define AT_GATHER(buf, slot) do { const LAS unsigned short* sp = (const LAS unsigned short*)(aux + AT_SEL + (slot) * 1024) + 32 * wave + dl8; unsigned svv[8]; \
        _Pragma("unroll") for (int j = 0; j < 8; ++j) svv[j] = sp[256 * (j >> 2) + 8 * (j & 3)]; \
        asm volatile("s_waitcnt lgkmcnt(0)" : "+v"(svv[0]), "+v"(svv[1]), "+v"(svv[2]), "+v"(svv[3]), "+v"(svv[4]), "+v"(svv[5]), "+v"(svv[6]), "+v"(svv[7]) :: "memory");     \
        _Pragma("unroll") for (int j = 0; j < 8; ++j) { const unsigned row = 32u * wave + 8u * (j & 3) + dl8; \
        __builtin_amdgcn_global_load_lds((const unsigned*)(ckvb + (size_t)(svv[j] & 2047u) * 128 + ((dp ^ at_f(row)) << 4)), (LAS unsigned*)(F.lds + ((buf) * 2 + (j >> 2)) * 32768 + (32 * wave + 8 * (j & 3)) * 128), 16, 0, 0); } } while (0)
    AT_DMA_SEL(AT_T(0), 0); AT_DMA_SEL(AT_T(1), 1); AT_DMA_Q(AT_T(0), 0);
    asm volatile("s_waitcnt vmcnt(0)" ::: "memory");
    __syncthreads();
    AT_GATHER(0, 0);
    const bf16x8 ones = {0x3F80, 0x3F80, 0x3F80, 0x3F80, 0x3F80, 0x3F80, 0x3F80, 0x3F80};
    const unsigned fsw = at_f((unsigned)fr);
    int s_cur = 0;
    for (int it = 0; it < 32; ++it) {
        const int t0 = AT_T(it), cur = it & 1;
        const int s_nxt = s_cur == 2 ? 0 : s_cur + 1, s_nn = s_nxt == 2 ? 0 : s_nxt + 1;
        asm volatile("s_waitcnt vmcnt(0) lgkmcnt(0)" ::: "memory");
        __builtin_amdgcn_s_barrier();
        if (it < 31) { AT_GATHER(cur ^ 1, s_nxt); AT_DMA_Q(AT_T(it + 1), cur ^ 1); if (it < 30) AT_DMA_SEL(AT_T(it + 2), s_nn); }
        {
            i32x8 qv[2], kv[2][2]; u32x2 pcw[2][2];
#pragma unroll
            for (int qq = 0; qq < 2; ++qq) {
                const LAS unsigned char* qrow = aux + AT_Q + cur * 4096 + (16 * qq + fr) * 128;
                const u32x4 qb0 = *(const LAS u32x4*)(qrow + (((2u * fq) ^ fsw) << 4)), qb1 = *(const LAS u32x4*)(qrow + (((2u * fq + 1u) ^ fsw) << 4));
                qv[qq] = (i32x8){(int)qb0.x, (int)qb0.y, (int)qb0.z, (int)qb0.w, (int)qb1.x, (int)qb1.y, (int)qb1.z, (int)qb1.w};
                const LAS unsigned char* srow = aux + AT_SEL + s_cur * 1024 + qq * 512 + (32 * wave + 4 * fq) * 2;
#pragma unroll
                for (int mt = 0; mt < 2; ++mt) {
                    const LAS unsigned char* krow = F.lds + (cur * 2 + qq) * 32768 + (32 * wave + 16 * mt + fr) * 128;
                    const u32x4 k0 = *(const LAS u32x4*)(krow + (((2u * fq) ^ fsw) << 4)), k1 = *(const LAS u32x4*)(krow + (((2u * fq + 1u) ^ fsw) << 4));
                    kv[qq][mt] = (i32x8){(int)k0.x, (int)k0.y, (int)k0.z, (int)k0.w, (int)k1.x, (int)k1.y, (int)k1.z, (int)k1.w};
                    pcw[qq][mt] = *(const LAS u32x2*)(srow + 32 * mt);
                }
            }
            float bv[2][2][4];
#pragma unroll
            for (int qq = 0; qq < 2; ++qq)
#pragma unroll
                for (int mt = 0; mt < 2; ++mt) {
                    const unsigned pw[2] = {pcw[qq][mt].x, pcw[qq][mt].y};
#pragma unroll
                    for (int r = 0; r < 4; ++r) { const unsigned bucket = ((pw[r >> 1] >> (16 * (r & 1))) & 0xffffu) >> 11; bv[qq][mt][r] = biast[bucket * 16 + fr]; }
                }
            f32x4 sacc[2][2];
#pragma unroll
            for (int qq = 0; qq < 2; ++qq)
#pragma unroll
                for (int mt = 0; mt < 2; ++mt)
                    sacc[qq][mt] = __builtin_amdgcn_mfma_scale_f32_16x16x128_f8f6f4(kv[qq][mt], qv[qq], (f32x4){0.f, 0.f, 0.f, 0.f}, 0, 0, 0, 0x7F7F7F7F, 0, 0x7F7F7F7F);
#pragma unroll
            for (int qq = 0; qq < 2; ++qq) {
                const int nsel = t0 + qq + 1 < TOPK ? t0 + qq + 1 : TOPK;
                float v2[2][4]; float mx = -115.f;
#pragma unroll
                for (int mt = 0; mt < 2; ++mt)
#pragma unroll
                    for (int r = 0; r < 4; ++r) {
                        const int slot = 32 * wave + 16 * mt + 4 * fq + r;
                        const float v = fminf(sacc[qq][mt][r] * 0.08838834764831845f + bv[qq][mt][r], 80.f) * 1.4426950408889634f;
                        v2[mt][r] = slot < nsel ? v : -1e30f; mx = fmaxf(mx, v2[mt][r]);
                    }
                {
                    const unsigned mb = __builtin_bit_cast(unsigned, mx);
                    const auto s16 = __builtin_amdgcn_permlane16_swap(mb, mb, false, false);
                    const float m1 = fmaxf(__builtin_bit_cast(float, (unsigned)s16[0]), __builtin_bit_cast(float, (unsigned)s16[1]));
                    const unsigned m1b = __builtin_bit_cast(unsigned, m1);
                    const auto s32 = __builtin_amdgcn_permlane32_swap(m1b, m1b, false, false);
                    mx = fmaxf(__builtin_bit_cast(float, (unsigned)s32[0]), __builtin_bit_cast(float, (unsigned)s32[1]));
                }
                const float ef = floorf(mx) + 1.f;
                LAS unsigned char* prow = aux + AT_P + qq * 4352 + fr * 272 + 32 * wave + 4 * fq;
#pragma unroll
                for (int mt = 0; mt < 2; ++mt)
                    *(LAS unsigned*)(prow + 16 * mt) = pk4_fp8(__builtin_amdgcn_exp2f(v2[mt][0] - ef), __builtin_amdgcn_exp2f(v2[mt][1] - ef), __builtin_amdgcn_exp2f(v2[mt][2] - ef), __builtin_amdgcn_exp2f(v2[mt][3] - ef));
                if (fq == 0) *(LAS unsigned char*)(aux + AT_SCT + qq * 128 + fr * 8 + wave) = (unsigned char)(127 + (int)ef);
            }
        }
        asm volatile("s_waitcnt lgkmcnt(0)" ::: "memory"); __builtin_amdgcn_s_barrier(); asm volatile("" ::: "memory");
        {
            const int qq = wave >> 2; const unsigned db = (unsigned)wave & 3u;
            const unsigned img = (unsigned)(size_t)(F.lds + (cur * 2 + qq) * 32768);
            const LAS unsigned char* pbase = aux + AT_P + qq * 4352 + fr * 272 + 16 * fq;
            const LAS unsigned char* sbase = aux + AT_SCT + qq * 128 + fr * 8 + fq;
            f32x4 oe = (f32x4){0.f, 0.f, 0.f, 0.f}, oo = (f32x4){0.f, 0.f, 0.f, 0.f}, tacc = (f32x4){0.f, 0.f, 0.f, 0.f};
            const unsigned r4 = (unsigned)(lane & 15) >> 2, c4 = (unsigned)lane & 3u;
            u32x2 ta[2][8]; u32x4 pf[2][2]; unsigned sb[2];
#pragma unroll
            for (int kb = 0; kb < 2; ++kb)
#pragma unroll
                for (int j = 0; j < 8; ++j) {
                    const unsigned row = 128u * kb + 64u * (j >> 2) + 16u * fq + 4u * (j & 3) + r4;
                    const unsigned a0 = img + row * 128u + (((2u * db + (c4 >> 1)) ^ at_f(row)) << 4) + 8u * (c4 & 1u);
                    asm volatile("ds_read_b64_tr_b16 %0, %1" : "=&v"(ta[kb][j]) : "v"(a0) : "memory");
                }
#pragma unroll
            for (int kb = 0; kb < 2; ++kb) { pf[kb][0] = *(const LAS u32x4*)(pbase + 128 * kb); pf[kb][1] = *(const LAS u32x4*)(pbase + 128 * kb + 64); sb[kb] = *(sbase + 4 * kb); }
            asm volatile("s_waitcnt lgkmcnt(0)" : "+v"(ta[0][0]), "+v"(ta[0][1]), "+v"(ta[0][2]), "+v"(ta[0][3]), "+v"(ta[0][4]), "+v"(ta[0][5]), "+v"(ta[0][6]), "+v"(ta[0][7]),
                         "+v"(ta[1][0]), "+v"(ta[1][1]), "+v"(ta[1][2]), "+v"(ta[1][3]), "+v"(ta[1][4]), "+v"(ta[1][5]), "+v"(ta[1][6]), "+v"(ta[1][7]) :: "memory");
            const i32x8 onesv = {0x38383838, 0x38383838, 0x38383838, 0x38383838, 0x38383838, 0x38383838, 0x38383838, 0x38383838};
#pragma unroll
            for (int kb = 0; kb < 2; ++kb) {
                i32x8 ev, od;
#pragma unroll
                for (int j = 0; j < 8; ++j) { ev[j] = (int)__builtin_amdgcn_perm(ta[kb][j].y, ta[kb][j].x, 0x06040200u); od[j] = (int)__builtin_amdgcn_perm(ta[kb][j].y, ta[kb][j].x, 0x07050301u); }
                const i32x8 pv8 = {(int)pf[kb][0].x, (int)pf[kb][0].y, (int)pf[kb][0].z, (int)pf[kb][0].w, (int)pf[kb][1].x, (int)pf[kb][1].y, (int)pf[kb][1].z, (int)pf[kb][1].w};
                oe = __builtin_amdgcn_mfma_scale_f32_16x16x128_f8f6f4(ev, pv8, oe, 0, 0, 0, 0x7F7F7F7F, 0, (int)sb[kb]);
                oo = __builtin_amdgcn_mfma_scale_f32_16x16x128_f8f6f4(od, pv8, oo, 0, 0, 0, 0x7F7F7F7F, 0, (int)sb[kb]);
                tacc = __builtin_amdgcn_mfma_scale_f32_16x16x128_f8f6f4(onesv, pv8, tacc, 0, 0, 0, 0x7F7F7F7F, 0, (int)sb[kb]);
            }
            const float inv = __builtin_amdgcn_rcpf(tacc[0]);
            *(u32x2*)(o + ((rb + t0 + qq) * 16 + fr) * 128 + 32 * db + 8 * fq) = (u32x2){pk4_fp8(oe[0] * inv, oo[0] * inv, oe[1] * inv, oo[1] * inv), pk4_fp8(oe[2] * inv, oo[2] * inv, oe[3] * inv, oo[3] * inv)};
        }
        s_cur = s_nxt;
    }
    asm volatile("s_waitcnt vmcnt(0)" ::: "memory");
    __syncthreads();
#undef AT_DMA_SEL
#undef AT_DMA_Q
#undef AT_GATHER
#undef AT_T
}

__global__ void __launch_bounds__(NTHREADS, 2) fwd_kernel(Params P) {
    extern __shared__ __attribute__((aligned(16))) unsigned char lds_raw[];
    Frame F;
    F.lds = (LAS unsigned char*)lds_raw;
    F.G = gridDim.x; F.bx = blockIdx.x; F.batch = F.bx & 7; F.jb = F.bx >> 3; F.ws = P.ws;
    unsigned char* ws = P.ws;
    for (int u = threadIdx.x; u < 256; u += NTHREADS) ((LAS unsigned*)(F.lds + LDS_MISC))[u] = 0u;
    __syncthreads();
    XcdBarrier bar = xcd_barrier_post((unsigned*)(ws + WS_CTL) + CW_BAR, (volatile LAS unsigned*)(F.lds + LDS_MISC));
#define GRID_BAR() xcd_barrier<false>(bar)
#define GRID_BAR_L() xcd_barrier<true>(bar)
    if (threadIdx.x == 0) (void)xb_add((unsigned*)(ws + WS_CTL) + CW_XCC + F.bx, bar.x + 1u);

    bf16_t* zA; bf16_t* zB; float* stA; float* stB;
    const float* ones; const float* zeros;

    p0_prologue(F, P);
    GRID_BAR();
    {
        volatile LAS unsigned* okw = (volatile LAS unsigned*)(F.lds + LDS_MISC) + 3;
        if (threadIdx.x == 0) okw[0] = (F.G == 256) ? 1u : 0u;
        __syncthreads();
        if (threadIdx.x < 256 && (int)threadIdx.x < F.G) { unsigned* tab = (unsigned*)(ws + WS_CTL) + CW_XCC; const unsigned v = xb_ld(tab + threadIdx.x), r = xb_ld(tab + (threadIdx.x & 7)); if (v == 0u || v != r) okw[0] = 0u; }
        __syncthreads();
        if (threadIdx.x == 0) ((volatile LAS unsigned*)(F.lds + LDS_MISC))[2] = okw[0];
        __syncthreads();
    }
    {
        const float* csp = (const float*)(ws + WS_CSP); float* cs = (float*)(ws + WS_CSUP); float* bs = (float*)(ws + WS_BSUP);
        constexpr int NV = 4 * 64 * 512;
        for (int i = F.bx * NTHREADS + (int)threadIdx.x; i < NV; i += F.G * NTHREADS) {
            float a = 0.f, b = 0.f;
#pragma unroll 8
            for (int kt = 0; kt < 16; ++kt) { a += csp[(size_t)kt * NV + i]; b += csp[(size_t)(32 + kt) * NV + i]; }
            cs[i] = a; bs[i] = b;
        }
    }

    for (int layer = 0; layer < DEPTH; ++layer) {
        asm volatile("" : "+s"(ws));
        zA = (bf16_t*)(ws + WS_ZA); zB = (bf16_t*)(ws + WS_ZB); stA = (float*)(ws + WS_STA); stB = (float*)(ws + WS_STB); ones = (const float*)(ws + WS_VEC); zeros = ones + 1024;
        const float* gprev = layer ? P.in[I_L2G] + (layer - 1) * DM : ones;
        const float* bprev = layer ? P.in[I_L2B] + (layer - 1) * DM : zeros;
        const int jl = layer >> 1;
        bool have_part = false;
        if ((layer & 1) == 0) {
            {
                pg8::StaticOrder S; S.init(T_TOK, 3072, F.G, F.bx, zA, DM * 2, (const bf16_t*)(ws + WS_WCI) + (size_t)jl * 3072 * DM, DM * 2);
                EpiConvIn E{stA, (const float*)(ws + WS_CSCI) + jl * 3072, (const float*)(ws + WS_BSCI) + jl * 3072, (bf16_t*)(ws + WS_U), (bf16_t*)(ws + WS_BG), F.lds + LDS_AUX};
                pg8::gemm_phase<EpiConvIn, pg8::StaticOrder, false>(F.lds + LDS_STAGE, DM, DM * 2, DM * 2, S, E);
            }
            GRID_BAR_L();
            conv_phase(F, (const bf16_t*)(ws + WS_U), (const bf16_t*)(ws + WS_BG), P.in[I_CK] + (size_t)jl * 3 * DM, (bf16_t*)(ws + WS_Y));
            GRID_BAR_L();
            {
                pg8::StaticOrder S; S.init(T_TOK, DM, F.G, F.bx, (const bf16_t*)(ws + WS_Y), DM * 2, (const bf16_t*)(ws + WS_WCO) + (size_t)jl * DM * DM, DM * 2);
                EpiRes E{zA, stA, gprev, bprev, zB, (float*)(ws + WS_PART), ws + WS_Z8};
                pg8::gemm_phase<EpiRes, pg8::StaticOrder, false>(F.lds + LDS_STAGE, DM, DM * 2, DM * 2, S, E);
            }
            have_part = true;
            GRID_BAR_L();
        } else {
            {
                pg8::StaticOrder S; S.init(T_TOK, 2048, F.G, F.bx, ws + WS_ZA8, DM, ws + WS_WAI + (size_t)jl * AIWP * DM * 2, DM);
                EpiAttnIn E{stA, (const float*)(ws + WS_CSAI) + jl * AIWP, (const float*)(ws + WS_BSAI) + jl * AIWP, ws + WS_Q, (bf16_t*)(ws + WS_QI), (float*)(ws + WS_MISC), 0, F.lds + LDS_AUX};
                pg8::gemm_phase<EpiAttnIn, pg8::StaticOrder, false, true>(F.lds + LDS_STAGE, DM / 2, DM, DM, S, E);
            }
            {
                pg8::StaticOrder S; S.init(T_TOK, AIWP - 2048, F.G, F.bx, zA, DM * 2, (const bf16_t*)(ws + WS_WAI) + (size_t)jl * AIWP * DM + (size_t)2048 * DM, DM * 2);
                EpiAttnIn E{stA, (const float*)(ws + WS_CSAI) + jl * AIWP, (const float*)(ws + WS_BSAI) + jl * AIWP, ws + WS_Q, (bf16_t*)(ws + WS_QI), (float*)(ws + WS_MISC), 8, F.lds + LDS_AUX + 12288};
                pg8::gemm_phase<EpiAttnIn, pg8::StaticOrder, false>(F.lds + LDS_STAGE, DM, DM * 2, DM * 2, S, E);
            }
            GRID_BAR_L();
            attn_norm_phase(F, (const float*)(ws + WS_MISC), P.in[I_KVG] + jl * KVL, P.in[I_KIG] + jl * IDXD, P.in[I_KIB] + jl * IDXD, ws + WS_CKV, (bf16_t*)(ws + WS_KI));
            GRID_BAR_L();
            index_phase(F, (const bf16_t*)(ws + WS_QI), (const float*)(ws + WS_MISC), (const bf16_t*)(ws + WS_KI), (unsigned short*)(ws + WS_SEL));
            asm volatile("s_waitcnt vmcnt(0)" ::: "memory"); __syncthreads();
            attn_phase(F, ws + WS_Q, ws + WS_CKV, (const unsigned short*)(ws + WS_SEL), P.in[I_RELB], ws + WS_O);
            GRID_BAR_L();
            {
                pg8::StaticOrder S; S.init(T_TOK, DM, F.G, F.bx, ws + WS_O, 2048, ws + WS_WAO + (size_t)jl * DM * 2048, 2048);
                EpiRes E{zA, stA, gprev, bprev, zB, (float*)(ws + WS_PART), ws + WS_Z8};
                pg8::gemm_phase<EpiRes, pg8::StaticOrder, false, true>(F.lds + LDS_STAGE, 2048 / 2, 2048, 2048, S, E, 127 - 6);
            }
            have_part = true;
            GRID_BAR_L();
        }
        const float* partin = have_part ? (const float*)(ws + WS_PART) : nullptr;
        const unsigned char* ym = nullptr;
        {
            unsigned* cnt = (unsigned*)(ws + WS_CTL) + CW_CNT + 64 * layer; unsigned* list = (unsigned*)(ws + WS_LIST); float* gate = (float*)(ws + WS_GATE);
            const bf16_t* wrh = (const bf16_t*)(ws + WS_WR) + (size_t)layer * 32 * 2 * 6 * 512;
            router_phase(F, zB, partin, stB, wrh, (const float*)(ws + WS_CSR) + layer * 96, (const float*)(ws + WS_BSR) + layer * 96, P.in[I_RBG] + layer * 8, P.in[I_RBE] + layer * 64, cnt, list, gate);
            partin = nullptr;
            GRID_BAR();
            {
                unsigned* done = (unsigned*)(ws + WS_CTL) + CW_DONE + 256 * layer;
                moe_build(F, cnt, list, stB, gate);
                {
                    MoeSched<true> S{F.lds + LDS_AUX, (const char*)(ws + WS_Z8), (const char*)(ws + WS_WUP) + (size_t)layer * 64 * 512 * DM, done};
                    EpiUp E{F.lds + LDS_AUX, stB, (const float*)(ws + WS_CSUP) + (size_t)layer * 64 * 512, (const float*)(ws + WS_BSUP) + (size_t)layer * 64 * 512, ws + WS_H, done};
                    pg8::gemm_phase<EpiUp, MoeSched<true>, true, true>(F.lds + LDS_STAGE, DM / 2, DM, DM, S, E);
                }
                {
                    MoeSched<false> S{F.lds + LDS_AUX, (const char*)(ws + WS_H), (const char*)(ws + WS_WDN) + (size_t)layer * 64 * DM * DEXP, done};
                    EpiDown E{F.lds + LDS_AUX, gate, ws + WS_YM};
                    pg8::gemm_phase<EpiDown, MoeSched<false>, false, true>(F.lds + LDS_STAGE, DEXP / 2, DEXP, DEXP, S, E);
                }
            }
            GRID_BAR();
            ym = ws + WS_YM;
        }
        if (layer < DEPTH - 1) combine_phase<false>(F, zB, stB, partin, P.in[I_L1G] + layer * DM, P.in[I_L1B] + layer * DM, ym, zA, stA, nullptr, nullptr, nullptr, (layer & 1) ? nullptr : ws + WS_ZA8);
        else combine_phase<true>(F, zB, stB, partin, P.in[I_L1G] + layer * DM, P.in[I_L1B] + layer * DM, ym, nullptr, nullptr, P.in[I_L2G] + layer * DM, P.in[I_L2B] + layer * DM, P.out, nullptr);
        if (layer < DEPTH - 1) GRID_BAR_L();
    }
}

extern "C" void kernel_launch(void* const* d_in, const int* in_sizes, int n_in, void* d_out, int out_size, void* d_ws, size_t ws_size, hipStream_t stream) {
    static int grid = 0;
    if (!grid) {
        if (n_in != 21 || out_size != T_TOK * DM || ws_size < WS_END) { fprintf(stderr, "kernel_launch: unexpected shapes (n_in %d out %d ws %zu need %zu)\n", n_in, out_size, ws_size, (size_t)WS_END); grid = -1; return; }
        int dev = 0, cus = 0, per_cu = 0;
        hipGetDevice(&dev); hipDeviceGetAttribute(&cus, hipDeviceAttributeMultiprocessorCount, dev);
        if (hipFuncSetAttribute((const void*)fwd_kernel, hipFuncAttributeMaxDynamicSharedMemorySize, LDS_BYTES) != hipSuccess) { fprintf(stderr, "kernel_launch: hipFuncSetAttribute failed\n"); grid = -1; return; }
        hipOccupancyMaxActiveBlocksPerMultiprocessor(&per_cu, (const void*)fwd_kernel, NTHREADS, LDS_BYTES);
        if (per_cu < 1) fprintf(stderr, "kernel_launch: occupancy query reports %d\n", per_cu);
        grid = 256;
        if (cus != 256) fprintf(stderr, "kernel_launch: %d CUs (built for 256)\n", cus);
    }
    if (grid <= 0) return;
    hipMemsetAsync((char*)d_ws + WS_CTL, 0, CTL_BYTES, stream);
    Params p{};
    for (int i = 0; i < 21; ++i) p.in[i] = (const float*)d_in[i];
    p.out = (float*)d_out; p.ws = (unsigned char*)d_ws; p.ph_lo = 0; p.ph_hi = 1000;
    hipLaunchKernelGGL(fwd_kernel, dim3(grid), dim3(NTHREADS), LDS_BYTES, stream, p);
}
```

```cpp
#include <hip/hip_runtime.h>
#include <cstdio>
#include <cstdint>

#define LAS __attribute__((address_space(3)))
#define GAS __attribute__((address_space(1)))
typedef unsigned short bf16_t;
typedef short bf16x8 __attribute__((ext_vector_type(8)));
typedef float f32x4 __attribute__((ext_vector_type(4)));
typedef float f32x2 __attribute__((ext_vector_type(2)));
typedef float f32x16 __attribute__((ext_vector_type(16)));
typedef unsigned u32x4 __attribute__((ext_vector_type(4)));
typedef unsigned u32x2 __attribute__((ext_vector_type(2)));

constexpr int T_TOK = 16384, DM = 1024, NBATCH = 8, SEQ = 2048, DEPTH = 4;
constexpr int NH = 16, KVL = 128, NIH = 8, IDXD = 64, TOPK = 256;
constexpr int AIW = 2760, AIWP = 2816;
constexpr int NGRP = 8, EPG = 8, NEXP = 64, DEXP = 256;
constexpr float LN_EPS = 1e-5f, RMS_EPS = 1e-6f;
constexpr float ALPHA = 1.6817928305074290f;
constexpr int NWAVES = 8, NTHREADS = 512;
constexpr int MAXBLK = 192;

constexpr size_t MiB = 1u << 20;
constexpr size_t alup(size_t x) { return (x + MiB - 1) & ~(MiB - 1); }
constexpr size_t WS_CTL = 0, CTL_BYTES = MiB;
constexpr size_t WS_VEC = WS_CTL + CTL_BYTES;
constexpr size_t WS_CSCI = WS_VEC + MiB;
constexpr size_t WS_BSCI = WS_CSCI + 2 * 3072 * 4;
constexpr size_t WS_CSAI = WS_BSCI + 2 * 3072 * 4;
constexpr size_t WS_BSAI = WS_CSAI + 2 * AIWP * 4;
constexpr size_t WS_CSR  = WS_BSAI + 2 * AIWP * 4;
constexpr size_t WS_BSR  = WS_CSR + 4 * 96 * 4;
constexpr size_t WS_CSUP = alup(WS_BSR + 4 * 96 * 4);
constexpr size_t WS_BSUP = WS_CSUP + (size_t)4 * 64 * 512 * 4;
constexpr size_t WS_WCI  = alup(WS_BSUP + (size_t)4 * 64 * 512 * 4);
constexpr size_t WS_WCO  = WS_WCI + (size_t)2 * 3072 * 1024 * 2;
constexpr size_t WS_WAI  = WS_WCO + (size_t)2 * 1024 * 1024 * 2;
constexpr size_t WS_WAO  = alup(WS_WAI + (size_t)2 * AIWP * 1024 * 2);
constexpr size_t WS_WR   = WS_WAO + (size_t)2 * 1024 * 2048 * 2;
constexpr size_t WS_WUP  = alup(WS_WR + (size_t)4 * 2 * 96 * 1024 * 2);
constexpr size_t WS_WDN  = WS_WUP + (size_t)4 * 64 * 512 * 1024 * 2;
constexpr size_t WS_ZA   = WS_WDN + (size_t)4 * 64 * 1024 * 256 * 2;
constexpr size_t WS_ZB   = WS_ZA + (size_t)T_TOK * DM * 2;
constexpr size_t WS_STA  = WS_ZB + (size_t)T_TOK * DM * 2;
constexpr size_t WS_STB  = WS_STA + (size_t)T_TOK * 8;
constexpr size_t WS_PART = alup(WS_STB + (size_t)T_TOK * 8);
constexpr size_t WS_U    = WS_PART + (size_t)T_TOK * 16 * 8;
constexpr size_t WS_BG   = WS_U + (size_t)T_TOK * DM * 2;
constexpr size_t WS_Y    = WS_BG + (size_t)T_TOK * DM * 2;
constexpr size_t WS_Q    = WS_Y + (size_t)T_TOK * DM * 2;
constexpr size_t WS_QI   = WS_Q + (size_t)T_TOK * 2048 * 2;
constexpr size_t WS_MISC = WS_QI + (size_t)T_TOK * 512 * 2;
constexpr size_t WS_CKV  = WS_MISC + (size_t)T_TOK * 256 * 4;
constexpr size_t WS_KI   = WS_CKV + (size_t)T_TOK * 128 * 2;
constexpr size_t WS_SEL  = WS_KI + (size_t)T_TOK * 64 * 2;
constexpr size_t WS_O    = WS_SEL + (size_t)T_TOK * 256 * 2;
constexpr size_t WS_LIST = WS_O + (size_t)T_TOK * 2048 * 2;
constexpr size_t WS_GATE = WS_LIST + (size_t)64 * 16384 * 4;
constexpr size_t WS_H    = alup(WS_GATE + (size_t)T_TOK * 8);
constexpr size_t WS_YM   = WS_H + (size_t)MAXBLK * 256 * 256 * 2;
constexpr size_t WS_CSP  = WS_YM + (size_t)T_TOK * 2 * DM * 2;
constexpr size_t WS_Z8   = WS_CSP + (size_t)2 * 32 * 4 * 64 * 512 * 4;
constexpr size_t WS_ZA8  = WS_Z8 + (size_t)T_TOK * DM;
constexpr size_t WS_END  = WS_ZA8 + (size_t)T_TOK * DM;

constexpr int CW_BAR = 4096;
constexpr int CW_CNT = 16384;
constexpr int CW_XCC = 8192;
constexpr int CW_QUEUE = 20480;
constexpr int CW_DONE = 24576;

constexpr int LDS_STAGE = 0, STAGE_BYTES_ALL = 131072;
constexpr int LDS_AUX = 131072;
constexpr int LDS_MISC = 131072 + 31744;
constexpr int LDS_BYTES = 163840;

__device__ __forceinline__ unsigned f2bf(float f) { unsigned u = __builtin_bit_cast(unsigned, f); return (u + 0x7fffu + ((u >> 16) & 1u)) >> 16; }
__device__ __forceinline__ float bf2f(unsigned b) { return __builtin_bit_cast(float, b << 16); }
__device__ __forceinline__ unsigned pk2(float lo, float hi) { return f2bf(lo) | (f2bf(hi) << 16); }
__device__ __forceinline__ float bflo(unsigned w) { return __builtin_bit_cast(float, w << 16); }
__device__ __forceinline__ float bfhi(unsigned w) { return __builtin_bit_cast(float, w & 0xffff0000u); }
__device__ __forceinline__ float shx(float v, int o, int lane) { return __builtin_bit_cast(float, __builtin_amdgcn_ds_bpermute((lane ^ o) << 2, __builtin_bit_cast(int, v))); }
__device__ __forceinline__ float dpp_f(float v, const int ctrl_sel) {
    const int x = __builtin_bit_cast(int, v);
    return __builtin_bit_cast(float, ctrl_sel == 0 ? __builtin_amdgcn_update_dpp(x, x, 0xB1, 0xF, 0xF, false)
                                   : ctrl_sel == 1 ? __builtin_amdgcn_update_dpp(x, x, 0x4E, 0xF, 0xF, false)
                                   : ctrl_sel == 2 ? __builtin_amdgcn_update_dpp(x, x, 0x141, 0xF, 0xF, false)
                                                   : __builtin_amdgcn_update_dpp(x, x, 0x140, 0xF, 0xF, false));
}
__device__ __forceinline__ float rows_sum(float v) {
    const unsigned a = __builtin_bit_cast(unsigned, v);
    const auto s16 = __builtin_amdgcn_permlane16_swap(a, a, false, false);
    const float m1 = __builtin_bit_cast(float, (unsigned)s16[0]) + __builtin_bit_cast(float, (unsigned)s16[1]);
    const unsigned b = __builtin_bit_cast(unsigned, m1);
    const auto s32 = __builtin_amdgcn_permlane32_swap(b, b, false, false);
    return __builtin_bit_cast(float, (unsigned)s32[0]) + __builtin_bit_cast(float, (unsigned)s32[1]);
}
__device__ __forceinline__ unsigned wave_incl_scan(unsigned v) {
    int x = (int)v;
    x += __builtin_amdgcn_update_dpp(0, x, 0x111, 0xF, 0xF, true);
    x += __builtin_amdgcn_update_dpp(0, x, 0x112, 0xF, 0xF, true);
    x += __builtin_amdgcn_update_dpp(0, x, 0x114, 0xF, 0xF, true);
    x += __builtin_amdgcn_update_dpp(0, x, 0x118, 0xF, 0xF, true);
    x += __builtin_amdgcn_update_dpp(0, x, 0x142, 0xA, 0xF, false);
    x += __builtin_amdgcn_update_dpp(0, x, 0x143, 0xC, 0xF, false);
    return (unsigned)x;
}
__device__ __forceinline__ unsigned dpp_u(unsigned v, const int ctrl_sel) {
    const int x = (int)v;
    return (unsigned)(ctrl_sel == 0 ? __builtin_amdgcn_update_dpp(x, x, 0xB1, 0xF, 0xF, false) : ctrl_sel == 1 ? __builtin_amdgcn_update_dpp(x, x, 0x4E, 0xF, 0xF, false)
                    : ctrl_sel == 2 ? __builtin_amdgcn_update_dpp(x, x, 0x141, 0xF, 0xF, false) : __builtin_amdgcn_update_dpp(x, x, 0x140, 0xF, 0xF, false));
}
__device__ __forceinline__ unsigned wave_max_u(unsigned v) {
    v = max(v, dpp_u(v, 0)); v = max(v, dpp_u(v, 1)); v = max(v, dpp_u(v, 2)); v = max(v, dpp_u(v, 3));
    const auto s16 = __builtin_amdgcn_permlane16_swap(v, v, false, false); v = max((unsigned)s16[0], (unsigned)s16[1]);
    const auto s32 = __builtin_amdgcn_permlane32_swap(v, v, false, false); return max((unsigned)s32[0], (unsigned)s32[1]);
}
__device__ __forceinline__ unsigned wave_sum_u(unsigned v) {
    v += dpp_u(v, 0); v += dpp_u(v, 1); v += dpp_u(v, 2); v += dpp_u(v, 3);
    const auto s16 = __builtin_amdgcn_permlane16_swap(v, v, false, false); v = (unsigned)s16[0] + (unsigned)s16[1];
    const auto s32 = __builtin_amdgcn_permlane32_swap(v, v, false, false); return (unsigned)s32[0] + (unsigned)s32[1];
}
__device__ __forceinline__ float wave_sum(float v, int lane) {
    (void)lane;
    v += dpp_f(v, 0); v += dpp_f(v, 1); v += dpp_f(v, 2); v += dpp_f(v, 3);
    return rows_sum(v);
}
__device__ __forceinline__ void st16wt(void* p, const u32x4 v) { asm volatile("global_store_dwordx4 %0, %1, off sc1\n\ts_nop 1" :: "v"(p), "v"(v) : "memory"); }
typedef int i32x8 __attribute__((ext_vector_type(8)));
__device__ __forceinline__ unsigned pk4_fp8(float a, float b, float c, float d) { int w = 0; w = __builtin_amdgcn_cvt_pk_fp8_f32(a, b, w, false); w = __builtin_amdgcn_cvt_pk_fp8_f32(c, d, w, true); return (unsigned)w; }
__device__ __forceinline__ float fp8_rt(float a) { const int w = __builtin_amdgcn_cvt_pk_fp8_f32(a, a, 0, false); return __builtin_amdgcn_cvt_f32_fp8(w, 0); }
__device__ __forceinline__ void st8wt(void* p, const u32x2 v) { __hip_atomic_store((unsigned long long*)p, ((unsigned long long)v.y << 32) | v.x, __ATOMIC_RELAXED, __HIP_MEMORY_SCOPE_AGENT); }
#define LDS_WAIT() asm volatile("s_waitcnt lgkmcnt(0)" ::: "memory")
#define VM_WAIT() asm volatile("s_waitcnt vmcnt(0)" ::: "memory")

#define XB_TMO      128
#define XB_XCNT(j)  (256  + 64 * (j))
#define XB_XSUB(j)  (1280 + 64 * (j))
#define XB_XGEN(j)  (2304 + 64 * (j))
#define XB_TOP      3328
#define XB_TOPGEN   3392
#define XCD_BAR_WORDS 3456
#define XB_SPIN_CAP (1u << 18)

__device__ __forceinline__ unsigned xb_ld(unsigned* p)              { return __hip_atomic_load(p, __ATOMIC_RELAXED, __HIP_MEMORY_SCOPE_AGENT); }
__device__ __forceinline__ unsigned xb_add(unsigned* p, unsigned v) { return __hip_atomic_fetch_add(p, v, __ATOMIC_RELAXED, __HIP_MEMORY_SCOPE_AGENT); }
__device__ __forceinline__ unsigned xb_xcc_id() { return (unsigned)__builtin_amdgcn_s_getreg((3 << 11) | 20) & 0xFu; }
#define XB_SPIN(cond, bar) do { unsigned _sp = 0; while (cond) { __builtin_amdgcn_s_sleep(1); \
    if ((++_sp & 255u) == 0u) { if (xb_ld(&(bar)[XB_TMO])) break; if (_sp > XB_SPIN_CAP) { atomicAdd(&(bar)[XB_TMO], 1u); break; } } } } while (0)

struct XcdBarrier {
    unsigned* bar; unsigned x;
    volatile LAS unsigned* st;
};

__device__ __forceinline__ XcdBarrier xcd_barrier_post(unsigned* bar, volatile LAS unsigned* st) {
    XcdBarrier b; b.bar = bar; b.x = xb_xcc_id(); b.st = st;
    if (threadIdx.x == 0) (void)xb_add(&bar[XB_XCNT(b.x)], 1u);
    return b;
}
__device__ __forceinline__ void xcd_barrier_complete(unsigned* bar, unsigned x, unsigned& nloc, unsigned& nx) {
    const unsigned G = gridDim.x * gridDim.y * gridDim.z;
    unsigned sum, cnt, mine, sp = 0u;
    for (;;) {
        sum = 0u; cnt = 0u; mine = 0u;
#pragma unroll
        for (unsigned j = 0; j < 16; ++j) { const unsigned c = xb_ld(&bar[XB_XCNT(j)]); sum += c; cnt += (c > 0u) ? 1u : 0u; mine = (j == x) ? c : mine; }
        if (sum == G) break;
        __builtin_amdgcn_s_sleep(1);
        if ((++sp & 255u) == 0u) { if (xb_ld(&bar[XB_TMO])) break; if (sp > XB_SPIN_CAP) { atomicAdd(&bar[XB_TMO], 1u); break; } }
    }
    nloc = mine > 0u ? mine : 1u; nx = cnt > 0u ? cnt : 1u;
}

template <bool LOCAL = false>
__device__ __forceinline__ void xcd_barrier(const XcdBarrier& b_in) {
    XcdBarrier b = b_in; asm volatile("" : "+s"(b.bar), "+s"(b.x));
    asm volatile("s_waitcnt vmcnt(0)" ::: "memory");
    __syncthreads();
    if (threadIdx.x == 0) {
        unsigned* bar = b.bar;
        __builtin_amdgcn_s_waitcnt(0);
        unsigned nloc = b.st[0], nx = b.st[1];
        if (nloc == 0u) { xcd_barrier_complete(bar, b.x, nloc, nx); b.st[0] = nloc; b.st[1] = nx; }
        const unsigned old = xb_add(&bar[XB_XSUB(b.x)], 1u);
        const unsigned gen = old / nloc;
        if (old + 1u == (gen + 1u) * nloc) {
          if (!(LOCAL && b.st[2] != 0u)) {
            __builtin_amdgcn_fence(__ATOMIC_RELEASE, "agent");
            asm volatile("s_waitcnt vmcnt(0)" ::: "memory");
            const unsigned og = xb_add(&bar[XB_TOP], 1u);
            const unsigned tg = og / nx;
            if (og + 1u == (tg + 1u) * nx) xb_add(&bar[XB_TOPGEN], 1u);
            else XB_SPIN(xb_ld(&bar[XB_TOPGEN]) == tg, bar);
          }
            __builtin_amdgcn_fence(__ATOMIC_ACQUIRE, "agent");
            xb_add(&bar[XB_XGEN(b.x)], 1u);
            asm volatile("s_waitcnt vmcnt(0)" ::: "memory");
        } else {
            XB_SPIN(xb_ld(&bar[XB_XGEN(b.x)]) == gen, bar);
            __builtin_amdgcn_fence(__ATOMIC_ACQUIRE, "agent");
            asm volatile("s_waitcnt vmcnt(0)" ::: "memory");
        }
    }
    __syncthreads();
}

struct Params { const float* in[21]; float* out; unsigned char* ws; int ph_lo, ph_hi; };
enum { I_X = 0, I_CWIN, I_CK, I_CWOUT, I_AWIN, I_KVG, I_KIG, I_KIB, I_AWOUT, I_RELB, I_RWG, I_RBG, I_RWE, I_RBE, I_W1, I_W3, I_W2, I_L1G, I_L1B, I_L2G, I_L2B };

struct Frame {
    LAS unsigned char* lds;
    int G, bx;
    int batch, jb;
    unsigned char* ws;
};

__device__ __forceinline__ unsigned bf4_to_fp8(const u32x2 w) {
    return pk4_fp8(__builtin_bit_cast(float, w.x << 16), __builtin_bit_cast(float, w.x & 0xffff0000u), __builtin_bit_cast(float, w.y << 16), __builtin_bit_cast(float, w.y & 0xffff0000u));
}
template <bool F8 = false>
__device__ __forceinline__ void prol_item64(const float* W, int K, int ldw, int src0, int nvalid, const float* gk, const float* bk, float colscale,
                                            void* Btv, int ldbt, int n0, float* cs, float* bs, LAS unsigned char* scr, int lane) {
    const int kk = lane >> 4, c4 = lane & 15;
    float csum[4] = {0.f, 0.f, 0.f, 0.f}, bsum[4] = {0.f, 0.f, 0.f, 0.f};
    const bool cv = 4 * c4 < nvalid;
    const unsigned sbase = (unsigned)(size_t)scr;
    const unsigned q4 = (unsigned)(lane & 15) >> 2, p4 = (unsigned)lane & 3u;
    for (int k0 = 0; k0 < K; k0 += 64) {
        f32x4 v[16]; float gv[16], bv[16];
#pragma unroll
        for (int ld = 0; ld < 16; ++ld) { gv[ld] = gk ? gk[k0 + 4 * ld + kk] : 1.f; bv[ld] = bk ? bk[k0 + 4 * ld + kk] : 0.f; }
#pragma unroll
        for (int ld = 0; ld < 16; ++ld) v[ld] = cv ? *(const GAS f32x4*)(W + (size_t)(k0 + 4 * ld + kk) * ldw + src0 + 4 * c4) : (f32x4){0.f, 0.f, 0.f, 0.f};
#pragma unroll
        for (int ld = 0; ld < 16; ++ld) {
            const float g = gv[ld] * colscale, bb = bv[ld] * colscale;
            unsigned h[4];
#pragma unroll
            for (int e = 0; e < 4; ++e) { if constexpr (F8) { const float r = fp8_rt(v[ld][e] * g); h[e] = __builtin_bit_cast(unsigned, r) >> 16; csum[e] += r; } else { h[e] = f2bf(v[ld][e] * g); csum[e] += bf2f(h[e]); } bsum[e] += v[ld][e] * bb; }
            *(LAS u32x2*)(scr + (4 * ld + kk) * 144 + c4 * 8) = (u32x2){h[0] | (h[1] << 16), h[2] | (h[3] << 16)};
        }
        LDS_WAIT(); asm volatile("" ::: "memory");
        u32x2 tr[4][2][2];
#pragma unroll
        for (int nt = 0; nt < 4; ++nt)
#pragma unroll
            for (int ch = 0; ch < 2; ++ch) {
                const unsigned a0 = sbase + (8u * (unsigned)(kk + 4 * ch) + q4) * 144u + (16u * nt + 4u * p4) * 2u, a1 = a0 + 4u * 144u;
                asm volatile("ds_read_b64_tr_b16 %0, %2\n\tds_read_b64_tr_b16 %1, %3" : "=&v"(tr[nt][ch][0]), "=&v"(tr[nt][ch][1]) : "v"(a0), "v"(a1) : "memory");
            }
        asm volatile("s_waitcnt lgkmcnt(0)" : "+v"(tr[0][0][0]), "+v"(tr[0][0][1]), "+v"(tr[0][1][0]), "+v"(tr[0][1][1]), "+v"(tr[1][0][0]), "+v"(tr[1][0][1]), "+v"(tr[1][1][0]), "+v"(tr[1][1][1]),
                     "+v"(tr[2][0][0]), "+v"(tr[2][0][1]), "+v"(tr[2][1][0]), "+v"(tr[2][1][1]), "+v"(tr[3][0][0]), "+v"(tr[3][0][1]), "+v"(tr[3][1][0]), "+v"(tr[3][1][1]) :: "memory");
#pragma unroll
        for (int nt = 0; nt < 4; ++nt)
#pragma unroll
            for (int ch = 0; ch < 2; ++ch) {
                if constexpr (F8) *(GAS u32x2*)((unsigned char*)Btv + (size_t)(n0 + 16 * nt + (lane & 15)) * ldbt + k0 + 8 * (kk + 4 * ch)) = (u32x2){bf4_to_fp8(tr[nt][ch][0]), bf4_to_fp8(tr[nt][ch][1])};
                else { u32x4 o; o.x = tr[nt][ch][0].x; o.y = tr[nt][ch][0].y; o.z = tr[nt][ch][1].x; o.w = tr[nt][ch][1].y;
                    *(GAS u32x4*)((bf16_t*)Btv + (size_t)(n0 + 16 * nt + (lane & 15)) * ldbt + k0 + 8 * (kk + 4 * ch)) = o; }
            }
    }
    if (cs) {
#pragma unroll
        for (int e = 0; e < 4; ++e) { csum[e] = rows_sum(csum[e]); bsum[e] = rows_sum(bsum[e]); }
        if (kk == 0) { *(GAS f32x4*)(cs + n0 + 4 * c4) = (f32x4){csum[0], csum[1], csum[2], csum[3]}; *(GAS f32x4*)(bs + n0 + 4 * c4) = (f32x4){bsum[0], bsum[1], bsum[2], bsum[3]}; }
    }
}

constexpr int PT_TILES = 3 * 4096, PT_GRAN = 2, PT_BUF = 50176;
struct PTile { const float* src; int ldw; unsigned char* bt; int ldbt; int kbase; int rowadd; int up; const float* gk; const float* bk; float* csp; };
__device__ __forceinline__ PTile pt_decode(const Params& P, unsigned char* ws, int T) {
    PTile t;
    if (T < 8192) { const int which = T >> 12, r = T & 4095, le = r >> 4, kt = r & 15, l = le >> 6;
        t.src = (which ? P.in[I_W3] : P.in[I_W1]) + (size_t)le * DM * DEXP + (size_t)kt * 64 * DEXP; t.ldw = DEXP; t.bt = ws + WS_WUP + (size_t)le * 512 * DM; t.ldbt = DM; t.kbase = 64 * kt;
        t.rowadd = 128 * which; t.up = 1; t.gk = P.in[I_L1G] + l * DM + 64 * kt; t.bk = P.in[I_L1B] + l * DM + 64 * kt; t.csp = (float*)(ws + WS_CSP) + ((size_t)kt * 256 + le) * 512;
    } else { const int r = T - 8192, le = r >> 4, kt = (r >> 2) & 3, nq = r & 3;
        t.src = P.in[I_W2] + (size_t)le * DEXP * DM + (size_t)kt * 64 * DM + 256 * nq; t.ldw = DM; t.bt = ws + WS_WDN + (size_t)le * DM * DEXP; t.ldbt = DEXP; t.kbase = 64 * kt;
        t.rowadd = 256 * nq; t.up = 0; t.gk = nullptr; t.bk = nullptr; t.csp = nullptr; }
    return t;
}
__device__ __forceinline__ void p0_expert_tiles(const Frame& F, const Params& P, int tid, int lane, int wave) {
    unsigned char* ws = F.ws;
    volatile LAS int* slot = (volatile LAS int*)(F.lds + LDS_MISC + 64);
    unsigned* qctr = (unsigned*)(ws + WS_CTL) + CW_QUEUE;
    if (tid == 0) { slot[0] = (int)atomicAdd(qctr, (unsigned)PT_GRAN); slot[1] = (int)atomicAdd(qctr, (unsigned)PT_GRAN); }
    __syncthreads();
    int g0 = slot[0], g1 = slot[1], par = 0;
    const unsigned g16 = (unsigned)lane >> 4, q4 = (unsigned)(lane & 15) >> 2, p4 = (unsigned)lane & 3u;
    f32x4 cur[PT_GRAN][8], nxt[PT_GRAN][8];
#define PT_LOAD(T, vv) do { const PTile _t = pt_decode(P, ws, (T)); _Pragma("unroll") for (int i = 0; i < 8; ++i) vv[i] = *(const GAS f32x4*)(_t.src + (size_t)(8 * wave + i) * _t.ldw + 4 * lane); } while (0)
    if (g0 < PT_TILES) {
#pragma unroll
        for (int j = 0; j < PT_GRAN; ++j) PT_LOAD(g0 + j, cur[j]); }
    while (g0 < PT_TILES) {
        if (tid == 0) slot[2 + par] = (int)atomicAdd(qctr, (unsigned)PT_GRAN);
        if (g1 < PT_TILES) {
#pragma unroll
            for (int j = 0; j < PT_GRAN; ++j) PT_LOAD(g1 + j, nxt[j]); }
#pragma unroll
        for (int j = 0; j < PT_GRAN; ++j) {
            const PTile t = pt_decode(P, ws, g0 + j);
            LAS unsigned char* tile = F.lds + (j & 1) * PT_BUF;
            LAS float* part = (LAS float*)(F.lds + (j & 1) * PT_BUF + 33792);
            f32x4 pc = (f32x4){0.f, 0.f, 0.f, 0.f}, pb = (f32x4){0.f, 0.f, 0.f, 0.f};
#pragma unroll
            for (int i = 0; i < 8; ++i) {
                const float gvi = t.up ? t.gk[8 * wave + i] : 1.f, bvi = t.up ? t.bk[8 * wave + i] : 0.f;
                const int w8 = (int)pk4_fp8(cur[j][i][0] * gvi, cur[j][i][1] * gvi, cur[j][i][2] * gvi, cur[j][i][3] * gvi);
                const float r0 = __builtin_amdgcn_cvt_f32_fp8(w8, 0), r1 = __builtin_amdgcn_cvt_f32_fp8(w8, 1), r2 = __builtin_amdgcn_cvt_f32_fp8(w8, 2), r3 = __builtin_amdgcn_cvt_f32_fp8(w8, 3);
                pc[0] += r0; pc[1] += r1; pc[2] += r2; pc[3] += r3;
#pragma unroll
                for (int e = 0; e < 4; ++e) pb[e] += cur[j][i][e] * bvi;
                *(LAS u32x2*)(tile + (8 * wave + i) * 528 + lane * 8) = (u32x2){(__builtin_bit_cast(unsigned, r0) >> 16) | (__builtin_bit_cast(unsigned, r1) & 0xffff0000u),
                                                                                (__builtin_bit_cast(unsigned, r2) >> 16) | (__builtin_bit_cast(unsigned, r3) & 0xffff0000u)};
            }
            if (t.up) { *(LAS f32x4*)(part + wave * 256 + 4 * lane) = pc; *(LAS f32x4*)(part + 2048 + wave * 256 + 4 * lane) = pb; }
            __syncthreads();
            {
                u32x2 tr[2][4];
                const unsigned sbase = (unsigned)(size_t)tile;
#pragma unroll
                for (int jj = 0; jj < 2; ++jj)
#pragma unroll
                    for (int c = 0; c < 4; ++c) {
                        const unsigned a0 = sbase + (16u * g16 + 4u * c + q4) * 528u + (16u * (2 * wave + jj) + 4u * p4) * 2u;
                        asm volatile("ds_read_b64_tr_b16 %0, %1" : "=&v"(tr[jj][c]) : "v"(a0) : "memory");
                    }
                asm volatile("s_waitcnt lgkmcnt(0)" : "+v"(tr[0][0]), "+v"(tr[0][1]), "+v"(tr[0][2]), "+v"(tr[0][3]), "+v"(tr[1][0]), "+v"(tr[1][1]), "+v"(tr[1][2]), "+v"(tr[1][3]) :: "memory");
#pragma unroll
                for (int jj = 0; jj < 2; ++jj) {
                    const int n = 16 * (2 * wave + jj) + (lane & 15);
                    const int brow = t.up ? (n & 127) + 256 * (n >> 7) + t.rowadd : 128 * ((n >> 3) & 1) + 32 * (n >> 6) + 8 * ((n >> 4) & 3) + (n & 7) + t.rowadd;
                    u32x4 o; o.x = bf4_to_fp8(tr[jj][0]); o.y = bf4_to_fp8(tr[jj][1]); o.z = bf4_to_fp8(tr[jj][2]); o.w = bf4_to_fp8(tr[jj][3]);
                    *(GAS u32x4*)(t.bt + (size_t)brow * t.ldbt + t.kbase + 16 * g16) = o;
                }
            }
            if (t.up && tid < 256) {
                float cs = part[tid], bs = part[2048 + tid];
#pragma unroll
                for (int w2 = 1; w2 < 8; ++w2) { cs += part[w2 * 256 + tid]; bs += part[2048 + w2 * 256 + tid]; }
                const int brow = (tid & 127) + 256 * (tid >> 7) + t.rowadd;
                t.csp[brow] = cs; t.csp[(size_t)32 * 4 * 64 * 512 + brow] = bs;
            }
        }
        g0 = g1; g1 = slot[2 + par]; par ^= 1;
#pragma unroll
        for (int j = 0; j < PT_GRAN; ++j)
#pragma unroll
            for (int i = 0; i < 8; ++i) cur[j][i] = nxt[j][i];
    }
    __syncthreads();
#undef PT_LOAD
}

__device__ __forceinline__ void p0_heavy_item(const Params& P, unsigned char* ws, int r, LAS unsigned char* scr, int lane) {
    constexpr int N_AO = 2 * 16 * 2, N_CI = 2 * 48, N_AI = 2 * 44;
    if (r < N_AO) {
        const int jl = r / 32, g = (r % 32) >> 1, kh = r & 1;
        prol_item64<true>(P.in[I_AWOUT] + (size_t)jl * 2048 * DM + (size_t)kh * 1024 * DM, 1024, DM, 64 * g, 64, nullptr, nullptr, 64.f,
                    ws + WS_WAO + (size_t)jl * DM * 2048 + kh * 1024, 2048, 64 * g, nullptr, nullptr, scr, lane);
        return; }
    r -= N_AO;
    if (r < N_CI) {
        const int jl = r / 48, g = r % 48, n0 = 64 * g;
        int src;
        if (n0 < 2048) { const int p = n0 >> 8, half = (n0 >> 7) & 1; src = (half ? 2048 : 1024) + 128 * p + (n0 & 127); } else src = n0 - 2048;
        const float* gk = jl ? P.in[I_L2G] + (2 * jl - 1) * DM : nullptr; const float* bk = jl ? P.in[I_L2B] + (2 * jl - 1) * DM : nullptr;
        prol_item64(P.in[I_CWIN] + (size_t)jl * DM * 3072, DM, 3072, src, 64, gk, bk, 1.f, (bf16_t*)(ws + WS_WCI) + (size_t)jl * 3072 * DM, DM, n0,
                    (float*)(ws + WS_CSCI) + jl * 3072, (float*)(ws + WS_BSCI) + jl * 3072, scr, lane);
        return; }
    r -= N_CI;
    if (r < N_AI) {
        const int jl = r / 44, g = r % 44, n0 = 64 * g;
        int src, nvalid = 64; float sc = 1.f;
        if (n0 < 2048) { src = n0; sc = 0.08838834764831845f; }
        else if (n0 < 2176) src = n0;
        else if (n0 < 2240) src = 2688;
        else if (n0 < 2304) { src = 2752; nvalid = 8; sc = 0.35355339059327373f; }
        else { src = 2176 + (n0 - 2304); sc = 0.125f; }
        if (n0 < 2048)
            prol_item64<true>(P.in[I_AWIN] + (size_t)jl * DM * AIW, DM, AIW, src, nvalid, P.in[I_L2G] + (2 * jl) * DM, P.in[I_L2B] + (2 * jl) * DM, 1.f,
                    ws + WS_WAI + (size_t)jl * AIWP * DM * 2, DM, n0, (float*)(ws + WS_CSAI) + jl * AIWP, (float*)(ws + WS_BSAI) + jl * AIWP, scr, lane);
        else
            prol_item64(P.in[I_AWIN] + (size_t)jl * DM * AIW, DM, AIW, src, nvalid, P.in[I_L2G] + (2 * jl) * DM, P.in[I_L2B] + (2 * jl) * DM, sc,
                    (bf16_t*)(ws + WS_WAI) + (size_t)jl * AIWP * DM, DM, n0, (float*)(ws + WS_CSAI) + jl * AIWP, (float*)(ws + WS_BSAI) + jl * AIWP, scr, lane);
        return; }
    r -= N_AI;
    {
        const int jl = r / 16, g = r % 16;
        prol_item64<true>(P.in[I_CWOUT] + (size_t)jl * DM * DM, DM, DM, 64 * g, 64, nullptr, nullptr, 64.f, ws + WS_WCO + (size_t)jl * DM * DM, DM, 64 * g, nullptr, nullptr, scr, lane);
    }
}

__device__ __forceinline__ void p0_prologue(const Frame& F, const Params& P) {
    int tid = threadIdx.x; asm volatile("" : "+v"(tid)); const int lane = tid & 63, wave = __builtin_amdgcn_readfirstlane(tid >> 6);
    LAS unsigned char* scr = F.lds + LDS_STAGE + wave * 16896;
    const int gw = F.bx * NWAVES + wave, NGW = F.G * NWAVES;
    unsigned char* ws = F.ws;
    constexpr int N_DENSE = 2 * 16 * 2 + 2 * 48 + 2 * 44 + 2 * 16;
    if (gw < N_DENSE) p0_heavy_item(P, ws, gw, scr, lane);
    __syncthreads();
    p0_expert_tiles(F, P, tid, lane, wave);
    if (gw < 4 * 96) {
        const int l = gw / 96, n = gw % 96;
        const int ks = lane >> 1, fq0 = 2 * (lane & 1), nt = n >> 4;
        bf16_t* hi = (bf16_t*)(ws + WS_WR) + ((((size_t)(l * 32 + ks) * 2 + 0) * 6 + nt) * 64 + (n & 15) + 16 * fq0) * 8; bf16_t* lo = hi + (size_t)6 * 64 * 8;
        float csum = 0.f, bsum = 0.f; unsigned hw[8], lw[8];
        if (n < 72) {
            const float* Wc = n < 8 ? P.in[I_RWG] + (size_t)l * DM * 8 + n : P.in[I_RWE] + (size_t)l * DM * 64 + (n - 8); const int ldw = n < 8 ? 8 : 64;
            float w[16], g[16], b[16];
#pragma unroll
            for (int i = 0; i < 16; ++i) w[i] = Wc[(size_t)(16 * lane + i) * ldw];
#pragma unroll
            for (int i = 0; i < 4; ++i) { const f32x4 g4 = *(const GAS f32x4*)(P.in[I_L1G] + l * DM + 16 * lane + 4 * i), b4 = *(const GAS f32x4*)(P.in[I_L1B] + l * DM + 16 * lane + 4 * i);
#pragma unroll
                for (int e = 0; e < 4; ++e) { g[4 * i + e] = g4[e]; b[4 * i + e] = b4[e]; } }
            unsigned hb[16], lb[16];
#pragma unroll
            for (int i = 0; i < 16; ++i) { const float wf = w[i] * g[i]; hb[i] = f2bf(wf); const float h = bf2f(hb[i]); lb[i] = f2bf(wf - h); csum += h + bf2f(lb[i]); bsum += w[i] * b[i]; }
#pragma unroll
            for (int i = 0; i < 8; ++i) { hw[i] = hb[2 * i] | (hb[2 * i + 1] << 16); lw[i] = lb[2 * i] | (lb[2 * i + 1] << 16); }
        } else {
#pragma unroll
            for (int i = 0; i < 8; ++i) { hw[i] = 0u; lw[i] = 0u; }
        }
        *(u32x4*)hi = (u32x4){hw[0], hw[1], hw[2], hw[3]}; *(GAS u32x4*)(hi + 16 * 8) = (u32x4){hw[4], hw[5], hw[6], hw[7]};
        *(u32x4*)lo = (u32x4){lw[0], lw[1], lw[2], lw[3]}; *(GAS u32x4*)(lo + 16 * 8) = (u32x4){lw[4], lw[5], lw[6], lw[7]};
        csum = wave_sum(csum, lane); bsum = wave_sum(bsum, lane);
        if (lane == 0) { ((float*)(ws + WS_CSR))[l * 96 + n] = csum; ((float*)(ws + WS_BSR))[l * 96 + n] = bsum; }
    }
    for (int m0 = gw; m0 < T_TOK; m0 += 4 * NGW) {
        f32x4 xv[4][4];
#pragma unroll
        for (int r = 0; r < 4; ++r) { const GAS f32x4* xr = (const GAS f32x4*)(P.in[I_X] + (size_t)(m0 + r * NGW) * DM) + lane;
#pragma unroll
            for (int q = 0; q < 4; ++q) xv[r][q] = xr[64 * q]; }
#pragma unroll
        for (int r = 0; r < 4; ++r) { const int m = m0 + r * NGW;
            GAS u32x2* o = (GAS u32x2*)((bf16_t*)(ws + WS_ZA) + (size_t)m * DM) + lane;
#pragma unroll
            for (int q = 0; q < 4; ++q) { const f32x4 v = xv[r][q]; u32x2 w; w.x = pk2(v.x, v.y); w.y = pk2(v.z, v.w); o[64 * q] = w; }
            if (lane == 0) { float* st = (float*)(ws + WS_STA) + 2 * m; st[0] = 0.f; st[1] = 1.f; } }
    }
    if (F.bx == 0) { float* v = (float*)(ws + WS_VEC); for (int i = tid; i < 2048; i += NTHREADS) v[i] = i < 1024 ? 1.f : 0.f; }
}

__device__ __forceinline__ f32x2 stats_from_part(const float* part, int row);
template <bool FINAL>
__device__ __forceinline__ void combine_phase(const Frame& F, const bf16_t* zin, const float* stin, const float* partin, const float* g, const float* b, const unsigned char* y,
                                              bf16_t* zout, float* stout, const float* gout, const float* bout, float* out, unsigned char* z8out) {
    int tid = threadIdx.x; asm volatile("" : "+v"(tid)); const int lane = tid & 63, wave = __builtin_amdgcn_readfirstlane(tid >> 6); (void)lane; (void)wave;
    const int row0 = 2048 * F.batch + 64 * F.jb + 8 * wave;
    const int c0 = 8 * lane;
    float gv[2][8], bv[2][8];
#pragma unroll
    for (int j2 = 0; j2 < 2; ++j2) {
        const f32x4 g0 = *(const GAS f32x4*)(g + c0 + 512 * j2), g1 = *(const GAS f32x4*)(g + c0 + 512 * j2 + 4), b0 = *(const GAS f32x4*)(b + c0 + 512 * j2), b1 = *(const GAS f32x4*)(b + c0 + 512 * j2 + 4);
#pragma unroll
        for (int e = 0; e < 4; ++e) { gv[j2][e] = g0[e]; gv[j2][4 + e] = g1[e]; bv[j2][e] = b0[e]; bv[j2][4 + e] = b1[e]; }
    }
    for (int r2 = 0; r2 < 8; r2 += 8) {
      u32x4 zws[8][2]; u32x2 yws[8][2][2]; f32x2 sts[8];
#pragma unroll
      for (int rr = 0; rr < 8; ++rr) { const int row = row0 + r2 + rr;
          sts[rr] = partin ? stats_from_part(partin, row) : *(const GAS f32x2*)(stin + 2 * row);
#pragma unroll
          for (int j2 = 0; j2 < 2; ++j2) { zws[rr][j2] = *(const GAS u32x4*)(zin + (size_t)row * DM + c0 + 512 * j2);
              if (y) {
#pragma unroll
                  for (int sl = 0; sl < 2; ++sl) yws[rr][j2][sl] = *(const GAS u32x2*)(y + ((size_t)row * 2 + sl) * DM + c0 + 512 * j2); } } }
#pragma unroll
      for (int rr = 0; rr < 8; ++rr) {
        const int row = row0 + r2 + rr;
        const f32x2 st = sts[rr];
        float v[2][8]; float s = 0.f;
#pragma unroll
        for (int j2 = 0; j2 < 2; ++j2) {
            const u32x4 zw = zws[rr][j2];
            float z[8] = {bflo(zw.x), bfhi(zw.x), bflo(zw.y), bfhi(zw.y), bflo(zw.z), bfhi(zw.z), bflo(zw.w), bfhi(zw.w)};
            float acc[8];
#pragma unroll
            for (int e = 0; e < 8; ++e) acc[e] = ALPHA * ((z[e] - st.x) * st.y * gv[j2][e] + bv[j2][e]);
            if (y) {
#pragma unroll
                for (int sl = 0; sl < 2; ++sl) {
                    const u32x2 yw = yws[rr][j2][sl];
                    acc[0] += 0.0625f * __builtin_amdgcn_cvt_f32_fp8((int)yw.x, 0); acc[1] += 0.0625f * __builtin_amdgcn_cvt_f32_fp8((int)yw.x, 1); acc[2] += 0.0625f * __builtin_amdgcn_cvt_f32_fp8((int)yw.x, 2); acc[3] += 0.0625f * __builtin_amdgcn_cvt_f32_fp8((int)yw.x, 3);
                    acc[4] += 0.0625f * __builtin_amdgcn_cvt_f32_fp8((int)yw.y, 0); acc[5] += 0.0625f * __builtin_amdgcn_cvt_f32_fp8((int)yw.y, 1); acc[6] += 0.0625f * __builtin_amdgcn_cvt_f32_fp8((int)yw.y, 2); acc[7] += 0.0625f * __builtin_amdgcn_cvt_f32_fp8((int)yw.y, 3);
                }
            }
            if (!FINAL) {
#pragma unroll
                for (int e = 0; e < 8; ++e) acc[e] = bf2f(f2bf(acc[e]));
            }
#pragma unroll
            for (int e = 0; e < 8; ++e) { v[j2][e] = acc[e]; s += acc[e]; }
        }
        const float mean = wave_sum(s, lane) * (1.f / DM);
        float s2 = 0.f;
#pragma unroll
        for (int j2 = 0; j2 < 2; ++j2)
#pragma unroll
            for (int e = 0; e < 8; ++e) { const float d = v[j2][e] - mean; s2 += d * d; }
        const float rstd = __builtin_amdgcn_rsqf(wave_sum(s2, lane) * (1.f / DM) + LN_EPS);
        if (!FINAL) {
#pragma unroll
            for (int j2 = 0; j2 < 2; ++j2) {
                u32x4 o; o.x = pk2(v[j2][0], v[j2][1]); o.y = pk2(v[j2][2], v[j2][3]); o.z = pk2(v[j2][4], v[j2][5]); o.w = pk2(v[j2][6], v[j2][7]);
                *(GAS u32x4*)(zout + (size_t)row * DM + c0 + 512 * j2) = o;
                if (z8out) *(GAS u32x2*)(z8out + (size_t)row * DM + c0 + 512 * j2) = (u32x2){pk4_fp8(v[j2][0], v[j2][1], v[j2][2], v[j2][3]), pk4_fp8(v[j2][4], v[j2][5], v[j2][6], v[j2][7])};
            }
            if (lane == 0) { *(GAS f32x2*)(stout + 2 * row) = (f32x2){mean, rstd}; }
        } else {
#pragma unroll
            for (int j2 = 0; j2 < 2; ++j2) {
                const f32x4 g0 = *(const GAS f32x4*)(gout + c0 + 512 * j2), g1 = *(const GAS f32x4*)(gout + c0 + 512 * j2 + 4), b0 = *(const GAS f32x4*)(bout + c0 + 512 * j2), b1 = *(const GAS f32x4*)(bout + c0 + 512 * j2 + 4);
                f32x4 o0, o1;
#pragma unroll
                for (int e = 0; e < 4; ++e) { o0[e] = (v[j2][e] - mean) * rstd * g0[e] + b0[e]; o1[e] = (v[j2][4 + e] - mean) * rstd * g1[e] + b1[e]; }
                *(GAS f32x4*)(out + (size_t)row * DM + c0 + 512 * j2) = o0; *(GAS f32x4*)(out + (size_t)row * DM + c0 + 512 * j2 + 4) = o1;
            }
        }
      }
    }
}

namespace pg8 {
constexpr int BM = 256, BK = 64, HALF = 128, HTB = HALF * BK * 2, STAGE_BYTES = 8 * HTB, NXCD = 8, WGM = 8;
__host__ __device__ __forceinline__ int lds_byte(int r, int c) { const int st = (r >> 4) * 2 + (c >> 5), rr = r & 15, cc = c & 31, ob = rr * 64 + cc * 2; return st * 1024 + (ob ^ (((ob >> 9) & 1) << 5)); }
__host__ __device__ __forceinline__ void stage_rc(int b, int& R, int& C) { const int st = b / 1024, sb = b % 1024, swz = sb ^ (((sb >> 9) & 1) << 5); R = (st >> 1) * 16 + swz / 64; C = (st & 1) * 32 + (swz % 64) / 2; }
__host__ __device__ __forceinline__ int perm32(int rho) { const int n = rho >> 4, i = rho & 15; return 8 * (i >> 2) + 4 * n + (i & 3); }

struct Unit { const char* A; const char* B; int pm, pn, x0, x1; };

struct StaticOrder {
    int nM, nN, nwg, G, c; const char* A; const char* B; size_t astep, bstep;
    __device__ void init(int M, int N, int G_, int c_, const void* A_, size_t lda_bytes, const void* B_, size_t ldb_bytes) { nM = M / BM; nN = N / BM; nwg = nM * nN; G = G_; c = c_; A = (const char*)A_; B = (const char*)B_; astep = lda_bytes * BM; bstep = ldb_bytes * BM; }
    __device__ bool next(int i, Unit& u) const {
        const long L = (long)i * G + c; if (L >= nwg) return false;
        int wgid = (int)L; { const int q = nwg / NXCD, r = nwg % NXCD, xcd = wgid % NXCD, off = wgid / NXCD; wgid = (xcd < r ? xcd * (q + 1) : r * (q + 1) + (xcd - r) * q) + off; }
        const int nig = WGM * nN, gid = wgid / nig, fm = gid * WGM, gsz = (nM - fm) < WGM ? (nM - fm) : WGM;
        u.pm = fm + ((wgid % nig) % gsz); u.pn = (wgid % nig) / gsz; u.A = A + (size_t)u.pm * astep; u.B = B + (size_t)u.pn * bstep; u.x0 = 0; u.x1 = 0; return true;
    }
    __device__ __forceinline__ const LAS unsigned* rowoff(int) const { return nullptr; }
    __device__ __forceinline__ void a_ready(const Unit&) const {}
};

__device__ __forceinline__ unsigned cvt_pk_bf16(float lo, float hi) { unsigned r; asm volatile("v_cvt_pk_bf16_f32 %0, %1, %2" : "=v"(r) : "v"(lo), "v"(hi)); return r; }

template <class Epi, class Sched, bool GATHER, bool FP8 = false>
__device__ __forceinline__ void gemm_phase(LAS unsigned char* lds, const int K, const unsigned lda_bytes, const unsigned ldb_bytes, const Sched& S, const Epi& E, const int b_e8m0 = 127) {
    int tid = threadIdx.x; asm volatile("" : "+v"(tid));
    const int wid = __builtin_amdgcn_readfirstlane(tid >> 6), lane = tid & 63, wr = wid >> 2, wc = wid & 3, fr = lane & 15, fq = lane >> 4;
    int nt = K / BK; asm volatile("" : "+s"(nt));
    unsigned voffA[2], voffB[2];
#pragma unroll
    for (int i = 0; i < 2; ++i) { int R, C; stage_rc(tid * 16 + i * 8192, R, C); const int Rb = (R & ~31) + perm32(R & 31);
        voffA[i] = (unsigned)R * lda_bytes + (unsigned)C * 2u; voffB[i] = (unsigned)Rb * ldb_bytes + (unsigned)C * 2u; }
#define PG8_GOFF(dst, ro) do { int _t = threadIdx.x; asm volatile("" : "+v"(_t)); _Pragma("unroll") for (int _i = 0; _i < 2; ++_i) { int _R, _C; stage_rc(_t * 16 + _i * 8192, _R, _C); \
        _Pragma("unroll") for (int _h = 0; _h < 2; ++_h) dst[_h][_i] = (ro)[_h * HALF + _R] + (unsigned)_C * 2u; } } while (0)
    const size_t kstep = (size_t)(BK * 2);
    const size_t hstepA = (size_t)HALF * lda_bytes, hstepB = (size_t)HALF * ldb_bytes;
    const unsigned ldsw = (unsigned)wid * 1024u;
    const int aoff = lds_byte(wr * 64 + fr, fq * 8), boff = lds_byte(wc * 32 + fr, fq * 8);
#define PG8_SA(b, h) (((b) * 2 + (h)) * HTB)
#define PG8_SB(b, h) ((4 + (b) * 2 + (h)) * HTB)
#define PG8_GLDS(src, bufoff, i) __builtin_amdgcn_global_load_lds((const unsigned*)(src), (LAS unsigned*)(lds + (bufoff) + ldsw + (i) * 8192), 16, 0, 0)
#define PG8_STAGE_B(bufoff, gbase) do { _Pragma("unroll") for (int _i = 0; _i < 2; ++_i) PG8_GLDS((const char*)(gbase) + voffB[_i], bufoff, _i); } while (0)
#define PG8_STAGE_A(bufoff, gbase, h, GO) do { _Pragma("unroll") for (int _i = 0; _i < 2; ++_i) { \
        if constexpr (GATHER) PG8_GLDS((const char*)(gbase) + (GO)[h][_i], bufoff, _i); else PG8_GLDS((const char*)(gbase) + (h) * hstepA + voffA[_i], bufoff, _i); } } while (0)
#define PG8_LDA(dst, b, h) do { _Pragma("unroll") for (int m = 0; m < 4; ++m) _Pragma("unroll") for (int k = 0; k < 2; ++k) dst[m][k] = *(const LAS bf16x8*)(lds + PG8_SA(b, h) + aoff + m * 2048 + k * 1024); } while (0)
#define PG8_LDB(dst, b, h) do { _Pragma("unroll") for (int n = 0; n < 2; ++n) _Pragma("unroll") for (int k = 0; k < 2; ++k) dst[n][k] = *(const LAS bf16x8*)(lds + PG8_SB(b, h) + boff + n * 2048 + k * 1024); } while (0)
#define PG8_MMA(ai, bj, At, Bt) do { __builtin_amdgcn_s_setprio(1); _Pragma("unroll") for (int m = 0; m < 4; ++m) _Pragma("unroll") for (int n = 0; n < 2; ++n) { \
        if constexpr (FP8) { const u32x4 b0 = __builtin_bit_cast(u32x4, Bt[n][0]), b1 = __builtin_bit_cast(u32x4, Bt[n][1]), a0 = __builtin_bit_cast(u32x4, At[m][0]), a1 = __builtin_bit_cast(u32x4, At[m][1]); \
            const i32x8 vb = {(int)b0.x, (int)b0.y, (int)b0.z, (int)b0.w, (int)b1.x, (int)b1.y, (int)b1.z, (int)b1.w}, va = {(int)a0.x, (int)a0.y, (int)a0.z, (int)a0.w, (int)a1.x, (int)a1.y, (int)a1.z, (int)a1.w}; \
            asm volatile("v_mfma_scale_f32_16x16x128_f8f6f4 %0, %1, %2, %0, %3, %4 op_sel_hi:[0,0,0]" : "+v"(acc[ai][bj][m][n]) : "v"(vb), "v"(va), "v"(fp8_bscale), "v"(fp8_scale)); } \
        else { _Pragma("unroll") for (int k = 0; k < 2; ++k) acc[ai][bj][m][n] = __builtin_amdgcn_mfma_f32_16x16x32_bf16(Bt[n][k], At[m][k], acc[ai][bj][m][n], 0, 0, 0); } } \
        __builtin_amdgcn_s_setprio(0); } while (0)
#define PG8_WAIT_V(n) asm volatile("s_waitcnt vmcnt(" #n ")" ::: "memory")
#define PG8_WAIT_L(n) asm volatile("s_waitcnt lgkmcnt(" #n ")" ::: "memory")
#define PG8_BAR __builtin_amdgcn_s_barrier()
#define PG8_SCHED __builtin_amdgcn_sched_barrier(0)
    Unit cur, nxt; int ui = 0;
    if (!S.next(0, cur)) return;
    int fp8_scale = 0x7F7F7F7F; asm volatile("" : "+v"(fp8_scale));
    int fp8_bscale = b_e8m0 * 0x01010101; asm volatile("" : "+v"(fp8_bscale));
    (void)fp8_scale; (void)fp8_bscale;
    f32x4 acc[2][2][4][2];
#pragma unroll
    for (int a = 0; a < 2; ++a)
#pragma unroll
        for (int b = 0; b < 2; ++b)
#pragma unroll
            for (int m = 0; m < 4; ++m)
#pragma unroll
                for (int n = 0; n < 2; ++n) acc[a][b][m][n] = (f32x4){0.f, 0.f, 0.f, 0.f};
    bf16x8 At[4][2], B0[2][2], B1[2][2];
    unsigned cG[2][2] = {{0u, 0u}, {0u, 0u}};
    if constexpr (GATHER) { const LAS unsigned* ro = S.rowoff(0); PG8_GOFF(cG, ro); }
    const char* cA = cur.A; const char* cB = cur.B;
    int eslot = 0;
    E.prefetch(cur, 0, wid, lane);
    S.a_ready(cur);
    PG8_STAGE_B(PG8_SB(0, 0), cB); PG8_STAGE_B(PG8_SB(0, 1), cB + hstepB); PG8_STAGE_A(PG8_SA(0, 0), cA, 0, cG); PG8_STAGE_A(PG8_SA(0, 1), cA, 1, cG);
    if (wr == 1) PG8_BAR;
    PG8_WAIT_V(2); PG8_BAR;
    PG8_STAGE_B(PG8_SB(1, 0), cB + kstep); PG8_STAGE_A(PG8_SA(1, 0), cA + kstep, 0, cG); PG8_STAGE_B(PG8_SB(1, 1), cB + hstepB + kstep);
    PG8_WAIT_V(6); PG8_BAR;
    for (;;) {
        const bool has_next = S.next(ui + 1, nxt);
        const int nslot = eslot == 2 ? 0 : eslot + 1;
        if (has_next) E.prefetch(nxt, nslot, wid, lane);
        const char* nA = has_next ? nxt.A : cA; const char* nB = has_next ? nxt.B : cB;
        for (int t = 0; t < nt; t += 2) {
            const bool last = (t == nt - 2);
            if (last && has_next) S.a_ready(nxt);
            const char* a1 = cA + (size_t)(t + 1) * kstep;
            const char* a2 = last ? nA : cA + (size_t)(t + 2) * kstep; const char* b2 = last ? nB : cB + (size_t)(t + 2) * kstep;
            const char* a3 = a2 + kstep; const char* b3 = b2 + kstep;
            unsigned g2[2][2] = {{0u, 0u}, {0u, 0u}};
            if constexpr (GATHER) { const LAS unsigned* ro = S.rowoff((last && has_next) ? ui + 1 : ui); PG8_GOFF(g2, ro); }
            PG8_LDB(B0, 0, 0); PG8_LDB(B1, 0, 1); PG8_SCHED; PG8_LDA(At, 0, 0); PG8_STAGE_A(PG8_SA(1, 1), a1, 1, cG);
            PG8_WAIT_V(8); PG8_WAIT_L(0); PG8_BAR; PG8_MMA(0, 0, At, B0); PG8_MMA(0, 1, At, B1); PG8_BAR; PG8_SCHED;
            PG8_LDA(At, 0, 1); PG8_STAGE_B(PG8_SB(0, 0), b2); PG8_STAGE_B(PG8_SB(0, 1), b2 + hstepB); PG8_STAGE_A(PG8_SA(0, 0), a2, 0, g2);
            PG8_WAIT_V(8); PG8_WAIT_L(0); PG8_BAR; PG8_MMA(1, 0, At, B0); PG8_MMA(1, 1, At, B1); PG8_BAR; PG8_SCHED;
            PG8_LDB(B0, 1, 0); PG8_LDB(B1, 1, 1); PG8_SCHED; PG8_LDA(At, 1, 0); PG8_STAGE_A(PG8_SA(0, 1), a2, 1, g2);
            PG8_WAIT_V(8); PG8_WAIT_L(0); PG8_BAR; PG8_MMA(0, 0, At, B0); PG8_MMA(0, 1, At, B1); PG8_BAR; PG8_SCHED;
            PG8_LDA(At, 1, 1); PG8_STAGE_B(PG8_SB(1, 0), b3); PG8_STAGE_B(PG8_SB(1, 1), b3 + hstepB); PG8_STAGE_A(PG8_SA(1, 0), a3, 0, g2);
            PG8_WAIT_V(8); PG8_WAIT_L(0); PG8_BAR; PG8_MMA(1, 0, At, B0); PG8_MMA(1, 1, At, B1); PG8_BAR; PG8_SCHED;
        }
        if constexpr (FP8) asm volatile("s_nop 15\n\ts_nop 15\n\ts_nop 7" ::: "memory");
        if (wr == 0) PG8_BAR;
        E(acc, cur, ui, wr, wc, fr, fq, eslot);
        if (!has_next) break;
#pragma unroll
        for (int a = 0; a < 2; ++a)
#pragma unroll
            for (int b = 0; b < 2; ++b)
#pragma unroll
                for (int m = 0; m < 4; ++m)
#pragma unroll
                    for (int n = 0; n < 2; ++n) acc[a][b][m][n] = (f32x4){0.f, 0.f, 0.f, 0.f};
        cur = nxt; cA = nA; cB = nB; ++ui; eslot = nslot;
        if constexpr (GATHER) { const LAS unsigned* ro = S.rowoff(ui); PG8_GOFF(cG, ro); }
        if (wr == 1) PG8_BAR;
    }
    PG8_WAIT_V(0);
    PG8_BAR;
#undef PG8_SA
#undef PG8_SB
#undef PG8_GLDS
#undef PG8_GOFF
#undef PG8_STAGE_A
#undef PG8_STAGE_B
#undef PG8_LDA
#undef PG8_LDB
#undef PG8_MMA
#undef PG8_WAIT_V
#undef PG8_WAIT_L
#undef PG8_BAR
#undef PG8_SCHED
}
}

__device__ __forceinline__ void ld8(const float* p, float (&v)[8]) { const f32x4 a = *(const f32x4*)p, b = *(const GAS f32x4*)(p + 4); v[0] = a.x; v[1] = a.y; v[2] = a.z; v[3] = a.w; v[4] = b.x; v[5] = b.y; v[6] = b.z; v[7] = b.w; }
__device__ __forceinline__ void unpack8(const u32x4 w, float (&v)[8]) { v[0] = bflo(w.x); v[1] = bfhi(w.x); v[2] = bflo(w.y); v[3] = bfhi(w.y); v[4] = bflo(w.z); v[5] = bfhi(w.z); v[6] = bflo(w.w); v[7] = bfhi(w.w); }
__device__ __forceinline__ u32x4 pack8(const float (&v)[8]) { u32x4 o; o.x = pg8::cvt_pk_bf16(v[0], v[1]); o.y = pg8::cvt_pk_bf16(v[2], v[3]); o.z = pg8::cvt_pk_bf16(v[4], v[5]); o.w = pg8::cvt_pk_bf16(v[6], v[7]); return o; }

__device__ __forceinline__ void ld8l(const LAS float* p, float (&v)[8]) { const f32x4 a = *(const LAS f32x4*)p, b = *(const LAS f32x4*)(p + 4); v[0] = a.x; v[1] = a.y; v[2] = a.z; v[3] = a.w; v[4] = b.x; v[5] = b.y; v[6] = b.z; v[7] = b.w; }
__device__ __forceinline__ void epi_prefetch(LAS unsigned char* dst, const float* st256, const float* cs256, const float* bs256, int wid, int lane) {
    if (wid < 4) { const char* src = wid < 2 ? (const char*)st256 + wid * 1024 : (wid == 2 ? (const char*)cs256 : (const char*)bs256); int t = threadIdx.x; asm volatile("" : "+v"(t)); (void)lane;
        __builtin_amdgcn_global_load_lds((const unsigned*)(src + (t & 63) * 16), (LAS unsigned*)(dst + wid * 1024), 16, 0, 0); }
}
struct EpiConvIn {
    const float* st; const float* cs; const float* bs; bf16_t* u; bf16_t* bg; LAS unsigned char* aux;
    __device__ __forceinline__ void prefetch(const pg8::Unit& un, int slot, int wid, int lane) const { epi_prefetch(aux + slot * 4096, st + 2 * 256 * un.pm, cs + 256 * un.pn, bs + 256 * un.pn, wid, lane); }
    __device__ __forceinline__ void operator()(const f32x4 (&acc)[2][2][4][2], const pg8::Unit& un, int, int wr, int wc, int fr, int fq, int slot) const {
        const int colL = 32 * wc + 8 * fq;
        const LAS unsigned char* ep = aux + slot * 4096;
        float csv[2][8], bsv[2][8];
        ld8l((const LAS float*)(ep + 2048) + colL, csv[0]); ld8l((const LAS float*)(ep + 2048) + colL + 128, csv[1]); ld8l((const LAS float*)(ep + 3072) + colL, bsv[0]); ld8l((const LAS float*)(ep + 3072) + colL + 128, bsv[1]);
        f32x2 sv[2][4];
#pragma unroll
        for (int ai = 0; ai < 2; ++ai)
#pragma unroll
            for (int m = 0; m < 4; ++m) sv[ai][m] = ((const LAS f32x2*)ep)[128 * ai + 64 * wr + 16 * m + fr];
#pragma unroll
        for (int ai = 0; ai < 2; ++ai)
#pragma unroll
            for (int m = 0; m < 4; ++m) {
                const int row = 256 * un.pm + 128 * ai + 64 * wr + 16 * m + fr;
                const f32x2 s = sv[ai][m];
                float f[2][8];
#pragma unroll
                for (int bj = 0; bj < 2; ++bj)
#pragma unroll
                    for (int e = 0; e < 8; ++e) f[bj][e] = s.y * (acc[ai][bj][m][e >> 2][e & 3] - s.x * csv[bj][e]) + bsv[bj][e];
                if (un.pn < 8) {
                    float p[8];
#pragma unroll
                    for (int e = 0; e < 8; ++e) p[e] = f[0][e] * f[1][e];
                    *(GAS u32x4*)(u + (size_t)row * DM + 128 * un.pn + colL) = pack8(p);
                } else {
                    *(GAS u32x4*)(bg + (size_t)row * DM + 256 * (un.pn - 8) + colL) = pack8(f[0]);
                    *(GAS u32x4*)(bg + (size_t)row * DM + 256 * (un.pn - 8) + 128 + colL) = pack8(f[1]);
                }
            }
    }
};

struct EpiRes {
    const bf16_t* zprev; const float* stprev; const float* gprev; const float* bprev; bf16_t* zout; float* part; unsigned char* z8;
    __device__ __forceinline__ void prefetch(const pg8::Unit&, int, int, int) const {}
    __device__ __forceinline__ void operator()(const f32x4 (&acc)[2][2][4][2], const pg8::Unit& un, int, int wr, int wc, int fr, int fq, int) const {
        const int cb = 256 * un.pn + 32 * wc + 8 * fq;
        float gv[2][8], bv[2][8];
        ld8(gprev + cb, gv[0]); ld8(gprev + cb + 128, gv[1]); ld8(bprev + cb, bv[0]); ld8(bprev + cb + 128, bv[1]);
#pragma unroll
        for (int ai = 0; ai < 2; ++ai) {
            f32x2 sv[4]; u32x4 zw[4][2];
#pragma unroll
            for (int m = 0; m < 4; ++m) { const int row = 256 * un.pm + 128 * ai + 64 * wr + 16 * m + fr; sv[m] = *(const GAS f32x2*)(stprev + 2 * row);
#pragma unroll
                for (int bj = 0; bj < 2; ++bj) zw[m][bj] = *(const GAS u32x4*)(zprev + (size_t)row * DM + cb + 128 * bj); }
#pragma unroll
            for (int m = 0; m < 4; ++m) {
                const int row = 256 * un.pm + 128 * ai + 64 * wr + 16 * m + fr;
                const f32x2 s = sv[m];
                float sum = 0.f, sq = 0.f;
#pragma unroll
                for (int bj = 0; bj < 2; ++bj) {
                    float z[8], v[8]; unpack8(zw[m][bj], z);
#pragma unroll
                    for (int e = 0; e < 8; ++e) v[e] = ALPHA * ((z[e] - s.x) * s.y * gv[bj][e] + bv[bj][e]) + acc[ai][bj][m][e >> 2][e & 3];
                    const u32x4 o = pack8(v);
                    *(GAS u32x4*)(zout + (size_t)row * DM + cb + 128 * bj) = o;
                    *(GAS u32x2*)(z8 + (size_t)row * DM + cb + 128 * bj) = (u32x2){pk4_fp8(v[0], v[1], v[2], v[3]), pk4_fp8(v[4], v[5], v[6], v[7])};
                    float r[8]; unpack8(o, r);
#pragma unroll
                    for (int e = 0; e < 8; ++e) { sum += r[e]; sq += r[e] * r[e]; }
                }
                sum = rows_sum(sum); sq = rows_sum(sq);
                if (fq == 0) *(GAS f32x2*)(part + ((size_t)row * 16 + un.pn * 4 + wc) * 2) = (f32x2){sum, sq};
            }
        }
    }
};

__device__ __forceinline__ void conv_phase(const Frame& F, const bf16_t* u, const bf16_t* bg, const float* ck, unsigned char* y) {
    int tid = threadIdx.x; asm volatile("" : "+v"(tid)); const int lane = tid & 63, wave = __builtin_amdgcn_readfirstlane(tid >> 6); (void)lane; (void)wave;
    const int cg = tid & 127, rs = tid >> 7, t0 = 64 * F.jb + 16 * rs, c0 = 8 * cg;
    const size_t rowb = (size_t)2048 * F.batch;
    float k0[8], k1[8], k2[8], um2[8], um1[8];
    ld8(ck + c0, k0); ld8(ck + DM + c0, k1); ld8(ck + 2 * DM + c0, k2);
    if (t0 >= 2) { unpack8(*(const GAS u32x4*)(u + (rowb + t0 - 2) * DM + c0), um2); unpack8(*(const GAS u32x4*)(u + (rowb + t0 - 1) * DM + c0), um1); }
    else {
#pragma unroll
        for (int e = 0; e < 8; ++e) { um2[e] = 0.f; um1[e] = 0.f; } }
    for (int r4 = 0; r4 < 16; r4 += 16) {
        u32x4 uw[16], bw[16];
#pragma unroll
        for (int i = 0; i < 16; ++i) { const size_t row = rowb + t0 + r4 + i; uw[i] = *(const GAS u32x4*)(u + row * DM + c0); bw[i] = *(const GAS u32x4*)(bg + row * DM + c0); }
#pragma unroll
        for (int i = 0; i < 16; ++i) {
            const size_t row = rowb + t0 + r4 + i;
            float uc[8], b[8], o[8];
            unpack8(uw[i], uc); unpack8(bw[i], b);
#pragma unroll
            for (int e = 0; e < 8; ++e) { o[e] = b[e] * (k0[e] * um2[e] + k1[e] * um1[e] + k2[e] * uc[e]); um2[e] = um1[e]; um1[e] = uc[e]; }
            *(GAS u32x2*)(y + row * DM + c0) = (u32x2){pk4_fp8(o[0], o[1], o[2], o[3]), pk4_fp8(o[4], o[5], o[6], o[7])};
        }
    }
}

__device__ __forceinline__ f32x2 stats_from_part(const float* part, int row) {
    float s = 0.f, q = 0.f;
#pragma unroll
    for (int i = 0; i < 8; ++i) { const f32x4 p = *(const GAS f32x4*)(part + (size_t)row * 32 + 4 * i); s += p.x + p.z; q += p.y + p.w; }
    const float mu = s * (1.f / DM); float var = q * (1.f / DM) - mu * mu; var = var > 0.f ? var : 0.f;
    return (f32x2){mu, __builtin_amdgcn_rsqf(var + LN_EPS)};
}


constexpr int RT_LG = 0, RT_ST = 64 * 97 * 4, RT_HIST = RT_ST + 512, RT_BASE = RT_HIST + 256, RT_SEL = RT_BASE + 256, RT_GATE = RT_SEL + 1024;
__device__ __forceinline__ void router_phase(const Frame& F, const bf16_t* z, const float* part, float* stout, const bf16_t* wr_hi, const float* csr, const float* bsr,
                                             const float* rbg, const float* rbe, unsigned* cnt, unsigned* list, float* gate) {
    int tid = threadIdx.x; asm volatile("" : "+v"(tid)); const int lane = tid & 63, wave = __builtin_amdgcn_readfirstlane(tid >> 6);
    LAS unsigned char* aux = F.lds + LDS_AUX;
    LAS float* lg = (LAS float*)(aux + RT_LG); LAS float* stl = (LAS float*)(aux + RT_ST); LAS unsigned* hist = (LAS unsigned*)(aux + RT_HIST); LAS unsigned* base = (LAS unsigned*)(aux + RT_BASE);
    LAS unsigned* sel = (LAS unsigned*)(aux + RT_SEL); LAS float* gl = (LAS float*)(aux + RT_GATE);
    const int row0 = 2048 * F.batch + 64 * F.jb;
    if (tid < 64) { f32x2 s; if (part) { s = stats_from_part(part, row0 + tid); *(GAS f32x2*)(stout + 2 * (row0 + tid)) = s; } else s = *(const GAS f32x2*)(stout + 2 * (row0 + tid));
        stl[2 * tid] = s.x; stl[2 * tid + 1] = s.y; hist[tid] = 0u; }
    const int fr = lane & 15, fq = lane >> 4;
    f32x4 acc[4][6];
#pragma unroll
    for (int m = 0; m < 4; ++m)
#pragma unroll
        for (int j = 0; j < 6; ++j) acc[m][j] = (f32x4){0.f, 0.f, 0.f, 0.f};
    const bf16_t* ap = z + (size_t)(row0 + fr) * DM + 8 * fq;
    const bf16_t* wf = wr_hi + (size_t)lane * 8;
#pragma unroll 1
    for (int k4 = 0; k4 < 4; ++k4) {
        const int ks = 4 * wave + k4;
        bf16x8 a[4], bh[6], bl[6];
#pragma unroll
        for (int m = 0; m < 4; ++m) a[m] = *(const GAS bf16x8*)(ap + (size_t)(16 * m) * DM + 32 * ks);
#pragma unroll
        for (int j = 0; j < 6; ++j) { bh[j] = *(const GAS bf16x8*)(wf + ((size_t)(ks * 2 + 0) * 6 + j) * 512); bl[j] = *(const GAS bf16x8*)(wf + ((size_t)(ks * 2 + 1) * 6 + j) * 512); }
#pragma unroll
        for (int m = 0; m < 4; ++m)
#pragma unroll
            for (int j = 0; j < 6; ++j) { acc[m][j] = __builtin_amdgcn_mfma_f32_16x16x32_bf16(a[m], bh[j], acc[m][j], 0, 0, 0); acc[m][j] = __builtin_amdgcn_mfma_f32_16x16x32_bf16(a[m], bl[j], acc[m][j], 0, 0, 0); }
    }
    {
        LAS f32x4* slots = (LAS f32x4*)(F.lds + LDS_STAGE);
#pragma unroll
        for (int half = 4; half >= 1; half >>= 1) {
            __syncthreads();
            if (wave >= half && wave < 2 * half) {
#pragma unroll
                for (int m = 0; m < 4; ++m)
#pragma unroll
                    for (int j = 0; j < 6; ++j) slots[((wave - half) * 24 + m * 6 + j) * 64 + lane] = acc[m][j];
            }
            __syncthreads();
            if (wave < half) {
#pragma unroll
                for (int m = 0; m < 4; ++m)
#pragma unroll
                    for (int j = 0; j < 6; ++j) acc[m][j] += slots[(wave * 24 + m * 6 + j) * 64 + lane];
            }
        }
    }
    if (wave == 0) {
#pragma unroll
        for (int j = 0; j < 6; ++j) {
            const int n = 16 * j + fr;
            const float c = csr[n], b = bsr[n] + (n < 8 ? rbg[n] : (n < 72 ? rbe[n - 8] : 0.f));
#pragma unroll
            for (int m = 0; m < 4; ++m)
#pragma unroll
                for (int r = 0; r < 4; ++r) { const int tk = 16 * m + 4 * fq + r; lg[tk * 97 + n] = stl[2 * tk + 1] * (acc[m][j][r] - stl[2 * tk] * c) + b; }
        }
    }
    __syncthreads();
    if (tid < 64) {
        const LAS float* l = lg + tid * 97;
        int g = 0; float gm = l[0];
#pragma unroll
        for (int i = 1; i < 8; ++i) { const float v = l[i]; if (v > gm) { gm = v; g = i; } }
        float gs = 0.f;
#pragma unroll
        for (int i = 0; i < 8; ++i) gs += __expf(l[i] - gm);
        const float ggate = 1.f / gs;
        const LAS float* el = l + 8 + 8 * g;
        int i0 = 0; float v0 = el[0];
#pragma unroll
        for (int i = 1; i < 8; ++i) { const float v = el[i]; if (v > v0) { v0 = v; i0 = i; } }
        int i1 = -1; float v1 = 0.f;
#pragma unroll
        for (int i = 0; i < 8; ++i) { const float v = el[i]; if (i != i0 && (i1 < 0 || v > v1)) { v1 = v; i1 = i; } }
        const float ex = __expf(v1 - v0), p0 = 1.f / (1.f + ex), p1 = ex * p0;
        const unsigned e0 = 8 * g + i0, e1 = 8 * g + i1;
        const unsigned r0 = atomicAdd((unsigned*)(hist + e0), 1u), r1 = atomicAdd((unsigned*)(hist + e1), 1u);
        sel[4 * tid] = e0; sel[4 * tid + 1] = e1; sel[4 * tid + 2] = r0; sel[4 * tid + 3] = r1;
        gl[2 * tid] = p0 * ggate; gl[2 * tid + 1] = p1 * ggate;
    }
    __syncthreads();
    if (tid < 64) { const unsigned h = hist[tid]; base[tid] = h ? __hip_atomic_fetch_add(cnt + tid, h, __ATOMIC_RELAXED, __HIP_MEMORY_SCOPE_AGENT) : 0u; }
    __syncthreads();
    if (tid < 64) {
        const unsigned e0 = sel[4 * tid], e1 = sel[4 * tid + 1], tok = (unsigned)(row0 + tid);
        list[(size_t)e0 * 16384 + base[e0] + sel[4 * tid + 2]] = 2u * tok;
        list[(size_t)e1 * 16384 + base[e1] + sel[4 * tid + 3]] = 2u * tok + 1u;
        *(GAS f32x2*)(gate + 2 * tok) = (f32x2){gl[2 * tid], gl[2 * tid + 1]};
    }
}

constexpr int MS_PRE = 0, MS_N = 272, MS_DESC = 288, MS_DDN = 320, MS_ROFF = 512, MS_RINFO = MS_ROFF + 2 * 1024, MS_RDN = MS_RINFO + 2 * 1024, MS_CL = MS_RDN + 6 * 1024, MS_GDN = MS_CL + 256, MS_STUP = MS_GDN + 6 * 1024, MS_EPI = MS_STUP + 2 * 2048  , MS_END = MS_EPI + 3 * 2048;
static_assert(MS_END <= 31744, "MoE tables exceed the AUX region");
constexpr int MOE_MAXDN = 6;
__device__ __forceinline__ void moe_build(const Frame& F, const unsigned* cnt, const unsigned* list, const float* st, const float* gate) {
    int tid = threadIdx.x; asm volatile("" : "+v"(tid));
    LAS unsigned char* aux = F.lds + LDS_AUX;
    LAS unsigned* pre = (LAS unsigned*)(aux + MS_PRE); LAS unsigned* nd = (LAS unsigned*)(aux + MS_N); LAS unsigned* desc = (LAS unsigned*)(aux + MS_DESC); LAS unsigned* ddn = (LAS unsigned*)(aux + MS_DDN);
    LAS unsigned* roff = (LAS unsigned*)(aux + MS_ROFF); LAS unsigned* rinfo = (LAS unsigned*)(aux + MS_RINFO); LAS unsigned* rdn = (LAS unsigned*)(aux + MS_RDN);
    LAS unsigned* cl = (LAS unsigned*)(aux + MS_CL);
    __syncthreads();
    if (tid < 64) {
        const int lane = tid;
        const unsigned c = cnt[lane], nb = (c + 255u) >> 8;
        unsigned incl = nb;
#pragma unroll
        for (int o = 1; o < 64; o <<= 1) { const unsigned t = (unsigned)__builtin_amdgcn_ds_bpermute(((lane - o) & 63) << 2, (int)incl); incl += lane >= o ? t : 0u; }
        const unsigned excl = incl - nb;
        cl[lane] = c; pre[lane] = excl; if (lane == 63) pre[64] = incl;
        const unsigned NB = (unsigned)__builtin_amdgcn_readlane((int)incl, 63), G = (unsigned)F.G, v = (unsigned)((F.bx & 7) * (F.G >> 3) + (F.bx >> 3));
        const unsigned tup = 2u * NB, tdn = 4u * NB, nup2 = tup > G ? tup - G : 0u, nlight = G - nup2;
        unsigned n = 0;
#pragma unroll
        for (int k = 0; k < 2; ++k) {
            const unsigned u = v + (unsigned)k * G;
            if (u < tup) { const unsigned gb = u >> 1, nt = u & 1u;
                const unsigned e = (unsigned)__builtin_popcountll(__builtin_amdgcn_ballot_w64(excl <= gb)) - 1u;
                if (lane == 0) { desc[4 * k] = e; desc[4 * k + 1] = gb; desc[4 * k + 2] = nt; desc[4 * k + 3] = 0u; }
                n = (unsigned)k + 1u; }
        }
        const unsigned pos0 = v >= nup2 ? v - nup2 : nlight + v;
        unsigned m = 0;
#pragma unroll
        for (int k = 0; k < MOE_MAXDN; ++k) {
            const unsigned d = pos0 < nlight ? pos0 + (unsigned)k * nlight : 0xffffffffu;
            if (d < tdn && k < 4) { const unsigned gb = d >> 2, nt = d & 3u;
                const unsigned e = (unsigned)__builtin_popcountll(__builtin_amdgcn_ballot_w64(excl <= gb)) - 1u;
                if (lane == 0) { ddn[4 * m] = e; ddn[4 * m + 1] = gb; ddn[4 * m + 2] = nt; ddn[4 * m + 3] = 0u; }
                m = m + 1u; }
        }
        {
            const unsigned done4 = 4u * nlight;
#pragma unroll
            for (int k = 0; k < 2; ++k) {
                const unsigned d = done4 + v + (unsigned)k * G;
                if (d < tdn) { const unsigned gb = d >> 2, nt = d & 3u;
                    const unsigned e = (unsigned)__builtin_popcountll(__builtin_amdgcn_ballot_w64(excl <= gb)) - 1u;
                    if (lane == 0) { ddn[4 * m] = e; ddn[4 * m + 1] = gb; ddn[4 * m + 2] = nt; ddn[4 * m + 3] = 0u; }
                    m = m + 1u; }
            }
        }
        if (lane == 0) { nd[0] = n; nd[1] = m; }
    }
    __syncthreads();
    const unsigned n = nd[0], m = nd[1];
    for (unsigned i = 0; i < n; ++i) {
        if (tid < 256) { const unsigned e = desc[4 * i], gb = desc[4 * i + 1], idx = (gb - pre[e]) * 256u + (unsigned)tid, c = cl[e];
            LAS f32x2* stup = (LAS f32x2*)(aux + MS_STUP);
            if (idx < c) { const unsigned ts = list[(size_t)e * 16384 + idx]; roff[i * 256 + tid] = (ts >> 1) * (unsigned)DM; rinfo[i * 256 + tid] = ts; stup[i * 256 + tid] = *(const GAS f32x2*)(st + 2 * (ts >> 1)); }
            else { roff[i * 256 + tid] = 0u; rinfo[i * 256 + tid] = 0xffffffffu; stup[i * 256 + tid] = (f32x2){0.f, 1.f}; } }
    }
    for (unsigned i = 0; i < m; ++i) {
        if (tid >= 256) { const unsigned r = (unsigned)tid - 256u, e = ddn[4 * i], gb = ddn[4 * i + 1], idx = (gb - pre[e]) * 256u + r, c = cl[e];
            LAS float* gdn = (LAS float*)(aux + MS_GDN);
            if (idx < c) { const unsigned ts = list[(size_t)e * 16384 + idx]; rdn[i * 256 + r] = ts; gdn[i * 256 + r] = 16.f * gate[ts]; }
            else { rdn[i * 256 + r] = 0xffffffffu; gdn[i * 256 + r] = 0.f; } }
    }
    __syncthreads();
}
template <bool UP>
struct MoeSched {
    LAS unsigned char* aux; const char* Abase; const char* Wbase; unsigned* done;
    __device__ __forceinline__ bool next(int i, pg8::Unit& u) const {
        const unsigned n = ((const LAS unsigned*)(aux + MS_N))[UP ? 0 : 1]; if ((unsigned)i >= n) return false;
        const LAS unsigned* d = (const LAS unsigned*)(aux + (UP ? MS_DESC : MS_DDN)) + 4 * i; const unsigned e = d[0], gb = d[1], nt = d[2];
        if (UP) { u.A = Abase; u.B = Wbase + ((size_t)e * 512 + nt * 256) * DM; }
        else { u.A = Abase + (size_t)gb * 256 * DEXP; u.B = Wbase + ((size_t)e * DM + nt * 256) * DEXP; }
        u.pm = (int)gb; u.pn = (int)nt; u.x0 = (int)e; u.x1 = i; return true;
    }
    __device__ __forceinline__ const LAS unsigned* rowoff(int i) const { return (const LAS unsigned*)(aux + MS_ROFF) + 256 * i; }
    __device__ __forceinline__ void a_ready(const pg8::Unit& u) const {
        if (!UP) {
            int t = threadIdx.x; asm volatile("" : "+v"(t));
            if (__builtin_amdgcn_readfirstlane(t >> 6) == 0) {
                unsigned sp = 0;
                while ((unsigned)__builtin_amdgcn_readfirstlane((int)__hip_atomic_load(done + u.pm, __ATOMIC_RELAXED, __HIP_MEMORY_SCOPE_AGENT)) < 2u) { __builtin_amdgcn_s_sleep(2); if (++sp > (1u << 22)) break; }
                __builtin_amdgcn_fence(__ATOMIC_ACQUIRE, "agent");
                asm volatile("s_waitcnt vmcnt(0)" ::: "memory");
            }
            asm volatile("" ::: "memory"); __builtin_amdgcn_s_barrier(); asm volatile("" ::: "memory");
        }
    }
};
struct EpiUp {
    LAS unsigned char* aux; const float* st; const float* cs; const float* bs; unsigned char* h; unsigned* done;
    __device__ __forceinline__ void prefetch(const pg8::Unit& un, int slot, int wid, int lane) const {
        if (wid == 2 || wid == 3) { const char* s = (const char*)((wid == 2 ? cs : bs) + un.x0 * 512 + 256 * un.pn); int t = threadIdx.x; asm volatile("" : "+v"(t)); (void)lane;
            __builtin_amdgcn_global_load_lds((const unsigned*)(s + (t & 63) * 16), (LAS unsigned*)(aux + MS_EPI + slot * 2048 + (wid - 2) * 1024), 16, 0, 0); } }
    __device__ __forceinline__ void operator()(const f32x4 (&acc)[2][2][4][2], const pg8::Unit& un, int ui, int wr, int wc, int fr, int fq, int slot) const {
        asm volatile("" : "+v"(fr), "+v"(fq));
        const int colL = 32 * wc + 8 * fq;
        const LAS float* ep = (const LAS float*)(aux + MS_EPI + slot * 2048);
        float csv[2][8], bsv[2][8];
        ld8l(ep + colL, csv[0]); ld8l(ep + colL + 128, csv[1]); ld8l(ep + 256 + colL, bsv[0]); ld8l(ep + 256 + colL + 128, bsv[1]);
        const LAS unsigned* rinfo = (const LAS unsigned*)(aux + MS_RINFO) + 256 * ui;
        const LAS f32x2* stup = (const LAS f32x2*)(aux + MS_STUP) + 256 * ui; (void)rinfo;
        f32x2 sv[2][4];
#pragma unroll
        for (int ai = 0; ai < 2; ++ai)
#pragma unroll
            for (int m = 0; m < 4; ++m) sv[ai][m] = stup[128 * ai + 64 * wr + 16 * m + fr];
#pragma unroll
        for (int ai = 0; ai < 2; ++ai)
#pragma unroll
            for (int m = 0; m < 4; ++m) {
                const int r = 128 * ai + 64 * wr + 16 * m + fr;
                const f32x2 s = sv[ai][m];
                float p[8];
#pragma unroll
                for (int e = 0; e < 8; ++e) {
                    const float a1 = s.y * (acc[ai][0][m][e >> 2][e & 3] - s.x * csv[0][e]) + bsv[0][e];
                    const float a3 = s.y * (acc[ai][1][m][e >> 2][e & 3] - s.x * csv[1][e]) + bsv[1][e];
                    p[e] = a1 * __builtin_amdgcn_rcpf(1.f + __expf(-a1)) * a3;
                }
                st8wt(h + ((size_t)un.pm * 256 + r) * DEXP + 128 * un.pn + colL, (u32x2){pk4_fp8(p[0], p[1], p[2], p[3]), pk4_fp8(p[4], p[5], p[6], p[7])});
            }
        asm volatile("s_waitcnt vmcnt(0)" ::: "memory");
        __builtin_amdgcn_s_barrier();
        if (wr == 0 && wc == 0 && fr == 0 && fq == 0) __hip_atomic_fetch_add(done + un.pm, 1u, __ATOMIC_RELAXED, __HIP_MEMORY_SCOPE_AGENT);
    }
};
struct EpiDown {
    LAS unsigned char* aux; const float* gate; unsigned char* y;
    __device__ __forceinline__ void prefetch(const pg8::Unit&, int, int, int) const {}
    __device__ __forceinline__ void operator()(const f32x4 (&acc)[2][2][4][2], const pg8::Unit& un, int ui, int wr, int wc, int fr, int fq, int) const {
        const int cb = 256 * un.pn + 64 * wc + 16 * fq;
        const LAS unsigned* rinfo = (const LAS unsigned*)(aux + MS_RDN) + 256 * ui;
        const LAS float* gdn = (const LAS float*)(aux + MS_GDN) + 256 * ui;
        unsigned tsv[2][4]; float gvv[2][4];
#pragma unroll
        for (int ai = 0; ai < 2; ++ai)
#pragma unroll
            for (int m = 0; m < 4; ++m) { const int r = 128 * ai + 64 * wr + 16 * m + fr; tsv[ai][m] = rinfo[r]; gvv[ai][m] = gdn[r]; }
#pragma unroll
        for (int ai = 0; ai < 2; ++ai)
#pragma unroll
            for (int m = 0; m < 4; ++m) {
                const unsigned ts = tsv[ai][m];
                if (ts != 0xffffffffu) {
                    const float g = gvv[ai][m];
                    u32x4 o;
#pragma unroll
                    for (int bj = 0; bj < 2; ++bj) {
                        float p[8];
#pragma unroll
                        for (int e = 0; e < 8; ++e) p[e] = g * acc[ai][bj][m][e >> 2][e & 3];
                        o[2 * bj] = pk4_fp8(p[0], p[1], p[2], p[3]); o[2 * bj + 1] = pk4_fp8(p[4], p[5], p[6], p[7]);
                    }
                    *(GAS u32x4*)(y + (size_t)ts * DM + cb) = o;
                }
            }
    }
};


struct EpiAttnIn {
    const float* st; const float* cs; const float* bs; unsigned char* q; bf16_t* qi; float* misc; int pn0; LAS unsigned char* aux;
    __device__ __forceinline__ void prefetch(const pg8::Unit& un, int slot, int wid, int lane) const { epi_prefetch(aux + slot * 4096, st + 2 * 256 * un.pm, cs + 256 * (un.pn + pn0), bs + 256 * (un.pn + pn0), wid, lane); }
    __device__ __forceinline__ void operator()(const f32x4 (&acc)[2][2][4][2], const pg8::Unit& un, int, int wr, int wc, int fr, int fq, int slot) const {
        const int pn = un.pn + pn0;
        const int colL = 32 * wc + 8 * fq;
        const LAS unsigned char* ep = aux + slot * 4096;
        float csv[2][8], bsv[2][8];
        ld8l((const LAS float*)(ep + 2048) + colL, csv[0]); ld8l((const LAS float*)(ep + 2048) + colL + 128, csv[1]); ld8l((const LAS float*)(ep + 3072) + colL, bsv[0]); ld8l((const LAS float*)(ep + 3072) + colL + 128, bsv[1]);
        f32x2 sv[2][4];
#pragma unroll
        for (int ai = 0; ai < 2; ++ai)
#pragma unroll
            for (int m = 0; m < 4; ++m) sv[ai][m] = ((const LAS f32x2*)ep)[128 * ai + 64 * wr + 16 * m + fr];
#pragma unroll
        for (int ai = 0; ai < 2; ++ai)
#pragma unroll
            for (int m = 0; m < 4; ++m) {
                const int row = 256 * un.pm + 128 * ai + 64 * wr + 16 * m + fr;
                const f32x2 s = sv[ai][m];
#pragma unroll
                for (int bj = 0; bj < 2; ++bj) {
                    float f[8];
#pragma unroll
                    for (int e = 0; e < 8; ++e) f[e] = s.y * (acc[ai][bj][m][e >> 2][e & 3] - s.x * csv[bj][e]) + bsv[bj][e];
                    if (pn < 8) *(GAS u32x2*)(q + (size_t)row * 2048 + 256 * pn + 128 * bj + colL) = (u32x2){pk4_fp8(f[0], f[1], f[2], f[3]), pk4_fp8(f[4], f[5], f[6], f[7])};
                    else if (pn == 8) { float* d = misc + (size_t)row * 256 + 128 * bj + colL; *(f32x4*)d = (f32x4){f[0], f[1], f[2], f[3]}; *(GAS f32x4*)(d + 4) = (f32x4){f[4], f[5], f[6], f[7]}; }
                    else *(GAS u32x4*)(qi + (size_t)row * 512 + 256 * (pn - 9) + 128 * bj + colL) = pack8(f);
                }
            }
    }
};

__device__ __forceinline__ void attn_norm_phase(const Frame& F, const float* misc, const float* kvg, const float* kig, const float* kib, unsigned char* ckv8, bf16_t* ki) {
    int tid = threadIdx.x; asm volatile("" : "+v"(tid)); const int lane = tid & 63, wave = __builtin_amdgcn_readfirstlane(tid >> 6);
    const int row0 = 2048 * F.batch + 64 * F.jb + 8 * wave;
    const float g0 = kvg[2 * lane], g1 = kvg[2 * lane + 1], kg = kig[lane], kb = kib[lane];
    f32x2 cv[8]; float kv[8];
#pragma unroll
    for (int r = 0; r < 8; ++r) { cv[r] = *(const GAS f32x2*)(misc + (size_t)(row0 + r) * 256 + 2 * lane); kv[r] = misc[(size_t)(row0 + r) * 256 + 128 + lane]; }
#pragma unroll
    for (int r = 0; r < 8; ++r) {
        const int row = row0 + r;
        const f32x2 c = cv[r];
        const float k = kv[r];
        const float ss = wave_sum(c.x * c.x + c.y * c.y, lane);
        const float rinv = __builtin_amdgcn_rsqf(ss * (1.f / 128.f) + RMS_EPS);
        ((unsigned short*)(ckv8 + (size_t)row * 128))[lane] = (unsigned short)__builtin_amdgcn_cvt_pk_fp8_f32(c.x * rinv * g0, c.y * rinv * g1, 0, false);
        const float mu = wave_sum(k, lane) * (1.f / 64.f); const float d = k - mu;
        const float var = wave_sum(d * d, lane) * (1.f / 64.f);
        ki[(size_t)row * 64 + lane] = (bf16_t)f2bf(d * __builtin_amdgcn_rsqf(var + LN_EPS) * kg + kb);
    }
}

__device__ __forceinline__ unsigned sortable(float f) { const unsigned u = __builtin_bit_cast(unsigned, f); return (u & 0x80000000u) ? ~u : (u | 0x80000000u); }
__device__ __forceinline__ unsigned radix_select256(const unsigned (&k)[32], int nvalid, LAS unsigned* hist, int lane) {
    unsigned prefix = 0u, pmask = 0u, krem = 256u;
    int shift0 = 24;
    {
        unsigned mxk = 0u;
#pragma unroll
        for (int i = 0; i < 32; ++i) mxk = max(mxk, k[i]);
        unsigned dg = (unsigned)__builtin_amdgcn_readfirstlane((int)(wave_max_u(mxk) >> 24)), cum = 0u;
        bool found = false, whole = false;
#pragma unroll 1
        for (int c4 = 0; c4 < 4; ++c4) {
            unsigned c = 0u;
#pragma unroll
            for (int i = 0; i < 32; ++i) c += (k[i] != 0u && (k[i] >> 24) == dg) ? 1u : 0u;
            c = (unsigned)__builtin_amdgcn_readfirstlane((int)wave_sum_u(c));
            if (cum + c >= krem) { krem -= cum; prefix = dg << 24; pmask = 0xff000000u; found = true; whole = (c == krem); break; }
            cum += c;
            if (dg == 0u) break;
            dg -= 1u;
        }
        if (found) { if (whole) return prefix; shift0 = 16; }
    }
#pragma unroll 1
    for (int shift = shift0; shift >= 0; shift -= 8) {
#pragma unroll
        for (int j = 0; j < 4; ++j) hist[lane + 64 * j] = 0u;
        asm volatile("s_waitcnt lgkmcnt(0)" ::: "memory");
#pragma unroll
        for (int g8 = 0; g8 < 4; ++g8) if (512 * g8 < nvalid) {
#pragma unroll
            for (int i = 8 * g8; i < 8 * g8 + 8; ++i) { const unsigned key = k[i]; if (key != 0u && (key & pmask) == prefix) __hip_atomic_fetch_add(hist + ((key >> shift) & 255u), 1u, __ATOMIC_RELAXED, __HIP_MEMORY_SCOPE_WAVEFRONT); } }
        asm volatile("s_waitcnt lgkmcnt(0)" ::: "memory");
        unsigned h[4];
#pragma unroll
        for (int j = 0; j < 4; ++j) h[j] = hist[255 - 4 * lane - j];
        const unsigned local = (h[0] + h[1]) + (h[2] + h[3]);
        const unsigned incl = wave_incl_scan(local);
        const unsigned long long m = __builtin_amdgcn_ballot_w64(incl >= krem);
        const int L = __builtin_ctzll(m);
        unsigned cum = (unsigned)__builtin_amdgcn_readlane((int)(incl - local), L);
        const unsigned c0 = (unsigned)__builtin_amdgcn_readlane((int)h[0], L), c1 = (unsigned)__builtin_amdgcn_readlane((int)h[1], L), c2 = (unsigned)__builtin_amdgcn_readlane((int)h[2], L), c3 = (unsigned)__builtin_amdgcn_readlane((int)h[3], L);
        unsigned bin, cb;
        if (cum + c0 >= krem) { bin = 255u - 4u * L; cb = c0; }
        else { cum += c0; if (cum + c1 >= krem) { bin = 254u - 4u * L; cb = c1; } else { cum += c1; if (cum + c2 >= krem) { bin = 253u - 4u * L; cb = c2; } else { cum += c2; bin = 252u - 4u * L; cb = c3; } } }
        krem -= cum; prefix |= bin << shift; pmask |= 255u << shift;
        if (cb == krem) break;
    }
    return prefix;
}

__device__ __forceinline__ void index_unit(const Frame& F, const bf16_t* qi, const float* misc, const bf16_t* ki, unsigned short* sel, int b, int t0, int lane, int wave) {
    const int hh = lane >> 5, l31 = lane & 31;
    const size_t rb = (size_t)b * 2048;
    LAS unsigned* sc = (LAS unsigned*)(F.lds + LDS_STAGE);
    const LAS unsigned* bkt = (const LAS unsigned*)(F.lds + LDS_AUX);
#define IDX_PACK(key, t) ({ const int _k = (key), _d = (t) - _k; (unsigned short)(_k | (int)(bkt[_d < 0 ? 0 : (_d > 127 ? 127 : _d)] << 11)); })
    if (t0 < 256) {
#pragma unroll
        for (int qq = 0; qq < 2; ++qq) { const int t = t0 + 2 * wave + qq;
#pragma unroll
            for (int j = 0; j < 4; ++j) { const int idx = lane + 64 * j; sel[(rb + t) * 256 + idx] = idx <= t ? IDX_PACK(idx, t) : (unsigned short)0; } }
        return;
    }
    const int nkt = (t0 + 16 + 31) >> 5;
    {
        LAS unsigned char* aq_l = F.lds + LDS_AUX + 10240; LAS float* w_l = (LAS float*)(F.lds + LDS_AUX + 26624);
        { const char* src = (const char*)(qi + (rb + t0) * 512);
#pragma unroll
          for (int j = 0; j < 2; ++j) __builtin_amdgcn_global_load_lds((const unsigned*)(src + (2 * wave + j) * 1024 + lane * 16), (LAS unsigned*)(aq_l + (2 * wave + j) * 1024), 16, 0, 0);
          if (wave < 2) { const int i = 64 * wave + lane; w_l[i] = misc[(rb + t0 + (i >> 3)) * 256 + 192 + (i & 7)]; } }
        asm volatile("s_waitcnt vmcnt(0)" ::: "memory");
        __syncthreads();
        bf16x8 aq[4][4];
        { const int r = l31, head = (r & 3) + 4 * ((r >> 3) & 1), query = (r >> 4) + 2 * ((r >> 2) & 1);
#pragma unroll
          for (int mt = 0; mt < 4; ++mt) { const LAS unsigned char* ap = aq_l + ((4 * mt + query) * 8 + head) * 128 + 16 * hh;
#pragma unroll
              for (int ks = 0; ks < 4; ++ks) aq[mt][ks] = *(const LAS bf16x8*)(ap + 32 * ks); } }
        const bf16_t* kp = ki + (rb + l31) * 64 + 8 * hh;
        bf16x8 bk[4], bn[4];
        if (wave < nkt) {
#pragma unroll
            for (int ks = 0; ks < 4; ++ks) bk[ks] = *(const GAS bf16x8*)(kp + (size_t)wave * 2048 + 16 * ks); }
        for (int kt = wave; kt < nkt; kt += 8) {
            const bool more = kt + 8 < nkt;
            if (more) {
#pragma unroll
                for (int ks = 0; ks < 4; ++ks) bn[ks] = *(const GAS bf16x8*)(kp + (size_t)(kt + 8) * 2048 + 16 * ks); }
            const int key = 32 * kt + l31;
#pragma unroll
            for (int mt = 0; mt < 4; ++mt) {
                f32x16 acc;
#pragma unroll
                for (int e = 0; e < 16; ++e) acc[e] = 0.f;
#pragma unroll
                for (int ks = 0; ks < 4; ++ks) acc = __builtin_amdgcn_mfma_f32_32x32x16_bf16(aq[mt][ks], bk[ks], acc, 0, 0, 0);
                float s0 = 0.f, s1 = 0.f;
                {
                    const LAS f32x4* wp = (const LAS f32x4*)(w_l + (4 * mt + 2 * hh) * 8); const f32x4 wa = wp[0], wb = wp[1], wc = wp[2], wd = wp[3];
                    const float w0[8] = {wa.x, wa.y, wa.z, wa.w, wb.x, wb.y, wb.z, wb.w}, w1[8] = {wc.x, wc.y, wc.z, wc.w, wd.x, wd.y, wd.z, wd.w};
#pragma unroll
                    for (int e = 0; e < 8; ++e) { s0 += fmaxf(acc[e], 0.f) * w0[e]; s1 += fmaxf(acc[8 + e], 0.f) * w1[e]; }
                }
                const int tq = t0 + 4 * mt + 2 * hh;
                sc[(4 * mt + 2 * hh) * 2048 + key] = key <= tq ? sortable(s0) : 0u;
                sc[(4 * mt + 2 * hh + 1) * 2048 + key] = key <= tq + 1 ? sortable(s1) : 0u;
            }
            if (more) {
#pragma unroll
                for (int ks = 0; ks < 4; ++ks) bk[ks] = bn[ks]; }
        }
    }
    asm volatile("s_waitcnt lgkmcnt(0)" ::: "memory"); __builtin_amdgcn_s_barrier(); asm volatile("" ::: "memory");
    {
    unsigned ka[32], kb[32];
    const int nvalid = 32 * nkt;
#pragma unroll
    for (int i = 0; i < 32; ++i) { const int key = 64 * i + lane; const bool v = key < nvalid; ka[i] = v ? sc[(2 * wave) * 2048 + key] : 0u; kb[i] = v ? sc[(2 * wave + 1) * 2048 + key] : 0u; }
    LAS unsigned* hist = (LAS unsigned*)(F.lds + LDS_AUX + 1024 + wave * 1024);
    const unsigned Ta = radix_select256(ka, nvalid, hist, lane), Tb = radix_select256(kb, nvalid, hist, lane);
#pragma unroll
    for (int qq = 0; qq < 2; ++qq) {
        const unsigned T = qq ? Tb : Ta;
        unsigned nge = 0u;
#pragma unroll
        for (int g8 = 0; g8 < 4; ++g8) if (512 * g8 < nvalid) {
#pragma unroll
            for (int i = 8 * g8; i < 8 * g8 + 8; ++i) nge += (unsigned)__builtin_popcountll(__builtin_amdgcn_ballot_w64((qq ? kb[i] : ka[i]) >= T)); }
        LAS unsigned short* out = (LAS unsigned short*)hist + 256 * qq;
        unsigned base = 0u;
        if (nge == 256u) {
#pragma unroll
            for (int i = 0; i < 32; ++i) if (64 * i < nvalid) {
                const unsigned k = qq ? kb[i] : ka[i];
                const bool take = k >= T;
                const unsigned long long mtk = __builtin_amdgcn_ballot_w64(take);
                const unsigned tkbelow = __builtin_amdgcn_mbcnt_hi((unsigned)(mtk >> 32), __builtin_amdgcn_mbcnt_lo((unsigned)mtk, 0u));
                if (take) out[base + tkbelow] = IDX_PACK(64 * i + lane, t0 + 2 * wave + qq);
                base += (unsigned)__builtin_popcountll(mtk);
            }
        } else {
            unsigned ngt = 0u;
#pragma unroll
            for (int i = 0; i < 32; ++i) ngt += (unsigned)__builtin_popcountll(__builtin_amdgcn_ballot_w64((qq ? kb[i] : ka[i]) > T));
            const unsigned need = 256u - ngt;
            unsigned tbase = 0u;
#pragma unroll 4
            for (int i = 0; i < 32; ++i) if (64 * i < nvalid) {
                const unsigned k = qq ? kb[i] : ka[i];
                const bool eq = (k == T), gt = (k > T);
                const unsigned long long meq = __builtin_amdgcn_ballot_w64(eq);
                const unsigned eqbelow = __builtin_amdgcn_mbcnt_hi((unsigned)(meq >> 32), __builtin_amdgcn_mbcnt_lo((unsigned)meq, 0u));
                const bool take = gt || (eq && (tbase + eqbelow) < need);
                tbase += (unsigned)__builtin_popcountll(meq);
                const unsigned long long mtk = __builtin_amdgcn_ballot_w64(take);
                const unsigned tkbelow = __builtin_amdgcn_mbcnt_hi((unsigned)(mtk >> 32), __builtin_amdgcn_mbcnt_lo((unsigned)mtk, 0u));
                if (take) out[base + tkbelow] = IDX_PACK(64 * i + lane, t0 + 2 * wave + qq);
                base += (unsigned)__builtin_popcountll(mtk);
            }
        }
    }
    asm volatile("s_waitcnt lgkmcnt(0)" ::: "memory");
    *(GAS u32x4*)(sel + (rb + t0 + 2 * wave + (lane >> 5)) * 256 + 8 * (lane & 31)) = *(const LAS u32x4*)((const LAS unsigned char*)hist + 16 * lane);
    }
    asm volatile("s_waitcnt lgkmcnt(0)" ::: "memory"); __builtin_amdgcn_s_barrier(); asm volatile("" ::: "memory");
#undef IDX_PACK
}
__device__ __forceinline__ void index_phase(const Frame& F, const bf16_t* qi, const float* misc, const bf16_t* ki, unsigned short* sel) {
    int tid = threadIdx.x; asm volatile("" : "+v"(tid)); const int lane = tid & 63, wave = __builtin_amdgcn_readfirstlane(tid >> 6);
    if (tid < 128) { unsigned bk = (unsigned)tid; if (tid >= 16) { int v = 16 + (int)(__logf((float)tid / 16.f) / 2.0794415416798357f * 16.f); bk = (unsigned)(v < 31 ? v : 31); } ((LAS unsigned*)(F.lds + LDS_AUX))[tid] = bk; }
    __syncthreads();
    const int us[4] = {127 - F.jb, 64 + F.jb, 63 - F.jb, F.jb};
    for (int k = 0; k < 4; ++k) index_unit(F, qi, misc, ki, sel, F.batch, 16 * us[k], lane, wave);
}

constexpr int AT_P = 0  , AT_SCT = 17408  , AT_BIAS = 17920, AT_Q = 19968  , AT_SEL = 28160  ;
static_assert(AT_SEL + 3 * 1024 <= 31744, "attention tables exceed the AUX region");
__device__ __forceinline__ unsigned at_f(unsigned row) { return ((row >> 2) & 1u) | (((row >> 1) & 1u) << 1) | (((row >> 3) & 1u) << 2); }
__device__ __forceinline__ void attn_phase(const Frame& F, const unsigned char* q8, const unsigned char* ckv8, const unsigned short* sel, const float* relb, unsigned char* o) {
    int tid = threadIdx.x; asm volatile("" : "+v"(tid)); const int lane = tid & 63, wave = __builtin_amdgcn_readfirstlane(tid >> 6);
    const int fr = lane & 15, fq = lane >> 4;
    LAS unsigned char* aux = F.lds + LDS_AUX;
    LAS float* biast = (LAS float*)(aux + AT_BIAS);
    for (int i = tid; i < 512; i += NTHREADS) biast[i] = relb[i] * 1.4426950408889634f;
    const size_t rb = (size_t)F.batch * 2048;
    const int us0 = 127 - F.jb, us1 = 64 + F.jb, us2 = 63 - F.jb, us3 = F.jb;
#define AT_T(it) (16 * ((it) < 8 ? us0 : ((it) < 16 ? us1 : ((it) < 24 ? us2 : us3))) + 2 * ((it) & 7))
    const unsigned char* ckvb = ckv8 + rb * 128;
    const unsigned dl8 = (unsigned)lane >> 3, dp = (unsigned)lane & 7u;
#define AT_DMA_SEL(t, slot) do { if (wave == 0) \
        __builtin_amdgcn_global_load_lds((const unsigned*)((const unsigned char*)(sel + (rb + (t)) * 256) + 16 * lane), (LAS unsigned*)(aux + AT_SEL + (slot) * 1024), 16, 0, 16); } while (0)
#define AT_DMA_Q(t, buf) do { if (wave == 1) { _Pragma("unroll") for (int j = 0; j < 4; ++j) { const unsigned R = 8u * j + dl8; \
        __builtin_amdgcn_global_load_lds((const unsigned*)(q8 + (rb + (t)) * 2048 + R * 128u + ((dp ^ at_f(R)) << 4)), (LAS unsigned*)(aux + AT_Q + (buf) * 4096 + j * 1024), 16, 0, 0); } } } while (0)
#define AT_GATHER(buf, slot) do { const LAS unsigned short* sp = (const LAS unsigned short*)(aux + AT_SEL + (slot) * 1024) + 32 * wave + dl8; unsigned svv[8]; \
        _Pragma("unroll") for (int j = 0; j < 8; ++j) svv[j] = sp[256 * (j >> 2) + 8 * (j & 3)]; \
        asm volatile("s_waitcnt lgkmcnt(0)" : "+v"(svv[0]), "+v"(svv[1]), "+v"(svv[2]), "+v"(svv[3]), "+v"(svv[4]), "+v"(svv[5]), "+v"(svv[6]), "+v"(svv[7]) :: "memory");     \
        _Pragma("unroll") for (int j = 0; j < 8; ++j) { const unsigned row = 32u * wave + 8u * (j & 3) + dl8; \
        __builtin_amdgcn_global_load_lds((const unsigned*)(ckvb + (size_t)(svv[j] & 2047u) * 128 + ((dp ^ at_f(row)) << 4)), (LAS unsigned*)(F.lds + ((buf) * 2 + (j >> 2)) * 32768 + (32 * wave + 8 * (j & 3)) * 128), 16, 0, 0); } } while (0)
    AT_DMA_SEL(AT_T(0), 0); AT_DMA_SEL(AT_T(1), 1); AT_DMA_SEL(AT_T(2), 2); AT_DMA_Q(AT_T(0), 0); AT_DMA_Q(AT_T(1), 1);
    asm volatile("s_waitcnt vmcnt(0)" ::: "memory");
    __syncthreads();
    AT_GATHER(0, 0);
    const bf16x8 ones = {0x3F80, 0x3F80, 0x3F80, 0x3F80, 0x3F80, 0x3F80, 0x3F80, 0x3F80};
    const unsigned fsw = at_f((unsigned)fr);
    int s_cur = 0;
    for (int it = 0; it < 32; ++it) {
        const int t0 = AT_T(it), cur = it & 1;
        const int s_nxt = s_cur == 2 ? 0 : s_cur + 1, s_nn = s_nxt == 2 ? 0 : s_nxt + 1;
        if (it == 0) asm volatile("s_waitcnt vmcnt(0)" ::: "memory");
        asm volatile("s_waitcnt vmcnt(1) lgkmcnt(0)" ::: "memory");
        {
            i32x8 qv[2], kv[2][2]; u32x2 pcw[2][2];
#pragma unroll
            for (int qq = 0; qq < 2; ++qq) {
                const LAS unsigned char* qrow = aux + AT_Q + cur * 4096 + (16 * qq + fr) * 128;
                const u32x4 qb0 = *(const LAS u32x4*)(qrow + (((2u * fq) ^ fsw) << 4)), qb1 = *(const LAS u32x4*)(qrow + (((2u * fq + 1u) ^ fsw) << 4));
                qv[qq] = (i32x8){(int)qb0.x, (int)qb0.y, (int)qb0.z, (int)qb0.w, (int)qb1.x, (int)qb1.y, (int)qb1.z, (int)qb1.w};
                const LAS unsigned char* srow = aux + AT_SEL + s_cur * 1024 + qq * 512 + (32 * wave + 4 * fq) * 2;
#pragma unroll
                for (int mt = 0; mt < 2; ++mt) {
                    const LAS unsigned char* krow = F.lds + (cur * 2 + qq) * 32768 + (32 * wave + 16 * mt + fr) * 128;
                    const u32x4 k0 = *(const LAS u32x4*)(krow + (((2u * fq) ^ fsw) << 4)), k1 = *(const LAS u32x4*)(krow + (((2u * fq + 1u) ^ fsw) << 4));
                    kv[qq][mt] = (i32x8){(int)k0.x, (int)k0.y, (int)k0.z, (int)k0.w, (int)k1.x, (int)k1.y, (int)k1.z, (int)k1.w};
                    pcw[qq][mt] = *(const LAS u32x2*)(srow + 32 * mt);
                }
            }
            float bv[2][2][4];
#pragma unroll
            for (int qq = 0; qq < 2; ++qq)
#pragma unroll
                for (int mt = 0; mt < 2; ++mt) {
                    const unsigned pw[2] = {pcw[qq][mt].x, pcw[qq][mt].y};
#pragma unroll
                    for (int r = 0; r < 4; ++r) { const unsigned bucket = ((pw[r >> 1] >> (16 * (r & 1))) & 0xffffu) >> 11; bv[qq][mt][r] = biast[bucket * 16 + fr]; }
                }
            f32x4 sacc[2][2];
#pragma unroll
            for (int qq = 0; qq < 2; ++qq)
#pragma unroll
                for (int mt = 0; mt < 2; ++mt)
                    sacc[qq][mt] = __builtin_amdgcn_mfma_scale_f32_16x16x128_f8f6f4(kv[qq][mt], qv[qq], (f32x4){0.f, 0.f, 0.f, 0.f}, 0, 0, 0, 0x7F7F7F7F, 0, 0x7F7F7F7F);
#pragma unroll
            for (int qq = 0; qq < 2; ++qq) {
                const int nsel = t0 + qq + 1 < TOPK ? t0 + qq + 1 : TOPK;
                float v2[2][4]; float mx = -115.f;
#pragma unroll
                for (int mt = 0; mt < 2; ++mt)
#pragma unroll
                    for (int r = 0; r < 4; ++r) {
                        const int slot = 32 * wave + 16 * mt + 4 * fq + r;
                        const float v = fminf(sacc[qq][mt][r] * (0.08838834764831845f * 1.4426950408889634f) + bv[qq][mt][r], 80.f * 1.4426950408889634f);
                        v2[mt][r] = slot < nsel ? v : -1e30f; mx = fmaxf(mx, v2[mt][r]);
                    }
                {
                    const unsigned mb = __builtin_bit_cast(unsigned, mx);
                    const auto s16 = __builtin_amdgcn_permlane16_swap(mb, mb, false, false);
                    const float m1 = fmaxf(__builtin_bit_cast(float, (unsigned)s16[0]), __builtin_bit_cast(float, (unsigned)s16[1]));
                    const unsigned m1b = __builtin_bit_cast(unsigned, m1);
                    const auto s32 = __builtin_amdgcn_permlane32_swap(m1b, m1b, false, false);
                    mx = fmaxf(__builtin_bit_cast(float, (unsigned)s32[0]), __builtin_bit_cast(float, (unsigned)s32[1]));
                }
                const float ef = floorf(mx) + 1.f;
                LAS unsigned char* prow = aux + AT_P + cur * 8704 + qq * 4352 + fr * 272 + 32 * wave + 4 * fq;
#pragma unroll
                for (int mt = 0; mt < 2; ++mt)
                    *(LAS unsigned*)(prow + 16 * mt) = pk4_fp8(__builtin_amdgcn_exp2f(v2[mt][0] - ef), __builtin_amdgcn_exp2f(v2[mt][1] - ef), __builtin_amdgcn_exp2f(v2[mt][2] - ef), __builtin_amdgcn_exp2f(v2[mt][3] - ef));
                if (fq == 0) *(LAS unsigned char*)(aux + AT_SCT + cur * 256 + qq * 128 + fr * 8 + wave) = (unsigned char)(127 + (int)ef);
            }
        }
        asm volatile("s_waitcnt lgkmcnt(0)" ::: "memory"); __builtin_amdgcn_s_barrier(); asm volatile("" ::: "memory");
        if (it < 31) AT_GATHER(cur ^ 1, s_nxt);
        if (it < 30) AT_DMA_Q(AT_T(it + 2), cur);
        if (it < 29) AT_DMA_SEL(AT_T(it + 3), s_cur);
        {
            const int qq = wave >> 2; const unsigned db = (unsigned)wave & 3u;
            const unsigned img = (unsigned)(size_t)(F.lds + (cur * 2 + qq) * 32768);
            const LAS unsigned char* pbase = aux + AT_P + cur * 8704 + qq * 4352 + fr * 272 + 16 * fq;
            const LAS unsigned char* sbase = aux + AT_SCT + cur * 256 + qq * 128 + fr * 8 + fq;
            f32x4 oe = (f32x4){0.f, 0.f, 0.f, 0.f}, oo = (f32x4){0.f, 0.f, 0.f, 0.f}, tacc = (f32x4){0.f, 0.f, 0.f, 0.f};
            const unsigned r4 = (unsigned)(lane & 15) >> 2, c4 = (unsigned)lane & 3u;
            u32x2 ta[2][8]; u32x4 pf[2][2]; unsigned sb[2];
#pragma unroll
            for (int kb = 0; kb < 2; ++kb)
#pragma unroll
                for (int j = 0; j < 8; ++j) {
                    const unsigned row = 128u * kb + 64u * (j >> 2) + 16u * fq + 4u * (j & 3) + r4;
                    const unsigned a0 = img + row * 128u + (((2u * db + (c4 >> 1)) ^ at_f(row)) << 4) + 8u * (c4 & 1u);
                    asm volatile("ds_read_b64_tr_b16 %0, %1" : "=&v"(ta[kb][j]) : "v"(a0) : "memory");
                }
#pragma unroll
            for (int kb = 0; kb < 2; ++kb) { pf[kb][0] = *(const LAS u32x4*)(pbase + 128 * kb); pf[kb][1] = *(const LAS u32x4*)(pbase + 128 * kb + 64); sb[kb] = *(sbase + 4 * kb); }
            asm volatile("s_waitcnt lgkmcnt(0)" : "+v"(ta[0][0]), "+v"(ta[0][1]), "+v"(ta[0][2]), "+v"(ta[0][3]), "+v"(ta[0][4]), "+v"(ta[0][5]), "+v"(ta[0][6]), "+v"(ta[0][7]),
                         "+v"(ta[1][0]), "+v"(ta[1][1]), "+v"(ta[1][2]), "+v"(ta[1][3]), "+v"(ta[1][4]), "+v"(ta[1][5]), "+v"(ta[1][6]), "+v"(ta[1][7]) :: "memory");
            const i32x8 onesv = {0x38383838, 0x38383838, 0x38383838, 0x38383838, 0x38383838, 0x38383838, 0x38383838, 0x38383838};
#pragma unroll
            for (int kb = 0; kb < 2; ++kb) {
                i32x8 ev, od;
#pragma unroll
                for (int j = 0; j < 8; ++j) { ev[j] = (int)__builtin_amdgcn_perm(ta[kb][j].y, ta[kb][j].x, 0x06040200u); od[j] = (int)__builtin_amdgcn_perm(ta[kb][j].y, ta[kb][j].x, 0x07050301u); }
                const i32x8 pv8 = {(int)pf[kb][0].x, (int)pf[kb][0].y, (int)pf[kb][0].z, (int)pf[kb][0].w, (int)pf[kb][1].x, (int)pf[kb][1].y, (int)pf[kb][1].z, (int)pf[kb][1].w};
                oe = __builtin_amdgcn_mfma_scale_f32_16x16x128_f8f6f4(ev, pv8, oe, 0, 0, 0, 0x7F7F7F7F, 0, (int)sb[kb]);
                oo = __builtin_amdgcn_mfma_scale_f32_16x16x128_f8f6f4(od, pv8, oo, 0, 0, 0, 0x7F7F7F7F, 0, (int)sb[kb]);
                tacc = __builtin_amdgcn_mfma_scale_f32_16x16x128_f8f6f4(onesv, pv8, tacc, 0, 0, 0, 0x7F7F7F7F, 0, (int)sb[kb]);
            }
            const float inv = __builtin_amdgcn_rcpf(tacc[0]);
            *(GAS u32x2*)(o + ((rb + t0 + qq) * 16 + fr) * 128 + 32 * db + 8 * fq) = (u32x2){pk4_fp8(oe[0] * inv, oo[0] * inv, oe[1] * inv, oo[1] * inv), pk4_fp8(oe[2] * inv, oo[2] * inv, oe[3] * inv, oo[3] * inv)};
        }
        s_cur = s_nxt;
    }
    asm volatile("s_waitcnt vmcnt(0)" ::: "memory");
    __syncthreads();
#undef AT_DMA_SEL
#undef AT_DMA_Q
#undef AT_GATHER
#undef AT_T
}

__global__ void __launch_bounds__(NTHREADS, 2) fwd_kernel(Params P) {
    extern __shared__ __attribute__((aligned(16))) unsigned char lds_raw[];
    Frame F;
    F.lds = (LAS unsigned char*)lds_raw;
    F.G = gridDim.x; F.bx = blockIdx.x; F.batch = F.bx & 7; F.jb = F.bx >> 3; F.ws = P.ws;
    unsigned char* ws = P.ws;
    for (int u = threadIdx.x; u < 256; u += NTHREADS) ((LAS unsigned*)(F.lds + LDS_MISC))[u] = 0u;
    __syncthreads();
    XcdBarrier bar = xcd_barrier_post((unsigned*)(ws + WS_CTL) + CW_BAR, (volatile LAS unsigned*)(F.lds + LDS_MISC));
#define GRID_BAR() xcd_barrier<false>(bar)
#define GRID_BAR_L() xcd_barrier<true>(bar)
    if (threadIdx.x == 0) (void)xb_add((unsigned*)(ws + WS_CTL) + CW_XCC + F.bx, bar.x + 1u);

    bf16_t* zA; bf16_t* zB; float* stA; float* stB;
    const float* ones; const float* zeros;

    p0_prologue(F, P);
    GRID_BAR();
    {
        volatile LAS unsigned* okw = (volatile LAS unsigned*)(F.lds + LDS_MISC) + 3;
        if (threadIdx.x == 0) okw[0] = (F.G == 256) ? 1u : 0u;
        __syncthreads();
        if (threadIdx.x < 256 && (int)threadIdx.x < F.G) { unsigned* tab = (unsigned*)(ws + WS_CTL) + CW_XCC; const unsigned v = xb_ld(tab + threadIdx.x), r = xb_ld(tab + (threadIdx.x & 7)); if (v == 0u || v != r) okw[0] = 0u; }
        __syncthreads();
        if (threadIdx.x == 0) ((volatile LAS unsigned*)(F.lds + LDS_MISC))[2] = okw[0];
        __syncthreads();
    }
    {
        const float* csp = (const float*)(ws + WS_CSP); float* cs = (float*)(ws + WS_CSUP); float* bs = (float*)(ws + WS_BSUP);
        constexpr int NV = 4 * 64 * 512;
        for (int i = F.bx * NTHREADS + (int)threadIdx.x; i < NV; i += F.G * NTHREADS) {
            float a = 0.f, b = 0.f;
#pragma unroll 8
            for (int kt = 0; kt < 16; ++kt) { a += csp[(size_t)kt * NV + i]; b += csp[(size_t)(32 + kt) * NV + i]; }
            cs[i] = a; bs[i] = b;
        }
    }

    for (int layer = 0; layer < DEPTH; ++layer) {
        asm volatile("" : "+s"(ws));
        zA = (bf16_t*)(ws + WS_ZA); zB = (bf16_t*)(ws + WS_ZB); stA = (float*)(ws + WS_STA); stB = (float*)(ws + WS_STB); ones = (const float*)(ws + WS_VEC); zeros = ones + 1024;
        const float* gprev = layer ? P.in[I_L2G] + (layer - 1) * DM : ones;
        const float* bprev = layer ? P.in[I_L2B] + (layer - 1) * DM : zeros;
        const int jl = layer >> 1;
        bool have_part = false;
        if ((layer & 1) == 0) {
            {
                pg8::StaticOrder S; S.init(T_TOK, 3072, F.G, F.bx, zA, DM * 2, (const bf16_t*)(ws + WS_WCI) + (size_t)jl * 3072 * DM, DM * 2);
                EpiConvIn E{stA, (const float*)(ws + WS_CSCI) + jl * 3072, (const float*)(ws + WS_BSCI) + jl * 3072, (bf16_t*)(ws + WS_U), (bf16_t*)(ws + WS_BG), F.lds + LDS_AUX};
                pg8::gemm_phase<EpiConvIn, pg8::StaticOrder, false>(F.lds + LDS_STAGE, DM, DM * 2, DM * 2, S, E);
            }
            GRID_BAR_L();
            conv_phase(F, (const bf16_t*)(ws + WS_U), (const bf16_t*)(ws + WS_BG), P.in[I_CK] + (size_t)jl * 3 * DM, ws + WS_Y);
            GRID_BAR_L();
            {
                pg8::StaticOrder S; S.init(T_TOK, DM, F.G, F.bx, ws + WS_Y, DM, ws + WS_WCO + (size_t)jl * DM * DM, DM);
                EpiRes E{zA, stA, gprev, bprev, zB, (float*)(ws + WS_PART), ws + WS_Z8};
                pg8::gemm_phase<EpiRes, pg8::StaticOrder, false, true>(F.lds + LDS_STAGE, DM / 2, DM, DM, S, E, 127 - 6);
            }
            have_part = true;
            GRID_BAR_L();
        } else {
            {
                pg8::StaticOrder S; S.init(T_TOK, 2048, F.G, F.bx, ws + WS_ZA8, DM, ws + WS_WAI + (size_t)jl * AIWP * DM * 2, DM);
                EpiAttnIn E{stA, (const float*)(ws + WS_CSAI) + jl * AIWP, (const float*)(ws + WS_BSAI) + jl * AIWP, ws + WS_Q, (bf16_t*)(ws + WS_QI), (float*)(ws + WS_MISC), 0, F.lds + LDS_AUX};
                pg8::gemm_phase<EpiAttnIn, pg8::StaticOrder, false, true>(F.lds + LDS_STAGE, DM / 2, DM, DM, S, E);
            }
            {
                pg8::StaticOrder S; S.init(T_TOK, AIWP - 2048, F.G, F.bx, zA, DM * 2, (const bf16_t*)(ws + WS_WAI) + (size_t)jl * AIWP * DM + (size_t)2048 * DM, DM * 2);
                EpiAttnIn E{stA, (const float*)(ws + WS_CSAI) + jl * AIWP, (const float*)(ws + WS_BSAI) + jl * AIWP, ws + WS_Q, (bf16_t*)(ws + WS_QI), (float*)(ws + WS_MISC), 8, F.lds + LDS_AUX + 12288};
                pg8::gemm_phase<EpiAttnIn, pg8::StaticOrder, false>(F.lds + LDS_STAGE, DM, DM * 2, DM * 2, S, E);
            }
            GRID_BAR_L();
            attn_norm_phase(F, (const float*)(ws + WS_MISC), P.in[I_KVG] + jl * KVL, P.in[I_KIG] + jl * IDXD, P.in[I_KIB] + jl * IDXD, ws + WS_CKV, (bf16_t*)(ws + WS_KI));
            GRID_BAR_L();
            index_phase(F, (const bf16_t*)(ws + WS_QI), (const float*)(ws + WS_MISC), (const bf16_t*)(ws + WS_KI), (unsigned short*)(ws + WS_SEL));
            asm volatile("s_waitcnt vmcnt(0)" ::: "memory"); __syncthreads();
            attn_phase(F, ws + WS_Q, ws + WS_CKV, (const unsigned short*)(ws + WS_SEL), P.in[I_RELB], ws + WS_O);
            GRID_BAR_L();
            {
                pg8::StaticOrder S; S.init(T_TOK, DM, F.G, F.bx, ws + WS_O, 2048, ws + WS_WAO + (size_t)jl * DM * 2048, 2048);
                EpiRes E{zA, stA, gprev, bprev, zB, (float*)(ws + WS_PART), ws + WS_Z8};
                pg8::gemm_phase<EpiRes, pg8::StaticOrder, false, true>(F.lds + LDS_STAGE, 2048 / 2, 2048, 2048, S, E, 127 - 6);
            }
            have_part = true;
            GRID_BAR_L();
        }
        const float* partin = have_part ? (const float*)(ws + WS_PART) : nullptr;
        const unsigned char* ym = nullptr;
        {
            unsigned* cnt = (unsigned*)(ws + WS_CTL) + CW_CNT + 64 * layer; unsigned* list = (unsigned*)(ws + WS_LIST); float* gate = (float*)(ws + WS_GATE);
            const bf16_t* wrh = (const bf16_t*)(ws + WS_WR) + (size_t)layer * 32 * 2 * 6 * 512;
            router_phase(F, zB, partin, stB, wrh, (const float*)(ws + WS_CSR) + layer * 96, (const float*)(ws + WS_BSR) + layer * 96, P.in[I_RBG] + layer * 8, P.in[I_RBE] + layer * 64, cnt, list, gate);
            partin = nullptr;
            GRID_BAR();
            {
                unsigned* done = (unsigned*)(ws + WS_CTL) + CW_DONE + 256 * layer;
                moe_build(F, cnt, list, stB, gate);
                {
                    MoeSched<true> S{F.lds + LDS_AUX, (const char*)(ws + WS_Z8), (const char*)(ws + WS_WUP) + (size_t)layer * 64 * 512 * DM, done};
                    EpiUp E{F.lds + LDS_AUX, stB, (const float*)(ws + WS_CSUP) + (size_t)layer * 64 * 512, (const float*)(ws + WS_BSUP) + (size_t)layer * 64 * 512, ws + WS_H, done};
                    pg8::gemm_phase<EpiUp, MoeSched<true>, true, true>(F.lds + LDS_STAGE, DM / 2, DM, DM, S, E);
                }
                {
                    MoeSched<false> S{F.lds + LDS_AUX, (const char*)(ws + WS_H), (const char*)(ws + WS_WDN) + (size_t)layer * 64 * DM * DEXP, done};
                    EpiDown E{F.lds + LDS_AUX, gate, ws + WS_YM};
                    pg8::gemm_phase<EpiDown, MoeSched<false>, false, true>(F.lds + LDS_STAGE, DEXP / 2, DEXP, DEXP, S, E);
                }
            }
            GRID_BAR();
            ym = ws + WS_YM;
        }
        if (layer < DEPTH - 1) combine_phase<false>(F, zB, stB, partin, P.in[I_L1G] + layer * DM, P.in[I_L1B] + layer * DM, ym, zA, stA, nullptr, nullptr, nullptr, (layer & 1) ? nullptr : ws + WS_ZA8);
        else combine_phase<true>(F, zB, stB, partin, P.in[I_L1G] + layer * DM, P.in[I_L1B] + layer * DM, ym, nullptr, nullptr, P.in[I_L2G] + layer * DM, P.in[I_L2B] + layer * DM, P.out, nullptr);
        if (layer < DEPTH - 1) GRID_BAR_L();
    }
}

extern "C" void kernel_launch(void* const* d_in, const int* in_sizes, int n_in, void* d_out, int out_size, void* d_ws, size_t ws_size, hipStream_t stream) {
    static int grid = 0;
    if (!grid) {
        if (n_in != 21 || out_size != T_TOK * DM || ws_size < WS_END) { fprintf(stderr, "kernel_launch: unexpected shapes (n_in %d out %d ws %zu need %zu)\n", n_in, out_size, ws_size, (size_t)WS_END); grid = -1; return; }
        int dev = 0, cus = 0, per_cu = 0;
        hipGetDevice(&dev); hipDeviceGetAttribute(&cus, hipDeviceAttributeMultiprocessorCount, dev);
        if (hipFuncSetAttribute((const void*)fwd_kernel, hipFuncAttributeMaxDynamicSharedMemorySize, LDS_BYTES) != hipSuccess) { fprintf(stderr, "kernel_launch: hipFuncSetAttribute failed\n"); grid = -1; return; }
        hipOccupancyMaxActiveBlocksPerMultiprocessor(&per_cu, (const void*)fwd_kernel, NTHREADS, LDS_BYTES);
        if (per_cu < 1) fprintf(stderr, "kernel_launch: occupancy query reports %d\n", per_cu);
        grid = 256;
        if (cus != 256) fprintf(stderr, "kernel_launch: %d CUs (built for 256)\n", cus);
    }
    if (grid <= 0) return;
    hipMemsetAsync((char*)d_ws + WS_CTL, 0, CTL_BYTES, stream);
    Params p{};
    for (int i = 0; i < 21; ++i) p.in[i] = (const float*)d_in[i];
    p.out = (float*)d_out; p.ws = (unsigned char*)d_ws; p.ph_lo = 0; p.ph_hi = 1000;
    hipLaunchKernelGGL(fwd_kernel, dim3(grid), dim3(NTHREADS), LDS_BYTES, stream, p);
}
```
